# Optimizing an MI355X kernel written in HIP

```python
import jax, jax.numpy as jnp
from jax import lax
import numpy as np

D_MODEL = 1024
BATCH = 8
SEQ = 2048
DEPTH = 1

HEAD_DIM = 64
N_ATTN_HEADS = 8
ATTN_WIDTH = N_ATTN_HEADS * HEAD_DIM
Q_BLOCK = 128
N_SGU_GROUPS = 8
SGU_GROUP_DIM = 64
SGU_WIDTH = N_SGU_GROUPS * SGU_GROUP_DIM
CHUNK = 128
N_BRANCHES = 2
OFF_Q = 0
OFF_K = OFF_Q + ATTN_WIDTH
OFF_V = OFF_K + ATTN_WIDTH
OFF_F = OFF_V + ATTN_WIDTH
OFF_UG = OFF_F + N_ATTN_HEADS
OFF_VG = OFF_UG + SGU_WIDTH
OFF_GATE = OFF_VG + SGU_WIDTH
IN_WIDTH = OFF_GATE + N_BRANCHES * D_MODEL
PEER_HEADS = 8
PEER_N_KEYS = 128
PEER_N_EXPERTS = PEER_N_KEYS * PEER_N_KEYS
PEER_KEY_DIM = 256
PEER_HALF = PEER_KEY_DIM // 2
PEER_TOPK = 16
PEER_TOKEN_BLOCK = 128
EPS = 1e-6

kernel_name = "hybrid_fox_sgu_peer_block"


def rmsnorm(x, g):
    x32 = x.astype(jnp.float32)
    r = x32 * lax.rsqrt(jnp.mean(x32 * x32, axis=-1, keepdims=True) + EPS)
    return (r * g.astype(jnp.float32)).astype(x.dtype)


def forgetting_attention(q, k, v, log_f):
    B, H, S, Dh = q.shape
    c = jnp.cumsum(log_f, axis=-1)
    scale = Dh ** -0.5
    neg = jnp.finfo(jnp.float32).min
    outs = []
    for i in range(S // Q_BLOCK):
        q0 = i * Q_BLOCK
        end = q0 + Q_BLOCK
        qb = q[:, :, q0:end]
        kb = k[:, :, :end]
        vb = v[:, :, :end]
        logits = jnp.einsum('bhqd,bhkd->bhqk', qb, kb, preferred_element_type=jnp.float32) * scale
        logits = logits + c[:, :, q0:end, None] - c[:, :, None, :end]
        causal = (q0 + jnp.arange(Q_BLOCK))[:, None] >= jnp.arange(end)[None, :]
        logits = jnp.where(causal[None, None], logits, neg)
        p = jax.nn.softmax(logits, axis=-1)
        outs.append(jnp.einsum('bhqk,bhkd->bhqd', p.astype(vb.dtype), vb))
    return jnp.concatenate(outs, axis=2)


def chunked_spatial_gating(u, v, ln_g, ln_b, w_s, b_s):
    B, S, W = v.shape
    v32 = v.astype(jnp.float32)
    mu = jnp.mean(v32, axis=-1, keepdims=True)
    var = jnp.mean(jnp.square(v32 - mu), axis=-1, keepdims=True)
    vn = ((v32 - mu) * lax.rsqrt(var + EPS) * ln_g.astype(jnp.float32) + ln_b.astype(jnp.float32)).astype(v.dtype)
    vn = vn.reshape(B, S // CHUNK, CHUNK, N_SGU_GROUPS, SGU_GROUP_DIM)
    mask = jnp.tril(jnp.ones((CHUNK, CHUNK), dtype=w_s.dtype))
    w = w_s * mask[None]
    z = jnp.einsum('gts,bnsgc->bntgc', w, vn) + b_s.T[None, None, :, :, None]
    return u * z.reshape(B, S, W).astype(u.dtype)


def peer_ffn(h, w_query, sub_keys, expert_u, expert_v):
    B, S, D = h.shape
    T = B * S
    xt = h.reshape(T, D)
    q = (xt @ w_query).reshape(T, PEER_HEADS, 2, PEER_HALF)
    scores = jnp.einsum('thpk,hpnk->thpn', q, sub_keys, preferred_element_type=jnp.float32)
    s_top, i_top = lax.top_k(scores, PEER_TOPK)
    cand_s = s_top[:, :, 0, :, None] + s_top[:, :, 1, None, :]
    cand_i = i_top[:, :, 0, :, None] * PEER_N_KEYS + i_top[:, :, 1, None, :]
    cand_s = cand_s.reshape(T, PEER_HEADS, PEER_TOPK * PEER_TOPK)
    cand_i = cand_i.reshape(T, PEER_HEADS, PEER_TOPK * PEER_TOPK)
    best_s, best_pos = lax.top_k(cand_s, PEER_TOPK)
    expert_idx = jnp.take_along_axis(cand_i, best_pos, axis=-1)
    gate = jax.nn.softmax(best_s, axis=-1)
    HK = PEER_HEADS * PEER_TOPK
    n_blk = T // PEER_TOKEN_BLOCK

    def block_fn(args):
        xb, idx, g = args
        u = expert_u[idx]
        a = jax.nn.gelu(jnp.einsum('td,tkd->tk', xb, u, preferred_element_type=jnp.float32), approximate=False)
        vv = expert_v[idx]
        return jnp.einsum('tk,tkd->td', (g * a).astype(vv.dtype), vv)

    out = lax.map(block_fn, (xt.reshape(n_blk, PEER_TOKEN_BLOCK, D),
                             expert_idx.reshape(n_blk, PEER_TOKEN_BLOCK, HK),
                             gate.reshape(n_blk, PEER_TOKEN_BLOCK, HK)))
    return out.reshape(B, S, D)


def setup_inputs(seed: int = 0) -> dict:
    key = jax.random.key(seed)
    ks = jax.random.split(key, 20)
    L = DEPTH
    f32 = jnp.float32

    def nrm(k, shape, scale):
        return jax.random.normal(k, shape, f32) * scale

    x = jax.random.normal(ks[0], (BATCH, SEQ, D_MODEL), f32)
    norm_mix_g = 1.0 + nrm(ks[1], (L, D_MODEL), 0.01)
    w_in = nrm(ks[2], (L, D_MODEL, IN_WIDTH), D_MODEL ** -0.5)
    b_f = jax.random.uniform(ks[3], (L, N_ATTN_HEADS), f32, minval=1.0, maxval=4.0)
    sgu_ln_g = 1.0 + nrm(ks[4], (L, SGU_WIDTH), 0.01)
    sgu_ln_b = nrm(ks[5], (L, SGU_WIDTH), 0.01)
    w_s = nrm(ks[6], (L, N_SGU_GROUPS, CHUNK, CHUNK), CHUNK ** -0.5)
    b_s = 1.0 + nrm(ks[7], (L, N_SGU_GROUPS, CHUNK), 0.01)
    w_branch_a = nrm(ks[8], (L, ATTN_WIDTH, D_MODEL), ATTN_WIDTH ** -0.5)
    w_branch_b = nrm(ks[9], (L, SGU_WIDTH, D_MODEL), SGU_WIDTH ** -0.5)
    w_out = nrm(ks[10], (L, D_MODEL, D_MODEL), D_MODEL ** -0.5)
    norm_ffn_g = 1.0 + nrm(ks[11], (L, D_MODEL), 0.01)
    w_query = nrm(ks[12], (L, D_MODEL, PEER_HEADS * PEER_KEY_DIM), D_MODEL ** -0.5)
    sub_keys = nrm(ks[13], (L, PEER_HEADS, 2, PEER_N_KEYS, PEER_HALF), PEER_HALF ** -0.5)
    expert_u = nrm(ks[14], (L, PEER_N_EXPERTS, D_MODEL), D_MODEL ** -0.5)
    expert_v = nrm(ks[15], (L, PEER_N_EXPERTS, D_MODEL), 0.5)
    norm_final_g = 1.0 + nrm(ks[16], (D_MODEL,), 0.01)
    return {"x": x, "norm_mix_g": norm_mix_g, "w_in": w_in, "b_f": b_f,
            "sgu_ln_g": sgu_ln_g, "sgu_ln_b": sgu_ln_b, "w_s": w_s, "b_s": b_s,
            "w_branch_a": w_branch_a, "w_branch_b": w_branch_b, "w_out": w_out,
            "norm_ffn_g": norm_ffn_g, "w_query": w_query, "sub_keys": sub_keys,
            "expert_u": expert_u, "expert_v": expert_v, "norm_final_g": norm_final_g}


def reference(x, norm_mix_g, w_in, b_f, sgu_ln_g, sgu_ln_b, w_s, b_s, w_branch_a, w_branch_b,
              w_out, norm_ffn_g, w_query, sub_keys, expert_u, expert_v, norm_final_g):
    B, S, D = x.shape
    for l in range(DEPTH):
        h = rmsnorm(x, norm_mix_g[l])
        proj = h @ w_in[l]
        q = proj[..., OFF_Q:OFF_K].reshape(B, S, N_ATTN_HEADS, HEAD_DIM).transpose(0, 2, 1, 3)
        k = proj[..., OFF_K:OFF_V].reshape(B, S, N_ATTN_HEADS, HEAD_DIM).transpose(0, 2, 1, 3)
        v = proj[..., OFF_V:OFF_F].reshape(B, S, N_ATTN_HEADS, HEAD_DIM).transpose(0, 2, 1, 3)
        log_f = jax.nn.log_sigmoid(proj[..., OFF_F:OFF_UG].astype(jnp.float32)
                                   + b_f[l].astype(jnp.float32)).transpose(0, 2, 1)
        y_a = forgetting_attention(q, k, v, log_f).transpose(0, 2, 1, 3).reshape(B, S, ATTN_WIDTH)
        u_g = jax.nn.gelu(proj[..., OFF_UG:OFF_VG], approximate=False)
        v_g = jax.nn.gelu(proj[..., OFF_VG:OFF_GATE], approximate=False)
        y_b = chunked_spatial_gating(u_g, v_g, sgu_ln_g[l], sgu_ln_b[l], w_s[l], b_s[l])
        gates = jax.nn.sigmoid(proj[..., OFF_GATE:].astype(jnp.float32)).reshape(B, S, N_BRANCHES, D)
        merged = (gates[:, :, 0] * (y_a @ w_branch_a[l]).astype(jnp.float32)
                  + gates[:, :, 1] * (y_b @ w_branch_b[l]).astype(jnp.float32)).astype(x.dtype)
        x = x + merged @ w_out[l]
        h2 = rmsnorm(x, norm_ffn_g[l])
        x = x + peer_ffn(h2, w_query[l], sub_keys[l], expert_u[l], expert_v[l])
    return rmsnorm(x, norm_final_g)
```

```cpp
#include <hip/hip_runtime.h>
#include <cstdint>
#include <cmath>

constexpr int D = 1024, BATCH = 8, SEQ = 2048, M = BATCH * SEQ;
constexpr int NH = 8, HD = 64, AW = 512, SW = 512, CHUNK = 128, NG = 8, GD = 64;
constexpr int OFF_Q = 0, OFF_K = 512, OFF_V = 1024, OFF_F = 1536, OFF_UG = 1544, OFF_VG = 2056, OFF_GATE = 2568, IN_W = 4616;
constexpr int PH = 8, PKEYS = 128, PHALF = 128, PTOP = 16, NEXP = 16384, QPW = 2048, HK = 128;
constexpr float EPS = 1e-6f;
constexpr float LOG2E = 1.4426950408889634f;
constexpr float C2 = 0.125f * LOG2E;

constexpr size_t MiB = 1u << 20;
constexpr size_t WS_CTL = 0;
constexpr size_t WS_XN = 84 * MiB;
constexpr size_t WS_Q = 116 * MiB;
constexpr size_t WS_K = 132 * MiB;
constexpr size_t WS_V = 148 * MiB;
constexpr size_t WS_UG = 164 * MiB;
constexpr size_t WS_VG = 180 * MiB;
constexpr size_t WS_LOGF = 196 * MiB;
constexpr size_t WS_CL2 = 197 * MiB;
constexpr size_t WS_STAT = 198 * MiB;
constexpr size_t WS_MERGED = WS_K;
constexpr size_t WS_QP = WS_Q;
constexpr size_t WS_PIDX = WS_VG;
constexpr size_t WS_PGATE = WS_VG + 8 * MiB;

typedef unsigned short bf16_t;
__device__ __forceinline__ float bf2f(bf16_t v) { return __uint_as_float((unsigned)v << 16); }
__device__ __forceinline__ bf16_t f2bf(float f) { unsigned u = __float_as_uint(f); return (bf16_t)((u + 0x7fffu + ((u >> 16) & 1u)) >> 16); }
__device__ __forceinline__ float gelu_exact(float v) { return 0.5f * v * (1.0f + erff(v * 0.70710678118654752f)); }
__device__ __forceinline__ float sigmoidf_(float v) { return 1.0f / (1.0f + __expf(-v)); }
__device__ __forceinline__ float log_sigmoid(float z) { return z > 0.f ? -log1pf(expf(-z)) : z - log1pf(expf(z)); }
__device__ __forceinline__ float wave_sum(float v) {
#pragma unroll
    for (int o = 1; o < 64; o <<= 1) v += __shfl_xor(v, o);
    return v;
}
__device__ __forceinline__ float wave_max(float v) {
#pragma unroll
    for (int o = 1; o < 64; o <<= 1) v = fmaxf(v, __shfl_xor(v, o));
    return v;
}

namespace nv {
__global__ void __launch_bounds__(256) rmsnorm_bf16(const float* __restrict__ x, const float* __restrict__ g, bf16_t* __restrict__ out) {
    const int row = blockIdx.x * 4 + (threadIdx.x >> 6), lane = threadIdx.x & 63;
    const float* xr = x + (size_t)row * D;
    float v[16]; float s = 0.f;
#pragma unroll
    for (int j = 0; j < 16; ++j) { v[j] = xr[lane + 64 * j]; s += v[j] * v[j]; }
    const float r = rsqrtf(wave_sum(s) * (1.0f / D) + EPS);
#pragma unroll
    for (int j = 0; j < 16; ++j) out[(size_t)row * D + lane + 64 * j] = f2bf(v[j] * r * g[lane + 64 * j]);
}
__global__ void __launch_bounds__(256) rmsnorm_f32_inplace(float* __restrict__ x, const float* __restrict__ g) {
    const int row = blockIdx.x * 4 + (threadIdx.x >> 6), lane = threadIdx.x & 63;
    float* xr = x + (size_t)row * D;
    float v[16]; float s = 0.f;
#pragma unroll
    for (int j = 0; j < 16; ++j) { v[j] = xr[lane + 64 * j]; s += v[j] * v[j]; }
    const float r = rsqrtf(wave_sum(s) * (1.0f / D) + EPS);
#pragma unroll
    for (int j = 0; j < 16; ++j) xr[lane + 64 * j] = v[j] * r * g[lane + 64 * j];
}

struct GemmArgs {
    const bf16_t* A; int lda; const float* B; int ldb; int N; int K; int mode;
    bf16_t *Q, *Kb, *V, *UG, *VG, *GATE, *MERGED, *QP; float* LOGF; const float* bf; const float* x; float* x1;
};
__global__ void __launch_bounds__(256) gemm_naive(GemmArgs a) {
    __shared__ float As[16][65];
    __shared__ float Bs[16][64];
    const int tid = threadIdx.x, tx = tid & 15, ty = tid >> 4;
    const int m0 = blockIdx.y * 64, n0 = blockIdx.x * 64;
    float acc[4][4];
#pragma unroll
    for (int i = 0; i < 4; ++i)
#pragma unroll
        for (int j = 0; j < 4; ++j) acc[i][j] = 0.f;
    for (int k0 = 0; k0 < a.K; k0 += 16) {
        {
            const int r = tid >> 2, kk = (tid & 3) * 4;
#pragma unroll
            for (int i = 0; i < 4; ++i) As[kk + i][r] = bf2f(a.A[(size_t)(m0 + r) * a.lda + k0 + kk + i]);
        }
        {
            const int kk = tid >> 4, c = (tid & 15) * 4;
#pragma unroll
            for (int i = 0; i < 4; ++i) { const int col = n0 + c + i; Bs[kk][c + i] = col < a.N ? a.B[(size_t)(k0 + kk) * a.ldb + col] : 0.f; }
        }
        __syncthreads();
#pragma unroll
        for (int kk = 0; kk < 16; ++kk) {
            float av[4], bv[4];
#pragma unroll
            for (int i = 0; i < 4; ++i) av[i] = As[kk][ty * 4 + i];
#pragma unroll
            for (int j = 0; j < 4; ++j) bv[j] = Bs[kk][tx * 4 + j];
#pragma unroll
            for (int i = 0; i < 4; ++i)
#pragma unroll
                for (int j = 0; j < 4; ++j) acc[i][j] += av[i] * bv[j];
        }
        __syncthreads();
    }
#pragma unroll
    for (int i = 0; i < 4; ++i)
#pragma unroll
        for (int j = 0; j < 4; ++j) {
            const int t = m0 + ty * 4 + i, c = n0 + tx * 4 + j; const float v = acc[i][j];
            if (c >= a.N) continue;
            if (a.mode == 0) {
                if (c < OFF_K) a.Q[(size_t)t * AW + c] = f2bf(v * C2);
                else if (c < OFF_V) a.Kb[(size_t)t * AW + c - OFF_K] = f2bf(v);
                else if (c < OFF_F) a.V[(size_t)t * AW + c - OFF_V] = f2bf(v);
                else if (c < OFF_UG) a.LOGF[(size_t)t * NH + c - OFF_F] = log_sigmoid(v + a.bf[c - OFF_F]);
                else if (c < OFF_VG) a.UG[(size_t)t * SW + c - OFF_UG] = f2bf(gelu_exact(v));
                else if (c < OFF_GATE) a.VG[(size_t)t * SW + c - OFF_VG] = f2bf(gelu_exact(v));
                else a.GATE[(size_t)t * 2048 + c - OFF_GATE] = f2bf(sigmoidf_(v));
            } else if (a.mode == 1) {
                a.MERGED[(size_t)t * D + c] = f2bf(bf2f(a.GATE[(size_t)t * 2048 + c]) * v);
            } else if (a.mode == 2) {
                a.MERGED[(size_t)t * D + c] = f2bf(bf2f(a.MERGED[(size_t)t * D + c]) + bf2f(a.GATE[(size_t)t * 2048 + 1024 + c]) * v);
            } else if (a.mode == 3) {
                a.x1[(size_t)t * D + c] = a.x[(size_t)t * D + c] + v;
            } else {
                a.QP[(size_t)t * QPW + c] = f2bf(v);
            }
        }
}

__global__ void __launch_bounds__(64) cumsum_logf(const float* __restrict__ logf, float* __restrict__ cl2) {
    const int bh = blockIdx.x, b = bh / NH, h = bh % NH, lane = threadIdx.x;
    float run = 0.f;
    for (int s0 = 0; s0 < SEQ; s0 += 64) {
        float v = logf[(size_t)(b * SEQ + s0 + lane) * NH + h];
#pragma unroll
        for (int o = 1; o < 64; o <<= 1) { const float u = __shfl_up(v, o); if (lane >= o) v += u; }
        v += run;
        cl2[(size_t)bh * SEQ + s0 + lane] = v * LOG2E;
        run = __shfl(v, 63);
    }
}

__global__ void __launch_bounds__(64) attn_naive(const bf16_t* __restrict__ Q, const bf16_t* __restrict__ Kb, const bf16_t* __restrict__ V, const float* __restrict__ cl2, bf16_t* __restrict__ O) {
    __shared__ float qs[64];
    const int idx = blockIdx.x, t = idx % SEQ, h = (idx / SEQ) % NH, b = idx / (SEQ * NH), lane = threadIdx.x;
    const size_t rowb = (size_t)b * SEQ;
    qs[lane] = bf2f(Q[(rowb + t) * AW + h * HD + lane]);
    __syncthreads();
    const float* c = cl2 + (size_t)(b * NH + h) * SEQ;
    const float ct = c[t];
    float mrun = -INFINITY, lrun = 0.f, o = 0.f;
    for (int s0 = 0; s0 <= t; s0 += 64) {
        const int s = s0 + lane;
        float lg = -INFINITY;
        if (s <= t) {
            const bf16_t* kr = Kb + (rowb + s) * AW + h * HD; float d = 0.f;
#pragma unroll 8
            for (int i = 0; i < 64; ++i) d += qs[i] * bf2f(kr[i]);
            lg = d + ct - c[s];
        }
        const float mb = wave_max(lg), mn = fmaxf(mrun, mb), f = exp2f(mrun - mn);
        const float p = (s <= t) ? exp2f(lg - mn) : 0.f;
        lrun = lrun * f + wave_sum(p); o *= f; mrun = mn;
        const int cnt = min(64, t - s0 + 1);
        for (int l = 0; l < cnt; ++l) { const float pl = __shfl(p, l); o += pl * bf2f(V[(rowb + s0 + l) * AW + h * HD + lane]); }
    }
    O[(rowb + t) * AW + h * HD + lane] = f2bf(o / lrun);
}

__global__ void __launch_bounds__(256) sgu_stats(const bf16_t* __restrict__ VG, float* __restrict__ st) {
    const int row = blockIdx.x * 4 + (threadIdx.x >> 6), lane = threadIdx.x & 63;
    float v[8]; float s = 0.f;
#pragma unroll
    for (int j = 0; j < 8; ++j) { v[j] = bf2f(VG[(size_t)row * SW + lane + 64 * j]); s += v[j]; }
    const float mu = wave_sum(s) * (1.f / SW); float q = 0.f;
#pragma unroll
    for (int j = 0; j < 8; ++j) { const float d = v[j] - mu; q += d * d; }
    const float var = wave_sum(q) * (1.f / SW);
    if (lane == 0) { st[2 * row] = mu; st[2 * row + 1] = rsqrtf(var + EPS); }
}
__global__ void __launch_bounds__(256) sgu_mix(const bf16_t* __restrict__ VG, const float* __restrict__ st, const float* __restrict__ lng, const float* __restrict__ lnb,
                                               const float* __restrict__ ws, const float* __restrict__ bs, bf16_t* UGY) {
    __shared__ float vn[128][64];
    const int g = blockIdx.x % NG, ck = blockIdx.x / NG, tid = threadIdx.x;
    const size_t row0 = (size_t)ck * CHUNK;
    for (int i = tid; i < 128 * 64; i += 256) { const int s = i >> 6, c = i & 63; const size_t r = row0 + s;
        vn[s][c] = (bf2f(VG[r * SW + g * GD + c]) - st[2 * r]) * st[2 * r + 1] * lng[g * GD + c] + lnb[g * GD + c]; }
    __syncthreads();
    const int c = tid & 63;
    for (int t = tid >> 6; t < 128; t += 4) {
        const float* w = ws + ((size_t)g * CHUNK + t) * CHUNK; float z = 0.f;
        for (int s = 0; s <= t; ++s) z += w[s] * vn[s][c];
        z += bs[g * CHUNK + t];
        const size_t o = (row0 + t) * SW + g * GD + c;
        UGY[o] = f2bf(bf2f(UGY[o]) * z);
    }
}

__device__ __forceinline__ void wave_argmax(float v, int i, float& bv, int& bi) {
#pragma unroll
    for (int o = 1; o < 64; o <<= 1) { const float ov = __shfl_xor(v, o); const int oi = __shfl_xor(i, o); if (ov > v || (ov == v && oi < i)) { v = ov; i = oi; } }
    bv = v; bi = i;
}
__global__ void __launch_bounds__(64) peer_topk(const bf16_t* __restrict__ QP, const float* __restrict__ sk, int* __restrict__ pidx, float* __restrict__ pgate) {
    __shared__ float qs[256];
    const int t = blockIdx.x / PH, h = blockIdx.x % PH, lane = threadIdx.x;
#pragma unroll
    for (int j = 0; j < 4; ++j) qs[lane + 64 * j] = bf2f(QP[(size_t)t * QPW + h * 256 + lane + 64 * j]);
    __syncthreads();
    float tops[2] = {0.f, 0.f}; int topi[2] = {0, 0};
#pragma unroll
    for (int p = 0; p < 2; ++p) {
        const float* kb = sk + ((size_t)(h * 2 + p) * PKEYS) * PHALF;
        float s0 = 0.f, s1 = 0.f;
        for (int k = 0; k < PHALF; ++k) { const float q = qs[p * 128 + k]; s0 += q * kb[(size_t)lane * PHALF + k]; s1 += q * kb[(size_t)(lane + 64) * PHALF + k]; }
        for (int r = 0; r < PTOP; ++r) {
            float v; int i; if (s0 >= s1) { v = s0; i = lane; } else { v = s1; i = lane + 64; }
            float bv; int bi; wave_argmax(v, i, bv, bi);
            if (lane == r) { tops[p] = bv; topi[p] = bi; }
            if (bi == lane) s0 = -INFINITY; if (bi == lane + 64) s1 = -INFINITY;
        }
    }
    float cs[4]; int ci[4];
#pragma unroll
    for (int q = 0; q < 4; ++q) { const int c = lane + 64 * q, i = c >> 4, j = c & 15;
        cs[q] = __shfl(tops[0], i) + __shfl(tops[1], j); ci[q] = __shfl(topi[0], i) * PKEYS + __shfl(topi[1], j); }
    float bs_ = 0.f; int be = 0;
    for (int r = 0; r < PTOP; ++r) {
        float v = cs[0]; int c = lane;
#pragma unroll
        for (int q = 1; q < 4; ++q) if (cs[q] > v) { v = cs[q]; c = lane + 64 * q; }
        float bv; int bc; wave_argmax(v, c, bv, bc);
        const int ql = bc >> 6, ll = bc & 63;
        int e = 0;
#pragma unroll
        for (int q = 0; q < 4; ++q) { const int eq = __shfl(ci[q], ll); if (q == ql) e = eq; }
        if (lane == r) { bs_ = bv; be = e; }
        if (lane == ll) {
#pragma unroll
            for (int q = 0; q < 4; ++q) if (q == ql) cs[q] = -INFINITY;
        }
    }
    const float v = lane < PTOP ? bs_ : -INFINITY;
    const float mx = wave_max(v), ex = lane < PTOP ? __expf(v - mx) : 0.f, sm = wave_sum(ex);
    if (lane < PTOP) { pidx[(size_t)t * HK + h * PTOP + lane] = be; pgate[(size_t)t * HK + h * PTOP + lane] = ex / sm; }
}

__global__ void __launch_bounds__(256) peer_experts(const bf16_t* __restrict__ H2, const int* __restrict__ pidx, const float* __restrict__ pgate,
                                                    const float* __restrict__ eu, const float* __restrict__ ev, float* x1) {
    __shared__ float hs[D];
    __shared__ float wgt[HK];
    __shared__ int eidx[HK];
    const int t = blockIdx.x, tid = threadIdx.x, lane = tid & 63, w = tid >> 6;
    for (int i = tid; i < D; i += 256) hs[i] = bf2f(H2[(size_t)t * D + i]);
    if (tid < HK) eidx[tid] = pidx[(size_t)t * HK + tid];
    __syncthreads();
    for (int j = w; j < HK; j += 4) {
        const float* ur = eu + (size_t)eidx[j] * D; float d = 0.f;
#pragma unroll
        for (int i = 0; i < 16; ++i) d += hs[lane + 64 * i] * ur[lane + 64 * i];
        d = wave_sum(d);
        if (lane == 0) wgt[j] = pgate[(size_t)t * HK + j] * gelu_exact(d);
    }
    __syncthreads();
    float acc[4] = {0.f, 0.f, 0.f, 0.f};
    for (int j = 0; j < HK; ++j) {
        const float* vr = ev + (size_t)eidx[j] * D; const float g = wgt[j];
#pragma unroll
        for (int i = 0; i < 4; ++i) acc[i] += g * vr[tid + 256 * i];
    }
#pragma unroll
    for (int i = 0; i < 4; ++i) x1[(size_t)t * D + tid + 256 * i] += acc[i];
}
}

extern "C" void kernel_launch(void* const* d_in, const int* in_sizes, int n_in, void* d_out, int out_size, void* d_ws, size_t ws_size, hipStream_t stream) {
    const float* x = (const float*)d_in[0]; const float* norm_mix_g = (const float*)d_in[1]; const float* w_in = (const float*)d_in[2]; const float* b_f = (const float*)d_in[3];
    const float* sgu_ln_g = (const float*)d_in[4]; const float* sgu_ln_b = (const float*)d_in[5]; const float* w_s = (const float*)d_in[6]; const float* b_s = (const float*)d_in[7];
    const float* w_a = (const float*)d_in[8]; const float* w_b = (const float*)d_in[9]; const float* w_out = (const float*)d_in[10]; const float* norm_ffn_g = (const float*)d_in[11];
    const float* w_query = (const float*)d_in[12]; const float* sub_keys = (const float*)d_in[13]; const float* expert_u = (const float*)d_in[14]; const float* expert_v = (const float*)d_in[15];
    const float* norm_final_g = (const float*)d_in[16];
    unsigned char* ws = (unsigned char*)d_ws; float* out = (float*)d_out;
    bf16_t* XN = (bf16_t*)(ws + WS_XN); bf16_t* Qb = (bf16_t*)(ws + WS_Q); bf16_t* Kb = (bf16_t*)(ws + WS_K); bf16_t* Vb = (bf16_t*)(ws + WS_V);
    bf16_t* UG = (bf16_t*)(ws + WS_UG); bf16_t* VG = (bf16_t*)(ws + WS_VG); float* LOGF = (float*)(ws + WS_LOGF); float* CL2 = (float*)(ws + WS_CL2); float* STAT = (float*)(ws + WS_STAT);
    bf16_t* MERGED = (bf16_t*)(ws + WS_MERGED); bf16_t* QP = (bf16_t*)(ws + WS_QP); int* PIDX = (int*)(ws + WS_PIDX); float* PGATE = (float*)(ws + WS_PGATE);
    bf16_t* GATE = (bf16_t*)d_out;

    nv::rmsnorm_bf16<<<M / 4, 256, 0, stream>>>(x, norm_mix_g, XN);
    nv::GemmArgs g{}; g.Q = Qb; g.Kb = Kb; g.V = Vb; g.UG = UG; g.VG = VG; g.GATE = GATE; g.MERGED = MERGED; g.QP = QP; g.LOGF = LOGF; g.bf = b_f; g.x = x; g.x1 = out;
    g.A = XN; g.lda = D; g.B = w_in; g.ldb = IN_W; g.N = IN_W; g.K = D; g.mode = 0;
    nv::gemm_naive<<<dim3((IN_W + 63) / 64, M / 64), 256, 0, stream>>>(g);
    nv::cumsum_logf<<<BATCH * NH, 64, 0, stream>>>(LOGF, CL2);
    nv::attn_naive<<<BATCH * NH * SEQ, 64, 0, stream>>>(Qb, Kb, Vb, CL2, Qb);
    nv::sgu_stats<<<M / 4, 256, 0, stream>>>(VG, STAT);
    nv::sgu_mix<<<(M / CHUNK) * NG, 256, 0, stream>>>(VG, STAT, sgu_ln_g, sgu_ln_b, w_s, b_s, UG);
    g.A = Qb; g.lda = AW; g.B = w_a; g.ldb = D; g.N = D; g.K = AW; g.mode = 1;
    nv::gemm_naive<<<dim3(D / 64, M / 64), 256, 0, stream>>>(g);
    g.A = UG; g.lda = SW; g.B = w_b; g.ldb = D; g.N = D; g.K = SW; g.mode = 2;
    nv::gemm_naive<<<dim3(D / 64, M / 64), 256, 0, stream>>>(g);
    g.A = MERGED; g.lda = D; g.B = w_out; g.ldb = D; g.N = D; g.K = D; g.mode = 3;
    nv::gemm_naive<<<dim3(D / 64, M / 64), 256, 0, stream>>>(g);
    nv::rmsnorm_bf16<<<M / 4, 256, 0, stream>>>(out, norm_ffn_g, XN);
    g.A = XN; g.lda = D; g.B = w_query; g.ldb = QPW; g.N = QPW; g.K = D; g.mode = 4;
    nv::gemm_naive<<<dim3(QPW / 64, M / 64), 256, 0, stream>>>(g);
    nv::peer_topk<<<M * PH, 64, 0, stream>>>(QP, sub_keys, PIDX, PGATE);
    nv::peer_experts<<<M, 256, 0, stream>>>(XN, PIDX, PGATE, expert_u, expert_v, out);
    nv::rmsnorm_f32_inplace<<<M / 4, 256, 0, stream>>>(out, norm_final_g);
}
```

```cpp
#include <hip/hip_runtime.h>
#include <cstdio>
#include <cstdint>
#include <cmath>

constexpr int D = 1024, BATCH = 8, SEQ = 2048, M = BATCH * SEQ;
constexpr int NH = 8, HD = 64, AW = 512, SW = 512, CHUNK = 128, NG = 8, GD = 64;
constexpr int OFF_Q = 0, OFF_K = 512, OFF_V = 1024, OFF_F = 1536, OFF_UG = 1544, OFF_VG = 2056, OFF_GATE = 2568, IN_W = 4616;
constexpr int NPROJ = 4608;
constexpr int PH = 8, PKEYS = 128, PHALF = 128, PTOP = 16, NEXP = 16384, QPW = 2048, HK = 128;
constexpr float EPS = 1e-6f;
constexpr float LOG2E = 1.4426950408889634f;
constexpr float C2 = 0.125f * LOG2E;

constexpr size_t MiB = 1u << 20;
constexpr size_t WS_CTL = 0, CTL_ZERO_BYTES = 65536;
constexpr size_t WS_WIN = 1 * MiB;
constexpr size_t WS_WA = 10 * MiB;
constexpr size_t WS_WB = 11 * MiB;
constexpr size_t WS_WOUT = 12 * MiB;
constexpr size_t WS_WQ = 14 * MiB;
constexpr size_t WS_SK = 18 * MiB;
constexpr size_t WS_WSM = 18 * MiB + 512 * 1024;
constexpr size_t WS_EU = 20 * MiB;
constexpr size_t WS_EV = 52 * MiB;
constexpr size_t WS_XN = 84 * MiB;
constexpr size_t WS_Q = 116 * MiB;
constexpr size_t WS_K = 132 * MiB;
constexpr size_t WS_V = 148 * MiB;
constexpr size_t WS_UG = 164 * MiB;
constexpr size_t WS_VG = 180 * MiB;
constexpr size_t WS_LOGF = 196 * MiB;
constexpr size_t WS_CL2 = 197 * MiB;
constexpr size_t WS_STAT = 199 * MiB;
constexpr size_t WS_SU = 198 * MiB;
constexpr size_t WS_SV = 198 * MiB + 65536;
constexpr size_t WS_MERGED = WS_K;
constexpr size_t WS_QP = WS_Q;
constexpr size_t WS_PIDX = WS_VG;
constexpr size_t WS_PGATE = WS_VG + 8 * MiB;
constexpr size_t WS_H2Q = 200 * MiB;
constexpr size_t WS_ST = 198 * MiB + 131072;
constexpr size_t WS_SSQP = 198 * MiB + 262144;
constexpr size_t WS_SBQ = 198 * MiB + 524288;
constexpr size_t WS_PID = 180 * MiB;
constexpr size_t WS_G2 = 184 * MiB;
constexpr size_t WS_PS2 = 216 * MiB;
constexpr size_t WS_AP = 116 * MiB;
constexpr size_t WS_WP = 84 * MiB;
constexpr size_t WS_SW = 88 * MiB;
constexpr size_t WS_SSQ = 224 * MiB;
constexpr size_t WS_END = 256 * MiB;

template <int CTRL> __device__ __forceinline__ float wr_dppf(float v) { return __int_as_float(__builtin_amdgcn_update_dpp(0, __float_as_int(v), CTRL, 0xf, 0xf, false)); }
__device__ __forceinline__ float wave_allsum(float v) {
    v += wr_dppf<0xB1>(v); v += wr_dppf<0x4E>(v); v += wr_dppf<0x141>(v); v += wr_dppf<0x128>(v);
    { const auto s = __builtin_amdgcn_permlane16_swap(__float_as_uint(v), __float_as_uint(v), false, false); v = __uint_as_float(s[0]) + __uint_as_float(s[1]); }
    { const auto s = __builtin_amdgcn_permlane32_swap(__float_as_uint(v), __float_as_uint(v), false, false); v = __uint_as_float(s[0]) + __uint_as_float(s[1]); }
    return v;
}
__device__ __forceinline__ float wave_allmax(float v) {
    v = fmaxf(v, wr_dppf<0xB1>(v)); v = fmaxf(v, wr_dppf<0x4E>(v)); v = fmaxf(v, wr_dppf<0x141>(v)); v = fmaxf(v, wr_dppf<0x128>(v));
    { const auto s = __builtin_amdgcn_permlane16_swap(__float_as_uint(v), __float_as_uint(v), false, false); v = fmaxf(__uint_as_float(s[0]), __uint_as_float(s[1])); }
    { const auto s = __builtin_amdgcn_permlane32_swap(__float_as_uint(v), __float_as_uint(v), false, false); v = fmaxf(__uint_as_float(s[0]), __uint_as_float(s[1])); }
    return v;
}
namespace pg8 {
#define PG8_LAS __attribute__((address_space(3)))
typedef unsigned short bf16_t;
typedef short bf16x8 __attribute__((ext_vector_type(8)));
typedef float f32x4 __attribute__((ext_vector_type(4)));
typedef unsigned u32x4 __attribute__((ext_vector_type(4)));
constexpr int BM = 256, BK = 64, HALF = 128, HTB = HALF * BK * 2  , STAGE_BYTES = 8 * HTB, NXCD = 8, WGM = 8;

__host__ __device__ __forceinline__ int lds_byte(int r, int c) { const int st = (r >> 4) * 2 + (c >> 5), rr = r & 15, cc = c & 31, ob = rr * 64 + cc * 2; return st * 1024 + (ob ^ (((ob >> 9) & 1) << 5)); }
__host__ __device__ __forceinline__ void stage_rc(int b, int& R, int& C) { const int st = b / 1024, sb = b % 1024, swz = sb ^ (((sb >> 9) & 1) << 5); R = (st >> 1) * 16 + swz / 64; C = (st & 1) * 32 + (swz % 64) / 2; }
__host__ __device__ __forceinline__ int perm32(int rho) { const int n = rho >> 4, i = rho & 15; return 8 * (i >> 2) + 4 * n + (i & 3); }

struct Unit { int pm, pn; };
struct Gemm { const bf16_t* A; const bf16_t* Bt; int M, N, K; };

struct StaticOrder {
    int nM, nN, nwg, G, c;
    __host__ __device__ void init(int M, int N, int G_, int c_) { nM = M / BM; nN = N / BM; nwg = nM * nN; G = G_; c = c_; }
    __host__ __device__ bool next(int i, Unit& u) const {
        const long L = (long)i * G + c; if (L >= nwg) return false;
        int wgid = (int)L; { const int q = nwg / NXCD, r = nwg % NXCD, xcd = wgid % NXCD, off = wgid / NXCD; wgid = (xcd < r ? xcd * (q + 1) : r * (q + 1) + (xcd - r) * q) + off; }
        const int nig = WGM * nN, gid = wgid / nig, fm = gid * WGM, gsz = (nM - fm) < WGM ? (nM - fm) : WGM;
        u.pm = fm + ((wgid % nig) % gsz); u.pn = (wgid % nig) / gsz; return true;
    }
    __device__ __forceinline__ void a_ready(const Unit&) const {}
    __device__ __forceinline__ void done(const Unit&) const {}
};

typedef float cvt_f32x2_t __attribute__((ext_vector_type(2))); typedef __bf16 cvt_bf16x2_t __attribute__((ext_vector_type(2)));
__device__ __forceinline__ unsigned cvt_pk_bf16(float lo, float hi) { cvt_f32x2_t v = {lo, hi}; cvt_bf16x2_t b = __builtin_convertvector(v, cvt_bf16x2_t); return __builtin_bit_cast(unsigned, b); }
typedef float f32x2 __attribute__((ext_vector_type(2)));
__device__ __forceinline__ f32x2 gelu_pk(f32x2 v) {
    const f32x2 av = __builtin_elementwise_abs(v), d = av * 0.2316418882f + 1.0f;
    f32x2 t; t.x = __builtin_amdgcn_rcpf(d.x); t.y = __builtin_amdgcn_rcpf(d.y);
    f32x2 q = t * 0.5307027145f + (-0.7265760135f); q = q * t + 0.7107068705f; q = q * t + (-0.142248368f); q = q * t + 0.127414796f; q = q * t;
    const f32x2 s = (v * v) * (-0.72134752044f);
    f32x2 e; e.x = __builtin_amdgcn_exp2f(s.x); e.y = __builtin_amdgcn_exp2f(s.y);
    const f32x2 m = v * (q * e), r = v - m;
    f32x2 o; o.x = v.x < 0.f ? m.x : r.x; o.y = v.y < 0.f ? m.y : r.y; return o;
}

template <int ACT  > struct EpiBf16 {
    static constexpr bool PERM = true, AFTER_DRAIN = false; static_assert(ACT == 0 || ACT == 1, "EpiBf16: ACT is 0 (none) or 1 (gelu_pk)");
    bf16_t* O; int ldc; const float* bias; int split_cols; size_t split_stride; float scale0;
    __device__ __forceinline__ void operator()(const f32x4 (&acc)[2][2][4][2], const Unit& u, int wr, int wc, int fr, int fq) const {
        const int row0 = u.pm * BM + wr * 64 + fr; int colt = u.pn * BM; bf16_t* base = O;
        float sc = 1.f; if (split_cols) { const int t = colt / split_cols; base += (size_t)t * split_stride; colt -= t * split_cols; if (t == 0) sc = scale0; }
        const int col0 = colt + wc * 32 + 8 * fq, bcol0 = u.pn * BM + wc * 32 + 8 * fq;
        f32x4 bv[2][2];
#pragma unroll
        for (int bj = 0; bj < 2; ++bj)
#pragma unroll
            for (int n = 0; n < 2; ++n) bv[bj][n] = bias ? *(const f32x4*)(bias + bcol0 + bj * HALF + 4 * n) : (f32x4){0.f, 0.f, 0.f, 0.f};
#pragma unroll
        for (int ai = 0; ai < 2; ++ai)
#pragma unroll
            for (int m = 0; m < 4; ++m) { bf16_t* rowp = base + (size_t)(row0 + ai * HALF + m * 16) * ldc + col0;
#pragma unroll
                for (int bj = 0; bj < 2; ++bj) { f32x4 v0 = acc[ai][bj][m][0] + bv[bj][0], v1 = acc[ai][bj][m][1] + bv[bj][1];
                    if (ACT == 1) { f32x2 a = gelu_pk((f32x2){v0[0], v0[1]}), b = gelu_pk((f32x2){v0[2], v0[3]}), c = gelu_pk((f32x2){v1[0], v1[1]}), d = gelu_pk((f32x2){v1[2], v1[3]});
                        v0 = (f32x4){a.x, a.y, b.x, b.y}; v1 = (f32x4){c.x, c.y, d.x, d.y}; }
                    v0 = v0 * sc; v1 = v1 * sc; u32x4 w; w.x = cvt_pk_bf16(v0[0], v0[1]); w.y = cvt_pk_bf16(v0[2], v0[3]); w.z = cvt_pk_bf16(v1[0], v1[1]); w.w = cvt_pk_bf16(v1[2], v1[3]);
                    *(u32x4*)(rowp + bj * HALF) = w; } }
    }
};
__device__ __forceinline__ f32x2 sigmoid_pk(f32x2 v) {
#ifdef DBG_SIG
    f32x2 o; o.x = 1.0f / (1.0f + __expf(-v.x)); o.y = 1.0f / (1.0f + __expf(-v.y)); return o;
#else
    f32x2 e; e.x = __builtin_amdgcn_exp2f(v.x * -1.4426950408889634f); e.y = __builtin_amdgcn_exp2f(v.y * -1.4426950408889634f);
    f32x2 o; o.x = __builtin_amdgcn_rcpf(1.0f + e.x); o.y = __builtin_amdgcn_rcpf(1.0f + e.y); return o;
#endif
}
template <int ACT> __device__ __forceinline__ f32x4 act4(f32x4 v, float sc) {
    if (ACT == 0) return v * sc;
    f32x2 a, b;
    if (ACT == 2) { a = gelu_pk((f32x2){v[0], v[1]}); b = gelu_pk((f32x2){v[2], v[3]}); }
    else { a = sigmoid_pk((f32x2){v[0], v[1]}); b = sigmoid_pk((f32x2){v[2], v[3]}); }
    return (f32x4){a.x, a.y, b.x, b.y};
}
struct EpiProj {
    static constexpr bool PERM = true, AFTER_DRAIN = false;
    bf16_t* QKVUV; size_t tstride; bf16_t* GATE; float qscale;
    template <int ACT> __device__ __forceinline__ void body(const f32x4 (&acc)[2][2][4][2], bf16_t* base, int ldc, int row0, int col0, float sc) const {
#pragma unroll
        for (int ai = 0; ai < 2; ++ai)
#pragma unroll
            for (int m = 0; m < 4; ++m) { bf16_t* rowp = base + (size_t)(row0 + ai * HALF + m * 16) * ldc + col0;
#pragma unroll
                for (int bj = 0; bj < 2; ++bj) { const f32x4 v0 = act4<ACT>(acc[ai][bj][m][0], sc), v1 = act4<ACT>(acc[ai][bj][m][1], sc);
                    u32x4 w; w.x = cvt_pk_bf16(v0[0], v0[1]); w.y = cvt_pk_bf16(v0[2], v0[3]); w.z = cvt_pk_bf16(v1[0], v1[1]); w.w = cvt_pk_bf16(v1[2], v1[3]);
                    *(u32x4*)(rowp + bj * HALF) = w; } }
    }
    __device__ __forceinline__ void operator()(const f32x4 (&acc)[2][2][4][2], const Unit& u, int wr, int wc, int fr, int fq) const {
        const int row0 = u.pm * BM + wr * 64 + fr, pn = u.pn;
        if (pn < 10) { bf16_t* base = QKVUV + (size_t)(pn >> 1) * tstride; const int col0 = (pn & 1) * BM + wc * 32 + 8 * fq;
            if (pn < 6) body<0>(acc, base, 512, row0, col0, pn < 2 ? qscale : 1.0f); else body<2>(acc, base, 512, row0, col0, 1.0f); }
        else body<3>(acc, GATE, 2048, row0, (pn - 10) * BM + wc * 32 + 8 * fq, 1.0f);
    }
};
template <int PASS> struct EpiMerge {
    static constexpr bool PERM = true, AFTER_DRAIN = false;
    const bf16_t* GATE; bf16_t* MERGED;
    __device__ __forceinline__ void operator()(const f32x4 (&acc)[2][2][4][2], const Unit& u, int wr, int wc, int fr, int fq) const {
        const int row0 = u.pm * BM + wr * 64 + fr, col0 = u.pn * BM + wc * 32 + 8 * fq;
#pragma unroll
        for (int ai = 0; ai < 2; ++ai) {
            u32x4 gq[4][2], tq[4][2];
#pragma unroll
            for (int m = 0; m < 4; ++m) { const size_t r = (size_t)(row0 + ai * HALF + m * 16);
#pragma unroll
                for (int bj = 0; bj < 2; ++bj) { const int c = col0 + bj * HALF; gq[m][bj] = *(const u32x4*)(GATE + r * 2048 + PASS * 1024 + c);
                    if (PASS == 1) tq[m][bj] = *(const u32x4*)(MERGED + r * 1024 + c); } }
            asm volatile("" ::: "memory");
#pragma unroll
            for (int m = 0; m < 4; ++m) { const size_t r = (size_t)(row0 + ai * HALF + m * 16);
#pragma unroll
                for (int bj = 0; bj < 2; ++bj) { const int c = col0 + bj * HALF; const u32x4 g = gq[m][bj];
                    f32x4 v0 = acc[ai][bj][m][0], v1 = acc[ai][bj][m][1];
                    v0[0] *= __uint_as_float(g.x << 16); v0[1] *= __uint_as_float(g.x & 0xffff0000u); v0[2] *= __uint_as_float(g.y << 16); v0[3] *= __uint_as_float(g.y & 0xffff0000u);
                    v1[0] *= __uint_as_float(g.z << 16); v1[1] *= __uint_as_float(g.z & 0xffff0000u); v1[2] *= __uint_as_float(g.w << 16); v1[3] *= __uint_as_float(g.w & 0xffff0000u);
                    if (PASS == 1) { const u32x4 t = tq[m][bj];
                        v0[0] += __uint_as_float(t.x << 16); v0[1] += __uint_as_float(t.x & 0xffff0000u); v0[2] += __uint_as_float(t.y << 16); v0[3] += __uint_as_float(t.y & 0xffff0000u);
                        v1[0] += __uint_as_float(t.z << 16); v1[1] += __uint_as_float(t.z & 0xffff0000u); v1[2] += __uint_as_float(t.w << 16); v1[3] += __uint_as_float(t.w & 0xffff0000u); }
                    u32x4 w; w.x = cvt_pk_bf16(v0[0], v0[1]); w.y = cvt_pk_bf16(v0[2], v0[3]); w.z = cvt_pk_bf16(v1[0], v1[1]); w.w = cvt_pk_bf16(v1[2], v1[3]);
                    *(u32x4*)(MERGED + r * 1024 + c) = w; } }
            asm volatile("" ::: "memory");
        }
    }
};
struct EpiResid {
    static constexpr bool PERM = false, AFTER_DRAIN = false;
    const float* base; float* out; int ldc; int nrows;
    __device__ __forceinline__ void operator()(const f32x4 (&acc)[2][2][4][2], const Unit& u, int wr, int wc, int fr, int fq) const {
        const int col0 = u.pn * BM + wc * 32 + 4 * fq;
#pragma unroll
        for (int ai = 0; ai < 2; ++ai) {
            f32x4 pre[4][2][2];
#pragma unroll
            for (int m = 0; m < 4; ++m) { const size_t off = (size_t)(u.pm * BM + ai * HALF + wr * 64 + m * 16 + fr) * ldc + col0;
#pragma unroll
                for (int bj = 0; bj < 2; ++bj)
#pragma unroll
                    for (int n = 0; n < 2; ++n) pre[m][bj][n] = *(const f32x4*)(base + off + bj * HALF + n * 16); }
            asm volatile("" ::: "memory");
#pragma unroll
            for (int m = 0; m < 4; ++m) { const size_t off = (size_t)(u.pm * BM + ai * HALF + wr * 64 + m * 16 + fr) * ldc + col0;
#pragma unroll
                for (int bj = 0; bj < 2; ++bj)
#pragma unroll
                    for (int n = 0; n < 2; ++n) *(f32x4*)(out + off + bj * HALF + n * 16) = pre[m][bj][n] + acc[ai][bj][m][n]; }
            asm volatile("" ::: "memory");
        }
    }
};

constexpr int MERGE_DPM = 192;
struct MergeOrder : StaticOrder {
    __host__ __device__ bool next(int i, Unit& u) const {
        if (!StaticOrder::next(i >> 1, u)) return false;
        if (i & 1) { u.pm += MERGE_DPM; u.pn += 4; }
        return true;
    }
};
struct EpiMergeAB {
    static constexpr bool PERM = true, AFTER_DRAIN = false;
    const bf16_t* GATE; bf16_t* MERGED;
    __device__ __forceinline__ void operator()(const f32x4 (&acc)[2][2][4][2], const Unit& u, int wr, int wc, int fr, int fq) const {
        if (u.pn < 4) { EpiMerge<0> E{GATE, MERGED}; E(acc, u, wr, wc, fr, fq); }
        else { Unit v; v.pm = u.pm - MERGE_DPM; v.pn = u.pn - 4; EpiMerge<1> E{GATE, MERGED}; E(acc, v, wr, wc, fr, fq); }
    }
};
struct QueryOrder {
    int v, G, ntask;
    __host__ __device__ bool next(int i, Unit& u) const { const int tk = v + (i >> 1) * G; if (tk >= ntask) return false; u.pm = 2 * (tk >> 3) + (i & 1); u.pn = tk & 7; return true; }
    __device__ __forceinline__ void a_ready(const Unit&) const {}
    __device__ __forceinline__ void done(const Unit&) const {}
};
template <class Epi, class Sched, bool ALIGN_EPI = false, bool SP2 = false>
__device__ __forceinline__ void gemm_phase(PG8_LAS unsigned char* lds, const Gemm g, const Sched& S, const Epi& E) {
    int tid = threadIdx.x; asm volatile("" : "+v"(tid));
    const int wid = __builtin_amdgcn_readfirstlane(tid >> 6), lane = tid & 63, wr = wid >> 2, wc = wid & 3, fr = lane & 15, fq = lane >> 4;
    const int K = g.K, nt = K / BK;
    unsigned voffA[2], voffB[2];
#pragma unroll
    for (int i = 0; i < 2; ++i) { int R, C; stage_rc(tid * 16 + i * 8192, R, C); const int Rb = Epi::PERM ? ((R & ~31) + perm32(R & 31)) : R;
        voffA[i] = (unsigned)(R * K + C) * 2u; voffB[i] = (unsigned)(Rb * K + C) * 2u; }
    const size_t kstep = (size_t)(BK * 2);
    const size_t hstep = (size_t)HALF * K * 2;
    const size_t tstep = 2 * hstep;
    const unsigned ldsw = (unsigned)wid * 1024u;
    const int aoff = lds_byte(wr * 64 + fr, fq * 8), boff = lds_byte(wc * 32 + fr, fq * 8);
#define PG8_SA(b, h) (((b) * 2 + (h)) * HTB)
#define PG8_SB(b, h) ((4 + (b) * 2 + (h)) * HTB)
#define PG8_STAGE(bufoff, gbase, voff) do { _Pragma("unroll") for (int _i = 0; _i < 2; ++_i) \
        __builtin_amdgcn_global_load_lds((const unsigned*)((const char*)(gbase) + (voff)[_i]), (PG8_LAS unsigned*)(lds + (bufoff) + ldsw + _i * 8192), 16, 0, 0); } while (0)
#define PG8_LDA(dst, b, h) do { _Pragma("unroll") for (int m = 0; m < 4; ++m) _Pragma("unroll") for (int k = 0; k < 2; ++k) dst[m][k] = *(const PG8_LAS bf16x8*)(lds + PG8_SA(b, h) + aoff + m * 2048 + k * 1024); } while (0)
#define PG8_LDB(dst, b, h) do { _Pragma("unroll") for (int n = 0; n < 2; ++n) _Pragma("unroll") for (int k = 0; k < 2; ++k) dst[n][k] = *(const PG8_LAS bf16x8*)(lds + PG8_SB(b, h) + boff + n * 2048 + k * 1024); } while (0)
#define PG8_MMA(ai, bj, At, Bt) do { __builtin_amdgcn_s_setprio(1); _Pragma("unroll") for (int m = 0; m < 4; ++m) _Pragma("unroll") for (int n = 0; n < 2; ++n) _Pragma("unroll") for (int k = 0; k < 2; ++k) \
        acc[ai][bj][m][n] = __builtin_amdgcn_mfma_f32_16x16x32_bf16(Bt[n][k], At[m][k], acc[ai][bj][m][n], 0, 0, 0); __builtin_amdgcn_s_setprio(0); } while (0)
#define PG8_WAIT_V(n) asm volatile("s_waitcnt vmcnt(" #n ")" ::: "memory")
#define PG8_WAIT_L(n) asm volatile("s_waitcnt lgkmcnt(" #n ")" ::: "memory")
#define PG8_BAR __builtin_amdgcn_s_barrier()
#define PG8_SCHED __builtin_amdgcn_sched_barrier(0)
    Unit cur, nxt; int ui = 0;
    if (!S.next(0, cur)) return;
    f32x4 acc[2][2][4][2];
#pragma unroll
    for (int a = 0; a < 2; ++a)
#pragma unroll
        for (int b = 0; b < 2; ++b)
#pragma unroll
            for (int m = 0; m < 4; ++m)
#pragma unroll
                for (int n = 0; n < 2; ++n) acc[a][b][m][n] = (f32x4){0.f, 0.f, 0.f, 0.f};
    bf16x8 At[4][2], B0[2][2], B1[2][2];
    const char* cA = (const char*)g.A + (size_t)cur.pm * tstep; const char* cB = (const char*)g.Bt + (size_t)cur.pn * tstep;
    S.a_ready(cur);
    if constexpr (SP2) {
        PG8_STAGE(PG8_SB(0, 0), cB, voffB); PG8_STAGE(PG8_SB(0, 1), cB + hstep, voffB); PG8_STAGE(PG8_SA(0, 0), cA, voffA); PG8_STAGE(PG8_SA(0, 1), cA + hstep, voffA);
        if (wr == 1) PG8_BAR;
        PG8_WAIT_V(2); PG8_BAR;
        PG8_STAGE(PG8_SB(1, 0), cB + kstep, voffB); PG8_STAGE(PG8_SA(1, 0), cA + kstep, voffA); PG8_STAGE(PG8_SB(1, 1), cB + hstep + kstep, voffB);
        PG8_WAIT_V(6); PG8_BAR;
    } else {
        PG8_STAGE(PG8_SB(0, 0), cB, voffB); PG8_STAGE(PG8_SA(0, 0), cA, voffA); PG8_STAGE(PG8_SB(0, 1), cB + hstep, voffB); PG8_STAGE(PG8_SA(0, 1), cA + hstep, voffA);
        if (wr == 1) PG8_BAR;
        PG8_WAIT_V(4); PG8_BAR;
        PG8_STAGE(PG8_SB(1, 0), cB + kstep, voffB); PG8_STAGE(PG8_SA(1, 0), cA + kstep, voffA); PG8_STAGE(PG8_SB(1, 1), cB + hstep + kstep, voffB);
        PG8_WAIT_V(6); PG8_BAR;
    }
    for (;;) {
        const bool has_next = S.next(ui + 1, nxt);
        const char* nA = has_next ? (const char*)g.A + (size_t)nxt.pm * tstep : cA; const char* nB = has_next ? (const char*)g.Bt + (size_t)nxt.pn * tstep : cB;
        for (int t = 0; t < nt; t += 2) {
            const bool last = (t == nt - 2);
            const char* a1 = cA + (size_t)(t + 1) * kstep;
            const char* a2 = last ? nA : cA + (size_t)(t + 2) * kstep; const char* b2 = last ? nB : cB + (size_t)(t + 2) * kstep;
            const char* a3 = a2 + kstep; const char* b3 = b2 + kstep;
            if (last && has_next) S.a_ready(nxt);
            if constexpr (SP2) {
            PG8_LDB(B0, 0, 0); PG8_LDB(B1, 0, 1); PG8_SCHED; PG8_LDA(At, 0, 0); PG8_STAGE(PG8_SA(1, 1), a1 + hstep, voffA);
            PG8_WAIT_V(8); PG8_WAIT_L(0); PG8_BAR; PG8_MMA(0, 0, At, B0); PG8_MMA(0, 1, At, B1); PG8_BAR; PG8_SCHED;
            PG8_LDA(At, 0, 1); PG8_STAGE(PG8_SB(0, 0), b2, voffB); PG8_STAGE(PG8_SB(0, 1), b2 + hstep, voffB); PG8_STAGE(PG8_SA(0, 0), a2, voffA);
            PG8_WAIT_V(8); PG8_WAIT_L(0); PG8_BAR; PG8_MMA(1, 0, At, B0); PG8_MMA(1, 1, At, B1); PG8_BAR; PG8_SCHED;
            PG8_LDB(B0, 1, 0); PG8_LDB(B1, 1, 1); PG8_SCHED; PG8_LDA(At, 1, 0); PG8_STAGE(PG8_SA(0, 1), a2 + hstep, voffA);
            PG8_WAIT_V(8); PG8_WAIT_L(0); PG8_BAR; PG8_MMA(0, 0, At, B0); PG8_MMA(0, 1, At, B1); PG8_BAR; PG8_SCHED;
            PG8_LDA(At, 1, 1); PG8_STAGE(PG8_SB(1, 0), b3, voffB); PG8_STAGE(PG8_SB(1, 1), b3 + hstep, voffB); PG8_STAGE(PG8_SA(1, 0), a3, voffA);
            PG8_WAIT_V(8); PG8_WAIT_L(0); PG8_BAR; PG8_MMA(1, 0, At, B0); PG8_MMA(1, 1, At, B1); PG8_BAR; PG8_SCHED;
            } else {
            PG8_LDB(B0, 0, 0); PG8_SCHED; PG8_LDA(At, 0, 0); PG8_STAGE(PG8_SA(1, 1), a1 + hstep, voffA);
            PG8_WAIT_L(8); PG8_BAR; PG8_WAIT_L(0); PG8_MMA(0, 0, At, B0); PG8_BAR; PG8_SCHED;
            PG8_LDB(B1, 0, 1); PG8_STAGE(PG8_SB(0, 0), b2, voffB);
            PG8_BAR; PG8_WAIT_L(0); PG8_MMA(0, 1, At, B1); PG8_BAR;
            PG8_LDA(At, 0, 1); PG8_STAGE(PG8_SA(0, 0), a2, voffA);
            PG8_BAR; PG8_WAIT_L(0); PG8_MMA(1, 0, At, B0); PG8_BAR; PG8_SCHED;
            PG8_STAGE(PG8_SB(0, 1), b2 + hstep, voffB);
            PG8_WAIT_V(6); PG8_BAR; PG8_MMA(1, 1, At, B1); PG8_BAR;
            PG8_LDB(B0, 1, 0); PG8_SCHED; PG8_LDA(At, 1, 0); PG8_STAGE(PG8_SA(0, 1), a2 + hstep, voffA);
            PG8_WAIT_L(8); PG8_BAR; PG8_WAIT_L(0); PG8_MMA(0, 0, At, B0); PG8_BAR; PG8_SCHED;
            PG8_LDB(B1, 1, 1); PG8_STAGE(PG8_SB(1, 0), b3, voffB);
            PG8_BAR; PG8_WAIT_L(0); PG8_MMA(0, 1, At, B1); PG8_BAR;
            PG8_LDA(At, 1, 1); PG8_STAGE(PG8_SA(1, 0), a3, voffA);
            PG8_BAR; PG8_WAIT_L(0); PG8_MMA(1, 0, At, B0); PG8_BAR; PG8_SCHED;
            PG8_STAGE(PG8_SB(1, 1), b3 + hstep, voffB);
            PG8_WAIT_V(6); PG8_BAR; PG8_MMA(1, 1, At, B1); PG8_BAR;
            }
        }
        if constexpr (ALIGN_EPI) { if (wr == 0) PG8_BAR; }
        if constexpr (!Epi::AFTER_DRAIN) { E(acc, cur, wr, wc, fr, fq); S.done(cur); }
        if (!has_next) break;
#pragma unroll
        for (int a = 0; a < 2; ++a)
#pragma unroll
            for (int b = 0; b < 2; ++b)
#pragma unroll
                for (int m = 0; m < 4; ++m)
#pragma unroll
                    for (int n = 0; n < 2; ++n) acc[a][b][m][n] = (f32x4){0.f, 0.f, 0.f, 0.f};
        cur = nxt; cA = nA; cB = nB; ++ui;
        if constexpr (ALIGN_EPI) { if (wr == 1) PG8_BAR; }
    }
    PG8_WAIT_V(0);
    if constexpr (!ALIGN_EPI) { if (wr == 0) PG8_BAR; }
    PG8_BAR;
    if constexpr (Epi::AFTER_DRAIN) { E.fused(acc, cur, wr, wc, fr, fq, lds, wid, lane); S.done(cur); }
#undef PG8_SA
#undef PG8_SB
#undef PG8_STAGE
#undef PG8_LDA
#undef PG8_LDB
#undef PG8_MMA
#undef PG8_WAIT_V
#undef PG8_WAIT_L
#undef PG8_BAR
#undef PG8_SCHED
}
}
#include <hip/hip_bf16.h>
#include <cmath>
namespace attn_body {
using bf16=__hip_bfloat16;
using bf16x8=__attribute__((ext_vector_type(8)))short;
using s16x4=__attribute__((ext_vector_type(4)))short;
using f32x16=__attribute__((ext_vector_type(16)))float;
using u32x4=__attribute__((ext_vector_type(4)))unsigned;
constexpr int BATCH=8,NHEAD=8,SEQ=2048,D=64,DM=NHEAD*D;
constexpr int NW=8,QBLK=32,QB=QBLK*NW,KVBLK=64,NQB=SEQ/QB;
constexpr int ATTN_PITCH=DM, ATTN_UNIT_ROWS=QB;
__device__ __forceinline__ int crow(int r,int hi){return (r&3)+8*(r>>2)+4*hi;}
#define SBAR() __builtin_amdgcn_sched_barrier(0)
__device__ __forceinline__ void cmask(f32x16&p0,f32x16&p1,int jb,int qrel,int hi){
  const float NEG=-INFINITY; int kb=64*jb+4*hi;
  #pragma unroll
  for(int r=0;r<16;++r){int kv=kb+(r&3)+8*(r>>2); if(kv>qrel)p0[r]=NEG; if(kv+32>qrel)p1[r]=NEG;}
}

constexpr int NSLOT=3, SLOTB=8192;
constexpr int LDS_K=0, LDS_V=NSLOT*SLOTB, LDS_WS=2*NSLOT*SLOTB, LDS_OST=LDS_WS+NW*64*4, LDS_CS=LDS_OST+NW*4096, LDS_BYTES=LDS_CS+SEQ*4;
constexpr float C2=0.125f*1.4426950408889634f;
__device__ __forceinline__ void glds16(const void*gsrc,unsigned lds_dst){unsigned keep;
  asm volatile("s_mov_b32 %0, m0\n\ts_mov_b32 m0, %2\n\ts_nop 0\n\tglobal_load_lds_dwordx4 %1, off\n\ts_mov_b32 m0, %0":"=&s"(keep):"v"(gsrc),"s"(lds_dst):"memory");}
__device__ __forceinline__ float max3f(float a,float b,float c){float r;asm("v_max3_f32 %0, %1, %2, %3":"=v"(r):"v"(a),"v"(b),"v"(c));return r;}
__device__ __forceinline__ float max2f(float a,float b){float r;asm("v_max_f32_e32 %0, %1, %2":"=v"(r):"v"(a),"v"(b));return r;}
__device__ __forceinline__ float fadd_s(float a,float b){float r;asm("v_add_f32_e32 %0, %1, %2":"=v"(r):"v"(a),"v"(b));return r;}
__device__ __forceinline__ float fsub_s(float a,float b){float r;asm("v_sub_f32_e32 %0, %1, %2":"=v"(r):"v"(a),"v"(b));return r;}
typedef float f32x2_t __attribute__((ext_vector_type(2))); typedef __bf16 bf16x2_t __attribute__((ext_vector_type(2)));
__device__ __forceinline__ unsigned cvtpk_s(float lo,float hi){f32x2_t v={lo,hi};bf16x2_t b=__builtin_convertvector(v,bf16x2_t);return __builtin_bit_cast(unsigned,b);}
#define WAIT_BAR(N) asm volatile("s_waitcnt vmcnt(" #N ") lgkmcnt(0)\n\ts_barrier":::"memory")

__device__ __forceinline__ void qkt(f32x16&p0,f32x16&p1,const char*Kslot,const bf16x8*qr,int r32,int hi){
  const char*kb=Kslot+hi*1024+r32*16;
  #pragma unroll
  for(int d0=0;d0<4;++d0){
    const bf16x8 b0=*reinterpret_cast<const bf16x8*>(kb+d0*2048);
    const bf16x8 b1=*reinterpret_cast<const bf16x8*>(kb+d0*2048+512);
    p0=__builtin_amdgcn_mfma_f32_32x32x16_bf16(b0,qr[d0],p0,0,0,0);p1=__builtin_amdgcn_mfma_f32_32x32x16_bf16(b1,qr[d0],p1,0,0,0);}
}
typedef __attribute__((address_space(3))) const char* lds_cptr;
typedef short v4i16_t __attribute__((ext_vector_type(4)));
__device__ __forceinline__ void kload8(bf16x8*kf,lds_cptr kp){
  kf[0]=*(const __attribute__((address_space(3))) bf16x8*)(kp);      kf[1]=*(const __attribute__((address_space(3))) bf16x8*)(kp+512);
  kf[2]=*(const __attribute__((address_space(3))) bf16x8*)(kp+2048); kf[3]=*(const __attribute__((address_space(3))) bf16x8*)(kp+2560);
  kf[4]=*(const __attribute__((address_space(3))) bf16x8*)(kp+4096); kf[5]=*(const __attribute__((address_space(3))) bf16x8*)(kp+4608);
  kf[6]=*(const __attribute__((address_space(3))) bf16x8*)(kp+6144); kf[7]=*(const __attribute__((address_space(3))) bf16x8*)(kp+6656);
}
__device__ __forceinline__ void kload2(bf16x8*kf,lds_cptr kp,int j){ kf[2*j]=*(const __attribute__((address_space(3))) bf16x8*)(kp+j*2048); kf[2*j+1]=*(const __attribute__((address_space(3))) bf16x8*)(kp+j*2048+512); }
__device__ __forceinline__ s16x4 vtr(lds_cptr p){ return __builtin_bit_cast(s16x4,__builtin_amdgcn_ds_read_tr16_b64_v4i16((__attribute__((address_space(3))) v4i16_t*)p)); }
__device__ __forceinline__ float rowmax(const f32x16&p0,const f32x16&p1){
  float a=max3f(p0[0],p0[1],p1[0]),b=max3f(p0[2],p0[3],p1[1]);a=max3f(a,p1[2],p1[3]);
  #pragma unroll
  for(int r=4;r<16;r+=4){a=max3f(a,p0[r],p0[r+1]);b=max3f(b,p0[r+2],p0[r+3]);a=max3f(a,p1[r],p1[r+1]);b=max3f(b,p1[r+2],p1[r+3]);}
  const float m=max2f(a,b);
  auto rr=__builtin_amdgcn_permlane32_swap(__float_as_uint(m),__float_as_uint(m),false,false);
  return max2f(__uint_as_float(rr[0]),__uint_as_float(rr[1]));
}
__device__ __forceinline__ void pv(f32x16*o,int vb,bf16x8 pa0,bf16x8 pa1,bf16x8 pa2,bf16x8 pa3){
  #pragma unroll
  for(int d0=0;d0<2;++d0){s16x4 lo[4],hi[4];
    #pragma unroll
    for(int ks=0;ks<4;++ks){
      asm volatile("ds_read_b64_tr_b16 %0,%1 offset:%c2":"=&v"(lo[ks]):"v"(vb),"i"(d0*4096+ks*1024):"memory");
      asm volatile("ds_read_b64_tr_b16 %0,%1 offset:%c2":"=&v"(hi[ks]):"v"(vb),"i"(d0*4096+ks*1024+512):"memory");}
    asm volatile("s_waitcnt lgkmcnt(0)":::"memory");SBAR();
    #define PK(k) (bf16x8){lo[k][0],lo[k][1],lo[k][2],lo[k][3],hi[k][0],hi[k][1],hi[k][2],hi[k][3]}
    o[d0]=__builtin_amdgcn_mfma_f32_32x32x16_bf16(pa0,PK(0),o[d0],0,0,0);
    o[d0]=__builtin_amdgcn_mfma_f32_32x32x16_bf16(pa1,PK(1),o[d0],0,0,0);
    o[d0]=__builtin_amdgcn_mfma_f32_32x32x16_bf16(pa2,PK(2),o[d0],0,0,0);
    o[d0]=__builtin_amdgcn_mfma_f32_32x32x16_bf16(pa3,PK(3),o[d0],0,0,0);
    #undef PK
  }
}

#ifndef ATTN_STORE16
#define ATTN_STORE16(p,v) (*(u32x4*)(p)=(v))
#endif
template<int THRL> __device__ __forceinline__ void attn_unit(int b,int h,int qb,const bf16*Q,const bf16*__restrict__ K,const bf16*__restrict__ V,bf16*O,const float*__restrict__ CL2,char*shm,int t0=0){
  int tid=threadIdx.x; asm volatile("":"+v"(tid)); const int lane=tid&63,r32=lane&31,hi=lane>>5; const int wid=__builtin_amdgcn_readfirstlane(tid>>6);
  const long rowbase=(long)b*SEQ; const int q0=qb*QB;
  const bf16*Qw=Q+(rowbase+q0+wid*QBLK)*DM+h*D;
  const bf16*Kh=K+rowbase*DM+h*D,*Vh=V+rowbase*DM+h*D;
  const unsigned lds0=(unsigned)(uintptr_t)shm;
  float*wsf=(float*)(shm+LDS_WS)+wid*64;
  const bf16*ksrc=Kh+(long)(t0*KVBLK+lane)*DM+wid*8;
  const bf16*vsrc=Vh+(long)(t0*KVBLK+16*(wid&3)+(lane>>2))*DM+(wid>>2)*32+(lane&3)*8;
  const unsigned kdst=lds0+LDS_K+wid*1024, vdst=lds0+LDS_V+wid*1024;
  #define DMA_K(t,slot) glds16(ksrc+(long)(t)*KVBLK*DM,(unsigned)__builtin_amdgcn_readfirstlane(kdst+(slot)))
  #define DMA_V(t,slot) glds16(vsrc+(long)(t)*KVBLK*DM,(unsigned)__builtin_amdgcn_readfirstlane(vdst+(slot)))
  const int vb0=(int)(lds0+LDS_V)+((lane>>4)&1)*32+(lane&3)*8+(4*hi+((lane&15)>>2))*64;
  const char*Kbase=shm+LDS_K; bf16x8 kf[8];
  const lds_cptr shm3=(lds_cptr)shm; const lds_cptr kp0=shm3+LDS_K+hi*1024+r32*16; const lds_cptr vp0=shm3+LDS_V+((lane>>4)&1)*32+(lane&3)*8+(4*hi+((lane&15)>>2))*64;
  const int NT=(q0+QB)/KVBLK-t0;
  DMA_K(0,0);DMA_V(0,0);DMA_K(1,SLOTB);
  bf16x8 qr[4];
  #pragma unroll
  for(int d0=0;d0<4;++d0)qr[d0]=*reinterpret_cast<const bf16x8*>(&Qw[(long)r32*DM+d0*16+hi*8]);
  const float*cg=CL2+(long)(b*NHEAD+h)*SEQ;
  { float*csf=(float*)(shm+LDS_CS); for(int i=tid;i<q0+QB;i+=NW*64)csf[i]=cg[i]; }
  const lds_cptr cs3=(lds_cptr)shm+LDS_CS+hi*16+t0*256;
  float nm=cg[q0+wid*QBLK+r32],l_reg=0.f;f32x16 o[2];o[0]=f32x16{};o[1]=f32x16{};
  const int qrel=wid*QBLK+r32;
  #define CMASK(P0,P1,t) do{int jb_=(t)-(NT-4); if(jb_>=0)cmask(P0,P1,jb_,qrel,hi);}while(0)
  bool resc=false;
  typedef float f32x4_t __attribute__((ext_vector_type(4)));
  #define BIAS(C0,C1,t) do{ const lds_cptr cp_=cs3+(t)*256; \
    _Pragma("unroll") for(int g_=0;g_<4;++g_){ const f32x4_t a_=*(const __attribute__((address_space(3))) f32x4_t*)(cp_+g_*32), b_=*(const __attribute__((address_space(3))) f32x4_t*)(cp_+g_*32+128); \
      _Pragma("unroll") for(int i_=0;i_<4;++i_){ C0[4*g_+i_]=nm-a_[i_]; C1[4*g_+i_]=nm-b_[i_]; } } }while(0)
  #define START(P0,P1) do{ const float rm=rowmax(P0,P1); resc=false; \
    { const float dl=(rm>(float)THRL)?rm:0.f;     \
      nm=fsub_s(nm,dl); \
      _Pragma("unroll") for(int r=0;r<16;++r){P0[r]=fsub_s(P0[r],dl);P1[r]=fsub_s(P1[r],dl);} } \
    _Pragma("unroll") for(int r=0;r<16;++r)P0[r]=__builtin_amdgcn_exp2f(P0[r]); }while(0)
  #define RESC() do{ if(resc){ asm volatile("s_waitcnt lgkmcnt(0)":::"memory"); \
      _Pragma("unroll") for(int d_=0;d_<2;++d_) _Pragma("unroll") for(int r=0;r<16;++r)o[d_][r]*=wsf[crow(r,hi)]; } }while(0)
  f32x16 pA0,pA1,pB0,pB1;
  int sl_prev=0,sl_cur=0,sl_next=SLOTB;
  #define ROT() do{sl_prev=sl_cur;sl_cur=sl_next;sl_next=(sl_next==(NSLOT-1)*SLOTB)?0:sl_next+SLOTB;}while(0)
  DMA_K(2,2*SLOTB);
  WAIT_BAR(3);
  BIAS(pA0,pA1,0); qkt(pA0,pA1,Kbase,qr,r32,hi);asm volatile("s_nop 15\n\ts_nop 7":"+v"(pA0),"+v"(pA1));CMASK(pA0,pA1,0);
  START(pA0,pA1);
  _Pragma("unroll") for(int r=0;r<16;++r)pA1[r]=__builtin_amdgcn_exp2f(pA1[r]);
  WAIT_BAR(0);
  DMA_K(3,0);DMA_V(1,SLOTB);
  ROT();
  kload8(kf,kp0+sl_cur);
  WAIT_BAR(2);
  s16x4 vlo[8],vhi[8]; u32x4 pw0,pw1,pw2,pw3;
  #define PKW(P,B) cvtpk_s(P[B],P[B+1])
  #define PAF(k) __builtin_bit_cast(bf16x8,pw##k)
  #define VFR(i) (bf16x8){vlo[i][0],vlo[i][1],vlo[i][2],vlo[i][3],vhi[i][0],vhi[i][1],vhi[i][2],vhi[i][3]}
  #define PIN(x) asm volatile("":"+v"(x))
  #define MX3(a,b,c) __builtin_fmaxf(__builtin_fmaxf((a),(b)),(c))
  #define GAPA(MF,A0,A1,A2,A3,W0,W1,PW) do{ MF; sacc+=A0; sacc+=A1; sacc+=A2; sacc+=A3; PIN(sacc); W0; W1; PIN(PW); SBAR(); }while(0)
  #define EX(v) __builtin_amdgcn_exp2f(v)
  #define GAPB(MF,X,B) do{ MF; X[B]=EX(X[B]); X[B+1]=EX(X[B+1]); X[B+2]=EX(X[B+2]); X[B+3]=EX(X[B+3]); PIN(X); SBAR(); }while(0)
  #define VRD(i) do{ vlo[i]=vtr(vp_+(((i)>>2)*4096+((i)&3)*1024)); vhi[i]=vtr(vp_+(((i)>>2)*4096+((i)&3)*1024+512)); }while(0)
  #define KRD(G,j) do{ if(G){ kload2(kf,kp0+sl_next,j); SBAR(); } }while(0)
  #define STEP(C0,C1,P0,P1,t,GK,GV,GL) do{ SBAR(); BIAS(C0,C1,t); SBAR(); \
    const lds_cptr vp_=vp0+sl_prev; \
    VRD(0); SBAR(); float sacc=(P0[0]+P0[1]); \
    GAPA(C0=__builtin_amdgcn_mfma_f32_32x32x16_bf16(kf[0],qr[0],C0,0,0,0), P0[2],P0[3],P0[4],P0[5],     pw0[0]=PKW(P0,0), pw0[1]=PKW(P0,2), pw0); \
    VRD(4); SBAR(); GAPA(C1=__builtin_amdgcn_mfma_f32_32x32x16_bf16(kf[1],qr[0],C1,0,0,0), P0[6],P0[7],P0[8],P0[9],     pw0[2]=PKW(P0,4), pw0[3]=PKW(P0,6), pw0); \
    VRD(1); SBAR(); GAPA(C0=__builtin_amdgcn_mfma_f32_32x32x16_bf16(kf[2],qr[1],C0,0,0,0),   P0[10],P0[11],P0[12],P0[13], pw1[0]=PKW(P0,8), pw1[1]=PKW(P0,10), pw1); \
    VRD(5); SBAR(); GAPA(C1=__builtin_amdgcn_mfma_f32_32x32x16_bf16(kf[3],qr[1],C1,0,0,0),   P0[14],P0[15],P1[0],P1[1],   pw1[2]=PKW(P0,12),pw1[3]=PKW(P0,14), pw1); \
    VRD(2); SBAR(); GAPA(C0=__builtin_amdgcn_mfma_f32_32x32x16_bf16(kf[4],qr[2],C0,0,0,0),   P1[2],P1[3],P1[4],P1[5],     pw2[0]=PKW(P1,0), pw2[1]=PKW(P1,2), pw2); \
    VRD(6); SBAR(); GAPA(C1=__builtin_amdgcn_mfma_f32_32x32x16_bf16(kf[5],qr[2],C1,0,0,0),   P1[6],P1[7],P1[8],P1[9],     pw2[2]=PKW(P1,4), pw2[3]=PKW(P1,6), pw2); \
    VRD(3); SBAR(); GAPA(C0=__builtin_amdgcn_mfma_f32_32x32x16_bf16(kf[6],qr[3],C0,0,0,0),   P1[10],P1[11],P1[12],P1[13], pw3[0]=PKW(P1,8), pw3[1]=PKW(P1,10), pw3); \
    VRD(7); SBAR(); GAPA(C1=__builtin_amdgcn_mfma_f32_32x32x16_bf16(kf[7],qr[3],C1,0,0,0),   P1[14],P1[15],0.f,0.f,       pw3[2]=PKW(P1,12),pw3[3]=PKW(P1,14), pw3); \
    l_reg+=sacc; \
    if(GK){DMA_K((t)+3,sl_cur);} if(GV){DMA_V((t)+1,sl_next);} \
    CMASK(C0,C1,t); \
    { float a=MX3(C0[0],C0[1],C1[0]),b=MX3(C0[2],C0[3],C1[1]); a=MX3(a,C1[2],C1[3]); \
      _Pragma("unroll") for(int r=4;r<16;r+=4){a=MX3(a,C0[r],C0[r+1]);b=MX3(b,C0[r+2],C0[r+3]);a=MX3(a,C1[r],C1[r+1]);b=MX3(b,C1[r+2],C1[r+3]);} \
      float rm=__builtin_fmaxf(a,b); { auto rr=__builtin_amdgcn_permlane32_swap(__float_as_uint(rm),__float_as_uint(rm),false,false); rm=__builtin_fmaxf(__uint_as_float(rr[0]),__uint_as_float(rr[1])); } \
      resc=false; \
      if(__builtin_expect(__any(rm>(float)THRL),0)){ const float dl=__builtin_fmaxf(rm,0.f); nm-=dl; \
        _Pragma("unroll") for(int r=0;r<16;++r){C0[r]-=dl;C1[r]-=dl;} \
        const float f=__builtin_amdgcn_exp2f(-dl); l_reg*=f; if(hi==0)wsf[r32]=f; resc=true; } } \
    SBAR(); \
    GAPB(o[0]=__builtin_amdgcn_mfma_f32_32x32x16_bf16(PAF(0),VFR(0),o[0],0,0,0), C0,0); \
    GAPB(o[1]=__builtin_amdgcn_mfma_f32_32x32x16_bf16(PAF(0),VFR(4),o[1],0,0,0), C0,4); \
    KRD(GL,0); GAPB(o[0]=__builtin_amdgcn_mfma_f32_32x32x16_bf16(PAF(1),VFR(1),o[0],0,0,0), C0,8); \
    KRD(GL,1); GAPB(o[1]=__builtin_amdgcn_mfma_f32_32x32x16_bf16(PAF(1),VFR(5),o[1],0,0,0), C0,12); \
    KRD(GL,2); GAPB(o[0]=__builtin_amdgcn_mfma_f32_32x32x16_bf16(PAF(2),VFR(2),o[0],0,0,0), C1,0); \
    KRD(GL,3); GAPB(o[1]=__builtin_amdgcn_mfma_f32_32x32x16_bf16(PAF(2),VFR(6),o[1],0,0,0), C1,4); \
    GAPB(o[0]=__builtin_amdgcn_mfma_f32_32x32x16_bf16(PAF(3),VFR(3),o[0],0,0,0), C1,8); \
    GAPB(o[1]=__builtin_amdgcn_mfma_f32_32x32x16_bf16(PAF(3),VFR(7),o[1],0,0,0), C1,12); \
    }while(0)
  int t=1;
  #undef CMASK
  #define CMASK(P0,P1,t) do{}while(0)
  for(;t+5<NT;t+=2){
    STEP(pB0,pB1,pA0,pA1,t,true,true,true);     WAIT_BAR(2); RESC(); ROT();
    STEP(pA0,pA1,pB0,pB1,t+1,true,true,true);   WAIT_BAR(2); RESC(); ROT();
  }
  #undef CMASK
  #define CMASK(P0,P1,t) do{int jb_=(t)-(NT-4); if(jb_>=0)cmask(P0,P1,jb_,qrel,hi);}while(0)
  #define ENDW(tt) do{ if((tt)+3<NT){WAIT_BAR(2);} else if((tt)+2<NT){WAIT_BAR(1);} else {WAIT_BAR(0);} }while(0)
  for(;t+1<NT;t+=2){
    STEP(pB0,pB1,pA0,pA1,t,(t+3<NT),(t+1<NT),(t+1<NT));       ENDW(t);   RESC(); ROT();
    STEP(pA0,pA1,pB0,pB1,t+1,(t+4<NT),(t+2<NT),(t+2<NT));     ENDW(t+1); RESC(); ROT();
  }
  STEP(pB0,pB1,pA0,pA1,NT-1,false,false,false); RESC();
  { float sacc=pB0[0]+pB0[1]; _Pragma("unroll") for(int r=2;r<16;++r)sacc+=pB0[r]; _Pragma("unroll") for(int r=0;r<16;++r)sacc+=pB1[r]; l_reg+=sacc;
    pw0=(u32x4){PKW(pB0,0),PKW(pB0,2),PKW(pB0,4),PKW(pB0,6)};pw1=(u32x4){PKW(pB0,8),PKW(pB0,10),PKW(pB0,12),PKW(pB0,14)};pw2=(u32x4){PKW(pB1,0),PKW(pB1,2),PKW(pB1,4),PKW(pB1,6)};pw3=(u32x4){PKW(pB1,8),PKW(pB1,10),PKW(pB1,12),PKW(pB1,14)};
    SBAR(); pv(o,vb0+sl_cur,PAF(0),PAF(1),PAF(2),PAF(3)); }
  #undef PKW
  #undef PAF
  #undef VFR
  #undef PIN
  #undef MX3
  #undef GAPA
  #undef GAPB
  #undef EX
  #undef VRD
  #undef KRD
  #undef STEP
  #undef ENDW
  {auto rr=__builtin_amdgcn_permlane32_swap(__float_as_uint(l_reg),__float_as_uint(l_reg),false,false);l_reg=__uint_as_float(rr[0])+__uint_as_float(rr[1]);}
  if(hi==0)wsf[32+r32]=l_reg;asm volatile("s_waitcnt lgkmcnt(0)":::"memory");
  float rli[16];
  #pragma unroll
  for(int r=0;r<16;++r)rli[r]=__builtin_amdgcn_rcpf(wsf[32+crow(r,hi)]);
  bf16*Ow=O+(rowbase+q0+wid*QBLK)*DM+h*D;
  { bf16*stg=(bf16*)(shm+LDS_OST)+wid*2048;
    #pragma unroll
    for(int r=0;r<16;++r){const int orow=crow(r,hi);
      #pragma unroll
      for(int d0=0;d0<2;++d0)stg[orow*64+d0*32+r32]=__float2bfloat16(o[d0][r]*rli[r]);}
    asm volatile("s_waitcnt lgkmcnt(0)":::"memory");
    #pragma unroll
    for(int i=0;i<4;++i){const int row=i*8+(lane>>3),ch=lane&7; const u32x4 v=*(const u32x4*)(stg+row*64+ch*8); ATTN_STORE16(Ow+(long)row*DM+ch*8,v);} }
  asm volatile("s_waitcnt lgkmcnt(0)\n\ts_barrier":::"memory");
  #undef DMA_K
  #undef DMA_V
  #undef CMASK
  #undef START
  #undef RESC
  #undef ROT
  #undef BIAS
}
constexpr int ATTN_LDS_BYTES=LDS_BYTES;
constexpr float SKIP_THR=64.0f;
__device__ __forceinline__ int attn_first_tile(const float*__restrict__ CL2,int bh,int qb){
  const int lane=threadIdx.x&63; const float*c=CL2+(long)bh*SEQ; const int q0=qb*QB, nfar=4*qb;
  const float cq=c[q0]; const float cj=c[(lane<nfar?lane:0)*KVBLK+KVBLK-1];
  const unsigned long long keep=__ballot(lane<nfar && (cq-cj)>=-SKIP_THR) | (1ull<<nfar);
  const int t0=__builtin_ctzll(keep)&~1;
  return __builtin_amdgcn_readfirstlane(t0);
}
struct AttnTensors { const bf16* Q; const bf16* K; const bf16* V; bf16* O; const float* CL2; };
struct AttnUnit { int bh; int qb; };
struct StaticOrder {
  int vcu;
  __device__ __forceinline__ explicit StaticOrder(int grid,int block):vcu((block%8)*(grid/8)+block/8){}
  __device__ __forceinline__ bool next(int i,AttnUnit&u)const{ if(i>=2||vcu>=BATCH*NHEAD*4)return false; const int s=vcu&3; u.bh=vcu>>2; u.qb=(i==0)?s:7-s; return true; }
  __device__ __forceinline__ void a_ready(const AttnUnit&)const{}
  __device__ __forceinline__ void done(const AttnUnit&)const{}
};
template<class Sched,int THRL=8> __device__ __forceinline__ void attn_phase(char*lds,const AttnTensors&T,const Sched&S){
  AttnUnit u;
  for(int i=0;S.next(i,u);++i){ S.a_ready(u); attn_unit<THRL>(u.bh/NHEAD,u.bh%NHEAD,u.qb,T.Q,T.K,T.V,T.O,T.CL2,lds); S.done(u); }
}
#undef SBAR
#undef WAIT_BAR
}
namespace sgu_body {
using attn_body::bf16x8; using attn_body::s16x4; using attn_body::f32x16; using attn_body::u32x4; using attn_body::lds_cptr; using attn_body::vtr;
constexpr int SGU_LDS_BYTES = 65536;
__device__ __forceinline__ float bflo(unsigned w) { return __uint_as_float(w << 16); }
__device__ __forceinline__ float bfhi(unsigned w) { return __uint_as_float(w & 0xffff0000u); }
__device__ __forceinline__ void sgu_unit(int ck, int half, const unsigned short* __restrict__ VG, const unsigned short* UGI, unsigned short* UGY, const unsigned short* __restrict__ WSMP,
                                         const float* __restrict__ lng, const float* __restrict__ lnb, const float* __restrict__ bs, char* shm) {
    int tid = threadIdx.x; asm volatile("" : "+v"(tid)); const int lane = tid & 63, r32 = lane & 31, hi = lane >> 5; const int wid = __builtin_amdgcn_readfirstlane(tid >> 6);
    const size_t row0 = (size_t)ck * 128;
    u32x4 raw[16];
#pragma unroll
    for (int i = 0; i < 16; ++i) raw[i] = *(const u32x4*)(VG + (row0 + 16 * wid + i) * 512 + 8 * lane);
    float mu[16], rs[16];
#pragma unroll
    for (int i = 0; i < 16; ++i) {
        const float a0 = bflo(raw[i].x), a1 = bfhi(raw[i].x), a2 = bflo(raw[i].y), a3 = bfhi(raw[i].y), a4 = bflo(raw[i].z), a5 = bfhi(raw[i].z), a6 = bflo(raw[i].w), a7 = bfhi(raw[i].w);
        float s = ((a0 + a1) + (a2 + a3)) + ((a4 + a5) + (a6 + a7));
        float q = ((a0 * a0 + a1 * a1) + (a2 * a2 + a3 * a3)) + ((a4 * a4 + a5 * a5) + (a6 * a6 + a7 * a7));
        s = wave_allsum(s); q = wave_allsum(q);
        const float m = s * (1.0f / 512.0f); const float var = fmaxf(q * (1.0f / 512.0f) - m * m, 0.f);
        mu[i] = m; rs[i] = 1.0f / sqrtf(var + 1e-6f);
    }
    if ((lane >> 5) == half) {
        const int gl = (lane >> 3) & 3, cc = 8 * (lane & 7);
        float gv[8], bv[8];
#pragma unroll
        for (int j = 0; j < 8; ++j) { gv[j] = lng[8 * lane + j]; bv[j] = lnb[8 * lane + j]; }
        char* img = shm + gl * 16384 + (cc >> 5) * 4096 + (cc & 31) * 2;
#pragma unroll
        for (int i = 0; i < 16; ++i) {
            const int s = 16 * wid + i;
            const float m = mu[i], r = rs[i];
            const float v0 = (bflo(raw[i].x) - m) * r * gv[0] + bv[0], v1 = (bfhi(raw[i].x) - m) * r * gv[1] + bv[1], v2 = (bflo(raw[i].y) - m) * r * gv[2] + bv[2], v3 = (bfhi(raw[i].y) - m) * r * gv[3] + bv[3];
            const float v4 = (bflo(raw[i].z) - m) * r * gv[4] + bv[4], v5 = (bfhi(raw[i].z) - m) * r * gv[5] + bv[5], v6 = (bflo(raw[i].w) - m) * r * gv[6] + bv[6], v7 = (bfhi(raw[i].w) - m) * r * gv[7] + bv[7];
            u32x4 w; w.x = pg8::cvt_pk_bf16(v0, v1); w.y = pg8::cvt_pk_bf16(v2, v3); w.z = pg8::cvt_pk_bf16(v4, v5); w.w = pg8::cvt_pk_bf16(v6, v7);
            *(u32x4*)(img + (s >> 6) * 8192 + ((s & 63) >> 4) * 1024 + (s & 15) * 64) = w;
        }
    }
    typedef unsigned u32x2_t __attribute__((ext_vector_type(2)));
    const int gl4 = wid >> 1, cb4 = wid & 1, g4 = 4 * half + gl4;
    bf16x8 wf[20]; u32x2_t ugq[4][4]; float bsq[4];
#pragma unroll
    for (int tb = 0; tb < 4; ++tb) {
        const unsigned short* wrow = WSMP + ((size_t)(g4 * 128 + 32 * tb + r32)) * 128 + 8 * hi;
#pragma unroll
        for (int ks = 0; ks < 2 * (tb + 1); ++ks) wf[tb * (tb + 1) + ks] = *(const bf16x8*)(wrow + 16 * ks);
        const int t = 32 * tb + r32; bsq[tb] = bs[g4 * 128 + t];
        const unsigned short* urow = UGI + (row0 + t) * 512 + g4 * 64 + 32 * cb4 + 4 * hi;
#pragma unroll
        for (int q4 = 0; q4 < 4; ++q4) ugq[tb][q4] = *(const u32x2_t*)(urow + 8 * q4);
    }
    __syncthreads();
    {
        const int gl = gl4, cb = cb4, g = g4;
        const lds_cptr vp = (lds_cptr)shm + gl * 16384 + cb * 4096 + ((lane >> 4) & 1) * 32 + (lane & 3) * 8 + (4 * hi + ((lane & 15) >> 2)) * 64;
#pragma unroll
        for (int tb = 0; tb < 4; ++tb) {
            f32x16 acc = f32x16{};
#pragma unroll
            for (int ks = 0; ks < 2 * (tb + 1); ++ks) {
                const s16x4 lo = vtr(vp + (ks >> 2) * 8192 + (ks & 3) * 1024), hh = vtr(vp + (ks >> 2) * 8192 + (ks & 3) * 1024 + 512);
                const bf16x8 a = (bf16x8){lo[0], lo[1], lo[2], lo[3], hh[0], hh[1], hh[2], hh[3]};
                acc = __builtin_amdgcn_mfma_f32_32x32x16_bf16(a, wf[tb * (tb + 1) + ks], acc, 0, 0, 0);
            }
            const int t = 32 * tb + r32; const float bsv = bsq[tb];
            unsigned short* yrow = UGY + (row0 + t) * 512 + g * 64 + 32 * cb + 4 * hi;
#pragma unroll
            for (int q4 = 0; q4 < 4; ++q4) {
                const u32x2_t ug = ugq[tb][q4];
                const float y0 = bflo(ug.x) * (acc[4 * q4 + 0] + bsv), y1 = bfhi(ug.x) * (acc[4 * q4 + 1] + bsv), y2 = bflo(ug.y) * (acc[4 * q4 + 2] + bsv), y3 = bfhi(ug.y) * (acc[4 * q4 + 3] + bsv);
                u32x2_t w; w.x = pg8::cvt_pk_bf16(y0, y1); w.y = pg8::cvt_pk_bf16(y2, y3);
                *(u32x2_t*)(yrow + 8 * q4) = w;
            }
        }
    }
    __syncthreads();
}
}
namespace peer_body {
using attn_body::bf16x8; using attn_body::f32x16; using attn_body::u32x4;
typedef __bf16 bf16x2_t __attribute__((ext_vector_type(2)));
constexpr int PEER_TOK = 64;
constexpr int L_PI = 0, L_PG = 32768, L_PS = 65536, PEER_LDS_BYTES = 98304;
__device__ __forceinline__ int okey(int b) { return b ^ ((b >> 31) & 0x7fffffff); }
__device__ __forceinline__ void ce(int& a, int& b) { const int hi = a > b ? a : b, lo = a > b ? b : a; a = hi; b = lo; }
__device__ __forceinline__ void sort16(int (&v)[16]) {
#pragma unroll
    for (int k = 2; k <= 16; k <<= 1)
#pragma unroll
        for (int j = k >> 1; j > 0; j >>= 1)
#pragma unroll
            for (int i = 0; i < 16; ++i) { const int l = i ^ j; if (l > i) { if ((i & k) == 0) ce(v[i], v[l]); else ce(v[l], v[i]); } }
}
__device__ __forceinline__ void merge16(int (&a)[16], const int (&b)[16]) {
#pragma unroll
    for (int i = 0; i < 16; ++i) a[i] = a[i] > b[15 - i] ? a[i] : b[15 - i];
#pragma unroll
    for (int j = 8; j > 0; j >>= 1)
#pragma unroll
        for (int i = 0; i < 16; ++i) { const int l = i ^ j; if (l > i) ce(a[i], a[l]); }
}
__device__ __forceinline__ float dot2(unsigned w, unsigned x, float acc) { return __builtin_amdgcn_fdot2_f32_bf16(__builtin_bit_cast(bf16x2_t, w), __builtin_bit_cast(bf16x2_t, x), acc, false); }
__device__ __forceinline__ float gelu_erf(float v) { return 0.5f * v * (1.0f + erff(v * 0.70710678118654752f)); }

constexpr int SK_PITCH = 272;
__device__ __forceinline__ void top16_scores(int (&res)[16], const bf16x8 (&bq)[8], const char* SKl, int r32, int hi) {
    f32x16 acc[4];
#pragma unroll
    for (int nb = 0; nb < 4; ++nb) acc[nb] = f32x16{};
#pragma unroll
    for (int ks = 0; ks < 8; ++ks) {
#pragma unroll
        for (int nb = 0; nb < 4; ++nb) { const bf16x8 a = *(const bf16x8*)(SKl + (32 * nb + r32) * SK_PITCH + (16 * ks + 8 * hi) * 2);
            acc[nb] = __builtin_amdgcn_mfma_f32_32x32x16_bf16(a, bq[ks], acc[nb], 0, 0, 0); }
        if (ks & 1) __builtin_amdgcn_sched_barrier(0);
    }
    int k[4][16];
#pragma unroll
    for (int nb = 0; nb < 4; ++nb) {
#pragma unroll
        for (int r = 0; r < 16; ++r) { const int n = 32 * nb + (r & 3) + 8 * (r >> 2) + 4 * hi; k[nb][r] = okey((int)((__float_as_uint(acc[nb][r]) & ~0x7fu) | (unsigned)n)); }
        sort16(k[nb]);
    }
    merge16(k[0], k[1]); merge16(k[2], k[3]); merge16(k[0], k[2]);
    int lo[16], up[16];
#pragma unroll
    for (int i = 0; i < 16; ++i) { const auto rr = __builtin_amdgcn_permlane32_swap((unsigned)k[0][i], (unsigned)k[0][i], false, false); lo[i] = (int)rr[0]; up[i] = (int)rr[1]; }
    merge16(lo, up);
#pragma unroll
    for (int i = 0; i < 16; ++i) res[i] = lo[i];
}

__device__ __forceinline__ unsigned pack_i8x4(float a, float b, float c, float d) {
    const int ia = (int)__builtin_rintf(a), ib = (int)__builtin_rintf(b), ic = (int)__builtin_rintf(c), id = (int)__builtin_rintf(d);
    return (unsigned)(ia & 0xff) | ((unsigned)(ib & 0xff) << 8) | ((unsigned)(ic & 0xff) << 16) | ((unsigned)(id & 0xff) << 24);
}
typedef float f32x2_t __attribute__((ext_vector_type(2)));
typedef unsigned u32x2_t __attribute__((ext_vector_type(2)));
__device__ __forceinline__ void fma_fp8x4(f32x2_t& a01, f32x2_t& a23, unsigned v, f32x2_t w2) {
    const f32x2_t lo = __builtin_amdgcn_cvt_pk_f32_fp8((int)v, false), hi = __builtin_amdgcn_cvt_pk_f32_fp8((int)v, true);
    a01 = __builtin_elementwise_fma(lo, w2, a01); a23 = __builtin_elementwise_fma(hi, w2, a23);
}
template <int CTRL> __device__ __forceinline__ int dppi(int v) { return __builtin_amdgcn_update_dpp(0, v, CTRL, 0xf, 0xf, false); }
template <int CTRL> __device__ __forceinline__ float dppf(float v) { return __int_as_float(__builtin_amdgcn_update_dpp(0, __float_as_int(v), CTRL, 0xf, 0xf, false)); }
constexpr int DPP_HMIRROR = 0x141, DPP_XOR2 = 0x4E, DPP_XOR1 = 0xB1, DPP_ROR8 = 0x128;

__device__ __forceinline__ void peer_retrieve(int tk, const unsigned short* __restrict__ QP, const unsigned short* __restrict__ SK, const float* __restrict__ SU, const float* __restrict__ SV,
                                              const float* __restrict__ ST, unsigned short* __restrict__ PID, float* __restrict__ G2, float* __restrict__ PS2, char* shm) {
    int tid = threadIdx.x; asm volatile("" : "+v"(tid)); const int lane = tid & 63, r32 = lane & 31, hi = lane >> 5; const int wid = __builtin_amdgcn_readfirstlane(tid >> 6);
    const int h = tk & 7, T0 = (tk >> 3) * 512 + 64 * wid;
    {   const u32x4* src = (const u32x4*)(SK + (size_t)h * 2 * 128 * 128);
#pragma unroll
        for (int i = 0; i < 8; ++i) { const int c = tid + 512 * i, row = c >> 4, ch = c & 15; *(u32x4*)(shm + row * SK_PITCH + ch * 16) = src[c]; }
    }
    __syncthreads();
#pragma unroll 1
    for (int tb = 0; tb < 2; ++tb) {
        const unsigned short* QPt = QP + (size_t)(T0 + 32 * tb) * 2048 + h * 256;
        int A[16], B[16];
        bf16x8 bqa[8], bqb[8];
#pragma unroll
        for (int ks = 0; ks < 8; ++ks) { bqa[ks] = *(const bf16x8*)(QPt + (size_t)r32 * 2048 + 16 * ks + 8 * hi); bqb[ks] = *(const bf16x8*)(QPt + 128 + (size_t)r32 * 2048 + 16 * ks + 8 * hi); }
        top16_scores(A, bqa, shm, r32, hi);
        top16_scores(B, bqb, shm + 128 * SK_PITCH, r32, hi);
        float fa[16], fb[16]; int na[16], nb[16];
#pragma unroll
        for (int i = 0; i < 16; ++i) { const int ba = okey(A[i]), bb = okey(B[i]); fa[i] = __int_as_float(ba); fb[i] = __int_as_float(bb); na[i] = (ba & 0x7f) << 7; nb[i] = bb & 0x7f; }
#define CAND(i, j) okey((int)((__float_as_uint(fa[i] + fb[j]) & ~0x3fffu) | (unsigned)(na[i] | nb[j])))
        const int NEGK = (int)0x80000000;
        int L0[16], L1[16], L2[16], L3[16];
#pragma unroll
        for (int j = 0; j < 16; ++j) L0[j] = CAND(0, j);
#pragma unroll
        for (int j = 0; j < 8; ++j) L1[j] = CAND(1, j);
#pragma unroll
        for (int j = 0; j < 5; ++j) L1[8 + j] = CAND(2, j);
#pragma unroll
        for (int j = 0; j < 3; ++j) L1[13 + j] = CAND(3, j);
        L2[0] = CAND(3, 3);
#pragma unroll
        for (int j = 0; j < 3; ++j) L2[1 + j] = CAND(4, j);
#pragma unroll
        for (int j = 0; j < 2; ++j) { L2[4 + j] = CAND(5, j); L2[6 + j] = CAND(6, j); L2[8 + j] = CAND(7, j); }
#pragma unroll
        for (int i = 8; i < 14; ++i) L2[2 + i] = CAND(i, 0);
        L3[0] = CAND(14, 0); L3[1] = CAND(15, 0);
#pragma unroll
        for (int i = 2; i < 16; ++i) L3[i] = NEGK;
#undef CAND
        sort16(L1); sort16(L2); sort16(L3);
        merge16(L0, L1); merge16(L2, L3); merge16(L0, L2);
        float e[16]; int id[16]; float se = 0.f;
        const float s0 = __int_as_float((okey(L0[0]) & ~0x3fff) | 0x2000);
#pragma unroll
        for (int i = 0; i < 16; ++i) { const int b = okey(L0[i]); id[i] = b & 0x3fff; const float s = __int_as_float((b & ~0x3fff) | 0x2000); e[i] = __expf(s - s0); se += e[i]; }
        const float inv = 1.0f / se;
        if (hi == 0) {
            const size_t t = (size_t)(T0 + 32 * tb + r32); const float st = ST[t];
            unsigned short* pi = PID + t * 128 + h * 16; float* pg = G2 + t * 128 + h * 16; float* ps = PS2 + t * 128 + h * 16;
            u32x4 w0, w1;
            w0.x = (unsigned)id[0] | ((unsigned)id[1] << 16); w0.y = (unsigned)id[2] | ((unsigned)id[3] << 16); w0.z = (unsigned)id[4] | ((unsigned)id[5] << 16); w0.w = (unsigned)id[6] | ((unsigned)id[7] << 16);
            w1.x = (unsigned)id[8] | ((unsigned)id[9] << 16); w1.y = (unsigned)id[10] | ((unsigned)id[11] << 16); w1.z = (unsigned)id[12] | ((unsigned)id[13] << 16); w1.w = (unsigned)id[14] | ((unsigned)id[15] << 16);
            *(u32x4*)pi = w0; *(u32x4*)(pi + 8) = w1;
            float sv[16], su[16];
#pragma unroll
            for (int i = 0; i < 16; ++i) { sv[i] = SV[id[i]]; su[i] = SU[id[i]]; }
            asm volatile("" ::: "memory");
#pragma unroll
            for (int i = 0; i < 16; i += 4) {
                *(float4*)(pg + i) = make_float4(e[i] * inv * sv[i], e[i + 1] * inv * sv[i + 1], e[i + 2] * inv * sv[i + 2], e[i + 3] * inv * sv[i + 3]);
                *(float4*)(ps + i) = make_float4(su[i] * st, su[i + 1] * st, su[i + 2] * st, su[i + 3] * st); }
        }
    }
    __syncthreads();
}

__device__ __forceinline__ void peer_fused(int p, int wq, int nwq, const unsigned short* __restrict__ PID, const float* __restrict__ G2, const float* __restrict__ PS2, const unsigned char* __restrict__ H2Q,
                                           const unsigned char* __restrict__ EU8, const unsigned char* __restrict__ EV8, float* X, const float* __restrict__ gfin, char* shm, float oscale) {
    int tid = threadIdx.x; asm volatile("" : "+v"(tid)); const int lane = tid & 63, g = lane >> 3, r = lane & 7; const int wid = __builtin_amdgcn_readfirstlane(tid >> 6);
    char* wl = shm + wid * 12288;
    int2* aul = (int2*)(wl + 4096) + lane; float* ssl = (float*)(wl + 8192) + lane; float* swl = (float*)(wl + 3072);
    const int k0 = 8 * (r >> 2) + 4 * ((r >> 1) & 1) + 2 * (r & 1);
    const int e0 = 8 * ((g >> 2) & 1) + 4 * ((g >> 1) & 1) + 2 * (g & 1);
    constexpr size_t SLICE = (size_t)16384 * 128;
#define FIDS(i, I0, I1) do { const u32x4* ip_ = (const u32x4*)(wl + (i) * 256 + 32 * g); I0 = ip_[0]; I1 = ip_[1]; } while (0)
#define FLOAD(R, base, I0, I1) do { _Pragma("unroll") for (int k_ = 0; k_ < 16; ++k_) { const unsigned w_ = (k_ < 8) ? I0[k_ >> 1] : I1[(k_ - 8) >> 1]; const unsigned e_ = (k_ & 1) ? (w_ >> 16) : (w_ & 0xffffu); \
        R[k_] = *(const u32x4*)((base) + (size_t)e_ * 128); } } while (0)
#define FUMATH(R, HQ, ACC) do { int s[16]; \
        _Pragma("unroll") for (int k_ = 0; k_ < 16; ++k_) { int d_ = __builtin_amdgcn_sdot4((int)R[k_].x, (int)HQ.x, 0, false); d_ = __builtin_amdgcn_sdot4((int)R[k_].y, (int)HQ.y, d_, false); \
            d_ = __builtin_amdgcn_sdot4((int)R[k_].z, (int)HQ.z, d_, false); d_ = __builtin_amdgcn_sdot4((int)R[k_].w, (int)HQ.w, d_, false); s[k_] = d_; } \
        _Pragma("unroll") for (int h_ = 0; h_ < 8; ++h_) { const int t1 = s[h_] + dppi<DPP_HMIRROR>(s[h_]), t2 = s[h_ + 8] + dppi<DPP_HMIRROR>(s[h_ + 8]); s[h_] = (r & 4) ? t2 : t1; } \
        _Pragma("unroll") for (int h_ = 0; h_ < 4; ++h_) { const int t1 = s[h_] + dppi<DPP_XOR2>(s[h_]), t2 = s[h_ + 4] + dppi<DPP_XOR2>(s[h_ + 4]); s[h_] = (r & 2) ? t2 : t1; } \
        _Pragma("unroll") for (int h_ = 0; h_ < 2; ++h_) { const int t1 = s[h_] + dppi<DPP_XOR1>(s[h_]), t2 = s[h_ + 2] + dppi<DPP_XOR1>(s[h_ + 2]); s[h_] = (r & 1) ? t2 : t1; } \
        { const int2 o_ = ACC; ACC = make_int2(o_.x + s[0], o_.y + s[1]); } } while (0)
#define FVMATH(R, W, XP, XV, SWV, SSQ, VALID) do { int acc[16]; _Pragma("unroll") for (int i_ = 0; i_ < 16; ++i_) acc[i_] = 0; \
        _Pragma("unroll") for (int m_ = 0; m_ < 4; ++m_) { const int wm_ = (int)W[m_]; \
            _Pragma("unroll") for (int c_ = 0; c_ < 4; ++c_) { \
                const unsigned r0_ = R[4 * m_ + 0][c_], r1_ = R[4 * m_ + 1][c_], r2_ = R[4 * m_ + 2][c_], r3_ = R[4 * m_ + 3][c_]; \
                const unsigned t0_ = __builtin_amdgcn_perm(r1_, r0_, 0x05010400u), t1_ = __builtin_amdgcn_perm(r1_, r0_, 0x07030602u); \
                const unsigned t2_ = __builtin_amdgcn_perm(r3_, r2_, 0x05010400u), t3_ = __builtin_amdgcn_perm(r3_, r2_, 0x07030602u); \
                acc[4 * c_ + 0] = __builtin_amdgcn_sdot4((int)__builtin_amdgcn_perm(t2_, t0_, 0x05040100u), wm_, acc[4 * c_ + 0], false); \
                acc[4 * c_ + 1] = __builtin_amdgcn_sdot4((int)__builtin_amdgcn_perm(t2_, t0_, 0x07060302u), wm_, acc[4 * c_ + 1], false); \
                acc[4 * c_ + 2] = __builtin_amdgcn_sdot4((int)__builtin_amdgcn_perm(t3_, t1_, 0x05040100u), wm_, acc[4 * c_ + 2], false); \
                acc[4 * c_ + 3] = __builtin_amdgcn_sdot4((int)__builtin_amdgcn_perm(t3_, t1_, 0x07060302u), wm_, acc[4 * c_ + 3], false); } } \
          \
        _Pragma("unroll") for (int h_ = 0; h_ < 8; ++h_) { const auto sw_ = __builtin_amdgcn_permlane32_swap((unsigned)acc[h_], (unsigned)acc[h_ + 8], false, false); acc[h_] = (int)sw_[0] + (int)sw_[1]; } \
        _Pragma("unroll") for (int h_ = 0; h_ < 4; ++h_) { const auto sw_ = __builtin_amdgcn_permlane16_swap((unsigned)acc[h_], (unsigned)acc[h_ + 4], false, false); acc[h_] = (int)sw_[0] + (int)sw_[1]; } \
        _Pragma("unroll") for (int h_ = 0; h_ < 2; ++h_) { const int t1 = acc[h_] + dppi<DPP_ROR8>(acc[h_]), t2 = acc[h_ + 2] + dppi<DPP_ROR8>(acc[h_ + 2]); acc[h_] = (lane & 8) ? t2 : t1; } \
        const float2 xv = XV; const float o0 = xv.x + SWV * (float)acc[0], o1 = xv.y + SWV * (float)acc[1]; \
        if (VALID) *(float2*)(XP) = make_float2(o0, o1); SSQ += o0 * o0 + o1 * o1; } while (0)
    const int TEND = (p + 1) * (M / 8);
#pragma unroll 1
    for (int tb = p * (M / 8) + wq; tb < TEND; tb += 8 * nwq) {
#define TOK(i) ((tb + (i) * nwq) < TEND ? (tb + (i) * nwq) : tb)
#pragma unroll
        for (int i = 0; i < 8; ++i) ((unsigned*)(wl + i * 256))[lane] = ((const unsigned*)(PID + (size_t)TOK(i) * 128))[lane];
#pragma unroll
        for (int i = 0; i < 8; ++i) aul[64 * i] = make_int2(0, 0);
        {
            u32x4 RA[16], RB[16], i0, i1, hqa, hqb;
            { const int sl = p & 7; FIDS(0, i0, i1); hqa = *(const u32x4*)(H2Q + ((size_t)sl * M + TOK(0)) * 128 + r * 16); FLOAD(RA, EU8 + sl * SLICE + r * 16, i0, i1); }
#pragma unroll 1
            for (int st = 0; st < 8; ++st) {
                const int sl = (p + st) & 7, sln = (p + st + 1) & 7; const unsigned char* ub = EU8 + sl * SLICE + r * 16; const unsigned char* hb = H2Q + (size_t)sl * M * 128 + r * 16;
#pragma unroll 1
                for (int i = 0; i < 8; i += 2) {
                    FIDS(i + 1, i0, i1); hqb = *(const u32x4*)(hb + (size_t)TOK(i + 1) * 128); FLOAD(RB, ub, i0, i1);
                    FUMATH(RA, hqa, aul[64 * i]);
                    {
                        const bool last = (i == 6); const int in_ = last ? 0 : i + 2; const int sx = last ? sln : sl;
                        FIDS(in_, i0, i1); hqa = *(const u32x4*)(H2Q + ((size_t)sx * M + TOK(in_)) * 128 + r * 16); FLOAD(RA, EU8 + sx * SLICE + r * 16, i0, i1); }
                    FUMATH(RB, hqb, aul[64 * (i + 1)]);
                }
            }
        }
        float2 g2q[8], psq[8];
#pragma unroll
        for (int i = 0; i < 8; ++i) { const size_t o = (size_t)TOK(i) * 128 + 16 * g + k0; g2q[i] = *(const float2*)(G2 + o); psq[i] = *(const float2*)(PS2 + o); }
#pragma unroll
        for (int i = 0; i < 8; ++i) {
            const float2 g2 = g2q[i], ps = psq[i]; const int2 av = aul[64 * i];
            const float w0 = g2.x * gelu_erf((float)av.x * ps.x), w1 = g2.y * gelu_erf((float)av.y * ps.y);
            float am = fmaxf(fabsf(w0), fabsf(w1));
            am = wave_allmax(am);
            const float qs = am > 0.f ? 127.0f / am : 0.f; if (lane == 0) swl[i] = am * (1.0f / 127.0f);
            const int b0 = (int)__builtin_rintf(w0 * qs) & 0xff, b1 = (int)__builtin_rintf(w1 * qs) & 0xff;
            *(unsigned short*)(wl + 2048 + i * 128 + 16 * g + k0) = (unsigned short)(b0 | (b1 << 8));
        }
#pragma unroll
        for (int i = 0; i < 8; ++i) ssl[64 * i] = 0.f;
        {
            u32x4 RA[16], RB[16], i0, i1; float2 xva, xvb;
            { const int sl = p & 7; FIDS(0, i0, i1); xva = *(const float2*)(X + (size_t)TOK(0) * 1024 + sl * 128 + 16 * r + e0); FLOAD(RA, EV8 + sl * SLICE + r * 16, i0, i1); }
#pragma unroll 1
            for (int st = 0; st < 8; ++st) {
                const int sl = (p + st) & 7, sln = (p + st + 1) & 7; const unsigned char* vb = EV8 + sl * SLICE + r * 16; float* xb = X + sl * 128 + 16 * r + e0;
#pragma unroll 1
                for (int i = 0; i < 8; i += 2) {
                    FIDS(i + 1, i0, i1); xvb = *(const float2*)(xb + (size_t)TOK(i + 1) * 1024); FLOAD(RB, vb, i0, i1);
                    { const u32x4 wv = *(const u32x4*)(wl + 2048 + i * 128 + 16 * g); const float sw_ = swl[i]; float sq_ = ssl[64 * i]; FVMATH(RA, wv, xb + (size_t)TOK(i) * 1024, xva, sw_, sq_, (tb + i * nwq) < TEND); ssl[64 * i] = sq_; }
                    { const bool last = (i == 6); const int in_ = last ? 0 : i + 2; const int sx = last ? sln : sl; FIDS(in_, i0, i1); xva = *(const float2*)(X + (size_t)TOK(in_) * 1024 + sx * 128 + 16 * r + e0); FLOAD(RA, EV8 + sx * SLICE + r * 16, i0, i1); }
                    { const u32x4 wv = *(const u32x4*)(wl + 2048 + (i + 1) * 128 + 16 * g); const float sw_ = swl[i + 1]; float sq_ = ssl[64 * (i + 1)]; FVMATH(RB, wv, xb + (size_t)TOK(i + 1) * 1024, xvb, sw_, sq_, (tb + (i + 1) * nwq) < TEND); ssl[64 * (i + 1)] = sq_; }
                }
            }
        }
#pragma unroll 1
        for (int i = 0; i < 8; ++i) {
            float ss = ssl[64 * i];
            ss = wave_allsum(ss);
            const float rr = oscale / sqrtf(ss * (1.0f / 1024.0f) + 1e-6f);
            if (tb + i * nwq < TEND) {
                float* xr = X + (size_t)(tb + i * nwq) * 1024 + 16 * r + e0;
                float2 vv[8], gg[8];
#pragma unroll
                for (int sl = 0; sl < 8; ++sl) { vv[sl] = *(const float2*)(xr + sl * 128); gg[sl] = *(const float2*)(gfin + sl * 128 + 16 * r + e0); }
                asm volatile("" ::: "memory");
#pragma unroll
                for (int sl = 0; sl < 8; ++sl) *(float2*)(xr + sl * 128) = make_float2(vv[sl].x * rr * gg[sl].x, vv[sl].y * rr * gg[sl].y);
            }
        }
#undef TOK
    }
#undef FIDS
#undef FLOAD
#undef FUMATH
#undef FVMATH
}
}
#define GAS __attribute__((address_space(1)))
#define LAS __attribute__((address_space(3)))
typedef unsigned short bf16;
typedef unsigned v4u __attribute__((ext_vector_type(4)));
typedef float f32x4 __attribute__((ext_vector_type(4)));
typedef short bf16x8 __attribute__((ext_vector_type(8)));
typedef GAS unsigned gu32;
typedef GAS unsigned long long gu64;
#define RLX_AGENT __ATOMIC_RELAXED, __HIP_MEMORY_SCOPE_AGENT
#define LDS_WAIT() asm volatile("s_waitcnt lgkmcnt(0)" ::: "memory")
#define VM_WAIT() asm volatile("s_waitcnt vmcnt(0)" ::: "memory")
__device__ __forceinline__ unsigned long long rt() { return __builtin_amdgcn_s_memrealtime(); }
__device__ __forceinline__ unsigned f2bf(float f) { unsigned u = __builtin_bit_cast(unsigned, f); return (u + 0x7fffu + ((u >> 16) & 1u)) >> 16; }
__device__ __forceinline__ unsigned pk2(float lo, float hi) { return f2bf(lo) | (f2bf(hi) << 16); }

#define XB_TMO      128
#define XB_XCNT(j)  (256  + 64 * (j))
#define XB_XSUB(j)  (1280 + 64 * (j))
#define XB_XGEN(j)  (2304 + 64 * (j))
#define XB_TOP      3328
#define XB_TOPGEN   3392
#define XCD_BAR_WORDS 3456
#define XB_SPIN_CAP (1u << 18)

__device__ __forceinline__ unsigned xb_ld(unsigned* p)              { return __hip_atomic_load(p, __ATOMIC_RELAXED, __HIP_MEMORY_SCOPE_AGENT); }
__device__ __forceinline__ unsigned xb_add(unsigned* p, unsigned v) { return __hip_atomic_fetch_add(p, v, __ATOMIC_RELAXED, __HIP_MEMORY_SCOPE_AGENT); }
__device__ __forceinline__ unsigned xb_xcc_id() { return (unsigned)__builtin_amdgcn_s_getreg((3 << 11) | 20) & 0xFu; }
#define XB_SPIN(cond, bar) do { unsigned _sp = 0; while (cond) { __builtin_amdgcn_s_sleep(1); \
    if ((++_sp & 255u) == 0u) { if (xb_ld(&(bar)[XB_TMO])) break; if (_sp > XB_SPIN_CAP) { atomicAdd(&(bar)[XB_TMO], 1u); break; } } } } while (0)

struct XcdBarrier {
    unsigned* bar; unsigned x;
    volatile LAS unsigned* st;
};

__device__ __forceinline__ XcdBarrier xcd_barrier_post(unsigned* bar, volatile LAS unsigned* st) {
    XcdBarrier b; b.bar = bar; b.x = xb_xcc_id(); b.st = st;
    if (threadIdx.x == 0) (void)xb_add(&bar[XB_XCNT(b.x)], 1u);
    return b;
}
__device__ __forceinline__ void xcd_barrier_complete(unsigned* bar, unsigned x, unsigned& nloc, unsigned& nx) {
    const unsigned G = gridDim.x * gridDim.y * gridDim.z;
    unsigned sum, cnt, mine, sp = 0u;
    for (;;) {
        sum = 0u; cnt = 0u; mine = 0u;
#pragma unroll
        for (unsigned j = 0; j < 16; ++j) { const unsigned c = xb_ld(&bar[XB_XCNT(j)]); sum += c; cnt += (c > 0u) ? 1u : 0u; mine = (j == x) ? c : mine; }
        if (sum == G) break;
        __builtin_amdgcn_s_sleep(1);
        if ((++sp & 255u) == 0u) { if (xb_ld(&bar[XB_TMO])) break; if (sp > XB_SPIN_CAP) { atomicAdd(&bar[XB_TMO], 1u); break; } }
    }
    nloc = mine > 0u ? mine : 1u; nx = cnt > 0u ? cnt : 1u;
}

__device__ __forceinline__ void xcd_barrier(const XcdBarrier& b) {
    asm volatile("s_waitcnt vmcnt(0)" ::: "memory");
    __syncthreads();
    if (threadIdx.x == 0) {
        unsigned* bar = b.bar;
        __builtin_amdgcn_s_waitcnt(0);
        unsigned nloc = b.st[0], nx = b.st[1];
        if (nloc == 0u) { xcd_barrier_complete(bar, b.x, nloc, nx); b.st[0] = nloc; b.st[1] = nx; }
        const unsigned old = xb_add(&bar[XB_XSUB(b.x)], 1u);
        const unsigned gen = old / nloc;
        if (old + 1u == (gen + 1u) * nloc) {
            __builtin_amdgcn_fence(__ATOMIC_RELEASE, "agent");
            asm volatile("s_waitcnt vmcnt(0)" ::: "memory");
            const unsigned og = xb_add(&bar[XB_TOP], 1u);
            const unsigned tg = og / nx;
            if (og + 1u == (tg + 1u) * nx) xb_add(&bar[XB_TOPGEN], 1u);
            else XB_SPIN(xb_ld(&bar[XB_TOPGEN]) == tg, bar);
            __builtin_amdgcn_fence(__ATOMIC_ACQUIRE, "agent");
            xb_add(&bar[XB_XGEN(b.x)], 1u);
            asm volatile("s_waitcnt vmcnt(0)" ::: "memory");
        } else {
            XB_SPIN(xb_ld(&bar[XB_XGEN(b.x)]) == gen, bar);
            __builtin_amdgcn_fence(__ATOMIC_ACQUIRE, "agent");
            asm volatile("s_waitcnt vmcnt(0)" ::: "memory");
        }
    }
    __syncthreads();
}

typedef unsigned short bf16_t;
__device__ __forceinline__ float bf2f(bf16_t v) { return __uint_as_float((unsigned)v << 16); }
__device__ __forceinline__ float gelu_exact(float v) { return 0.5f * v * (1.0f + erff(v * 0.70710678118654752f)); }
__device__ __forceinline__ float log_sigmoid(float z) { return z > 0.f ? -log1pf(expf(-z)) : z - log1pf(expf(z)); }
__device__ __forceinline__ float wave_sum(float v) {
    return wave_allsum(v);
}
__device__ __forceinline__ float wave_max(float v) {
    return wave_allmax(v);
}

#ifndef RP7
#define RP7 1
#endif
#ifndef RP8
#define RP8 1
#endif
#ifndef RP9
#define RP9 1
#endif
#ifndef RP0
#define RP0 1
#endif
#ifndef RP1
#define RP1 1
#endif
#ifndef RP12
#define RP12 1
#endif
#ifndef RP3
#define RP3 1
#endif
#ifndef RP4
#define RP4 1
#endif
#ifndef RP5
#define RP5 1
#endif
#ifndef RP6
#define RP6 1
#endif
#ifndef CONV_P0_FROM
#define CONV_P0_FROM (2 * NEXP)
#endif
#ifndef CONV_SPLIT
#define CONV_SPLIT (NEXP / 2)
#endif
constexpr int NWAVES = 8;
constexpr int RING_OFF = 0, RING_BYTES = 131072;
constexpr int LDSCTL_OFF = RING_BYTES, MISC_OFF = LDSCTL_OFF + 320;
constexpr int LDS_BYTES = 147456;
constexpr int CW_BAR = 4096, CW_QUEUE = 3072;
constexpr int N_PHASES = 9;

struct Args { const float* in[17]; float* out; unsigned char* ws; int ph_lo, ph_hi, li, pad; };

__device__ __forceinline__ void p0_transpose_item(const float* W, int ldw, int col0, int K, bf16* WT, int row0, LAS float* scr, int item, int nblk, int lane) {
    const int kb = item / nblk, nb = item % nblk, k0 = 64 * kb, n0 = 32 * nb;
    f32x4 v[8];
#pragma unroll
    for (int i = 0; i < 8; ++i) v[i] = *(const GAS f32x4*)(W + (size_t)(k0 + 8 * i + (lane >> 3)) * ldw + col0 + n0 + 4 * (lane & 7));
#pragma unroll
    for (int i = 0; i < 8; ++i) *(LAS f32x4*)(scr + (8 * i + (lane >> 3)) * 36 + 4 * (lane & 7)) = v[i];
    LDS_WAIT(); asm volatile("" ::: "memory");
    const int c = lane & 7;
#pragma unroll
    for (int j = 0; j < 4; ++j) { const int n = (lane >> 3) + 8 * j; const LAS float* s = scr + (8 * c) * 36 + n;
        v4u o; o.x = pg8::cvt_pk_bf16(s[0 * 36], s[1 * 36]); o.y = pg8::cvt_pk_bf16(s[2 * 36], s[3 * 36]); o.z = pg8::cvt_pk_bf16(s[4 * 36], s[5 * 36]); o.w = pg8::cvt_pk_bf16(s[6 * 36], s[7 * 36]);
        *(GAS v4u*)(WT + (size_t)(row0 + n0 + n) * K + k0 + 8 * c) = o; }
    LDS_WAIT(); asm volatile("" ::: "memory");
}
__device__ __forceinline__ void cvt_chunks(const float* src, bf16* dst, size_t nchunks, size_t gtid, size_t nthr) {
    for (size_t c = gtid; c < nchunks; c += nthr) { const f32x4 a = ((const GAS f32x4*)src)[2 * c], b = ((const GAS f32x4*)src)[2 * c + 1];
        v4u o; o.x = pg8::cvt_pk_bf16(a.x, a.y); o.y = pg8::cvt_pk_bf16(a.z, a.w); o.z = pg8::cvt_pk_bf16(b.x, b.y); o.w = pg8::cvt_pk_bf16(b.z, b.w);
        ((GAS v4u*)dst)[c] = o; }
}

__device__ __forceinline__ void convert_rows4(int e0, const float* eu, const float* ev, unsigned char* ws, int lane) {
                const bool isV = e0 >= NEXP; const int row0 = isV ? e0 - NEXP : e0;
                const float* tab = isV ? ev : eu;
                f32x4 v[4][4];
#pragma unroll
                for (int rr = 0; rr < 4; ++rr)
#pragma unroll
                    for (int i = 0; i < 4; ++i) v[rr][i] = __builtin_nontemporal_load((const GAS f32x4*)(tab + (size_t)(row0 + rr) * D + 16 * lane) + i);
#pragma unroll
                for (int rr = 0; rr < 4; ++rr) {
                    const int row = row0 + rr; float am = 0.f;
#pragma unroll
                    for (int i = 0; i < 4; ++i) am = fmaxf(fmaxf(am, fmaxf(fabsf(v[rr][i].x), fabsf(v[rr][i].y))), fmaxf(fabsf(v[rr][i].z), fabsf(v[rr][i].w)));
                    am = wave_allmax(am);
                    v4u q;
                    if (!isV) { const float inv = am > 0.f ? 127.0f / am : 0.f;
                        q.x = peer_body::pack_i8x4(v[rr][0].x * inv, v[rr][0].y * inv, v[rr][0].z * inv, v[rr][0].w * inv); q.y = peer_body::pack_i8x4(v[rr][1].x * inv, v[rr][1].y * inv, v[rr][1].z * inv, v[rr][1].w * inv);
                        q.z = peer_body::pack_i8x4(v[rr][2].x * inv, v[rr][2].y * inv, v[rr][2].z * inv, v[rr][2].w * inv); q.w = peer_body::pack_i8x4(v[rr][3].x * inv, v[rr][3].y * inv, v[rr][3].z * inv, v[rr][3].w * inv);
                        *(GAS v4u*)(ws + WS_EU + (size_t)(lane >> 3) * ((size_t)NEXP * 128) + (size_t)row * 128 + (lane & 7) * 16) = q; if (lane == 0) ((GAS float*)(ws + WS_SU))[row] = am * (1.0f / 127.0f); }
                    else { const float inv = am > 0.f ? 127.0f / am : 0.f;
                        q.x = peer_body::pack_i8x4(v[rr][0].x * inv, v[rr][0].y * inv, v[rr][0].z * inv, v[rr][0].w * inv); q.y = peer_body::pack_i8x4(v[rr][1].x * inv, v[rr][1].y * inv, v[rr][1].z * inv, v[rr][1].w * inv);
                        q.z = peer_body::pack_i8x4(v[rr][2].x * inv, v[rr][2].y * inv, v[rr][2].z * inv, v[rr][2].w * inv); q.w = peer_body::pack_i8x4(v[rr][3].x * inv, v[rr][3].y * inv, v[rr][3].z * inv, v[rr][3].w * inv);
                        *(GAS v4u*)(ws + WS_EV + (size_t)(lane >> 3) * ((size_t)NEXP * 128) + (size_t)row * 128 + (lane & 7) * 16) = q; if (lane == 0) ((GAS float*)(ws + WS_SV))[row] = am * (1.0f / 127.0f); }
                }
}

__global__ void __launch_bounds__(NWAVES * 64, 2) skel_fwd(Args args) {
    extern __shared__ __attribute__((aligned(16))) unsigned char lds[];
    LAS unsigned char* L = (LAS unsigned char*)lds;
    volatile LAS unsigned* MISC = (volatile LAS unsigned*)(L + MISC_OFF);
    const int G = gridDim.x; const int bx = blockIdx.x; const int vcu = (G % 8 == 0) ? (bx % 8) * (G / 8) + bx / 8 : bx;
    for (int u = threadIdx.x; u < (LDS_BYTES - LDSCTL_OFF) / 4; u += NWAVES * 64) ((LAS unsigned*)(L + LDSCTL_OFF))[u] = 0u;
    __syncthreads();
    (void)xcd_barrier_post((unsigned*)((gu32*)(args.ws + WS_CTL) + CW_BAR) + args.li * XCD_BAR_WORDS, MISC + 8);
#define PHASE_VARS \
    GAS unsigned char* wsg_ = (GAS unsigned char*)args.ws; asm volatile("" : "+s"(wsg_)); unsigned char* ws = (unsigned char*)wsg_; GAS float* outg_ = (GAS float*)args.out; asm volatile("" : "+s"(outg_)); float* out = (float*)outg_; \
    int tid = threadIdx.x; asm volatile("" : "+v"(tid)); const int lane = tid & 63, wave = __builtin_amdgcn_readfirstlane(tid >> 6); (void)lane; (void)wave; \
    gu32* ctl = (gu32*)(ws + WS_CTL); (void)ctl; const float* x = args.in[0]; (void)x; \
    bf16* XN = (bf16*)(ws + WS_XN); bf16* Qb = (bf16*)(ws + WS_Q); bf16* UG = (bf16*)(ws + WS_UG); (void)XN; (void)Qb; (void)UG; \
    bf16* GATE = (bf16*)out; bf16* MERGED = (bf16*)(ws + WS_MERGED); bf16* QP = (bf16*)(ws + WS_QP); (void)GATE; (void)MERGED; (void)QP; \
    float* LOGF = (float*)(ws + WS_LOGF); float* CL2 = (float*)(ws + WS_CL2); (void)LOGF; (void)CL2; \
    const int gw = vcu * NWAVES + wave, NGW = G * NWAVES; (void)gw; (void)NGW;
    const int lo = args.ph_lo, hi = args.ph_hi;
#ifndef PHMASK
#define PHMASK 0x1ff
#endif
#define IN(k) (((PHMASK >> (k)) & 1) && lo <= (k) && (k) < hi)
#define BOTH(k) (IN(k) && IN((k) + 1))
#ifdef TIMEPH
    if (bx == 0 && threadIdx.x == 0) { const unsigned long long t0_ = rt(); MISC[24] = (unsigned)t0_; }
#define GRID_BAR(k) do { XcdBarrier b_; b_.bar = (unsigned*)((gu32*)(args.ws + WS_CTL) + CW_BAR) + args.li * XCD_BAR_WORDS; b_.x = xb_xcc_id(); b_.st = MISC + 8; xcd_barrier(b_); if (bx == 0 && threadIdx.x == 0) { gu32* ctl = (gu32*)(args.ws + WS_CTL); const unsigned t_now = (unsigned)rt(); __hip_atomic_store(ctl + 2048 + (k), t_now - MISC[24], RLX_AGENT); MISC[24] = t_now; } } while (0)
#else
#define GRID_BAR(k) do { XcdBarrier b_; b_.bar = (unsigned*)((gu32*)(args.ws + WS_CTL) + CW_BAR) + args.li * XCD_BAR_WORDS; b_.x = xb_xcc_id(); b_.st = MISC + 8; xcd_barrier(b_); } while (0)
#endif

    for (int rp_ = 0; rp_ < RP0; ++rp_) if (IN(0)) {
        PHASE_VARS
        LAS float* scr = (LAS float*)(L + RING_OFF + wave * 16384);
        const float* w_in = args.in[2];
        {
            constexpr int I_A = 16 * 48, I_B = 16 * 96, I_WA = 8 * 32, I_WB = 8 * 32, I_WO = 16 * 32, I_WQ = 16 * 64;
            constexpr int NITEMS = I_A + I_B + I_WA + I_WB + I_WO + I_WQ;
            for (int it = gw; it < NITEMS; it += NGW) {
                int r = it;
                if (r < I_A) { p0_transpose_item(w_in, IN_W, 0, D, (bf16*)(ws + WS_WIN), 0, scr, r, 48, lane); continue; } r -= I_A;
                if (r < I_B) { p0_transpose_item(w_in, IN_W, OFF_UG, D, (bf16*)(ws + WS_WIN), 1536, scr, r, 96, lane); continue; } r -= I_B;
                if (r < I_WA) { p0_transpose_item(args.in[8], D, 0, AW, (bf16*)(ws + WS_WA), 0, scr, r, 32, lane); continue; } r -= I_WA;
                if (r < I_WB) { p0_transpose_item(args.in[9], D, 0, SW, (bf16*)(ws + WS_WB), 0, scr, r, 32, lane); continue; } r -= I_WB;
                if (r < I_WO) { p0_transpose_item(args.in[10], D, 0, D, (bf16*)(ws + WS_WOUT), 0, scr, r, 32, lane); continue; } r -= I_WO;
                p0_transpose_item(args.in[12], QPW, 0, D, (bf16*)(ws + WS_WQ), 0, scr, r, 64, lane);
            }
        }
        {
            const size_t gtid = (size_t)gw * 64 + lane, nthr = (size_t)NGW * 64;
            cvt_chunks(args.in[13], (bf16*)(ws + WS_SK), (size_t)PH * 2 * PKEYS * PHALF / 8, gtid, nthr);
#pragma unroll 1
            for (int e0 = CONV_P0_FROM + 4 * gw; e0 < 2 * NEXP; e0 += 4 * NGW) convert_rows4(e0, args.in[14], args.in[15], ws, lane);
            const float* w_s = args.in[6]; bf16* wsm = (bf16*)(ws + WS_WSM);
            for (size_t c = gtid; c < (size_t)NG * CHUNK * CHUNK / 8; c += nthr) {
                const int pos = (int)((c * 8) & 127), t = (int)((c * 8) >> 7) & 127, ks = pos >> 4, hh = (pos >> 3) & 1, s0 = 16 * ks + 4 * hh, s1 = s0 + 8;
                const float* src = w_s + ((c * 8) & ~(size_t)127);
                const f32x4 a = *(const GAS f32x4*)(src + s0), b = *(const GAS f32x4*)(src + s1);
                v4u o; o.x = pg8::cvt_pk_bf16(s0 + 0 <= t ? a.x : 0.f, s0 + 1 <= t ? a.y : 0.f); o.y = pg8::cvt_pk_bf16(s0 + 2 <= t ? a.z : 0.f, s0 + 3 <= t ? a.w : 0.f);
                o.z = pg8::cvt_pk_bf16(s1 + 0 <= t ? b.x : 0.f, s1 + 1 <= t ? b.y : 0.f); o.w = pg8::cvt_pk_bf16(s1 + 2 <= t ? b.z : 0.f, s1 + 3 <= t ? b.w : 0.f);
                ((GAS v4u*)wsm)[c] = o; }
        }
        __syncthreads();
        {
            LAS float* wf = (LAS float*)(L + RING_OFF);
            for (int i = tid; i < 8 * D; i += NWAVES * 64) { const int k = i >> 3, c = i & 7; wf[c * D + k] = w_in[(size_t)k * IN_W + OFF_F + c]; }
            __syncthreads();
            const float* g1 = args.in[1]; const float* b_f = args.in[3];
            f32x4 gv[4];
#pragma unroll
            for (int j = 0; j < 4; ++j) gv[j] = ((const GAS f32x4*)g1)[lane + 64 * j];
#pragma unroll 1
            for (int m0 = 4 * gw; m0 < M; m0 += 4 * NGW) {
                f32x4 vv[4][4];
#pragma unroll
                for (int rr = 0; rr < 4; ++rr)
#pragma unroll
                    for (int j = 0; j < 4; ++j) vv[rr][j] = ((const GAS f32x4*)(x + (size_t)(m0 + rr) * D) + lane)[64 * j];
#pragma unroll
                for (int rr = 0; rr < 4; ++rr) {
                    const int m = m0 + rr; f32x4 v[4]; float s = 0.f;
#pragma unroll
                    for (int j = 0; j < 4; ++j) { v[j] = vv[rr][j]; s += (v[j].x * v[j].x + v[j].y * v[j].y) + (v[j].z * v[j].z + v[j].w * v[j].w); }
                    const float r = 1.0f / sqrtf(wave_sum(s) * (1.f / D) + EPS);
#pragma unroll
                    for (int j = 0; j < 4; ++j) v[j] = v[j] * r * gv[j];
                    GAS unsigned long long* o8 = (GAS unsigned long long*)(XN + (size_t)m * D) + lane;
#pragma unroll
                    for (int j = 0; j < 4; ++j) o8[64 * j] = (unsigned long long)pg8::cvt_pk_bf16(v[j].x, v[j].y) | ((unsigned long long)pg8::cvt_pk_bf16(v[j].z, v[j].w) << 32);
                    float fsum = 0.f;
#pragma unroll
                    for (int c = 0; c < 8; ++c) { float pp = 0.f;
#pragma unroll
                        for (int j = 0; j < 4; ++j) { const f32x4 w4 = *(const LAS f32x4*)(wf + c * D + 256 * j + 4 * lane); pp += (v[j].x * w4.x + v[j].y * w4.y) + (v[j].z * w4.z + v[j].w * w4.w); }
                        pp = wave_sum(pp); if (lane == c) fsum = pp; }
                    if (lane < 8) LOGF[(size_t)m * NH + lane] = log_sigmoid(fsum + b_f[lane]);
                }
            }
        }
        if (BOTH(0)) GRID_BAR(0);
    }

    for (int rp12_ = 0; rp12_ < RP12; ++rp12_) {
    for (int rp_ = 0; rp_ < RP1; ++rp_) if (IN(1)) {
        PHASE_VARS
        if (vcu < BATCH * NH) {
            const int b = vcu / NH, h = vcu % NH; LAS float* part = (LAS float*)(L + MISC_OFF + 64);
            float v[4];
#pragma unroll
            for (int i = 0; i < 4; ++i) v[i] = LOGF[(size_t)(b * SEQ + 4 * tid + i) * NH + h];
            v[1] += v[0]; v[2] += v[1]; v[3] += v[2];
            float tot = v[3];
#pragma unroll
            for (int o = 1; o < 64; o <<= 1) { const float u = __shfl_up(tot, o); if (lane >= o) tot += u; }
            if (lane == 63) part[wave] = tot;
            __syncthreads();
            float base = tot - v[3];
            for (int w = 0; w < wave; ++w) base += part[w];
#pragma unroll
            for (int i = 0; i < 4; ++i) CL2[(size_t)vcu * SEQ + 4 * tid + i] = (base + v[i]) * LOG2E;
            __syncthreads();
        }
        pg8::Gemm g{XN, (const bf16*)(ws + WS_WIN), M, NPROJ, D}; pg8::StaticOrder S; S.init(M, NPROJ, G, bx);
        pg8::EpiProj E{Qb, (size_t)M * 512, GATE, C2};
        pg8::gemm_phase<pg8::EpiProj, pg8::StaticOrder, true, true>(L + RING_OFF, g, S, E);
        {
            constexpr int NUN = (M / 256) * (NPROJ / 256);
            const int nmax = (NUN + G - 1) / G, nun = (NUN - bx + G - 1) / G;
            int ii_ = bx - (NUN - (nmax - 1) * G), nidle_ = G - (NUN - (nmax - 1) * G);
            if (nidle_ <= 0) { ii_ = bx; nidle_ = G; }
            if (nun < nmax || nidle_ == G) {
#pragma unroll 1
                for (int e0 = 4 * (ii_ * NWAVES + wave); e0 < CONV_SPLIT; e0 += 4 * nidle_ * NWAVES) convert_rows4(e0, args.in[14], args.in[15], ws, lane);
            }
        }
        if (BOTH(1)) GRID_BAR(1);
    }

    if (IN(2)) {
        PHASE_VARS
        static_assert(attn_body::ATTN_LDS_BYTES <= RING_BYTES, "attention LDS");
#ifdef P2PROBE
        for (int pr_ = 0; pr_ < P2PROBE; ++pr_) {
            for (int u = vcu; u < 2 * (M / CHUNK); u += G)
                sgu_body::sgu_unit(u >> 1, u & 1, (const bf16*)(ws + WS_VG), UG, (bf16*)(ws + 232 * MiB), (const bf16*)(ws + WS_WSM), args.in[4], args.in[5], args.in[7], (char*)lds + RING_OFF);
#ifndef P2PROBE_SGU_ONLY
            const attn_body::AttnTensors ATp{(const attn_body::bf16*)Qb, (const attn_body::bf16*)(ws + WS_K), (const attn_body::bf16*)(ws + WS_V), (attn_body::bf16*)(ws + 216 * MiB), CL2};
            const attn_body::StaticOrder Sp(G, bx);
            attn_body::attn_phase<attn_body::StaticOrder>((char*)lds + RING_OFF, ATp, Sp);
#endif
            GRID_BAR(2);
        }
#endif
        constexpr int NCONVQ = (CONV_P0_FROM - CONV_SPLIT) / 64, NIL = NCONVQ < 512 ? NCONVQ : 512;
        for (;;) {
            __syncthreads();
            if (tid == 0) MISC[26] = __hip_atomic_fetch_add(ctl + CW_QUEUE, 1u, RLX_AGENT);
            __syncthreads();
            const int u = __builtin_amdgcn_readfirstlane((int)MISC[26]);
            if (u >= 768 + NCONVQ) break;
            int ua = -1, uc = -1, us = -1;
            if (u < 2 * NIL) { if (u & 1) uc = u >> 1; else ua = u >> 1; }
            else if (u < 512 + NCONVQ) { if (NCONVQ > 512) uc = u - 512; else ua = u - NCONVQ; }
            else us = u - 512 - NCONVQ;
            if (ua >= 0) { const int qb = 7 - (ua >> 6), bh = ua & 63;
                const int t0 = attn_body::attn_first_tile(CL2, bh, qb);
                attn_body::attn_unit<8>(bh / NH, bh % NH, qb, (const attn_body::bf16*)Qb, (const attn_body::bf16*)(ws + WS_K), (const attn_body::bf16*)(ws + WS_V), (attn_body::bf16*)Qb, CL2, (char*)lds + RING_OFF, t0); }
            else if (uc >= 0) { convert_rows4(CONV_SPLIT + 64 * uc + 8 * wave, args.in[14], args.in[15], ws, lane); convert_rows4(CONV_SPLIT + 64 * uc + 8 * wave + 4, args.in[14], args.in[15], ws, lane); }
            else sgu_body::sgu_unit(us >> 1, us & 1, (const bf16*)(ws + WS_VG), UG, UG, (const bf16*)(ws + WS_WSM), args.in[4], args.in[5], args.in[7], (char*)lds + RING_OFF);
        }
        if (BOTH(2)) GRID_BAR(2);
    }
    }

    for (int rp_ = 0; rp_ < RP3; ++rp_) if (IN(3)) {
        PHASE_VARS
        static_assert(WS_UG - WS_Q == (size_t)pg8::MERGE_DPM * 256 * AW * 2 && WS_WB - WS_WA == (size_t)4 * 256 * AW * 2, "merge passes: buffer offsets");
        { pg8::Gemm g{Qb, (const bf16*)(ws + WS_WA), M, D, AW}; pg8::MergeOrder S; S.init(M, D, G, bx);
          pg8::EpiMergeAB E{GATE, MERGED};
          pg8::gemm_phase<pg8::EpiMergeAB, pg8::MergeOrder, true, true>(L + RING_OFF, g, S, E); }
        if (BOTH(3)) GRID_BAR(3);
    }

    for (int rp_ = 0; rp_ < RP4; ++rp_) if (IN(4)) {
        PHASE_VARS
        pg8::Gemm g{MERGED, (const bf16*)(ws + WS_WOUT), M, D, D}; pg8::StaticOrder S; S.init(M, D, G, bx);
        pg8::EpiResid E{x, out, D, M};
        pg8::gemm_phase<pg8::EpiResid, pg8::StaticOrder, false, true>(L + RING_OFF, g, S, E);
        if (BOTH(4)) GRID_BAR(4);
    }

    for (int rp_ = 0; rp_ < RP5; ++rp_) if (IN(5)) {
        PHASE_VARS
        const float* g2 = args.in[11];
        f32x4 gv[4];
#pragma unroll
        for (int j = 0; j < 4; ++j) gv[j] = ((const GAS f32x4*)g2)[lane + 64 * j];
#pragma unroll 1
        for (int m0 = 4 * gw; m0 < M; m0 += 4 * NGW) {
            f32x4 vv[4][4];
#pragma unroll
            for (int rr = 0; rr < 4; ++rr)
#pragma unroll
                for (int j = 0; j < 4; ++j) vv[rr][j] = ((const GAS f32x4*)(out + (size_t)(m0 + rr) * D) + lane)[64 * j];
            asm volatile("" ::: "memory");
#pragma unroll
            for (int rr = 0; rr < 4; ++rr) {
                const int m = m0 + rr; f32x4 v[4]; float s = 0.f;
#pragma unroll
                for (int j = 0; j < 4; ++j) { v[j] = vv[rr][j]; s += (v[j].x * v[j].x + v[j].y * v[j].y) + (v[j].z * v[j].z + v[j].w * v[j].w); }
                const float r = 1.0f / sqrtf(wave_sum(s) * (1.f / D) + EPS);
                GAS unsigned long long* o8 = (GAS unsigned long long*)(XN + (size_t)m * D) + lane;
                float am = 0.f;
#pragma unroll
                for (int j = 0; j < 4; ++j) { v[j] = v[j] * r * gv[j]; o8[64 * j] = (unsigned long long)pg8::cvt_pk_bf16(v[j].x, v[j].y) | ((unsigned long long)pg8::cvt_pk_bf16(v[j].z, v[j].w) << 32);
                    am = fmaxf(fmaxf(am, fmaxf(fabsf(v[j].x), fabsf(v[j].y))), fmaxf(fabsf(v[j].z), fabsf(v[j].w))); }
                am = wave_allmax(am);
                const float qs = am > 0.f ? 127.0f / am : 0.f;
#pragma unroll
                for (int j = 0; j < 4; ++j) *(GAS unsigned*)(ws + WS_H2Q + (size_t)(2 * j + (lane >> 5)) * ((size_t)M * 128) + (size_t)m * 128 + ((4 * lane) & 127)) = peer_body::pack_i8x4(v[j].x * qs, v[j].y * qs, v[j].z * qs, v[j].w * qs);
                if (lane == 0) ((GAS float*)(ws + WS_ST))[m] = am * (1.0f / 127.0f);
            }
        }
        if (BOTH(5)) GRID_BAR(5);
    }

    for (int rp_ = 0; rp_ < RP6; ++rp_) if (IN(6)) {
        PHASE_VARS
        pg8::Gemm g{XN, (const bf16*)(ws + WS_WQ), M, QPW, D}; pg8::StaticOrder S; S.init(M, QPW, G, bx);
        pg8::EpiBf16<0> E{QP, QPW, nullptr, 0, 0, 1.f};
        pg8::gemm_phase<pg8::EpiBf16<0>, pg8::StaticOrder, true, true>(L + RING_OFF, g, S, E);
        if (BOTH(6)) GRID_BAR(6);
    }
    for (int rp_ = 0; rp_ < RP7; ++rp_) if (IN(7)) {
        PHASE_VARS
        for (int tk = vcu; tk < 8 * (M / 512); tk += G)
            peer_body::peer_retrieve(tk, QP, (const bf16*)(ws + WS_SK), (const float*)(ws + WS_SU), (const float*)(ws + WS_SV), (const float*)(ws + WS_ST),
                                     (bf16*)(ws + WS_PID), (float*)(ws + WS_G2), (float*)(ws + WS_PS2), (char*)lds + RING_OFF);
        if (BOTH(7)) GRID_BAR(7);
    }
    if (IN(8)) {
        PHASE_VARS
#ifdef TIMEPH
        const float oscale = 1.0f + sqrtf((float)(((__hip_atomic_load(ctl + 2048 + TIMEPH, RLX_AGENT) + TIMEOFF) / TIMEQ) * TIMEQ) * 1e-5f);
#else
        const float oscale = 1.0f;
#endif
        const int p = bx & 7, cntp = (G - p + 7) >> 3;
        peer_body::peer_fused(p, (bx >> 3) * NWAVES + wave, cntp * NWAVES, (const bf16*)(ws + WS_PID), (const float*)(ws + WS_G2), (const float*)(ws + WS_PS2), (const unsigned char*)(ws + WS_H2Q),
                              (const unsigned char*)(ws + WS_EU), (const unsigned char*)(ws + WS_EV), out, args.in[16], (char*)lds + RING_OFF, oscale);
    }
#undef IN
#undef BOTH
#undef GRID_BAR
}

extern "C" void kernel_launch(void* const* d_in, const int* in_sizes, int n_in, void* d_out, int out_size, void* d_ws, size_t ws_size, hipStream_t stream) {
    static int grid = 0;
    if (grid == 0) {
        int dev = 0, cus = 0;
        if (n_in != 17 || out_size != M * D || ws_size < WS_END) { fprintf(stderr, "kernel_launch: unexpected shapes (n_in %d out %d ws %zu)\n", n_in, out_size, ws_size); grid = -1; return; }
        if (hipGetDevice(&dev) != hipSuccess || hipDeviceGetAttribute(&cus, hipDeviceAttributeMultiprocessorCount, dev) != hipSuccess) { grid = -1; return; }
        if (hipFuncSetAttribute((const void*)skel_fwd, hipFuncAttributeMaxDynamicSharedMemorySize, LDS_BYTES) != hipSuccess) { fprintf(stderr, "kernel_launch: hipFuncSetAttribute failed\n"); grid = -1; return; }
        int per_cu = 0;
        if (hipOccupancyMaxActiveBlocksPerMultiprocessor(&per_cu, (const void*)skel_fwd, NWAVES * 64, LDS_BYTES) != hipSuccess || per_cu < 1) { fprintf(stderr, "kernel_launch: occupancy query says %d workgroups per CU\n", per_cu); grid = -1; return; }
        grid = cus;
    }
    if (grid < 0) return;
    unsigned char* ws = (unsigned char*)d_ws; float* out = (float*)d_out;
    (void)hipMemsetAsync(ws + WS_CTL, 0, CTL_ZERO_BYTES, stream);
    Args a{};
    for (int i = 0; i < 17; ++i) a.in[i] = (const float*)d_in[i];
    a.out = out; a.ws = ws;
#ifndef MULTI_LAUNCH
    {
        a.ph_lo = 0; a.ph_hi = N_PHASES; a.li = 0;
        void* kargs[] = {(void*)&a};
#ifdef PLAIN_LAUNCH
        hipLaunchKernelGGL(skel_fwd, dim3(grid), dim3(NWAVES * 64), LDS_BYTES, stream, a); const hipError_t e = hipPeekAtLastError(); (void)kargs;
#else
        const hipError_t e = hipLaunchCooperativeKernel((const void*)skel_fwd, dim3(grid), dim3(NWAVES * 64), kargs, LDS_BYTES, stream);
#endif
        if (e != hipSuccess) fprintf(stderr, "kernel_launch: cooperative launch failed: %s (grid %d)\n", hipGetErrorString(e), grid);
    }
#else
    for (int k = 0; k < N_PHASES; ++k) { a.ph_lo = k; a.ph_hi = k + 1; a.li = k; hipLaunchKernelGGL(skel_fwd, dim3(grid), dim3(NWAVES * 64), LDS_BYTES, stream, a); }
#endif
}
```

```cpp
#include <hip/hip_runtime.h>
#include <cstdio>
#include <cstdint>
#include <cmath>

constexpr int D = 1024, BATCH = 8, SEQ = 2048, M = BATCH * SEQ;
constexpr int NH = 8, HD = 64, AW = 512, SW = 512, CHUNK = 128, NG = 8, GD = 64;
constexpr int OFF_Q = 0, OFF_K = 512, OFF_V = 1024, OFF_F = 1536, OFF_UG = 1544, OFF_VG = 2056, OFF_GATE = 2568, IN_W = 4616;
constexpr int NPROJ = 4608;
constexpr int PH = 8, PKEYS = 128, PHALF = 128, PTOP = 16, NEXP = 16384, QPW = 2048, HK = 128;
constexpr float EPS = 1e-6f;
constexpr float LOG2E = 1.4426950408889634f;
constexpr float C2 = 0.125f * LOG2E;

constexpr size_t MiB = 1u << 20;
constexpr size_t WS_CTL = 0, CTL_ZERO_BYTES = 65536;
constexpr size_t WS_WIN = 1 * MiB;
constexpr size_t WS_WA = 10 * MiB;
constexpr size_t WS_WB = 11 * MiB;
constexpr size_t WS_WOUT = 12 * MiB;
constexpr size_t WS_WQ = 14 * MiB;
constexpr size_t WS_SK = 18 * MiB;
constexpr size_t WS_WSM = 18 * MiB + 512 * 1024;
constexpr size_t WS_EU = 20 * MiB;
constexpr size_t WS_EV = 52 * MiB;
constexpr size_t WS_XN = 84 * MiB;
constexpr size_t WS_Q = 116 * MiB;
constexpr size_t WS_K = 132 * MiB;
constexpr size_t WS_V = 148 * MiB;
constexpr size_t WS_UG = 164 * MiB;
constexpr size_t WS_VG = 180 * MiB;
constexpr size_t WS_LOGF = 196 * MiB;
constexpr size_t WS_CL2 = 197 * MiB;
constexpr size_t WS_STAT = 199 * MiB;
constexpr size_t WS_SU = 198 * MiB;
constexpr size_t WS_SV = 198 * MiB + 65536;
constexpr size_t WS_MERGED = WS_K;
constexpr size_t WS_QP = WS_Q;
constexpr size_t WS_PIDX = WS_VG;
constexpr size_t WS_PGATE = WS_VG + 8 * MiB;
constexpr size_t WS_H2Q = 200 * MiB;
constexpr size_t WS_ST = 198 * MiB + 131072;
constexpr size_t WS_SSQP = 198 * MiB + 262144;
constexpr size_t WS_SBQ = 198 * MiB + 524288;
constexpr size_t WS_PID = 180 * MiB;
constexpr size_t WS_G2 = 184 * MiB;
constexpr size_t WS_PS2 = 216 * MiB;
constexpr size_t WS_AP = 116 * MiB;
constexpr size_t WS_WP = 84 * MiB;
constexpr size_t WS_SW = 88 * MiB;
constexpr size_t WS_SSQ = 224 * MiB;
constexpr size_t WS_SBW = 198 * MiB + 786432;
constexpr size_t WS_SA = 198 * MiB + 851968;
constexpr size_t WS_END = 256 * MiB;

template <int CTRL> __device__ __forceinline__ float wr_dppf(float v) { return __int_as_float(__builtin_amdgcn_update_dpp(0, __float_as_int(v), CTRL, 0xf, 0xf, false)); }
__device__ __forceinline__ float wave_allsum(float v) {
    v += wr_dppf<0xB1>(v); v += wr_dppf<0x4E>(v); v += wr_dppf<0x141>(v); v += wr_dppf<0x128>(v);
    { const auto s = __builtin_amdgcn_permlane16_swap(__float_as_uint(v), __float_as_uint(v), false, false); v = __uint_as_float(s[0]) + __uint_as_float(s[1]); }
    { const auto s = __builtin_amdgcn_permlane32_swap(__float_as_uint(v), __float_as_uint(v), false, false); v = __uint_as_float(s[0]) + __uint_as_float(s[1]); }
    return v;
}
__device__ __forceinline__ float wave_allmax(float v) {
    v = fmaxf(v, wr_dppf<0xB1>(v)); v = fmaxf(v, wr_dppf<0x4E>(v)); v = fmaxf(v, wr_dppf<0x141>(v)); v = fmaxf(v, wr_dppf<0x128>(v));
    { const auto s = __builtin_amdgcn_permlane16_swap(__float_as_uint(v), __float_as_uint(v), false, false); v = fmaxf(__uint_as_float(s[0]), __uint_as_float(s[1])); }
    { const auto s = __builtin_amdgcn_permlane32_swap(__float_as_uint(v), __float_as_uint(v), false, false); v = fmaxf(__uint_as_float(s[0]), __uint_as_float(s[1])); }
    return v;
}
namespace pg8 {
#define PG8_LAS __attribute__((address_space(3)))
typedef unsigned short bf16_t;
typedef short bf16x8 __attribute__((ext_vector_type(8)));
typedef float f32x4 __attribute__((ext_vector_type(4)));
typedef unsigned u32x4 __attribute__((ext_vector_type(4)));
constexpr int BM = 256, BK = 64, HALF = 128, HTB = HALF * BK * 2  , STAGE_BYTES = 8 * HTB, NXCD = 8, WGM = 8;

__host__ __device__ __forceinline__ int lds_byte(int r, int c) { const int st = (r >> 4) * 2 + (c >> 5), rr = r & 15, cc = c & 31, ob = rr * 64 + cc * 2; return st * 1024 + (ob ^ (((ob >> 9) & 1) << 5)); }
__host__ __device__ __forceinline__ void stage_rc(int b, int& R, int& C) { const int st = b / 1024, sb = b % 1024, swz = sb ^ (((sb >> 9) & 1) << 5); R = (st >> 1) * 16 + swz / 64; C = (st & 1) * 32 + (swz % 64) / 2; }
__host__ __device__ __forceinline__ int perm32(int rho) { const int n = rho >> 4, i = rho & 15; return 8 * (i >> 2) + 4 * n + (i & 3); }

struct Unit { int pm, pn; };
struct Gemm { const bf16_t* A; const bf16_t* Bt; int M, N, K; };

struct StaticOrder {
    int nM, nN, nwg, G, c;
    __host__ __device__ void init(int M, int N, int G_, int c_) { nM = M / BM; nN = N / BM; nwg = nM * nN; G = G_; c = c_; }
    __host__ __device__ bool next(int i, Unit& u) const {
        const long L = (long)i * G + c; if (L >= nwg) return false;
        int wgid = (int)L; { const int q = nwg / NXCD, r = nwg % NXCD, xcd = wgid % NXCD, off = wgid / NXCD; wgid = (xcd < r ? xcd * (q + 1) : r * (q + 1) + (xcd - r) * q) + off; }
        const int nig = WGM * nN, gid = wgid / nig, fm = gid * WGM, gsz = (nM - fm) < WGM ? (nM - fm) : WGM;
        u.pm = fm + ((wgid % nig) % gsz); u.pn = (wgid % nig) / gsz; return true;
    }
    __device__ __forceinline__ void a_ready(const Unit&) const {}
    __device__ __forceinline__ void done(const Unit&) const {}
};

typedef float cvt_f32x2_t __attribute__((ext_vector_type(2))); typedef __bf16 cvt_bf16x2_t __attribute__((ext_vector_type(2)));
__device__ __forceinline__ unsigned cvt_pk_bf16(float lo, float hi) { cvt_f32x2_t v = {lo, hi}; cvt_bf16x2_t b = __builtin_convertvector(v, cvt_bf16x2_t); return __builtin_bit_cast(unsigned, b); }
typedef float f32x2 __attribute__((ext_vector_type(2)));
__device__ __forceinline__ f32x2 gelu_pk(f32x2 v) {
    const f32x2 av = __builtin_elementwise_abs(v), d = av * 0.2316418882f + 1.0f;
    f32x2 t; t.x = __builtin_amdgcn_rcpf(d.x); t.y = __builtin_amdgcn_rcpf(d.y);
    f32x2 q = t * 0.5307027145f + (-0.7265760135f); q = q * t + 0.7107068705f; q = q * t + (-0.142248368f); q = q * t + 0.127414796f; q = q * t;
    const f32x2 s = (v * v) * (-0.72134752044f);
    f32x2 e; e.x = __builtin_amdgcn_exp2f(s.x); e.y = __builtin_amdgcn_exp2f(s.y);
    const f32x2 m = v * (q * e), r = v - m;
    f32x2 o; o.x = v.x < 0.f ? m.x : r.x; o.y = v.y < 0.f ? m.y : r.y; return o;
}

template <int ACT  > struct EpiBf16 {
    static constexpr bool PERM = true, AFTER_DRAIN = false; static_assert(ACT == 0 || ACT == 1, "EpiBf16: ACT is 0 (none) or 1 (gelu_pk)");
    bf16_t* O; int ldc; const float* bias; int split_cols; size_t split_stride; float scale0;
    __device__ __forceinline__ void operator()(const f32x4 (&acc)[2][2][4][2], const Unit& u, int wr, int wc, int fr, int fq) const {
        const int row0 = u.pm * BM + wr * 64 + fr; int colt = u.pn * BM; bf16_t* base = O;
        float sc = 1.f; if (split_cols) { const int t = colt / split_cols; base += (size_t)t * split_stride; colt -= t * split_cols; if (t == 0) sc = scale0; }
        const int col0 = colt + wc * 32 + 8 * fq, bcol0 = u.pn * BM + wc * 32 + 8 * fq;
        f32x4 bv[2][2];
#pragma unroll
        for (int bj = 0; bj < 2; ++bj)
#pragma unroll
            for (int n = 0; n < 2; ++n) bv[bj][n] = bias ? *(const f32x4*)(bias + bcol0 + bj * HALF + 4 * n) : (f32x4){0.f, 0.f, 0.f, 0.f};
#pragma unroll
        for (int ai = 0; ai < 2; ++ai)
#pragma unroll
            for (int m = 0; m < 4; ++m) { bf16_t* rowp = base + (size_t)(row0 + ai * HALF + m * 16) * ldc + col0;
#pragma unroll
                for (int bj = 0; bj < 2; ++bj) { f32x4 v0 = acc[ai][bj][m][0] + bv[bj][0], v1 = acc[ai][bj][m][1] + bv[bj][1];
                    if (ACT == 1) { f32x2 a = gelu_pk((f32x2){v0[0], v0[1]}), b = gelu_pk((f32x2){v0[2], v0[3]}), c = gelu_pk((f32x2){v1[0], v1[1]}), d = gelu_pk((f32x2){v1[2], v1[3]});
                        v0 = (f32x4){a.x, a.y, b.x, b.y}; v1 = (f32x4){c.x, c.y, d.x, d.y}; }
                    v0 = v0 * sc; v1 = v1 * sc; u32x4 w; w.x = cvt_pk_bf16(v0[0], v0[1]); w.y = cvt_pk_bf16(v0[2], v0[3]); w.z = cvt_pk_bf16(v1[0], v1[1]); w.w = cvt_pk_bf16(v1[2], v1[3]);
                    *(u32x4*)(rowp + bj * HALF) = w; } }
    }
};
__device__ __forceinline__ f32x2 sigmoid_pk(f32x2 v) {
#ifdef DBG_SIG
    f32x2 o; o.x = 1.0f / (1.0f + __expf(-v.x)); o.y = 1.0f / (1.0f + __expf(-v.y)); return o;
#else
    f32x2 e; e.x = __builtin_amdgcn_exp2f(v.x * -1.4426950408889634f); e.y = __builtin_amdgcn_exp2f(v.y * -1.4426950408889634f);
    f32x2 o; o.x = __builtin_amdgcn_rcpf(1.0f + e.x); o.y = __builtin_amdgcn_rcpf(1.0f + e.y); return o;
#endif
}
template <int ACT> __device__ __forceinline__ f32x4 act4(f32x4 v, float sc) {
    if (ACT == 0) return v * sc;
    f32x2 a, b;
    if (ACT == 2) { a = gelu_pk((f32x2){v[0], v[1]}); b = gelu_pk((f32x2){v[2], v[3]}); }
    else { a = sigmoid_pk((f32x2){v[0], v[1]}); b = sigmoid_pk((f32x2){v[2], v[3]}); }
    return (f32x4){a.x, a.y, b.x, b.y};
}
struct EpiProj {
    static constexpr bool PERM = true, AFTER_DRAIN = false;
    bf16_t* QKVUV; size_t tstride; bf16_t* GATE; float qscale;
    template <int ACT> __device__ __forceinline__ void body(const f32x4 (&acc)[2][2][4][2], bf16_t* base, int ldc, int row0, int col0, float sc) const {
#pragma unroll
        for (int ai = 0; ai < 2; ++ai)
#pragma unroll
            for (int m = 0; m < 4; ++m) { bf16_t* rowp = base + (size_t)(row0 + ai * HALF + m * 16) * ldc + col0;
#pragma unroll
                for (int bj = 0; bj < 2; ++bj) { const f32x4 v0 = act4<ACT>(acc[ai][bj][m][0], sc), v1 = act4<ACT>(acc[ai][bj][m][1], sc);
                    u32x4 w; w.x = cvt_pk_bf16(v0[0], v0[1]); w.y = cvt_pk_bf16(v0[2], v0[3]); w.z = cvt_pk_bf16(v1[0], v1[1]); w.w = cvt_pk_bf16(v1[2], v1[3]);
                    *(u32x4*)(rowp + bj * HALF) = w; } }
    }
    __device__ __forceinline__ void operator()(const f32x4 (&acc)[2][2][4][2], const Unit& u, int wr, int wc, int fr, int fq) const {
        const int row0 = u.pm * BM + wr * 64 + fr, pn = u.pn;
        if (pn < 10) { bf16_t* base = QKVUV + (size_t)(pn >> 1) * tstride; const int col0 = (pn & 1) * BM + wc * 32 + 8 * fq;
            if (pn < 6) body<0>(acc, base, 512, row0, col0, pn < 2 ? qscale : 1.0f); else body<2>(acc, base, 512, row0, col0, 1.0f); }
        else body<3>(acc, GATE, 2048, row0, (pn - 10) * BM + wc * 32 + 8 * fq, 1.0f);
    }
};
template <int PASS> struct EpiMerge {
    static constexpr bool PERM = true, AFTER_DRAIN = false;
    const bf16_t* GATE; bf16_t* MERGED;
    __device__ __forceinline__ void operator()(const f32x4 (&acc)[2][2][4][2], const Unit& u, int wr, int wc, int fr, int fq) const {
        const int row0 = u.pm * BM + wr * 64 + fr, col0 = u.pn * BM + wc * 32 + 8 * fq;
#pragma unroll
        for (int ai = 0; ai < 2; ++ai) {
            u32x4 gq[4][2], tq[4][2];
#pragma unroll
            for (int m = 0; m < 4; ++m) { const size_t r = (size_t)(row0 + ai * HALF + m * 16);
#pragma unroll
                for (int bj = 0; bj < 2; ++bj) { const int c = col0 + bj * HALF; gq[m][bj] = *(const u32x4*)(GATE + r * 2048 + PASS * 1024 + c);
                    if (PASS == 1) tq[m][bj] = *(const u32x4*)(MERGED + r * 1024 + c); } }
            asm volatile("" ::: "memory");
#pragma unroll
            for (int m = 0; m < 4; ++m) { const size_t r = (size_t)(row0 + ai * HALF + m * 16);
#pragma unroll
                for (int bj = 0; bj < 2; ++bj) { const int c = col0 + bj * HALF; const u32x4 g = gq[m][bj];
                    f32x4 v0 = acc[ai][bj][m][0], v1 = acc[ai][bj][m][1];
                    v0[0] *= __uint_as_float(g.x << 16); v0[1] *= __uint_as_float(g.x & 0xffff0000u); v0[2] *= __uint_as_float(g.y << 16); v0[3] *= __uint_as_float(g.y & 0xffff0000u);
                    v1[0] *= __uint_as_float(g.z << 16); v1[1] *= __uint_as_float(g.z & 0xffff0000u); v1[2] *= __uint_as_float(g.w << 16); v1[3] *= __uint_as_float(g.w & 0xffff0000u);
                    if (PASS == 1) { const u32x4 t = tq[m][bj];
                        v0[0] += __uint_as_float(t.x << 16); v0[1] += __uint_as_float(t.x & 0xffff0000u); v0[2] += __uint_as_float(t.y << 16); v0[3] += __uint_as_float(t.y & 0xffff0000u);
                        v1[0] += __uint_as_float(t.z << 16); v1[1] += __uint_as_float(t.z & 0xffff0000u); v1[2] += __uint_as_float(t.w << 16); v1[3] += __uint_as_float(t.w & 0xffff0000u); }
                    u32x4 w; w.x = cvt_pk_bf16(v0[0], v0[1]); w.y = cvt_pk_bf16(v0[2], v0[3]); w.z = cvt_pk_bf16(v1[0], v1[1]); w.w = cvt_pk_bf16(v1[2], v1[3]);
                    *(u32x4*)(MERGED + r * 1024 + c) = w; } }
            asm volatile("" ::: "memory");
        }
    }
};
struct EpiResid {
    static constexpr bool PERM = false, AFTER_DRAIN = false;
    const float* base; float* out; int ldc; int nrows;
    __device__ __forceinline__ void operator()(const f32x4 (&acc)[2][2][4][2], const Unit& u, int wr, int wc, int fr, int fq) const {
        const int col0 = u.pn * BM + wc * 32 + 4 * fq;
#pragma unroll
        for (int ai = 0; ai < 2; ++ai) {
            f32x4 pre[4][2][2];
#pragma unroll
            for (int m = 0; m < 4; ++m) { const size_t off = (size_t)(u.pm * BM + ai * HALF + wr * 64 + m * 16 + fr) * ldc + col0;
#pragma unroll
                for (int bj = 0; bj < 2; ++bj)
#pragma unroll
                    for (int n = 0; n < 2; ++n) pre[m][bj][n] = *(const f32x4*)(base + off + bj * HALF + n * 16); }
            asm volatile("" ::: "memory");
#pragma unroll
            for (int m = 0; m < 4; ++m) { const size_t off = (size_t)(u.pm * BM + ai * HALF + wr * 64 + m * 16 + fr) * ldc + col0;
#pragma unroll
                for (int bj = 0; bj < 2; ++bj)
#pragma unroll
                    for (int n = 0; n < 2; ++n) *(f32x4*)(out + off + bj * HALF + n * 16) = pre[m][bj][n] + acc[ai][bj][m][n]; }
            asm volatile("" ::: "memory");
        }
    }
};

constexpr int MERGE_DPM = 192;
struct MergeOrder : StaticOrder {
    __host__ __device__ bool next(int i, Unit& u) const {
        if (!StaticOrder::next(i >> 1, u)) return false;
        if (i & 1) { u.pm += MERGE_DPM; u.pn += 4; }
        return true;
    }
};
struct EpiMergeAB {
    static constexpr bool PERM = true, AFTER_DRAIN = false;
    const bf16_t* GATE; bf16_t* MERGED;
    __device__ __forceinline__ void operator()(const f32x4 (&acc)[2][2][4][2], const Unit& u, int wr, int wc, int fr, int fq) const {
        if (u.pn < 4) { EpiMerge<0> E{GATE, MERGED}; E(acc, u, wr, wc, fr, fq); }
        else { Unit v; v.pm = u.pm - MERGE_DPM; v.pn = u.pn - 4; EpiMerge<1> E{GATE, MERGED}; E(acc, v, wr, wc, fr, fq); }
    }
};
struct QueryOrder {
    int v, G, ntask;
    __host__ __device__ bool next(int i, Unit& u) const { const int tk = v + (i >> 1) * G; if (tk >= ntask) return false; u.pm = 2 * (tk >> 3) + (i & 1); u.pn = tk & 7; return true; }
    __device__ __forceinline__ void a_ready(const Unit&) const {}
    __device__ __forceinline__ void done(const Unit&) const {}
};

struct EpiProjI8 {
    static constexpr bool PERM = true, AFTER_DRAIN = false;
    bf16_t* QKVUV; size_t tstride; bf16_t* GATE; float qscale; const float* sA; const float* sB;
    template <int ACT> __device__ __forceinline__ void body(const f32x4 (&acc)[2][2][4][2], bf16_t* base, int ldc, int row0, int col0, int bcol0, float sc) const {
        f32x4 sb[2][2];
#pragma unroll
        for (int bj = 0; bj < 2; ++bj)
#pragma unroll
            for (int n = 0; n < 2; ++n) sb[bj][n] = *(const f32x4*)(sB + bcol0 + bj * HALF + 4 * n);
#pragma unroll
        for (int ai = 0; ai < 2; ++ai)
#pragma unroll
            for (int m = 0; m < 4; ++m) { const int row = row0 + ai * HALF + m * 16; bf16_t* rowp = base + (size_t)row * ldc + col0; const float sa = sA[row];
#pragma unroll
                for (int bj = 0; bj < 2; ++bj) {
                    typedef int i32x4_t __attribute__((ext_vector_type(4)));
                    const i32x4_t i0 = __builtin_bit_cast(i32x4_t, acc[ai][bj][m][0]), i1 = __builtin_bit_cast(i32x4_t, acc[ai][bj][m][1]);
                    const f32x4 f0 = (f32x4){(float)i0[0], (float)i0[1], (float)i0[2], (float)i0[3]} * sb[bj][0] * sa, f1 = (f32x4){(float)i1[0], (float)i1[1], (float)i1[2], (float)i1[3]} * sb[bj][1] * sa;
                    const f32x4 v0 = act4<ACT>(f0, sc), v1 = act4<ACT>(f1, sc);
                    u32x4 w; w.x = cvt_pk_bf16(v0[0], v0[1]); w.y = cvt_pk_bf16(v0[2], v0[3]); w.z = cvt_pk_bf16(v1[0], v1[1]); w.w = cvt_pk_bf16(v1[2], v1[3]);
                    *(u32x4*)(rowp + bj * HALF) = w; } }
    }
    __device__ __forceinline__ void operator()(const f32x4 (&acc)[2][2][4][2], const Unit& u, int wr, int wc, int fr, int fq) const {
        const int row0 = u.pm * BM + wr * 64 + fr, pn = u.pn, bcol0 = pn * BM + wc * 32 + 8 * fq;
        if (pn < 10) { bf16_t* base = QKVUV + (size_t)(pn >> 1) * tstride; const int col0 = (pn & 1) * BM + wc * 32 + 8 * fq;
            if (pn < 6) body<0>(acc, base, 512, row0, col0, bcol0, pn < 2 ? qscale : 1.0f); else body<2>(acc, base, 512, row0, col0, bcol0, 1.0f); }
        else body<3>(acc, GATE, 2048, row0, (pn - 10) * BM + wc * 32 + 8 * fq, bcol0, 1.0f);
    }
};
template <class Epi, class Sched, bool ALIGN_EPI = false, bool SP2 = false, bool I8 = false>
__device__ __forceinline__ void gemm_phase(PG8_LAS unsigned char* lds, const Gemm g, const Sched& S, const Epi& E) {
    typedef int i32x4_t __attribute__((ext_vector_type(4)));
    int tid = threadIdx.x; asm volatile("" : "+v"(tid));
    const int wid = __builtin_amdgcn_readfirstlane(tid >> 6), lane = tid & 63, wr = wid >> 2, wc = wid & 3, fr = lane & 15, fq = lane >> 4;
    const int K = g.K, nt = K / BK;
    unsigned voffA[2], voffB[2];
#pragma unroll
    for (int i = 0; i < 2; ++i) { int R, C; stage_rc(tid * 16 + i * 8192, R, C); const int Rb = Epi::PERM ? ((R & ~31) + perm32(R & 31)) : R;
        voffA[i] = (unsigned)(R * K + C) * 2u; voffB[i] = (unsigned)(Rb * K + C) * 2u; }
    const size_t kstep = (size_t)(BK * 2);
    const size_t hstep = (size_t)HALF * K * 2;
    const size_t tstep = 2 * hstep;
    const unsigned ldsw = (unsigned)wid * 1024u;
    const int aoff = lds_byte(wr * 64 + fr, fq * 8), boff = lds_byte(wc * 32 + fr, fq * 8);
#define PG8_SA(b, h) (((b) * 2 + (h)) * HTB)
#define PG8_SB(b, h) ((4 + (b) * 2 + (h)) * HTB)
#define PG8_STAGE(bufoff, gbase, voff) do { _Pragma("unroll") for (int _i = 0; _i < 2; ++_i) \
        __builtin_amdgcn_global_load_lds((const unsigned*)((const char*)(gbase) + (voff)[_i]), (PG8_LAS unsigned*)(lds + (bufoff) + ldsw + _i * 8192), 16, 0, 0); } while (0)
#define PG8_LDA(dst, b, h) do { _Pragma("unroll") for (int m = 0; m < 4; ++m) _Pragma("unroll") for (int k = 0; k < 2; ++k) dst[m][k] = *(const PG8_LAS bf16x8*)(lds + PG8_SA(b, h) + aoff + m * 2048 + k * 1024); } while (0)
#define PG8_LDB(dst, b, h) do { _Pragma("unroll") for (int n = 0; n < 2; ++n) _Pragma("unroll") for (int k = 0; k < 2; ++k) dst[n][k] = *(const PG8_LAS bf16x8*)(lds + PG8_SB(b, h) + boff + n * 2048 + k * 1024); } while (0)
#define PG8_MMA(ai, bj, At, Bt) do { __builtin_amdgcn_s_setprio(1); _Pragma("unroll") for (int m = 0; m < 4; ++m) _Pragma("unroll") for (int n = 0; n < 2; ++n) _Pragma("unroll") for (int k = 0; k < 2; ++k) \
        { if constexpr (I8) acc[ai][bj][m][n] = __builtin_bit_cast(f32x4, __builtin_amdgcn_mfma_i32_16x16x64_i8(__builtin_bit_cast(i32x4_t, Bt[n][k]), __builtin_bit_cast(i32x4_t, At[m][k]), __builtin_bit_cast(i32x4_t, acc[ai][bj][m][n]), 0, 0, 0)); \
          else acc[ai][bj][m][n] = __builtin_amdgcn_mfma_f32_16x16x32_bf16(Bt[n][k], At[m][k], acc[ai][bj][m][n], 0, 0, 0); } __builtin_amdgcn_s_setprio(0); } while (0)
#define PG8_WAIT_V(n) asm volatile("s_waitcnt vmcnt(" #n ")" ::: "memory")
#define PG8_WAIT_L(n) asm volatile("s_waitcnt lgkmcnt(" #n ")" ::: "memory")
#define PG8_BAR __builtin_amdgcn_s_barrier()
#define PG8_SCHED __builtin_amdgcn_sched_barrier(0)
    Unit cur, nxt; int ui = 0;
    if (!S.next(0, cur)) return;
    f32x4 acc[2][2][4][2];
#pragma unroll
    for (int a = 0; a < 2; ++a)
#pragma unroll
        for (int b = 0; b < 2; ++b)
#pragma unroll
            for (int m = 0; m < 4; ++m)
#pragma unroll
                for (int n = 0; n < 2; ++n) acc[a][b][m][n] = (f32x4){0.f, 0.f, 0.f, 0.f};
    bf16x8 At[4][2], B0[2][2], B1[2][2];
    const char* cA = (const char*)g.A + (size_t)cur.pm * tstep; const char* cB = (const char*)g.Bt + (size_t)cur.pn * tstep;
    S.a_ready(cur);
    if constexpr (SP2) {
        PG8_STAGE(PG8_SB(0, 0), cB, voffB); PG8_STAGE(PG8_SB(0, 1), cB + hstep, voffB); PG8_STAGE(PG8_SA(0, 0), cA, voffA); PG8_STAGE(PG8_SA(0, 1), cA + hstep, voffA);
        if (wr == 1) PG8_BAR;
        PG8_WAIT_V(2); PG8_BAR;
        PG8_STAGE(PG8_SB(1, 0), cB + kstep, voffB); PG8_STAGE(PG8_SA(1, 0), cA + kstep, voffA); PG8_STAGE(PG8_SB(1, 1), cB + hstep + kstep, voffB);
        PG8_WAIT_V(6); PG8_BAR;
    } else {
        PG8_STAGE(PG8_SB(0, 0), cB, voffB); PG8_STAGE(PG8_SA(0, 0), cA, voffA); PG8_STAGE(PG8_SB(0, 1), cB + hstep, voffB); PG8_STAGE(PG8_SA(0, 1), cA + hstep, voffA);
        if (wr == 1) PG8_BAR;
        PG8_WAIT_V(4); PG8_BAR;
        PG8_STAGE(PG8_SB(1, 0), cB + kstep, voffB); PG8_STAGE(PG8_SA(1, 0), cA + kstep, voffA); PG8_STAGE(PG8_SB(1, 1), cB + hstep + kstep, voffB);
        PG8_WAIT_V(6); PG8_BAR;
    }
    for (;;) {
        const bool has_next = S.next(ui + 1, nxt);
        const char* nA = has_next ? (const char*)g.A + (size_t)nxt.pm * tstep : cA; const char* nB = has_next ? (const char*)g.Bt + (size_t)nxt.pn * tstep : cB;
        for (int t = 0; t < nt; t += 2) {
            const bool last = (t == nt - 2);
            const char* a1 = cA + (size_t)(t + 1) * kstep;
            const char* a2 = last ? nA : cA + (size_t)(t + 2) * kstep; const char* b2 = last ? nB : cB + (size_t)(t + 2) * kstep;
            const char* a3 = a2 + kstep; const char* b3 = b2 + kstep;
            if (last && has_next) S.a_ready(nxt);
            if constexpr (SP2) {
            PG8_LDB(B0, 0, 0); PG8_LDB(B1, 0, 1); PG8_SCHED; PG8_LDA(At, 0, 0); PG8_STAGE(PG8_SA(1, 1), a1 + hstep, voffA);
            PG8_WAIT_V(8); PG8_WAIT_L(0); PG8_BAR; PG8_MMA(0, 0, At, B0); PG8_MMA(0, 1, At, B1); PG8_BAR; PG8_SCHED;
            PG8_LDA(At, 0, 1); PG8_STAGE(PG8_SB(0, 0), b2, voffB); PG8_STAGE(PG8_SB(0, 1), b2 + hstep, voffB); PG8_STAGE(PG8_SA(0, 0), a2, voffA);
            PG8_WAIT_V(8); PG8_WAIT_L(0); PG8_BAR; PG8_MMA(1, 0, At, B0); PG8_MMA(1, 1, At, B1); PG8_BAR; PG8_SCHED;
            PG8_LDB(B0, 1, 0); PG8_LDB(B1, 1, 1); PG8_SCHED; PG8_LDA(At, 1, 0); PG8_STAGE(PG8_SA(0, 1), a2 + hstep, voffA);
            PG8_WAIT_V(8); PG8_WAIT_L(0); PG8_BAR; PG8_MMA(0, 0, At, B0); PG8_MMA(0, 1, At, B1); PG8_BAR; PG8_SCHED;
            PG8_LDA(At, 1, 1); PG8_STAGE(PG8_SB(1, 0), b3, voffB); PG8_STAGE(PG8_SB(1, 1), b3 + hstep, voffB); PG8_STAGE(PG8_SA(1, 0), a3, voffA);
            PG8_WAIT_V(8); PG8_WAIT_L(0); PG8_BAR; PG8_MMA(1, 0, At, B0); PG8_MMA(1, 1, At, B1); PG8_BAR; PG8_SCHED;
            } else {
            PG8_LDB(B0, 0, 0); PG8_SCHED; PG8_LDA(At, 0, 0); PG8_STAGE(PG8_SA(1, 1), a1 + hstep, voffA);
            PG8_WAIT_L(8); PG8_BAR; PG8_WAIT_L(0); PG8_MMA(0, 0, At, B0); PG8_BAR; PG8_SCHED;
            PG8_LDB(B1, 0, 1); PG8_STAGE(PG8_SB(0, 0), b2, voffB);
            PG8_BAR; PG8_WAIT_L(0); PG8_MMA(0, 1, At, B1); PG8_BAR;
            PG8_LDA(At, 0, 1); PG8_STAGE(PG8_SA(0, 0), a2, voffA);
            PG8_BAR; PG8_WAIT_L(0); PG8_MMA(1, 0, At, B0); PG8_BAR; PG8_SCHED;
            PG8_STAGE(PG8_SB(0, 1), b2 + hstep, voffB);
            PG8_WAIT_V(6); PG8_BAR; PG8_MMA(1, 1, At, B1); PG8_BAR;
            PG8_LDB(B0, 1, 0); PG8_SCHED; PG8_LDA(At, 1, 0); PG8_STAGE(PG8_SA(0, 1), a2 + hstep, voffA);
            PG8_WAIT_L(8); PG8_BAR; PG8_WAIT_L(0); PG8_MMA(0, 0, At, B0); PG8_BAR; PG8_SCHED;
            PG8_LDB(B1, 1, 1); PG8_STAGE(PG8_SB(1, 0), b3, voffB);
            PG8_BAR; PG8_WAIT_L(0); PG8_MMA(0, 1, At, B1); PG8_BAR;
            PG8_LDA(At, 1, 1); PG8_STAGE(PG8_SA(1, 0), a3, voffA);
            PG8_BAR; PG8_WAIT_L(0); PG8_MMA(1, 0, At, B0); PG8_BAR; PG8_SCHED;
            PG8_STAGE(PG8_SB(1, 1), b3 + hstep, voffB);
            PG8_WAIT_V(6); PG8_BAR; PG8_MMA(1, 1, At, B1); PG8_BAR;
            }
        }
        if constexpr (ALIGN_EPI) { if (wr == 0) PG8_BAR; }
        if constexpr (!Epi::AFTER_DRAIN) { E(acc, cur, wr, wc, fr, fq); S.done(cur); }
        if (!has_next) break;
#pragma unroll
        for (int a = 0; a < 2; ++a)
#pragma unroll
            for (int b = 0; b < 2; ++b)
#pragma unroll
                for (int m = 0; m < 4; ++m)
#pragma unroll
                    for (int n = 0; n < 2; ++n) acc[a][b][m][n] = (f32x4){0.f, 0.f, 0.f, 0.f};
        cur = nxt; cA = nA; cB = nB; ++ui;
        if constexpr (ALIGN_EPI) { if (wr == 1) PG8_BAR; }
    }
    PG8_WAIT_V(0);
    if constexpr (!ALIGN_EPI) { if (wr == 0) PG8_BAR; }
    PG8_BAR;
    if constexpr (Epi::AFTER_DRAIN) { E.fused(acc, cur, wr, wc, fr, fq, lds, wid, lane); S.done(cur); }
#undef PG8_SA
#undef PG8_SB
#undef PG8_STAGE
#undef PG8_LDA
#undef PG8_LDB
#undef PG8_MMA
#undef PG8_WAIT_V
#undef PG8_WAIT_L
#undef PG8_BAR
#undef PG8_SCHED
}
}
#include <hip/hip_bf16.h>
#include <cmath>
namespace attn_body {
using bf16=__hip_bfloat16;
using bf16x8=__attribute__((ext_vector_type(8)))short;
using s16x4=__attribute__((ext_vector_type(4)))short;
using f32x16=__attribute__((ext_vector_type(16)))float;
using u32x4=__attribute__((ext_vector_type(4)))unsigned;
constexpr int BATCH=8,NHEAD=8,SEQ=2048,D=64,DM=NHEAD*D;
constexpr int NW=8,QBLK=32,QB=QBLK*NW,KVBLK=64,NQB=SEQ/QB;
constexpr int ATTN_PITCH=DM, ATTN_UNIT_ROWS=QB;
__device__ __forceinline__ int crow(int r,int hi){return (r&3)+8*(r>>2)+4*hi;}
#define SBAR() __builtin_amdgcn_sched_barrier(0)
__device__ __forceinline__ void cmask(f32x16&p0,f32x16&p1,int jb,int qrel,int hi){
  const float NEG=-INFINITY; int kb=64*jb+4*hi;
  #pragma unroll
  for(int r=0;r<16;++r){int kv=kb+(r&3)+8*(r>>2); if(kv>qrel)p0[r]=NEG; if(kv+32>qrel)p1[r]=NEG;}
}

constexpr int NSLOT=3, SLOTB=8192;
constexpr int LDS_K=0, LDS_V=NSLOT*SLOTB, LDS_WS=2*NSLOT*SLOTB, LDS_OST=LDS_WS+NW*64*4, LDS_CS=LDS_OST+NW*4096, LDS_BYTES=LDS_CS+SEQ*4;
constexpr float C2=0.125f*1.4426950408889634f;
__device__ __forceinline__ void glds16(const void*gsrc,unsigned lds_dst){unsigned keep;
  asm volatile("s_mov_b32 %0, m0\n\ts_mov_b32 m0, %2\n\ts_nop 0\n\tglobal_load_lds_dwordx4 %1, off\n\ts_mov_b32 m0, %0":"=&s"(keep):"v"(gsrc),"s"(lds_dst):"memory");}
__device__ __forceinline__ float max3f(float a,float b,float c){float r;asm("v_max3_f32 %0, %1, %2, %3":"=v"(r):"v"(a),"v"(b),"v"(c));return r;}
__device__ __forceinline__ float max2f(float a,float b){float r;asm("v_max_f32_e32 %0, %1, %2":"=v"(r):"v"(a),"v"(b));return r;}
__device__ __forceinline__ float fadd_s(float a,float b){float r;asm("v_add_f32_e32 %0, %1, %2":"=v"(r):"v"(a),"v"(b));return r;}
__device__ __forceinline__ float fsub_s(float a,float b){float r;asm("v_sub_f32_e32 %0, %1, %2":"=v"(r):"v"(a),"v"(b));return r;}
typedef float f32x2_t __attribute__((ext_vector_type(2))); typedef __bf16 bf16x2_t __attribute__((ext_vector_type(2)));
__device__ __forceinline__ unsigned cvtpk_s(float lo,float hi){f32x2_t v={lo,hi};bf16x2_t b=__builtin_convertvector(v,bf16x2_t);return __builtin_bit_cast(unsigned,b);}
#define WAIT_BAR(N) asm volatile("s_waitcnt vmcnt(" #N ") lgkmcnt(0)\n\ts_barrier":::"memory")

__device__ __forceinline__ void qkt(f32x16&p0,f32x16&p1,const char*Kslot,const bf16x8*qr,int r32,int hi){
  const char*kb=Kslot+hi*1024+r32*16;
  #pragma unroll
  for(int d0=0;d0<4;++d0){
    const bf16x8 b0=*reinterpret_cast<const bf16x8*>(kb+d0*2048);
    const bf16x8 b1=*reinterpret_cast<const bf16x8*>(kb+d0*2048+512);
    p0=__builtin_amdgcn_mfma_f32_32x32x16_bf16(b0,qr[d0],p0,0,0,0);p1=__builtin_amdgcn_mfma_f32_32x32x16_bf16(b1,qr[d0],p1,0,0,0);}
}
typedef __attribute__((address_space(3))) const char* lds_cptr;
typedef short v4i16_t __attribute__((ext_vector_type(4)));
__device__ __forceinline__ void kload8(bf16x8*kf,lds_cptr kp){
  kf[0]=*(const __attribute__((address_space(3))) bf16x8*)(kp);      kf[1]=*(const __attribute__((address_space(3))) bf16x8*)(kp+512);
  kf[2]=*(const __attribute__((address_space(3))) bf16x8*)(kp+2048); kf[3]=*(const __attribute__((address_space(3))) bf16x8*)(kp+2560);
  kf[4]=*(const __attribute__((address_space(3))) bf16x8*)(kp+4096); kf[5]=*(const __attribute__((address_space(3))) bf16x8*)(kp+4608);
  kf[6]=*(const __attribute__((address_space(3))) bf16x8*)(kp+6144); kf[7]=*(const __attribute__((address_space(3))) bf16x8*)(kp+6656);
}
__device__ __forceinline__ void kload2(bf16x8*kf,lds_cptr kp,int j){ kf[2*j]=*(const __attribute__((address_space(3))) bf16x8*)(kp+j*2048); kf[2*j+1]=*(const __attribute__((address_space(3))) bf16x8*)(kp+j*2048+512); }
__device__ __forceinline__ s16x4 vtr(lds_cptr p){ return __builtin_bit_cast(s16x4,__builtin_amdgcn_ds_read_tr16_b64_v4i16((__attribute__((address_space(3))) v4i16_t*)p)); }
__device__ __forceinline__ float rowmax(const f32x16&p0,const f32x16&p1){
  float a=max3f(p0[0],p0[1],p1[0]),b=max3f(p0[2],p0[3],p1[1]);a=max3f(a,p1[2],p1[3]);
  #pragma unroll
  for(int r=4;r<16;r+=4){a=max3f(a,p0[r],p0[r+1]);b=max3f(b,p0[r+2],p0[r+3]);a=max3f(a,p1[r],p1[r+1]);b=max3f(b,p1[r+2],p1[r+3]);}
  const float m=max2f(a,b);
  auto rr=__builtin_amdgcn_permlane32_swap(__float_as_uint(m),__float_as_uint(m),false,false);
  return max2f(__uint_as_float(rr[0]),__uint_as_float(rr[1]));
}
__device__ __forceinline__ void pv(f32x16*o,int vb,bf16x8 pa0,bf16x8 pa1,bf16x8 pa2,bf16x8 pa3){
  #pragma unroll
  for(int d0=0;d0<2;++d0){s16x4 lo[4],hi[4];
    #pragma unroll
    for(int ks=0;ks<4;++ks){
      asm volatile("ds_read_b64_tr_b16 %0,%1 offset:%c2":"=&v"(lo[ks]):"v"(vb),"i"(d0*4096+ks*1024):"memory");
      asm volatile("ds_read_b64_tr_b16 %0,%1 offset:%c2":"=&v"(hi[ks]):"v"(vb),"i"(d0*4096+ks*1024+512):"memory");}
    asm volatile("s_waitcnt lgkmcnt(0)":::"memory");SBAR();
    #define PK(k) (bf16x8){lo[k][0],lo[k][1],lo[k][2],lo[k][3],hi[k][0],hi[k][1],hi[k][2],hi[k][3]}
    o[d0]=__builtin_amdgcn_mfma_f32_32x32x16_bf16(pa0,PK(0),o[d0],0,0,0);
    o[d0]=__builtin_amdgcn_mfma_f32_32x32x16_bf16(pa1,PK(1),o[d0],0,0,0);
    o[d0]=__builtin_amdgcn_mfma_f32_32x32x16_bf16(pa2,PK(2),o[d0],0,0,0);
    o[d0]=__builtin_amdgcn_mfma_f32_32x32x16_bf16(pa3,PK(3),o[d0],0,0,0);
    #undef PK
  }
}

#ifndef ATTN_STORE16
#define ATTN_STORE16(p,v) (*(u32x4*)(p)=(v))
#endif
template<int THRL> __device__ __forceinline__ void attn_unit(int b,int h,int qb,const bf16*Q,const bf16*__restrict__ K,const bf16*__restrict__ V,bf16*O,const float*__restrict__ CL2,char*shm,int t0=0){
  int tid=threadIdx.x; asm volatile("":"+v"(tid)); const int lane=tid&63,r32=lane&31,hi=lane>>5; const int wid=__builtin_amdgcn_readfirstlane(tid>>6);
  const long rowbase=(long)b*SEQ; const int q0=qb*QB;
  const bf16*Qw=Q+(rowbase+q0+wid*QBLK)*DM+h*D;
  const bf16*Kh=K+rowbase*DM+h*D,*Vh=V+rowbase*DM+h*D;
  const unsigned lds0=(unsigned)(uintptr_t)shm;
  float*wsf=(float*)(shm+LDS_WS)+wid*64;
  const bf16*ksrc=Kh+(long)(t0*KVBLK+lane)*DM+wid*8;
  const bf16*vsrc=Vh+(long)(t0*KVBLK+16*(wid&3)+(lane>>2))*DM+(wid>>2)*32+(lane&3)*8;
  const unsigned kdst=lds0+LDS_K+wid*1024, vdst=lds0+LDS_V+wid*1024;
  #define DMA_K(t,slot) glds16(ksrc+(long)(t)*KVBLK*DM,(unsigned)__builtin_amdgcn_readfirstlane(kdst+(slot)))
  #define DMA_V(t,slot) glds16(vsrc+(long)(t)*KVBLK*DM,(unsigned)__builtin_amdgcn_readfirstlane(vdst+(slot)))
  const int vb0=(int)(lds0+LDS_V)+((lane>>4)&1)*32+(lane&3)*8+(4*hi+((lane&15)>>2))*64;
  const char*Kbase=shm+LDS_K; bf16x8 kf[8];
  const lds_cptr shm3=(lds_cptr)shm; const lds_cptr kp0=shm3+LDS_K+hi*1024+r32*16; const lds_cptr vp0=shm3+LDS_V+((lane>>4)&1)*32+(lane&3)*8+(4*hi+((lane&15)>>2))*64;
  const int NT=(q0+QB)/KVBLK-t0;
  DMA_K(0,0);DMA_V(0,0);DMA_K(1,SLOTB);
  bf16x8 qr[4];
  #pragma unroll
  for(int d0=0;d0<4;++d0)qr[d0]=*reinterpret_cast<const bf16x8*>(&Qw[(long)r32*DM+d0*16+hi*8]);
  const float*cg=CL2+(long)(b*NHEAD+h)*SEQ;
  { float*csf=(float*)(shm+LDS_CS); for(int i=tid;i<q0+QB;i+=NW*64)csf[i]=cg[i]; }
  const lds_cptr cs3=(lds_cptr)shm+LDS_CS+hi*16+t0*256;
  float nm=cg[q0+wid*QBLK+r32],l_reg=0.f;f32x16 o[2];o[0]=f32x16{};o[1]=f32x16{};
  const int qrel=wid*QBLK+r32;
  #define CMASK(P0,P1,t) do{int jb_=(t)-(NT-4); if(jb_>=0)cmask(P0,P1,jb_,qrel,hi);}while(0)
  bool resc=false;
  typedef float f32x4_t __attribute__((ext_vector_type(4)));
  #define BIAS(C0,C1,t) do{ const lds_cptr cp_=cs3+(t)*256; \
    _Pragma("unroll") for(int g_=0;g_<4;++g_){ const f32x4_t a_=*(const __attribute__((address_space(3))) f32x4_t*)(cp_+g_*32), b_=*(const __attribute__((address_space(3))) f32x4_t*)(cp_+g_*32+128); \
      _Pragma("unroll") for(int i_=0;i_<4;++i_){ C0[4*g_+i_]=nm-a_[i_]; C1[4*g_+i_]=nm-b_[i_]; } } }while(0)
  #define START(P0,P1) do{ const float rm=rowmax(P0,P1); resc=false; \
    { const float dl=(rm>(float)THRL)?rm:0.f;     \
      nm=fsub_s(nm,dl); \
      _Pragma("unroll") for(int r=0;r<16;++r){P0[r]=fsub_s(P0[r],dl);P1[r]=fsub_s(P1[r],dl);} } \
    _Pragma("unroll") for(int r=0;r<16;++r)P0[r]=__builtin_amdgcn_exp2f(P0[r]); }while(0)
  #define RESC() do{ if(resc){ asm volatile("s_waitcnt lgkmcnt(0)":::"memory"); \
      _Pragma("unroll") for(int d_=0;d_<2;++d_) _Pragma("unroll") for(int r=0;r<16;++r)o[d_][r]*=wsf[crow(r,hi)]; } }while(0)
  f32x16 pA0,pA1,pB0,pB1;
  int sl_prev=0,sl_cur=0,sl_next=SLOTB;
  #define ROT() do{sl_prev=sl_cur;sl_cur=sl_next;sl_next=(sl_next==(NSLOT-1)*SLOTB)?0:sl_next+SLOTB;}while(0)
  DMA_K(2,2*SLOTB);
  WAIT_BAR(3);
  BIAS(pA0,pA1,0); qkt(pA0,pA1,Kbase,qr,r32,hi);asm volatile("s_nop 15\n\ts_nop 7":"+v"(pA0),"+v"(pA1));CMASK(pA0,pA1,0);
  START(pA0,pA1);
  _Pragma("unroll") for(int r=0;r<16;++r)pA1[r]=__builtin_amdgcn_exp2f(pA1[r]);
  WAIT_BAR(0);
  DMA_K(3,0);DMA_V(1,SLOTB);
  ROT();
  kload8(kf,kp0+sl_cur);
  WAIT_BAR(2);
  s16x4 vlo[8],vhi[8]; u32x4 pw0,pw1,pw2,pw3;
  #define PKW(P,B) cvtpk_s(P[B],P[B+1])
  #define PAF(k) __builtin_bit_cast(bf16x8,pw##k)
  #define VFR(i) (bf16x8){vlo[i][0],vlo[i][1],vlo[i][2],vlo[i][3],vhi[i][0],vhi[i][1],vhi[i][2],vhi[i][3]}
  #define PIN(x) asm volatile("":"+v"(x))
  #define MX3(a,b,c) __builtin_fmaxf(__builtin_fmaxf((a),(b)),(c))
  #define GAPA(MF,A0,A1,A2,A3,W0,W1,PW) do{ MF; sacc+=A0; sacc+=A1; sacc+=A2; sacc+=A3; PIN(sacc); W0; W1; PIN(PW); SBAR(); }while(0)
  #define EX(v) __builtin_amdgcn_exp2f(v)
  #define GAPB(MF,X,B) do{ MF; X[B]=EX(X[B]); X[B+1]=EX(X[B+1]); X[B+2]=EX(X[B+2]); X[B+3]=EX(X[B+3]); PIN(X); SBAR(); }while(0)
  #define VRD(i) do{ vlo[i]=vtr(vp_+(((i)>>2)*4096+((i)&3)*1024)); vhi[i]=vtr(vp_+(((i)>>2)*4096+((i)&3)*1024+512)); }while(0)
  #define KRD(G,j) do{ if(G){ kload2(kf,kp0+sl_next,j); SBAR(); } }while(0)
  #define STEP(C0,C1,P0,P1,t,GK,GV,GL) do{ SBAR(); BIAS(C0,C1,t); SBAR(); \
    const lds_cptr vp_=vp0+sl_prev; \
    VRD(0); SBAR(); float sacc=(P0[0]+P0[1]); \
    GAPA(C0=__builtin_amdgcn_mfma_f32_32x32x16_bf16(kf[0],qr[0],C0,0,0,0), P0[2],P0[3],P0[4],P0[5],     pw0[0]=PKW(P0,0), pw0[1]=PKW(P0,2), pw0); \
    VRD(4); SBAR(); GAPA(C1=__builtin_amdgcn_mfma_f32_32x32x16_bf16(kf[1],qr[0],C1,0,0,0), P0[6],P0[7],P0[8],P0[9],     pw0[2]=PKW(P0,4), pw0[3]=PKW(P0,6), pw0); \
    VRD(1); SBAR(); GAPA(C0=__builtin_amdgcn_mfma_f32_32x32x16_bf16(kf[2],qr[1],C0,0,0,0),   P0[10],P0[11],P0[12],P0[13], pw1[0]=PKW(P0,8), pw1[1]=PKW(P0,10), pw1); \
    VRD(5); SBAR(); GAPA(C1=__builtin_amdgcn_mfma_f32_32x32x16_bf16(kf[3],qr[1],C1,0,0,0),   P0[14],P0[15],P1[0],P1[1],   pw1[2]=PKW(P0,12),pw1[3]=PKW(P0,14), pw1); \
    VRD(2); SBAR(); GAPA(C0=__builtin_amdgcn_mfma_f32_32x32x16_bf16(kf[4],qr[2],C0,0,0,0),   P1[2],P1[3],P1[4],P1[5],     pw2[0]=PKW(P1,0), pw2[1]=PKW(P1,2), pw2); \
    VRD(6); SBAR(); GAPA(C1=__builtin_amdgcn_mfma_f32_32x32x16_bf16(kf[5],qr[2],C1,0,0,0),   P1[6],P1[7],P1[8],P1[9],     pw2[2]=PKW(P1,4), pw2[3]=PKW(P1,6), pw2); \
    VRD(3); SBAR(); GAPA(C0=__builtin_amdgcn_mfma_f32_32x32x16_bf16(kf[6],qr[3],C0,0,0,0),   P1[10],P1[11],P1[12],P1[13], pw3[0]=PKW(P1,8), pw3[1]=PKW(P1,10), pw3); \
    VRD(7); SBAR(); GAPA(C1=__builtin_amdgcn_mfma_f32_32x32x16_bf16(kf[7],qr[3],C1,0,0,0),   P1[14],P1[15],0.f,0.f,       pw3[2]=PKW(P1,12),pw3[3]=PKW(P1,14), pw3); \
    l_reg+=sacc; \
    if(GK){DMA_K((t)+3,sl_cur);} if(GV){DMA_V((t)+1,sl_next);} \
    CMASK(C0,C1,t); \
    { float a=MX3(C0[0],C0[1],C1[0]),b=MX3(C0[2],C0[3],C1[1]); a=MX3(a,C1[2],C1[3]); \
      _Pragma("unroll") for(int r=4;r<16;r+=4){a=MX3(a,C0[r],C0[r+1]);b=MX3(b,C0[r+2],C0[r+3]);a=MX3(a,C1[r],C1[r+1]);b=MX3(b,C1[r+2],C1[r+3]);} \
      float rm=__builtin_fmaxf(a,b); { auto rr=__builtin_amdgcn_permlane32_swap(__float_as_uint(rm),__float_as_uint(rm),false,false); rm=__builtin_fmaxf(__uint_as_float(rr[0]),__uint_as_float(rr[1])); } \
      resc=false; \
      if(__builtin_expect(__any(rm>(float)THRL),0)){ const float dl=__builtin_fmaxf(rm,0.f); nm-=dl; \
        _Pragma("unroll") for(int r=0;r<16;++r){C0[r]-=dl;C1[r]-=dl;} \
        const float f=__builtin_amdgcn_exp2f(-dl); l_reg*=f; if(hi==0)wsf[r32]=f; resc=true; } } \
    SBAR(); \
    GAPB(o[0]=__builtin_amdgcn_mfma_f32_32x32x16_bf16(PAF(0),VFR(0),o[0],0,0,0), C0,0); \
    GAPB(o[1]=__builtin_amdgcn_mfma_f32_32x32x16_bf16(PAF(0),VFR(4),o[1],0,0,0), C0,4); \
    KRD(GL,0); GAPB(o[0]=__builtin_amdgcn_mfma_f32_32x32x16_bf16(PAF(1),VFR(1),o[0],0,0,0), C0,8); \
    KRD(GL,1); GAPB(o[1]=__builtin_amdgcn_mfma_f32_32x32x16_bf16(PAF(1),VFR(5),o[1],0,0,0), C0,12); \
    KRD(GL,2); GAPB(o[0]=__builtin_amdgcn_mfma_f32_32x32x16_bf16(PAF(2),VFR(2),o[0],0,0,0), C1,0); \
    KRD(GL,3); GAPB(o[1]=__builtin_amdgcn_mfma_f32_32x32x16_bf16(PAF(2),VFR(6),o[1],0,0,0), C1,4); \
    GAPB(o[0]=__builtin_amdgcn_mfma_f32_32x32x16_bf16(PAF(3),VFR(3),o[0],0,0,0), C1,8); \
    GAPB(o[1]=__builtin_amdgcn_mfma_f32_32x32x16_bf16(PAF(3),VFR(7),o[1],0,0,0), C1,12); \
    }while(0)
  int t=1;
  #undef CMASK
  #define CMASK(P0,P1,t) do{}while(0)
  for(;t+5<NT;t+=2){
    STEP(pB0,pB1,pA0,pA1,t,true,true,true);     WAIT_BAR(2); RESC(); ROT();
    STEP(pA0,pA1,pB0,pB1,t+1,true,true,true);   WAIT_BAR(2); RESC(); ROT();
  }
  #undef CMASK
  #define CMASK(P0,P1,t) do{int jb_=(t)-(NT-4); if(jb_>=0)cmask(P0,P1,jb_,qrel,hi);}while(0)
  #define ENDW(tt) do{ if((tt)+3<NT){WAIT_BAR(2);} else if((tt)+2<NT){WAIT_BAR(1);} else {WAIT_BAR(0);} }while(0)
  for(;t+1<NT;t+=2){
    STEP(pB0,pB1,pA0,pA1,t,(t+3<NT),(t+1<NT),(t+1<NT));       ENDW(t);   RESC(); ROT();
    STEP(pA0,pA1,pB0,pB1,t+1,(t+4<NT),(t+2<NT),(t+2<NT));     ENDW(t+1); RESC(); ROT();
  }
  STEP(pB0,pB1,pA0,pA1,NT-1,false,false,false); RESC();
  { float sacc=pB0[0]+pB0[1]; _Pragma("unroll") for(int r=2;r<16;++r)sacc+=pB0[r]; _Pragma("unroll") for(int r=0;r<16;++r)sacc+=pB1[r]; l_reg+=sacc;
    pw0=(u32x4){PKW(pB0,0),PKW(pB0,2),PKW(pB0,4),PKW(pB0,6)};pw1=(u32x4){PKW(pB0,8),PKW(pB0,10),PKW(pB0,12),PKW(pB0,14)};pw2=(u32x4){PKW(pB1,0),PKW(pB1,2),PKW(pB1,4),PKW(pB1,6)};pw3=(u32x4){PKW(pB1,8),PKW(pB1,10),PKW(pB1,12),PKW(pB1,14)};
    SBAR(); pv(o,vb0+sl_cur,PAF(0),PAF(1),PAF(2),PAF(3)); }
  #undef PKW
  #undef PAF
  #undef VFR
  #undef PIN
  #undef MX3
  #undef GAPA
  #undef GAPB
  #undef EX
  #undef VRD
  #undef KRD
  #undef STEP
  #undef ENDW
  {auto rr=__builtin_amdgcn_permlane32_swap(__float_as_uint(l_reg),__float_as_uint(l_reg),false,false);l_reg=__uint_as_float(rr[0])+__uint_as_float(rr[1]);}
  if(hi==0)wsf[32+r32]=l_reg;asm volatile("s_waitcnt lgkmcnt(0)":::"memory");
  float rli[16];
  #pragma unroll
  for(int r=0;r<16;++r)rli[r]=__builtin_amdgcn_rcpf(wsf[32+crow(r,hi)]);
  bf16*Ow=O+(rowbase+q0+wid*QBLK)*DM+h*D;
  { bf16*stg=(bf16*)(shm+LDS_OST)+wid*2048;
    #pragma unroll
    for(int r=0;r<16;++r){const int orow=crow(r,hi);
      #pragma unroll
      for(int d0=0;d0<2;++d0)stg[orow*64+d0*32+r32]=__float2bfloat16(o[d0][r]*rli[r]);}
    asm volatile("s_waitcnt lgkmcnt(0)":::"memory");
    #pragma unroll
    for(int i=0;i<4;++i){const int row=i*8+(lane>>3),ch=lane&7; const u32x4 v=*(const u32x4*)(stg+row*64+ch*8); ATTN_STORE16(Ow+(long)row*DM+ch*8,v);} }
  asm volatile("s_waitcnt lgkmcnt(0)\n\ts_barrier":::"memory");
  #undef DMA_K
  #undef DMA_V
  #undef CMASK
  #undef START
  #undef RESC
  #undef ROT
  #undef BIAS
}
constexpr int ATTN_LDS_BYTES=LDS_BYTES;
constexpr float SKIP_THR=64.0f;
__device__ __forceinline__ int attn_first_tile(const float*__restrict__ CL2,int bh,int qb){
  const int lane=threadIdx.x&63; const float*c=CL2+(long)bh*SEQ; const int q0=qb*QB, nfar=4*qb;
  const float cq=c[q0]; const float cj=c[(lane<nfar?lane:0)*KVBLK+KVBLK-1];
  const unsigned long long keep=__ballot(lane<nfar && (cq-cj)>=-SKIP_THR) | (1ull<<nfar);
  const int t0=__builtin_ctzll(keep)&~1;
  return __builtin_amdgcn_readfirstlane(t0);
}
struct AttnTensors { const bf16* Q; const bf16* K; const bf16* V; bf16* O; const float* CL2; };
struct AttnUnit { int bh; int qb; };
struct StaticOrder {
  int vcu;
  __device__ __forceinline__ explicit StaticOrder(int grid,int block):vcu((block%8)*(grid/8)+block/8){}
  __device__ __forceinline__ bool next(int i,AttnUnit&u)const{ if(i>=2||vcu>=BATCH*NHEAD*4)return false; const int s=vcu&3; u.bh=vcu>>2; u.qb=(i==0)?s:7-s; return true; }
  __device__ __forceinline__ void a_ready(const AttnUnit&)const{}
  __device__ __forceinline__ void done(const AttnUnit&)const{}
};
template<class Sched,int THRL=8> __device__ __forceinline__ void attn_phase(char*lds,const AttnTensors&T,const Sched&S){
  AttnUnit u;
  for(int i=0;S.next(i,u);++i){ S.a_ready(u); attn_unit<THRL>(u.bh/NHEAD,u.bh%NHEAD,u.qb,T.Q,T.K,T.V,T.O,T.CL2,lds); S.done(u); }
}
#undef SBAR
#undef WAIT_BAR
}
namespace sgu_body {
using attn_body::bf16x8; using attn_body::s16x4; using attn_body::f32x16; using attn_body::u32x4; using attn_body::lds_cptr; using attn_body::vtr;
constexpr int SGU_LDS_BYTES = 65536;
__device__ __forceinline__ float bflo(unsigned w) { return __uint_as_float(w << 16); }
__device__ __forceinline__ float bfhi(unsigned w) { return __uint_as_float(w & 0xffff0000u); }
__device__ __forceinline__ void sgu_unit(int ck, int half, const unsigned short* __restrict__ VG, const unsigned short* UGI, unsigned short* UGY, const unsigned short* __restrict__ WSMP,
                                         const float* __restrict__ lng, const float* __restrict__ lnb, const float* __restrict__ bs, char* shm) {
    int tid = threadIdx.x; asm volatile("" : "+v"(tid)); const int lane = tid & 63, r32 = lane & 31, hi = lane >> 5; const int wid = __builtin_amdgcn_readfirstlane(tid >> 6);
    const size_t row0 = (size_t)ck * 128;
    u32x4 raw[16];
#pragma unroll
    for (int i = 0; i < 16; ++i) raw[i] = *(const u32x4*)(VG + (row0 + 16 * wid + i) * 512 + 8 * lane);
    float mu[16], rs[16];
#pragma unroll
    for (int i = 0; i < 16; ++i) {
        const float a0 = bflo(raw[i].x), a1 = bfhi(raw[i].x), a2 = bflo(raw[i].y), a3 = bfhi(raw[i].y), a4 = bflo(raw[i].z), a5 = bfhi(raw[i].z), a6 = bflo(raw[i].w), a7 = bfhi(raw[i].w);
        float s = ((a0 + a1) + (a2 + a3)) + ((a4 + a5) + (a6 + a7));
        float q = ((a0 * a0 + a1 * a1) + (a2 * a2 + a3 * a3)) + ((a4 * a4 + a5 * a5) + (a6 * a6 + a7 * a7));
        s = wave_allsum(s); q = wave_allsum(q);
        const float m = s * (1.0f / 512.0f); const float var = fmaxf(q * (1.0f / 512.0f) - m * m, 0.f);
        mu[i] = m; rs[i] = 1.0f / sqrtf(var + 1e-6f);
    }
    if ((lane >> 5) == half) {
        const int gl = (lane >> 3) & 3, cc = 8 * (lane & 7);
        float gv[8], bv[8];
#pragma unroll
        for (int j = 0; j < 8; ++j) { gv[j] = lng[8 * lane + j]; bv[j] = lnb[8 * lane + j]; }
        char* img = shm + gl * 16384 + (cc >> 5) * 4096 + (cc & 31) * 2;
#pragma unroll
        for (int i = 0; i < 16; ++i) {
            const int s = 16 * wid + i;
            const float m = mu[i], r = rs[i];
            const float v0 = (bflo(raw[i].x) - m) * r * gv[0] + bv[0], v1 = (bfhi(raw[i].x) - m) * r * gv[1] + bv[1], v2 = (bflo(raw[i].y) - m) * r * gv[2] + bv[2], v3 = (bfhi(raw[i].y) - m) * r * gv[3] + bv[3];
            const float v4 = (bflo(raw[i].z) - m) * r * gv[4] + bv[4], v5 = (bfhi(raw[i].z) - m) * r * gv[5] + bv[5], v6 = (bflo(raw[i].w) - m) * r * gv[6] + bv[6], v7 = (bfhi(raw[i].w) - m) * r * gv[7] + bv[7];
            u32x4 w; w.x = pg8::cvt_pk_bf16(v0, v1); w.y = pg8::cvt_pk_bf16(v2, v3); w.z = pg8::cvt_pk_bf16(v4, v5); w.w = pg8::cvt_pk_bf16(v6, v7);
            *(u32x4*)(img + (s >> 6) * 8192 + ((s & 63) >> 4) * 1024 + (s & 15) * 64) = w;
        }
    }
    typedef unsigned u32x2_t __attribute__((ext_vector_type(2)));
    const int gl4 = wid >> 1, cb4 = wid & 1, g4 = 4 * half + gl4;
    bf16x8 wf[20]; u32x2_t ugq[4][4]; float bsq[4];
#pragma unroll
    for (int tb = 0; tb < 4; ++tb) {
        const unsigned short* wrow = WSMP + ((size_t)(g4 * 128 + 32 * tb + r32)) * 128 + 8 * hi;
#pragma unroll
        for (int ks = 0; ks < 2 * (tb + 1); ++ks) wf[tb * (tb + 1) + ks] = *(const bf16x8*)(wrow + 16 * ks);
        const int t = 32 * tb + r32; bsq[tb] = bs[g4 * 128 + t];
        const unsigned short* urow = UGI + (row0 + t) * 512 + g4 * 64 + 32 * cb4 + 4 * hi;
#pragma unroll
        for (int q4 = 0; q4 < 4; ++q4) ugq[tb][q4] = *(const u32x2_t*)(urow + 8 * q4);
    }
    __syncthreads();
    {
        const int gl = gl4, cb = cb4, g = g4;
        const lds_cptr vp = (lds_cptr)shm + gl * 16384 + cb * 4096 + ((lane >> 4) & 1) * 32 + (lane & 3) * 8 + (4 * hi + ((lane & 15) >> 2)) * 64;
#pragma unroll
        for (int tb = 0; tb < 4; ++tb) {
            f32x16 acc = f32x16{};
#pragma unroll
            for (int ks = 0; ks < 2 * (tb + 1); ++ks) {
                const s16x4 lo = vtr(vp + (ks >> 2) * 8192 + (ks & 3) * 1024), hh = vtr(vp + (ks >> 2) * 8192 + (ks & 3) * 1024 + 512);
                const bf16x8 a = (bf16x8){lo[0], lo[1], lo[2], lo[3], hh[0], hh[1], hh[2], hh[3]};
                acc = __builtin_amdgcn_mfma_f32_32x32x16_bf16(a, wf[tb * (tb + 1) + ks], acc, 0, 0, 0);
            }
            const int t = 32 * tb + r32; const float bsv = bsq[tb];
            unsigned short* yrow = UGY + (row0 + t) * 512 + g * 64 + 32 * cb + 4 * hi;
#pragma unroll
            for (int q4 = 0; q4 < 4; ++q4) {
                const u32x2_t ug = ugq[tb][q4];
                const float y0 = bflo(ug.x) * (acc[4 * q4 + 0] + bsv), y1 = bfhi(ug.x) * (acc[4 * q4 + 1] + bsv), y2 = bflo(ug.y) * (acc[4 * q4 + 2] + bsv), y3 = bfhi(ug.y) * (acc[4 * q4 + 3] + bsv);
                u32x2_t w; w.x = pg8::cvt_pk_bf16(y0, y1); w.y = pg8::cvt_pk_bf16(y2, y3);
                *(u32x2_t*)(yrow + 8 * q4) = w;
            }
        }
    }
    __syncthreads();
}
}
namespace peer_body {
using attn_body::bf16x8; using attn_body::f32x16; using attn_body::u32x4;
typedef __bf16 bf16x2_t __attribute__((ext_vector_type(2)));
constexpr int PEER_TOK = 64;
constexpr int L_PI = 0, L_PG = 32768, L_PS = 65536, PEER_LDS_BYTES = 98304;
__device__ __forceinline__ int okey(int b) { return b ^ ((b >> 31) & 0x7fffffff); }
__device__ __forceinline__ void ce(int& a, int& b) { const int hi = a > b ? a : b, lo = a > b ? b : a; a = hi; b = lo; }
__device__ __forceinline__ void sort16(int (&v)[16]) {
#pragma unroll
    for (int k = 2; k <= 16; k <<= 1)
#pragma unroll
        for (int j = k >> 1; j > 0; j >>= 1)
#pragma unroll
            for (int i = 0; i < 16; ++i) { const int l = i ^ j; if (l > i) { if ((i & k) == 0) ce(v[i], v[l]); else ce(v[l], v[i]); } }
}
__device__ __forceinline__ void merge16(int (&a)[16], const int (&b)[16]) {
#pragma unroll
    for (int i = 0; i < 16; ++i) a[i] = a[i] > b[15 - i] ? a[i] : b[15 - i];
#pragma unroll
    for (int j = 8; j > 0; j >>= 1)
#pragma unroll
        for (int i = 0; i < 16; ++i) { const int l = i ^ j; if (l > i) ce(a[i], a[l]); }
}
__device__ __forceinline__ float dot2(unsigned w, unsigned x, float acc) { return __builtin_amdgcn_fdot2_f32_bf16(__builtin_bit_cast(bf16x2_t, w), __builtin_bit_cast(bf16x2_t, x), acc, false); }
__device__ __forceinline__ float gelu_erf(float v) { return 0.5f * v * (1.0f + erff(v * 0.70710678118654752f)); }

constexpr int SK_PITCH = 272;
__device__ __forceinline__ void top16_scores(int (&res)[16], const bf16x8 (&bq)[8], const char* SKl, int r32, int hi) {
    f32x16 acc[4];
#pragma unroll
    for (int nb = 0; nb < 4; ++nb) acc[nb] = f32x16{};
#pragma unroll
    for (int ks = 0; ks < 8; ++ks) {
#pragma unroll
        for (int nb = 0; nb < 4; ++nb) { const bf16x8 a = *(const bf16x8*)(SKl + (32 * nb + r32) * SK_PITCH + (16 * ks + 8 * hi) * 2);
            acc[nb] = __builtin_amdgcn_mfma_f32_32x32x16_bf16(a, bq[ks], acc[nb], 0, 0, 0); }
        if (ks & 1) __builtin_amdgcn_sched_barrier(0);
    }
    int k[4][16];
#pragma unroll
    for (int nb = 0; nb < 4; ++nb) {
#pragma unroll
        for (int r = 0; r < 16; ++r) { const int n = 32 * nb + (r & 3) + 8 * (r >> 2) + 4 * hi; k[nb][r] = okey((int)((__float_as_uint(acc[nb][r]) & ~0x7fu) | (unsigned)n)); }
        sort16(k[nb]);
    }
    merge16(k[0], k[1]); merge16(k[2], k[3]); merge16(k[0], k[2]);
    int lo[16], up[16];
#pragma unroll
    for (int i = 0; i < 16; ++i) { const auto rr = __builtin_amdgcn_permlane32_swap((unsigned)k[0][i], (unsigned)k[0][i], false, false); lo[i] = (int)rr[0]; up[i] = (int)rr[1]; }
    merge16(lo, up);
#pragma unroll
    for (int i = 0; i < 16; ++i) res[i] = lo[i];
}

__device__ __forceinline__ unsigned pack_i8x4(float a, float b, float c, float d) {
    const int ia = (int)__builtin_rintf(a), ib = (int)__builtin_rintf(b), ic = (int)__builtin_rintf(c), id = (int)__builtin_rintf(d);
    return (unsigned)(ia & 0xff) | ((unsigned)(ib & 0xff) << 8) | ((unsigned)(ic & 0xff) << 16) | ((unsigned)(id & 0xff) << 24);
}
typedef float f32x2_t __attribute__((ext_vector_type(2)));
typedef unsigned u32x2_t __attribute__((ext_vector_type(2)));
__device__ __forceinline__ void fma_fp8x4(f32x2_t& a01, f32x2_t& a23, unsigned v, f32x2_t w2) {
    const f32x2_t lo = __builtin_amdgcn_cvt_pk_f32_fp8((int)v, false), hi = __builtin_amdgcn_cvt_pk_f32_fp8((int)v, true);
    a01 = __builtin_elementwise_fma(lo, w2, a01); a23 = __builtin_elementwise_fma(hi, w2, a23);
}
template <int CTRL> __device__ __forceinline__ int dppi(int v) { return __builtin_amdgcn_update_dpp(0, v, CTRL, 0xf, 0xf, false); }
template <int CTRL> __device__ __forceinline__ float dppf(float v) { return __int_as_float(__builtin_amdgcn_update_dpp(0, __float_as_int(v), CTRL, 0xf, 0xf, false)); }
constexpr int DPP_HMIRROR = 0x141, DPP_XOR2 = 0x4E, DPP_XOR1 = 0xB1, DPP_ROR8 = 0x128;

__device__ __forceinline__ void peer_retrieve(int tk, const unsigned short* __restrict__ QP, const unsigned short* __restrict__ SK, const float* __restrict__ SU, const float* __restrict__ SV,
                                              const float* __restrict__ ST, unsigned short* __restrict__ PID, float* __restrict__ G2, float* __restrict__ PS2, char* shm) {
    int tid = threadIdx.x; asm volatile("" : "+v"(tid)); const int lane = tid & 63, r32 = lane & 31, hi = lane >> 5; const int wid = __builtin_amdgcn_readfirstlane(tid >> 6);
    const int h = tk & 7, T0 = (tk >> 3) * 512 + 64 * wid;
    {   const u32x4* src = (const u32x4*)(SK + (size_t)h * 2 * 128 * 128);
#pragma unroll
        for (int i = 0; i < 8; ++i) { const int c = tid + 512 * i, row = c >> 4, ch = c & 15; *(u32x4*)(shm + row * SK_PITCH + ch * 16) = src[c]; }
    }
    __syncthreads();
#pragma unroll 1
    for (int tb = 0; tb < 2; ++tb) {
        const unsigned short* QPt = QP + (size_t)(T0 + 32 * tb) * 2048 + h * 256;
        int A[16], B[16];
        bf16x8 bqa[8], bqb[8];
#pragma unroll
        for (int ks = 0; ks < 8; ++ks) { bqa[ks] = *(const bf16x8*)(QPt + (size_t)r32 * 2048 + 16 * ks + 8 * hi); bqb[ks] = *(const bf16x8*)(QPt + 128 + (size_t)r32 * 2048 + 16 * ks + 8 * hi); }
        top16_scores(A, bqa, shm, r32, hi);
        top16_scores(B, bqb, shm + 128 * SK_PITCH, r32, hi);
        float fa[16], fb[16]; int na[16], nb[16];
#pragma unroll
        for (int i = 0; i < 16; ++i) { const int ba = okey(A[i]), bb = okey(B[i]); fa[i] = __int_as_float(ba); fb[i] = __int_as_float(bb); na[i] = (ba & 0x7f) << 7; nb[i] = bb & 0x7f; }
#define CAND(i, j) okey((int)((__float_as_uint(fa[i] + fb[j]) & ~0x3fffu) | (unsigned)(na[i] | nb[j])))
        const int NEGK = (int)0x80000000;
        int L0[16], L1[16], L2[16], L3[16];
#pragma unroll
        for (int j = 0; j < 16; ++j) L0[j] = CAND(0, j);
#pragma unroll
        for (int j = 0; j < 8; ++j) L1[j] = CAND(1, j);
#pragma unroll
        for (int j = 0; j < 5; ++j) L1[8 + j] = CAND(2, j);
#pragma unroll
        for (int j = 0; j < 3; ++j) L1[13 + j] = CAND(3, j);
        L2[0] = CAND(3, 3);
#pragma unroll
        for (int j = 0; j < 3; ++j) L2[1 + j] = CAND(4, j);
#pragma unroll
        for (int j = 0; j < 2; ++j) { L2[4 + j] = CAND(5, j); L2[6 + j] = CAND(6, j); L2[8 + j] = CAND(7, j); }
#pragma unroll
        for (int i = 8; i < 14; ++i) L2[2 + i] = CAND(i, 0);
        L3[0] = CAND(14, 0); L3[1] = CAND(15, 0);
#pragma unroll
        for (int i = 2; i < 16; ++i) L3[i] = NEGK;
#undef CAND
        sort16(L1); sort16(L2); sort16(L3);
        merge16(L0, L1); merge16(L2, L3); merge16(L0, L2);
        float e[16]; int id[16]; float se = 0.f;
        const float s0 = __int_as_float((okey(L0[0]) & ~0x3fff) | 0x2000);
#pragma unroll
        for (int i = 0; i < 16; ++i) { const int b = okey(L0[i]); id[i] = b & 0x3fff; const float s = __int_as_float((b & ~0x3fff) | 0x2000); e[i] = __expf(s - s0); se += e[i]; }
        const float inv = 1.0f / se;
        if (hi == 0) {
            const size_t t = (size_t)(T0 + 32 * tb + r32); const float st = ST[t];
            unsigned short* pi = PID + t * 128 + h * 16; float* pg = G2 + t * 128 + h * 16; float* ps = PS2 + t * 128 + h * 16;
            u32x4 w0, w1;
            w0.x = (unsigned)id[0] | ((unsigned)id[1] << 16); w0.y = (unsigned)id[2] | ((unsigned)id[3] << 16); w0.z = (unsigned)id[4] | ((unsigned)id[5] << 16); w0.w = (unsigned)id[6] | ((unsigned)id[7] << 16);
            w1.x = (unsigned)id[8] | ((unsigned)id[9] << 16); w1.y = (unsigned)id[10] | ((unsigned)id[11] << 16); w1.z = (unsigned)id[12] | ((unsigned)id[13] << 16); w1.w = (unsigned)id[14] | ((unsigned)id[15] << 16);
            *(u32x4*)pi = w0; *(u32x4*)(pi + 8) = w1;
            float sv[16], su[16];
#pragma unroll
            for (int i = 0; i < 16; ++i) { sv[i] = SV[id[i]]; su[i] = SU[id[i]]; }
            asm volatile("" ::: "memory");
#pragma unroll
            for (int i = 0; i < 16; i += 4) {
                *(float4*)(pg + i) = make_float4(e[i] * inv * sv[i], e[i + 1] * inv * sv[i + 1], e[i + 2] * inv * sv[i + 2], e[i + 3] * inv * sv[i + 3]);
                *(float4*)(ps + i) = make_float4(su[i] * st, su[i + 1] * st, su[i + 2] * st, su[i + 3] * st); }
        }
    }
    __syncthreads();
}

__device__ __forceinline__ void peer_fused(int p, int wq, int nwq, const unsigned short* __restrict__ PID, const float* __restrict__ G2, const float* __restrict__ PS2, const unsigned char* __restrict__ H2Q,
                                           const unsigned char* __restrict__ EU8, const unsigned char* __restrict__ EV8, float* X, const float* __restrict__ gfin, char* shm, float oscale) {
    int tid = threadIdx.x; asm volatile("" : "+v"(tid)); const int lane = tid & 63, g = lane >> 3, r = lane & 7; const int wid = __builtin_amdgcn_readfirstlane(tid >> 6);
    char* wl = shm + wid * 12288;
    int2* aul = (int2*)(wl + 4096) + lane; float* ssl = (float*)(wl + 8192) + lane; float* swl = (float*)(wl + 3072);
    const int k0 = 8 * (r >> 2) + 4 * ((r >> 1) & 1) + 2 * (r & 1);
    const int e0 = 8 * ((g >> 2) & 1) + 4 * ((g >> 1) & 1) + 2 * (g & 1);
    constexpr size_t SLICE = (size_t)16384 * 128;
#define FIDS(i, I0, I1) do { const u32x4* ip_ = (const u32x4*)(wl + (i) * 256 + 32 * g); I0 = ip_[0]; I1 = ip_[1]; } while (0)
#define FLOAD(R, base, I0, I1) do { _Pragma("unroll") for (int k_ = 0; k_ < 16; ++k_) { const unsigned w_ = (k_ < 8) ? I0[k_ >> 1] : I1[(k_ - 8) >> 1]; const unsigned e_ = (k_ & 1) ? (w_ >> 16) : (w_ & 0xffffu); \
        R[k_] = *(const u32x4*)((base) + (size_t)e_ * 128); } } while (0)
#define FUMATH(R, HQ, ACC) do { int s[16]; \
        _Pragma("unroll") for (int k_ = 0; k_ < 16; ++k_) { int d_ = __builtin_amdgcn_sdot4((int)R[k_].x, (int)HQ.x, 0, false); d_ = __builtin_amdgcn_sdot4((int)R[k_].y, (int)HQ.y, d_, false); \
            d_ = __builtin_amdgcn_sdot4((int)R[k_].z, (int)HQ.z, d_, false); d_ = __builtin_amdgcn_sdot4((int)R[k_].w, (int)HQ.w, d_, false); s[k_] = d_; } \
        _Pragma("unroll") for (int h_ = 0; h_ < 8; ++h_) { const int t1 = s[h_] + dppi<DPP_HMIRROR>(s[h_]), t2 = s[h_ + 8] + dppi<DPP_HMIRROR>(s[h_ + 8]); s[h_] = (r & 4) ? t2 : t1; } \
        _Pragma("unroll") for (int h_ = 0; h_ < 4; ++h_) { const int t1 = s[h_] + dppi<DPP_XOR2>(s[h_]), t2 = s[h_ + 4] + dppi<DPP_XOR2>(s[h_ + 4]); s[h_] = (r & 2) ? t2 : t1; } \
        _Pragma("unroll") for (int h_ = 0; h_ < 2; ++h_) { const int t1 = s[h_] + dppi<DPP_XOR1>(s[h_]), t2 = s[h_ + 2] + dppi<DPP_XOR1>(s[h_ + 2]); s[h_] = (r & 1) ? t2 : t1; } \
        { const int2 o_ = ACC; ACC = make_int2(o_.x + s[0], o_.y + s[1]); } } while (0)
#define FVMATH(R, W, XP, XV, SWV, SSQ, VALID) do { int acc[16]; _Pragma("unroll") for (int i_ = 0; i_ < 16; ++i_) acc[i_] = 0; \
        _Pragma("unroll") for (int m_ = 0; m_ < 4; ++m_) { const int wm_ = (int)W[m_]; \
            _Pragma("unroll") for (int c_ = 0; c_ < 4; ++c_) { \
                const unsigned r0_ = R[4 * m_ + 0][c_], r1_ = R[4 * m_ + 1][c_], r2_ = R[4 * m_ + 2][c_], r3_ = R[4 * m_ + 3][c_]; \
                const unsigned t0_ = __builtin_amdgcn_perm(r1_, r0_, 0x05010400u), t1_ = __builtin_amdgcn_perm(r1_, r0_, 0x07030602u); \
                const unsigned t2_ = __builtin_amdgcn_perm(r3_, r2_, 0x05010400u), t3_ = __builtin_amdgcn_perm(r3_, r2_, 0x07030602u); \
                acc[4 * c_ + 0] = __builtin_amdgcn_sdot4((int)__builtin_amdgcn_perm(t2_, t0_, 0x05040100u), wm_, acc[4 * c_ + 0], false); \
                acc[4 * c_ + 1] = __builtin_amdgcn_sdot4((int)__builtin_amdgcn_perm(t2_, t0_, 0x07060302u), wm_, acc[4 * c_ + 1], false); \
                acc[4 * c_ + 2] = __builtin_amdgcn_sdot4((int)__builtin_amdgcn_perm(t3_, t1_, 0x05040100u), wm_, acc[4 * c_ + 2], false); \
                acc[4 * c_ + 3] = __builtin_amdgcn_sdot4((int)__builtin_amdgcn_perm(t3_, t1_, 0x07060302u), wm_, acc[4 * c_ + 3], false); } } \
          \
        _Pragma("unroll") for (int h_ = 0; h_ < 8; ++h_) { const auto sw_ = __builtin_amdgcn_permlane32_swap((unsigned)acc[h_], (unsigned)acc[h_ + 8], false, false); acc[h_] = (int)sw_[0] + (int)sw_[1]; } \
        _Pragma("unroll") for (int h_ = 0; h_ < 4; ++h_) { const auto sw_ = __builtin_amdgcn_permlane16_swap((unsigned)acc[h_], (unsigned)acc[h_ + 4], false, false); acc[h_] = (int)sw_[0] + (int)sw_[1]; } \
        _Pragma("unroll") for (int h_ = 0; h_ < 2; ++h_) { const int t1 = acc[h_] + dppi<DPP_ROR8>(acc[h_]), t2 = acc[h_ + 2] + dppi<DPP_ROR8>(acc[h_ + 2]); acc[h_] = (lane & 8) ? t2 : t1; } \
        const float2 xv = XV; const float o0 = xv.x + SWV * (float)acc[0], o1 = xv.y + SWV * (float)acc[1]; \
        if (VALID) *(float2*)(XP) = make_float2(o0, o1); SSQ += o0 * o0 + o1 * o1; } while (0)
    const int TEND = (p + 1) * (M / 8);
#pragma unroll 1
    for (int tb = p * (M / 8) + wq; tb < TEND; tb += 8 * nwq) {
#define TOK(i) ((tb + (i) * nwq) < TEND ? (tb + (i) * nwq) : tb)
#pragma unroll
        for (int i = 0; i < 8; ++i) ((unsigned*)(wl + i * 256))[lane] = ((const unsigned*)(PID + (size_t)TOK(i) * 128))[lane];
#pragma unroll
        for (int i = 0; i < 8; ++i) aul[64 * i] = make_int2(0, 0);
        {
            u32x4 RA[16], RB[16], i0, i1, hqa, hqb;
            { const int sl = p & 7; FIDS(0, i0, i1); hqa = *(const u32x4*)(H2Q + ((size_t)sl * M + TOK(0)) * 128 + r * 16); FLOAD(RA, EU8 + sl * SLICE + r * 16, i0, i1); }
#pragma unroll 1
            for (int st = 0; st < 8; ++st) {
                const int sl = (p + st) & 7, sln = (p + st + 1) & 7; const unsigned char* ub = EU8 + sl * SLICE + r * 16; const unsigned char* hb = H2Q + (size_t)sl * M * 128 + r * 16;
#pragma unroll 1
                for (int i = 0; i < 8; i += 2) {
                    FIDS(i + 1, i0, i1); hqb = *(const u32x4*)(hb + (size_t)TOK(i + 1) * 128); FLOAD(RB, ub, i0, i1);
                    FUMATH(RA, hqa, aul[64 * i]);
                    {
                        const bool last = (i == 6); const int in_ = last ? 0 : i + 2; const int sx = last ? sln : sl;
                        FIDS(in_, i0, i1); hqa = *(const u32x4*)(H2Q + ((size_t)sx * M + TOK(in_)) * 128 + r * 16); FLOAD(RA, EU8 + sx * SLICE + r * 16, i0, i1); }
                    FUMATH(RB, hqb, aul[64 * (i + 1)]);
                }
            }
        }
        float2 g2q[8], psq[8];
#pragma unroll
        for (int i = 0; i < 8; ++i) { const size_t o = (size_t)TOK(i) * 128 + 16 * g + k0; g2q[i] = *(const float2*)(G2 + o); psq[i] = *(const float2*)(PS2 + o); }
#pragma unroll
        for (int i = 0; i < 8; ++i) {
            const float2 g2 = g2q[i], ps = psq[i]; const int2 av = aul[64 * i];
            const float w0 = g2.x * gelu_erf((float)av.x * ps.x), w1 = g2.y * gelu_erf((float)av.y * ps.y);
            float am = fmaxf(fabsf(w0), fabsf(w1));
            am = wave_allmax(am);
            const float qs = am > 0.f ? 127.0f / am : 0.f; if (lane == 0) swl[i] = am * (1.0f / 127.0f);
            const int b0 = (int)__builtin_rintf(w0 * qs) & 0xff, b1 = (int)__builtin_rintf(w1 * qs) & 0xff;
            *(unsigned short*)(wl + 2048 + i * 128 + 16 * g + k0) = (unsigned short)(b0 | (b1 << 8));
        }
#pragma unroll
        for (int i = 0; i < 8; ++i) ssl[64 * i] = 0.f;
        {
            u32x4 RA[16], RB[16], i0, i1; float2 xva, xvb;
            { const int sl = p & 7; FIDS(0, i0, i1); xva = *(const float2*)(X + (size_t)TOK(0) * 1024 + sl * 128 + 16 * r + e0); FLOAD(RA, EV8 + sl * SLICE + r * 16, i0, i1); }
#pragma unroll 1
            for (int st = 0; st < 8; ++st) {
                const int sl = (p + st) & 7, sln = (p + st + 1) & 7; const unsigned char* vb = EV8 + sl * SLICE + r * 16; float* xb = X + sl * 128 + 16 * r + e0;
#pragma unroll 1
                for (int i = 0; i < 8; i += 2) {
                    FIDS(i + 1, i0, i1); xvb = *(const float2*)(xb + (size_t)TOK(i + 1) * 1024); FLOAD(RB, vb, i0, i1);
                    { const u32x4 wv = *(const u32x4*)(wl + 2048 + i * 128 + 16 * g); const float sw_ = swl[i]; float sq_ = ssl[64 * i]; FVMATH(RA, wv, xb + (size_t)TOK(i) * 1024, xva, sw_, sq_, (tb + i * nwq) < TEND); ssl[64 * i] = sq_; }
                    { const bool last = (i == 6); const int in_ = last ? 0 : i + 2; const int sx = last ? sln : sl; FIDS(in_, i0, i1); xva = *(const float2*)(X + (size_t)TOK(in_) * 1024 + sx * 128 + 16 * r + e0); FLOAD(RA, EV8 + sx * SLICE + r * 16, i0, i1); }
                    { const u32x4 wv = *(const u32x4*)(wl + 2048 + (i + 1) * 128 + 16 * g); const float sw_ = swl[i + 1]; float sq_ = ssl[64 * (i + 1)]; FVMATH(RB, wv, xb + (size_t)TOK(i + 1) * 1024, xvb, sw_, sq_, (tb + (i + 1) * nwq) < TEND); ssl[64 * (i + 1)] = sq_; }
                }
            }
        }
#pragma unroll 1
        for (int i = 0; i < 8; ++i) {
            float ss = ssl[64 * i];
            ss = wave_allsum(ss);
            const float rr = oscale / sqrtf(ss * (1.0f / 1024.0f) + 1e-6f);
            if (tb + i * nwq < TEND) {
                float* xr = X + (size_t)(tb + i * nwq) * 1024 + 16 * r + e0;
                float2 vv[8], gg[8];
#pragma unroll
                for (int sl = 0; sl < 8; ++sl) { vv[sl] = *(const float2*)(xr + sl * 128); gg[sl] = *(const float2*)(gfin + sl * 128 + 16 * r + e0); }
                asm volatile("" ::: "memory");
#pragma unroll
                for (int sl = 0; sl < 8; ++sl) *(float2*)(xr + sl * 128) = make_float2(vv[sl].x * rr * gg[sl].x, vv[sl].y * rr * gg[sl].y);
            }
        }
#undef TOK
    }
#undef FIDS
#undef FLOAD
#undef FUMATH
#undef FVMATH
}
}
#define GAS __attribute__((address_space(1)))
#define LAS __attribute__((address_space(3)))
typedef unsigned short bf16;
typedef unsigned v4u __attribute__((ext_vector_type(4)));
typedef float f32x4 __attribute__((ext_vector_type(4)));
typedef short bf16x8 __attribute__((ext_vector_type(8)));
typedef GAS unsigned gu32;
typedef GAS unsigned long long gu64;
#define RLX_AGENT __ATOMIC_RELAXED, __HIP_MEMORY_SCOPE_AGENT
#define LDS_WAIT() asm volatile("s_waitcnt lgkmcnt(0)" ::: "memory")
#define VM_WAIT() asm volatile("s_waitcnt vmcnt(0)" ::: "memory")
__device__ __forceinline__ unsigned long long rt() { return __builtin_amdgcn_s_memrealtime(); }
__device__ __forceinline__ unsigned f2bf(float f) { unsigned u = __builtin_bit_cast(unsigned, f); return (u + 0x7fffu + ((u >> 16) & 1u)) >> 16; }
__device__ __forceinline__ unsigned pk2(float lo, float hi) { return f2bf(lo) | (f2bf(hi) << 16); }

#define XB_TMO      128
#define XB_XCNT(j)  (256  + 64 * (j))
#define XB_XSUB(j)  (1280 + 64 * (j))
#define XB_XGEN(j)  (2304 + 64 * (j))
#define XB_TOP      3328
#define XB_TOPGEN   3392
#define XCD_BAR_WORDS 3456
#define XB_SPIN_CAP (1u << 18)

__device__ __forceinline__ unsigned xb_ld(unsigned* p)              { return __hip_atomic_load(p, __ATOMIC_RELAXED, __HIP_MEMORY_SCOPE_AGENT); }
__device__ __forceinline__ unsigned xb_add(unsigned* p, unsigned v) { return __hip_atomic_fetch_add(p, v, __ATOMIC_RELAXED, __HIP_MEMORY_SCOPE_AGENT); }
__device__ __forceinline__ unsigned xb_xcc_id() { return (unsigned)__builtin_amdgcn_s_getreg((3 << 11) | 20) & 0xFu; }
#define XB_SPIN(cond, bar) do { unsigned _sp = 0; while (cond) { __builtin_amdgcn_s_sleep(1); \
    if ((++_sp & 255u) == 0u) { if (xb_ld(&(bar)[XB_TMO])) break; if (_sp > XB_SPIN_CAP) { atomicAdd(&(bar)[XB_TMO], 1u); break; } } } } while (0)

struct XcdBarrier {
    unsigned* bar; unsigned x;
    volatile LAS unsigned* st;
};

__device__ __forceinline__ XcdBarrier xcd_barrier_post(unsigned* bar, volatile LAS unsigned* st) {
    XcdBarrier b; b.bar = bar; b.x = xb_xcc_id(); b.st = st;
    if (threadIdx.x == 0) (void)xb_add(&bar[XB_XCNT(b.x)], 1u);
    return b;
}
__device__ __forceinline__ void xcd_barrier_complete(unsigned* bar, unsigned x, unsigned& nloc, unsigned& nx) {
    const unsigned G = gridDim.x * gridDim.y * gridDim.z;
    unsigned sum, cnt, mine, sp = 0u;
    for (;;) {
        sum = 0u; cnt = 0u; mine = 0u;
#pragma unroll
        for (unsigned j = 0; j < 16; ++j) { const unsigned c = xb_ld(&bar[XB_XCNT(j)]); sum += c; cnt += (c > 0u) ? 1u : 0u; mine = (j == x) ? c : mine; }
        if (sum == G) break;
        __builtin_amdgcn_s_sleep(1);
        if ((++sp & 255u) == 0u) { if (xb_ld(&bar[XB_TMO])) break; if (sp > XB_SPIN_CAP) { atomicAdd(&bar[XB_TMO], 1u); break; } }
    }
    nloc = mine > 0u ? mine : 1u; nx = cnt > 0u ? cnt : 1u;
}

__device__ __forceinline__ void xcd_barrier(const XcdBarrier& b) {
    asm volatile("s_waitcnt vmcnt(0)" ::: "memory");
    __syncthreads();
    if (threadIdx.x == 0) {
        unsigned* bar = b.bar;
        __builtin_amdgcn_s_waitcnt(0);
        unsigned nloc = b.st[0], nx = b.st[1];
        if (nloc == 0u) { xcd_barrier_complete(bar, b.x, nloc, nx); b.st[0] = nloc; b.st[1] = nx; }
        const unsigned old = xb_add(&bar[XB_XSUB(b.x)], 1u);
        const unsigned gen = old / nloc;
        if (old + 1u == (gen + 1u) * nloc) {
            __builtin_amdgcn_fence(__ATOMIC_RELEASE, "agent");
            asm volatile("s_waitcnt vmcnt(0)" ::: "memory");
            const unsigned og = xb_add(&bar[XB_TOP], 1u);
            const unsigned tg = og / nx;
            if (og + 1u == (tg + 1u) * nx) xb_add(&bar[XB_TOPGEN], 1u);
            else XB_SPIN(xb_ld(&bar[XB_TOPGEN]) == tg, bar);
            __builtin_amdgcn_fence(__ATOMIC_ACQUIRE, "agent");
            xb_add(&bar[XB_XGEN(b.x)], 1u);
            asm volatile("s_waitcnt vmcnt(0)" ::: "memory");
        } else {
            XB_SPIN(xb_ld(&bar[XB_XGEN(b.x)]) == gen, bar);
            __builtin_amdgcn_fence(__ATOMIC_ACQUIRE, "agent");
            asm volatile("s_waitcnt vmcnt(0)" ::: "memory");
        }
    }
    __syncthreads();
}

typedef unsigned short bf16_t;
__device__ __forceinline__ float bf2f(bf16_t v) { return __uint_as_float((unsigned)v << 16); }
__device__ __forceinline__ float gelu_exact(float v) { return 0.5f * v * (1.0f + erff(v * 0.70710678118654752f)); }
__device__ __forceinline__ float log_sigmoid(float z) { return z > 0.f ? -log1pf(expf(-z)) : z - log1pf(expf(z)); }
__device__ __forceinline__ float wave_sum(float v) {
    return wave_allsum(v);
}
__device__ __forceinline__ float wave_max(float v) {
    return wave_allmax(v);
}

#ifndef RP7
#define RP7 1
#endif
#ifndef RP8
#define RP8 1
#endif
#ifndef RP9
#define RP9 1
#endif
#ifndef RP0
#define RP0 1
#endif
#ifndef RP1
#define RP1 1
#endif
#ifndef RP12
#define RP12 1
#endif
#ifndef RP3
#define RP3 1
#endif
#ifndef RP4
#define RP4 1
#endif
#ifndef RP5
#define RP5 1
#endif
#ifndef RP6
#define RP6 1
#endif
#ifndef CONV_P0_FROM
#define CONV_P0_FROM (2 * NEXP)
#endif
#ifndef CONV_SPLIT
#define CONV_SPLIT (NEXP / 2)
#endif
constexpr int NWAVES = 8;
constexpr int RING_OFF = 0, RING_BYTES = 131072;
constexpr int LDSCTL_OFF = RING_BYTES, MISC_OFF = LDSCTL_OFF + 320;
constexpr int LDS_BYTES = 147456;
constexpr int CW_BAR = 4096, CW_QUEUE = 3072, CW_CMAX = 8192;
constexpr int N_PHASES = 9;

struct Args { const float* in[17]; float* out; unsigned char* ws; int ph_lo, ph_hi, li, pad; };

__device__ __forceinline__ void p0_transpose_item(const float* W, int ldw, int col0, int K, bf16* WT, int row0, LAS float* scr, int item, int nblk, int lane) {
    const int kb = item / nblk, nb = item % nblk, k0 = 64 * kb, n0 = 32 * nb;
    f32x4 v[8];
#pragma unroll
    for (int i = 0; i < 8; ++i) v[i] = *(const GAS f32x4*)(W + (size_t)(k0 + 8 * i + (lane >> 3)) * ldw + col0 + n0 + 4 * (lane & 7));
#pragma unroll
    for (int i = 0; i < 8; ++i) *(LAS f32x4*)(scr + (8 * i + (lane >> 3)) * 36 + 4 * (lane & 7)) = v[i];
    LDS_WAIT(); asm volatile("" ::: "memory");
    const int c = lane & 7;
#pragma unroll
    for (int j = 0; j < 4; ++j) { const int n = (lane >> 3) + 8 * j; const LAS float* s = scr + (8 * c) * 36 + n;
        v4u o; o.x = pg8::cvt_pk_bf16(s[0 * 36], s[1 * 36]); o.y = pg8::cvt_pk_bf16(s[2 * 36], s[3 * 36]); o.z = pg8::cvt_pk_bf16(s[4 * 36], s[5 * 36]); o.w = pg8::cvt_pk_bf16(s[6 * 36], s[7 * 36]);
        *(GAS v4u*)(WT + (size_t)(row0 + n0 + n) * K + k0 + 8 * c) = o; }
    LDS_WAIT(); asm volatile("" ::: "memory");
}
__device__ __forceinline__ void p0_transpose_item_i8(const float* W, int ldw, int col0, int K, unsigned char* WT8, float* sB, int row0, const unsigned* colmax, LAS float* scr, int item, int nblk, int lane) {
    const int kb = item / nblk, nb = item % nblk, k0 = 64 * kb, n0 = 32 * nb;
    f32x4 v[8];
#pragma unroll
    for (int i = 0; i < 8; ++i) v[i] = *(const GAS f32x4*)(W + (size_t)(k0 + 8 * i + (lane >> 3)) * ldw + col0 + n0 + 4 * (lane & 7));
#pragma unroll
    for (int i = 0; i < 8; ++i) *(LAS f32x4*)(scr + (8 * i + (lane >> 3)) * 36 + 4 * (lane & 7)) = v[i];
    LDS_WAIT(); asm volatile("" ::: "memory");
    const int c = lane & 3;
#pragma unroll
    for (int j = 0; j < 2; ++j) { const int n = (lane >> 2) + 16 * j; const LAS float* s = scr + (16 * c) * 36 + n;
        const float am = __uint_as_float(colmax[col0 + n0 + n]); const float qs = am > 0.f ? 127.0f / am : 0.f;
        v4u o;
        o.x = peer_body::pack_i8x4(s[0 * 36] * qs, s[1 * 36] * qs, s[2 * 36] * qs, s[3 * 36] * qs); o.y = peer_body::pack_i8x4(s[4 * 36] * qs, s[5 * 36] * qs, s[6 * 36] * qs, s[7 * 36] * qs);
        o.z = peer_body::pack_i8x4(s[8 * 36] * qs, s[9 * 36] * qs, s[10 * 36] * qs, s[11 * 36] * qs); o.w = peer_body::pack_i8x4(s[12 * 36] * qs, s[13 * 36] * qs, s[14 * 36] * qs, s[15 * 36] * qs);
        *(GAS v4u*)(WT8 + (size_t)(row0 + n0 + n) * K + k0 + 16 * c) = o;
        if (kb == 0 && c == 0) sB[row0 + n0 + n] = am * (1.0f / 127.0f); }
    LDS_WAIT(); asm volatile("" ::: "memory");
}
__device__ __forceinline__ void p0_colmax_task(const float* W, int ldw, int ncols, unsigned* colmax, int task, int lane) {
    const int ncb = (ncols + 255) / 256, cb = task % ncb, rb = task / ncb, c = 256 * cb + 4 * lane;
    if (c >= ncols) return;
    f32x4 m = (f32x4){0.f, 0.f, 0.f, 0.f};
#pragma unroll 8
    for (int i = 0; i < 32; ++i) { const f32x4 v = *(const GAS f32x4*)(W + (size_t)(32 * rb + i) * ldw + c);
        m.x = fmaxf(m.x, fabsf(v.x)); m.y = fmaxf(m.y, fabsf(v.y)); m.z = fmaxf(m.z, fabsf(v.z)); m.w = fmaxf(m.w, fabsf(v.w)); }
    atomicMax(colmax + c, __float_as_uint(m.x)); atomicMax(colmax + c + 1, __float_as_uint(m.y)); atomicMax(colmax + c + 2, __float_as_uint(m.z)); atomicMax(colmax + c + 3, __float_as_uint(m.w));
}
__device__ __forceinline__ void cvt_chunks(const float* src, bf16* dst, size_t nchunks, size_t gtid, size_t nthr) {
    for (size_t c = gtid; c < nchunks; c += nthr) { const f32x4 a = ((const GAS f32x4*)src)[2 * c], b = ((const GAS f32x4*)src)[2 * c + 1];
        v4u o; o.x = pg8::cvt_pk_bf16(a.x, a.y); o.y = pg8::cvt_pk_bf16(a.z, a.w); o.z = pg8::cvt_pk_bf16(b.x, b.y); o.w = pg8::cvt_pk_bf16(b.z, b.w);
        ((GAS v4u*)dst)[c] = o; }
}

__device__ __forceinline__ void convert_rows4(int e0, const float* eu, const float* ev, unsigned char* ws, int lane) {
                const bool isV = e0 >= NEXP; const int row0 = isV ? e0 - NEXP : e0;
                const float* tab = isV ? ev : eu;
                f32x4 v[4][4];
#pragma unroll
                for (int rr = 0; rr < 4; ++rr)
#pragma unroll
                    for (int i = 0; i < 4; ++i) v[rr][i] = __builtin_nontemporal_load((const GAS f32x4*)(tab + (size_t)(row0 + rr) * D + 16 * lane) + i);
#pragma unroll
                for (int rr = 0; rr < 4; ++rr) {
                    const int row = row0 + rr; float am = 0.f;
#pragma unroll
                    for (int i = 0; i < 4; ++i) am = fmaxf(fmaxf(am, fmaxf(fabsf(v[rr][i].x), fabsf(v[rr][i].y))), fmaxf(fabsf(v[rr][i].z), fabsf(v[rr][i].w)));
                    am = wave_allmax(am);
                    v4u q;
                    if (!isV) { const float inv = am > 0.f ? 127.0f / am : 0.f;
                        q.x = peer_body::pack_i8x4(v[rr][0].x * inv, v[rr][0].y * inv, v[rr][0].z * inv, v[rr][0].w * inv); q.y = peer_body::pack_i8x4(v[rr][1].x * inv, v[rr][1].y * inv, v[rr][1].z * inv, v[rr][1].w * inv);
                        q.z = peer_body::pack_i8x4(v[rr][2].x * inv, v[rr][2].y * inv, v[rr][2].z * inv, v[rr][2].w * inv); q.w = peer_body::pack_i8x4(v[rr][3].x * inv, v[rr][3].y * inv, v[rr][3].z * inv, v[rr][3].w * inv);
                        *(GAS v4u*)(ws + WS_EU + (size_t)(lane >> 3) * ((size_t)NEXP * 128) + (size_t)row * 128 + (lane & 7) * 16) = q; if (lane == 0) ((GAS float*)(ws + WS_SU))[row] = am * (1.0f / 127.0f); }
                    else { const float inv = am > 0.f ? 127.0f / am : 0.f;
                        q.x = peer_body::pack_i8x4(v[rr][0].x * inv, v[rr][0].y * inv, v[rr][0].z * inv, v[rr][0].w * inv); q.y = peer_body::pack_i8x4(v[rr][1].x * inv, v[rr][1].y * inv, v[rr][1].z * inv, v[rr][1].w * inv);
                        q.z = peer_body::pack_i8x4(v[rr][2].x * inv, v[rr][2].y * inv, v[rr][2].z * inv, v[rr][2].w * inv); q.w = peer_body::pack_i8x4(v[rr][3].x * inv, v[rr][3].y * inv, v[rr][3].z * inv, v[rr][3].w * inv);
                        *(GAS v4u*)(ws + WS_EV + (size_t)(lane >> 3) * ((size_t)NEXP * 128) + (size_t)row * 128 + (lane & 7) * 16) = q; if (lane == 0) ((GAS float*)(ws + WS_SV))[row] = am * (1.0f / 127.0f); }
                }
}

__global__ void __launch_bounds__(NWAVES * 64, 2) skel_fwd(Args args) {
    extern __shared__ __attribute__((aligned(16))) unsigned char lds[];
    LAS unsigned char* L = (LAS unsigned char*)lds;
    volatile LAS unsigned* MISC = (volatile LAS unsigned*)(L + MISC_OFF);
    const int G = gridDim.x; const int bx = blockIdx.x; const int vcu = (G % 8 == 0) ? (bx % 8) * (G / 8) + bx / 8 : bx;
    for (int u = threadIdx.x; u < (LDS_BYTES - LDSCTL_OFF) / 4; u += NWAVES * 64) ((LAS unsigned*)(L + LDSCTL_OFF))[u] = 0u;
    __syncthreads();
    (void)xcd_barrier_post((unsigned*)((gu32*)(args.ws + WS_CTL) + CW_BAR) + args.li * XCD_BAR_WORDS, MISC + 8);
#define PHASE_VARS \
    GAS unsigned char* wsg_ = (GAS unsigned char*)args.ws; asm volatile("" : "+s"(wsg_)); unsigned char* ws = (unsigned char*)wsg_; GAS float* outg_ = (GAS float*)args.out; asm volatile("" : "+s"(outg_)); float* out = (float*)outg_; \
    int tid = threadIdx.x; asm volatile("" : "+v"(tid)); const int lane = tid & 63, wave = __builtin_amdgcn_readfirstlane(tid >> 6); (void)lane; (void)wave; \
    gu32* ctl = (gu32*)(ws + WS_CTL); (void)ctl; const float* x = args.in[0]; (void)x; \
    bf16* XN = (bf16*)(ws + WS_XN); bf16* Qb = (bf16*)(ws + WS_Q); bf16* UG = (bf16*)(ws + WS_UG); (void)XN; (void)Qb; (void)UG; \
    bf16* GATE = (bf16*)out; bf16* MERGED = (bf16*)(ws + WS_MERGED); bf16* QP = (bf16*)(ws + WS_QP); (void)GATE; (void)MERGED; (void)QP; \
    float* LOGF = (float*)(ws + WS_LOGF); float* CL2 = (float*)(ws + WS_CL2); (void)LOGF; (void)CL2; \
    const int gw = vcu * NWAVES + wave, NGW = G * NWAVES; (void)gw; (void)NGW;
    const int lo = args.ph_lo, hi = args.ph_hi;
#ifndef PHMASK
#define PHMASK 0x1ff
#endif
#define IN(k) (((PHMASK >> (k)) & 1) && lo <= (k) && (k) < hi)
#define BOTH(k) (IN(k) && IN((k) + 1))
#ifdef TIMEPH
    if (bx == 0 && threadIdx.x == 0) { const unsigned long long t0_ = rt(); MISC[24] = (unsigned)t0_; }
#define GRID_BAR(k) do { XcdBarrier b_; b_.bar = (unsigned*)((gu32*)(args.ws + WS_CTL) + CW_BAR) + args.li * XCD_BAR_WORDS; b_.x = xb_xcc_id(); b_.st = MISC + 8; xcd_barrier(b_); if (bx == 0 && threadIdx.x == 0) { gu32* ctl = (gu32*)(args.ws + WS_CTL); const unsigned t_now = (unsigned)rt(); __hip_atomic_store(ctl + 2048 + (k), t_now - MISC[24], RLX_AGENT); MISC[24] = t_now; } } while (0)
#else
#define GRID_BAR(k) do { XcdBarrier b_; b_.bar = (unsigned*)((gu32*)(args.ws + WS_CTL) + CW_BAR) + args.li * XCD_BAR_WORDS; b_.x = xb_xcc_id(); b_.st = MISC + 8; xcd_barrier(b_); } while (0)
#endif

    for (int rp_ = 0; rp_ < RP0; ++rp_) if (IN(0)) {
        PHASE_VARS
        LAS float* scr = (LAS float*)(L + RING_OFF + wave * 16384);
        const float* w_in = args.in[2];
        unsigned* cmax_in = (unsigned*)(ctl + CW_CMAX);
        {
            constexpr int T_IN = ((IN_W + 255) / 256) * (D / 32);
            for (int it = gw; it < T_IN; it += NGW) p0_colmax_task(w_in, IN_W, IN_W, cmax_in, it, lane);
            GRID_BAR(0);
        }
        {
            constexpr int I_A = 16 * 48, I_B = 16 * 96, I_WA = 8 * 32, I_WB = 8 * 32, I_WO = 16 * 32, I_WQ = 16 * 64;
            constexpr int NITEMS = I_A + I_B + I_WA + I_WB + I_WO + I_WQ;
            for (int it = gw; it < NITEMS; it += NGW) {
                int r = it;
                if (r < I_A) { p0_transpose_item_i8(w_in, IN_W, 0, D, ws + WS_WIN, (float*)(ws + WS_SBW), 0, cmax_in, scr, r, 48, lane); continue; } r -= I_A;
                if (r < I_B) { p0_transpose_item_i8(w_in, IN_W, OFF_UG, D, ws + WS_WIN, (float*)(ws + WS_SBW), 1536, cmax_in, scr, r, 96, lane); continue; } r -= I_B;
                if (r < I_WA) { p0_transpose_item(args.in[8], D, 0, AW, (bf16*)(ws + WS_WA), 0, scr, r, 32, lane); continue; } r -= I_WA;
                if (r < I_WB) { p0_transpose_item(args.in[9], D, 0, SW, (bf16*)(ws + WS_WB), 0, scr, r, 32, lane); continue; } r -= I_WB;
                if (r < I_WO) { p0_transpose_item(args.in[10], D, 0, D, (bf16*)(ws + WS_WOUT), 0, scr, r, 32, lane); continue; } r -= I_WO;
                p0_transpose_item(args.in[12], QPW, 0, D, (bf16*)(ws + WS_WQ), 0, scr, r, 64, lane);
            }
        }
        {
            const size_t gtid = (size_t)gw * 64 + lane, nthr = (size_t)NGW * 64;
            cvt_chunks(args.in[13], (bf16*)(ws + WS_SK), (size_t)PH * 2 * PKEYS * PHALF / 8, gtid, nthr);
#pragma unroll 1
            for (int e0 = CONV_P0_FROM + 4 * gw; e0 < 2 * NEXP; e0 += 4 * NGW) convert_rows4(e0, args.in[14], args.in[15], ws, lane);
            const float* w_s = args.in[6]; bf16* wsm = (bf16*)(ws + WS_WSM);
            for (size_t c = gtid; c < (size_t)NG * CHUNK * CHUNK / 8; c += nthr) {
                const int pos = (int)((c * 8) & 127), t = (int)((c * 8) >> 7) & 127, ks = pos >> 4, hh = (pos >> 3) & 1, s0 = 16 * ks + 4 * hh, s1 = s0 + 8;
                const float* src = w_s + ((c * 8) & ~(size_t)127);
                const f32x4 a = *(const GAS f32x4*)(src + s0), b = *(const GAS f32x4*)(src + s1);
                v4u o; o.x = pg8::cvt_pk_bf16(s0 + 0 <= t ? a.x : 0.f, s0 + 1 <= t ? a.y : 0.f); o.y = pg8::cvt_pk_bf16(s0 + 2 <= t ? a.z : 0.f, s0 + 3 <= t ? a.w : 0.f);
                o.z = pg8::cvt_pk_bf16(s1 + 0 <= t ? b.x : 0.f, s1 + 1 <= t ? b.y : 0.f); o.w = pg8::cvt_pk_bf16(s1 + 2 <= t ? b.z : 0.f, s1 + 3 <= t ? b.w : 0.f);
                ((GAS v4u*)wsm)[c] = o; }
        }
        __syncthreads();
        {
            LAS float* wf = (LAS float*)(L + RING_OFF);
            for (int i = tid; i < 8 * D; i += NWAVES * 64) { const int k = i >> 3, c = i & 7; wf[c * D + k] = w_in[(size_t)k * IN_W + OFF_F + c]; }
            __syncthreads();
            const float* g1 = args.in[1]; const float* b_f = args.in[3];
            f32x4 gv[4];
#pragma unroll
            for (int j = 0; j < 4; ++j) gv[j] = ((const GAS f32x4*)g1)[lane + 64 * j];
#pragma unroll 1
            for (int m0 = 4 * gw; m0 < M; m0 += 4 * NGW) {
                f32x4 vv[4][4];
#pragma unroll
                for (int rr = 0; rr < 4; ++rr)
#pragma unroll
                    for (int j = 0; j < 4; ++j) vv[rr][j] = ((const GAS f32x4*)(x + (size_t)(m0 + rr) * D) + lane)[64 * j];
#pragma unroll
                for (int rr = 0; rr < 4; ++rr) {
                    const int m = m0 + rr; f32x4 v[4]; float s = 0.f;
#pragma unroll
                    for (int j = 0; j < 4; ++j) { v[j] = vv[rr][j]; s += (v[j].x * v[j].x + v[j].y * v[j].y) + (v[j].z * v[j].z + v[j].w * v[j].w); }
                    const float r = 1.0f / sqrtf(wave_sum(s) * (1.f / D) + EPS);
#pragma unroll
                    for (int j = 0; j < 4; ++j) v[j] = v[j] * r * gv[j];
                    {
                        float am = 0.f;
#pragma unroll
                        for (int j = 0; j < 4; ++j) am = fmaxf(fmaxf(am, fmaxf(fabsf(v[j].x), fabsf(v[j].y))), fmaxf(fabsf(v[j].z), fabsf(v[j].w)));
                        am = wave_allmax(am); const float qs = am > 0.f ? 127.0f / am : 0.f;
                        GAS unsigned* o4 = (GAS unsigned*)(ws + WS_XN + (size_t)m * D) + lane;
#pragma unroll
                        for (int j = 0; j < 4; ++j) o4[64 * j] = peer_body::pack_i8x4(v[j].x * qs, v[j].y * qs, v[j].z * qs, v[j].w * qs);
                        if (lane == 0) ((GAS float*)(ws + WS_SA))[m] = am * (1.0f / 127.0f); }
                    float fsum = 0.f;
#pragma unroll
                    for (int c = 0; c < 8; ++c) { float pp = 0.f;
#pragma unroll
                        for (int j = 0; j < 4; ++j) { const f32x4 w4 = *(const LAS f32x4*)(wf + c * D + 256 * j + 4 * lane); pp += (v[j].x * w4.x + v[j].y * w4.y) + (v[j].z * w4.z + v[j].w * w4.w); }
                        pp = wave_sum(pp); if (lane == c) fsum = pp; }
                    if (lane < 8) LOGF[(size_t)m * NH + lane] = log_sigmoid(fsum + b_f[lane]);
                }
            }
        }
        if (BOTH(0)) GRID_BAR(0);
    }

    for (int rp12_ = 0; rp12_ < RP12; ++rp12_) {
    for (int rp_ = 0; rp_ < RP1; ++rp_) if (IN(1)) {
        PHASE_VARS
        if (vcu < BATCH * NH) {
            const int b = vcu / NH, h = vcu % NH; LAS float* part = (LAS float*)(L + MISC_OFF + 64);
            float v[4];
#pragma unroll
            for (int i = 0; i < 4; ++i) v[i] = LOGF[(size_t)(b * SEQ + 4 * tid + i) * NH + h];
            v[1] += v[0]; v[2] += v[1]; v[3] += v[2];
            float tot = v[3];
#pragma unroll
            for (int o = 1; o < 64; o <<= 1) { const float u = __shfl_up(tot, o); if (lane >= o) tot += u; }
            if (lane == 63) part[wave] = tot;
            __syncthreads();
            float base = tot - v[3];
            for (int w = 0; w < wave; ++w) base += part[w];
#pragma unroll
            for (int i = 0; i < 4; ++i) CL2[(size_t)vcu * SEQ + 4 * tid + i] = (base + v[i]) * LOG2E;
            __syncthreads();
        }
        pg8::Gemm g{XN, (const bf16*)(ws + WS_WIN), M, NPROJ, D / 2}; pg8::StaticOrder S; S.init(M, NPROJ, G, bx);
        pg8::EpiProjI8 E{Qb, (size_t)M * 512, GATE, C2, (const float*)(ws + WS_SA), (const float*)(ws + WS_SBW)};
        pg8::gemm_phase<pg8::EpiProjI8, pg8::StaticOrder, true, true, true>(L + RING_OFF, g, S, E);
        {
            constexpr int NUN = (M / 256) * (NPROJ / 256);
            const int nmax = (NUN + G - 1) / G, nun = (NUN - bx + G - 1) / G;
            int ii_ = bx - (NUN - (nmax - 1) * G), nidle_ = G - (NUN - (nmax - 1) * G);
            if (nidle_ <= 0) { ii_ = bx; nidle_ = G; }
            if (nun < nmax || nidle_ == G) {
#pragma unroll 1
                for (int e0 = 4 * (ii_ * NWAVES + wave); e0 < CONV_SPLIT; e0 += 4 * nidle_ * NWAVES) convert_rows4(e0, args.in[14], args.in[15], ws, lane);
            }
        }
        if (BOTH(1)) GRID_BAR(1);
    }

    if (IN(2)) {
        PHASE_VARS
        static_assert(attn_body::ATTN_LDS_BYTES <= RING_BYTES, "attention LDS");
#ifdef P2PROBE
        for (int pr_ = 0; pr_ < P2PROBE; ++pr_) {
            for (int u = vcu; u < 2 * (M / CHUNK); u += G)
                sgu_body::sgu_unit(u >> 1, u & 1, (const bf16*)(ws + WS_VG), UG, (bf16*)(ws + 232 * MiB), (const bf16*)(ws + WS_WSM), args.in[4], args.in[5], args.in[7], (char*)lds + RING_OFF);
#ifndef P2PROBE_SGU_ONLY
            const attn_body::AttnTensors ATp{(const attn_body::bf16*)Qb, (const attn_body::bf16*)(ws + WS_K), (const attn_body::bf16*)(ws + WS_V), (attn_body::bf16*)(ws + 216 * MiB), CL2};
            const attn_body::StaticOrder Sp(G, bx);
            attn_body::attn_phase<attn_body::StaticOrder>((char*)lds + RING_OFF, ATp, Sp);
#endif
            GRID_BAR(2);
        }
#endif
        constexpr int NCONVQ = (CONV_P0_FROM - CONV_SPLIT) / 64, NIL = NCONVQ < 512 ? NCONVQ : 512;
        for (;;) {
            __syncthreads();
            if (tid == 0) MISC[26] = __hip_atomic_fetch_add(ctl + CW_QUEUE, 1u, RLX_AGENT);
            __syncthreads();
            const int u = __builtin_amdgcn_readfirstlane((int)MISC[26]);
            if (u >= 768 + NCONVQ) break;
            int ua = -1, uc = -1, us = -1;
            if (u < 2 * NIL) { if (u & 1) uc = u >> 1; else ua = u >> 1; }
            else if (u < 512 + NCONVQ) { if (NCONVQ > 512) uc = u - 512; else ua = u - NCONVQ; }
            else us = u - 512 - NCONVQ;
            if (ua >= 0) { const int qb = 7 - (ua >> 6), bh = ua & 63;
                const int t0 = attn_body::attn_first_tile(CL2, bh, qb);
                attn_body::attn_unit<8>(bh / NH, bh % NH, qb, (const attn_body::bf16*)Qb, (const attn_body::bf16*)(ws + WS_K), (const attn_body::bf16*)(ws + WS_V), (attn_body::bf16*)Qb, CL2, (char*)lds + RING_OFF, t0); }
            else if (uc >= 0) { convert_rows4(CONV_SPLIT + 64 * uc + 8 * wave, args.in[14], args.in[15], ws, lane); convert_rows4(CONV_SPLIT + 64 * uc + 8 * wave + 4, args.in[14], args.in[15], ws, lane); }
            else sgu_body::sgu_unit(us >> 1, us & 1, (const bf16*)(ws + WS_VG), UG, UG, (const bf16*)(ws + WS_WSM), args.in[4], args.in[5], args.in[7], (char*)lds + RING_OFF);
        }
        if (BOTH(2)) GRID_BAR(2);
    }
    }

    for (int rp_ = 0; rp_ < RP3; ++rp_) if (IN(3)) {
        PHASE_VARS
        static_assert(WS_UG - WS_Q == (size_t)pg8::MERGE_DPM * 256 * AW * 2 && WS_WB - WS_WA == (size_t)4 * 256 * AW * 2, "merge passes: buffer offsets");
        { pg8::Gemm g{Qb, (const bf16*)(ws + WS_WA), M, D, AW}; pg8::MergeOrder S; S.init(M, D, G, bx);
          pg8::EpiMergeAB E{GATE, MERGED};
          pg8::gemm_phase<pg8::EpiMergeAB, pg8::MergeOrder, true, true>(L + RING_OFF, g, S, E); }
        if (BOTH(3)) GRID_BAR(3);
    }

    for (int rp_ = 0; rp_ < RP4; ++rp_) if (IN(4)) {
        PHASE_VARS
        pg8::Gemm g{MERGED, (const bf16*)(ws + WS_WOUT), M, D, D}; pg8::StaticOrder S; S.init(M, D, G, bx);
        pg8::EpiResid E{x, out, D, M};
        pg8::gemm_phase<pg8::EpiResid, pg8::StaticOrder, false, true>(L + RING_OFF, g, S, E);
        if (BOTH(4)) GRID_BAR(4);
    }

    for (int rp_ = 0; rp_ < RP5; ++rp_) if (IN(5)) {
        PHASE_VARS
        const float* g2 = args.in[11];
        f32x4 gv[4];
#pragma unroll
        for (int j = 0; j < 4; ++j) gv[j] = ((const GAS f32x4*)g2)[lane + 64 * j];
#pragma unroll 1
        for (int m0 = 4 * gw; m0 < M; m0 += 4 * NGW) {
            f32x4 vv[4][4];
#pragma unroll
            for (int rr = 0; rr < 4; ++rr)
#pragma unroll
                for (int j = 0; j < 4; ++j) vv[rr][j] = ((const GAS f32x4*)(out + (size_t)(m0 + rr) * D) + lane)[64 * j];
            asm volatile("" ::: "memory");
#pragma unroll
            for (int rr = 0; rr < 4; ++rr) {
                const int m = m0 + rr; f32x4 v[4]; float s = 0.f;
#pragma unroll
                for (int j = 0; j < 4; ++j) { v[j] = vv[rr][j]; s += (v[j].x * v[j].x + v[j].y * v[j].y) + (v[j].z * v[j].z + v[j].w * v[j].w); }
                const float r = 1.0f / sqrtf(wave_sum(s) * (1.f / D) + EPS);
                GAS unsigned long long* o8 = (GAS unsigned long long*)(XN + (size_t)m * D) + lane;
                float am = 0.f;
#pragma unroll
                for (int j = 0; j < 4; ++j) { v[j] = v[j] * r * gv[j]; o8[64 * j] = (unsigned long long)pg8::cvt_pk_bf16(v[j].x, v[j].y) | ((unsigned long long)pg8::cvt_pk_bf16(v[j].z, v[j].w) << 32);
                    am = fmaxf(fmaxf(am, fmaxf(fabsf(v[j].x), fabsf(v[j].y))), fmaxf(fabsf(v[j].z), fabsf(v[j].w))); }
                am = wave_allmax(am);
                const float qs = am > 0.f ? 127.0f / am : 0.f;
#pragma unroll
                for (int j = 0; j < 4; ++j) *(GAS unsigned*)(ws + WS_H2Q + (size_t)(2 * j + (lane >> 5)) * ((size_t)M * 128) + (size_t)m * 128 + ((4 * lane) & 127)) = peer_body::pack_i8x4(v[j].x * qs, v[j].y * qs, v[j].z * qs, v[j].w * qs);
                if (lane == 0) ((GAS float*)(ws + WS_ST))[m] = am * (1.0f / 127.0f);
            }
        }
        if (BOTH(5)) GRID_BAR(5);
    }

    for (int rp_ = 0; rp_ < RP6; ++rp_) if (IN(6)) {
        PHASE_VARS
        pg8::Gemm g{XN, (const bf16*)(ws + WS_WQ), M, QPW, D}; pg8::StaticOrder S; S.init(M, QPW, G, bx);
        pg8::EpiBf16<0> E{QP, QPW, nullptr, 0, 0, 1.f};
        pg8::gemm_phase<pg8::EpiBf16<0>, pg8::StaticOrder, true, true>(L + RING_OFF, g, S, E);
        if (BOTH(6)) GRID_BAR(6);
    }
    for (int rp_ = 0; rp_ < RP7; ++rp_) if (IN(7)) {
        PHASE_VARS
        for (int tk = vcu; tk < 8 * (M / 512); tk += G)
            peer_body::peer_retrieve(tk, QP, (const bf16*)(ws + WS_SK), (const float*)(ws + WS_SU), (const float*)(ws + WS_SV), (const float*)(ws + WS_ST),
                                     (bf16*)(ws + WS_PID), (float*)(ws + WS_G2), (float*)(ws + WS_PS2), (char*)lds + RING_OFF);
        if (BOTH(7)) GRID_BAR(7);
    }
    if (IN(8)) {
        PHASE_VARS
#ifdef TIMEPH
        const float oscale = 1.0f + sqrtf((float)(((__hip_atomic_load(ctl + 2048 + TIMEPH, RLX_AGENT) + TIMEOFF) / TIMEQ) * TIMEQ) * 1e-5f);
#else
        const float oscale = 1.0f;
#endif
        const int p = bx & 7, cntp = (G - p + 7) >> 3;
        peer_body::peer_fused(p, (bx >> 3) * NWAVES + wave, cntp * NWAVES, (const bf16*)(ws + WS_PID), (const float*)(ws + WS_G2), (const float*)(ws + WS_PS2), (const unsigned char*)(ws + WS_H2Q),
                              (const unsigned char*)(ws + WS_EU), (const unsigned char*)(ws + WS_EV), out, args.in[16], (char*)lds + RING_OFF, oscale);
    }
#undef IN
#undef BOTH
#undef GRID_BAR
}

extern "C" void kernel_launch(void* const* d_in, const int* in_sizes, int n_in, void* d_out, int out_size, void* d_ws, size_t ws_size, hipStream_t stream) {
    static int grid = 0;
    if (grid == 0) {
        int dev = 0, cus = 0;
        if (n_in != 17 || out_size != M * D || ws_size < WS_END) { fprintf(stderr, "kernel_launch: unexpected shapes (n_in %d out %d ws %zu)\n", n_in, out_size, ws_size); grid = -1; return; }
        if (hipGetDevice(&dev) != hipSuccess || hipDeviceGetAttribute(&cus, hipDeviceAttributeMultiprocessorCount, dev) != hipSuccess) { grid = -1; return; }
        if (hipFuncSetAttribute((const void*)skel_fwd, hipFuncAttributeMaxDynamicSharedMemorySize, LDS_BYTES) != hipSuccess) { fprintf(stderr, "kernel_launch: hipFuncSetAttribute failed\n"); grid = -1; return; }
        int per_cu = 0;
        if (hipOccupancyMaxActiveBlocksPerMultiprocessor(&per_cu, (const void*)skel_fwd, NWAVES * 64, LDS_BYTES) != hipSuccess || per_cu < 1) { fprintf(stderr, "kernel_launch: occupancy query says %d workgroups per CU\n", per_cu); grid = -1; return; }
        grid = cus;
    }
    if (grid < 0) return;
    unsigned char* ws = (unsigned char*)d_ws; float* out = (float*)d_out;
    (void)hipMemsetAsync(ws + WS_CTL, 0, CTL_ZERO_BYTES, stream);
    Args a{};
    for (int i = 0; i < 17; ++i) a.in[i] = (const float*)d_in[i];
    a.out = out; a.ws = ws;
#ifndef MULTI_LAUNCH
    {
        a.ph_lo = 0; a.ph_hi = N_PHASES; a.li = 0;
        void* kargs[] = {(void*)&a};
#ifdef PLAIN_LAUNCH
        hipLaunchKernelGGL(skel_fwd, dim3(grid), dim3(NWAVES * 64), LDS_BYTES, stream, a); const hipError_t e = hipPeekAtLastError(); (void)kargs;
#else
        const hipError_t e = hipLaunchCooperativeKernel((const void*)skel_fwd, dim3(grid), dim3(NWAVES * 64), kargs, LDS_BYTES, stream);
#endif
        if (e != hipSuccess) fprintf(stderr, "kernel_launch: cooperative launch failed: %s (grid %d)\n", hipGetErrorString(e), grid);
    }
#else
    for (int k = 0; k < N_PHASES; ++k) { a.ph_lo = k; a.ph_hi = k + 1; a.li = k; hipLaunchKernelGGL(skel_fwd, dim3(grid), dim3(NWAVES * 64), LDS_BYTES, stream, a); }
#endif
}
```

```cpp
#include <hip/hip_runtime.h>
#include <cstdio>
#include <cstdint>
#include <cmath>

constexpr int D = 1024, BATCH = 8, SEQ = 2048, M = BATCH * SEQ;
constexpr int NH = 8, HD = 64, AW = 512, SW = 512, CHUNK = 128, NG = 8, GD = 64;
constexpr int OFF_Q = 0, OFF_K = 512, OFF_V = 1024, OFF_F = 1536, OFF_UG = 1544, OFF_VG = 2056, OFF_GATE = 2568, IN_W = 4616;
constexpr int NPROJ = 4608;
constexpr int PH = 8, PKEYS = 128, PHALF = 128, PTOP = 16, NEXP = 16384, QPW = 2048, HK = 128;
constexpr float EPS = 1e-6f;
constexpr float LOG2E = 1.4426950408889634f;
constexpr float C2 = 0.125f * LOG2E;

constexpr size_t MiB = 1u << 20;
constexpr size_t WS_CTL = 0, CTL_ZERO_BYTES = 65536;
constexpr size_t WS_WIN = 1 * MiB;
constexpr size_t WS_WA = 10 * MiB;
constexpr size_t WS_WB = 11 * MiB;
constexpr size_t WS_WOUT = 12 * MiB;
constexpr size_t WS_WQ = 14 * MiB;
constexpr size_t WS_SK = 18 * MiB;
constexpr size_t WS_WSM = 18 * MiB + 512 * 1024;
constexpr size_t WS_EU = 20 * MiB;
constexpr size_t WS_EV = 52 * MiB;
constexpr size_t WS_XN = 84 * MiB;
constexpr size_t WS_Q = 116 * MiB;
constexpr size_t WS_K = 132 * MiB;
constexpr size_t WS_V = 148 * MiB;
constexpr size_t WS_UG = 164 * MiB;
constexpr size_t WS_VG = 180 * MiB;
constexpr size_t WS_LOGF = 196 * MiB;
constexpr size_t WS_CL2 = 197 * MiB;
constexpr size_t WS_STAT = 199 * MiB;
constexpr size_t WS_SU = 198 * MiB;
constexpr size_t WS_SV = 198 * MiB + 65536;
constexpr size_t WS_MERGED = WS_K;
constexpr size_t WS_QP = WS_Q;
constexpr size_t WS_PIDX = WS_VG;
constexpr size_t WS_PGATE = WS_VG + 8 * MiB;
constexpr size_t WS_H2Q = 200 * MiB;
constexpr size_t WS_ST = 198 * MiB + 131072;
constexpr size_t WS_SSQP = 198 * MiB + 262144;
constexpr size_t WS_SBQ = 198 * MiB + 524288;
constexpr size_t WS_PID = 180 * MiB;
constexpr size_t WS_G2 = 184 * MiB;
constexpr size_t WS_PS2 = 216 * MiB;
constexpr size_t WS_AP = 116 * MiB;
constexpr size_t WS_WP = 84 * MiB;
constexpr size_t WS_SW = 88 * MiB;
constexpr size_t WS_SSQ = 224 * MiB;
constexpr size_t WS_SBW = 198 * MiB + 786432;
constexpr size_t WS_SA = 198 * MiB + 851968;
constexpr size_t WS_SBWQ = 198 * MiB + 917504;
constexpr size_t WS_END = 256 * MiB;

template <int CTRL> __device__ __forceinline__ float wr_dppf(float v) { return __int_as_float(__builtin_amdgcn_update_dpp(0, __float_as_int(v), CTRL, 0xf, 0xf, false)); }
__device__ __forceinline__ float wave_allsum(float v) {
    v += wr_dppf<0xB1>(v); v += wr_dppf<0x4E>(v); v += wr_dppf<0x141>(v); v += wr_dppf<0x128>(v);
    { const auto s = __builtin_amdgcn_permlane16_swap(__float_as_uint(v), __float_as_uint(v), false, false); v = __uint_as_float(s[0]) + __uint_as_float(s[1]); }
    { const auto s = __builtin_amdgcn_permlane32_swap(__float_as_uint(v), __float_as_uint(v), false, false); v = __uint_as_float(s[0]) + __uint_as_float(s[1]); }
    return v;
}
__device__ __forceinline__ float wave_allmax(float v) {
    v = fmaxf(v, wr_dppf<0xB1>(v)); v = fmaxf(v, wr_dppf<0x4E>(v)); v = fmaxf(v, wr_dppf<0x141>(v)); v = fmaxf(v, wr_dppf<0x128>(v));
    { const auto s = __builtin_amdgcn_permlane16_swap(__float_as_uint(v), __float_as_uint(v), false, false); v = fmaxf(__uint_as_float(s[0]), __uint_as_float(s[1])); }
    { const auto s = __builtin_amdgcn_permlane32_swap(__float_as_uint(v), __float_as_uint(v), false, false); v = fmaxf(__uint_as_float(s[0]), __uint_as_float(s[1])); }
    return v;
}
namespace pg8 {
#define PG8_LAS __attribute__((address_space(3)))
typedef unsigned short bf16_t;
typedef short bf16x8 __attribute__((ext_vector_type(8)));
typedef float f32x4 __attribute__((ext_vector_type(4)));
typedef unsigned u32x4 __attribute__((ext_vector_type(4)));
constexpr int BM = 256, BK = 64, HALF = 128, HTB = HALF * BK * 2  , STAGE_BYTES = 8 * HTB, NXCD = 8, WGM = 8;

__host__ __device__ __forceinline__ int lds_byte(int r, int c) { const int st = (r >> 4) * 2 + (c >> 5), rr = r & 15, cc = c & 31, ob = rr * 64 + cc * 2; return st * 1024 + (ob ^ (((ob >> 9) & 1) << 5)); }
__host__ __device__ __forceinline__ void stage_rc(int b, int& R, int& C) { const int st = b / 1024, sb = b % 1024, swz = sb ^ (((sb >> 9) & 1) << 5); R = (st >> 1) * 16 + swz / 64; C = (st & 1) * 32 + (swz % 64) / 2; }
__host__ __device__ __forceinline__ int perm32(int rho) { const int n = rho >> 4, i = rho & 15; return 8 * (i >> 2) + 4 * n + (i & 3); }

struct Unit { int pm, pn; };
struct Gemm { const bf16_t* A; const bf16_t* Bt; int M, N, K; };

struct StaticOrder {
    int nM, nN, nwg, G, c;
    __host__ __device__ void init(int M, int N, int G_, int c_) { nM = M / BM; nN = N / BM; nwg = nM * nN; G = G_; c = c_; }
    __host__ __device__ bool next(int i, Unit& u) const {
        const long L = (long)i * G + c; if (L >= nwg) return false;
        int wgid = (int)L; { const int q = nwg / NXCD, r = nwg % NXCD, xcd = wgid % NXCD, off = wgid / NXCD; wgid = (xcd < r ? xcd * (q + 1) : r * (q + 1) + (xcd - r) * q) + off; }
        const int nig = WGM * nN, gid = wgid / nig, fm = gid * WGM, gsz = (nM - fm) < WGM ? (nM - fm) : WGM;
        u.pm = fm + ((wgid % nig) % gsz); u.pn = (wgid % nig) / gsz; return true;
    }
    __device__ __forceinline__ void a_ready(const Unit&) const {}
    __device__ __forceinline__ void done(const Unit&) const {}
};

typedef float cvt_f32x2_t __attribute__((ext_vector_type(2))); typedef __bf16 cvt_bf16x2_t __attribute__((ext_vector_type(2)));
__device__ __forceinline__ unsigned cvt_pk_bf16(float lo, float hi) { cvt_f32x2_t v = {lo, hi}; cvt_bf16x2_t b = __builtin_convertvector(v, cvt_bf16x2_t); return __builtin_bit_cast(unsigned, b); }
typedef float f32x2 __attribute__((ext_vector_type(2)));
__device__ __forceinline__ f32x2 gelu_pk(f32x2 v) {
    const f32x2 av = __builtin_elementwise_abs(v), d = av * 0.2316418882f + 1.0f;
    f32x2 t; t.x = __builtin_amdgcn_rcpf(d.x); t.y = __builtin_amdgcn_rcpf(d.y);
    f32x2 q = t * 0.5307027145f + (-0.7265760135f); q = q * t + 0.7107068705f; q = q * t + (-0.142248368f); q = q * t + 0.127414796f; q = q * t;
    const f32x2 s = (v * v) * (-0.72134752044f);
    f32x2 e; e.x = __builtin_amdgcn_exp2f(s.x); e.y = __builtin_amdgcn_exp2f(s.y);
    const f32x2 m = v * (q * e), r = v - m;
    f32x2 o; o.x = v.x < 0.f ? m.x : r.x; o.y = v.y < 0.f ? m.y : r.y; return o;
}

template <int ACT  > struct EpiBf16 {
    static constexpr bool PERM = true, AFTER_DRAIN = false; static_assert(ACT == 0 || ACT == 1, "EpiBf16: ACT is 0 (none) or 1 (gelu_pk)");
    bf16_t* O; int ldc; const float* bias; int split_cols; size_t split_stride; float scale0;
    __device__ __forceinline__ void operator()(const f32x4 (&acc)[2][2][4][2], const Unit& u, int wr, int wc, int fr, int fq) const {
        const int row0 = u.pm * BM + wr * 64 + fr; int colt = u.pn * BM; bf16_t* base = O;
        float sc = 1.f; if (split_cols) { const int t = colt / split_cols; base += (size_t)t * split_stride; colt -= t * split_cols; if (t == 0) sc = scale0; }
        const int col0 = colt + wc * 32 + 8 * fq, bcol0 = u.pn * BM + wc * 32 + 8 * fq;
        f32x4 bv[2][2];
#pragma unroll
        for (int bj = 0; bj < 2; ++bj)
#pragma unroll
            for (int n = 0; n < 2; ++n) bv[bj][n] = bias ? *(const f32x4*)(bias + bcol0 + bj * HALF + 4 * n) : (f32x4){0.f, 0.f, 0.f, 0.f};
#pragma unroll
        for (int ai = 0; ai < 2; ++ai)
#pragma unroll
            for (int m = 0; m < 4; ++m) { bf16_t* rowp = base + (size_t)(row0 + ai * HALF + m * 16) * ldc + col0;
#pragma unroll
                for (int bj = 0; bj < 2; ++bj) { f32x4 v0 = acc[ai][bj][m][0] + bv[bj][0], v1 = acc[ai][bj][m][1] + bv[bj][1];
                    if (ACT == 1) { f32x2 a = gelu_pk((f32x2){v0[0], v0[1]}), b = gelu_pk((f32x2){v0[2], v0[3]}), c = gelu_pk((f32x2){v1[0], v1[1]}), d = gelu_pk((f32x2){v1[2], v1[3]});
                        v0 = (f32x4){a.x, a.y, b.x, b.y}; v1 = (f32x4){c.x, c.y, d.x, d.y}; }
                    v0 = v0 * sc; v1 = v1 * sc; u32x4 w; w.x = cvt_pk_bf16(v0[0], v0[1]); w.y = cvt_pk_bf16(v0[2], v0[3]); w.z = cvt_pk_bf16(v1[0], v1[1]); w.w = cvt_pk_bf16(v1[2], v1[3]);
                    *(u32x4*)(rowp + bj * HALF) = w; } }
    }
};
__device__ __forceinline__ f32x2 sigmoid_pk(f32x2 v) {
#ifdef DBG_SIG
    f32x2 o; o.x = 1.0f / (1.0f + __expf(-v.x)); o.y = 1.0f / (1.0f + __expf(-v.y)); return o;
#else
    f32x2 e; e.x = __builtin_amdgcn_exp2f(v.x * -1.4426950408889634f); e.y = __builtin_amdgcn_exp2f(v.y * -1.4426950408889634f);
    f32x2 o; o.x = __builtin_amdgcn_rcpf(1.0f + e.x); o.y = __builtin_amdgcn_rcpf(1.0f + e.y); return o;
#endif
}
template <int ACT> __device__ __forceinline__ f32x4 act4(f32x4 v, float sc) {
    if (ACT == 0) return v * sc;
    f32x2 a, b;
    if (ACT == 2) { a = gelu_pk((f32x2){v[0], v[1]}); b = gelu_pk((f32x2){v[2], v[3]}); }
    else { a = sigmoid_pk((f32x2){v[0], v[1]}); b = sigmoid_pk((f32x2){v[2], v[3]}); }
    return (f32x4){a.x, a.y, b.x, b.y};
}
struct EpiProj {
    static constexpr bool PERM = true, AFTER_DRAIN = false;
    bf16_t* QKVUV; size_t tstride; bf16_t* GATE; float qscale;
    template <int ACT> __device__ __forceinline__ void body(const f32x4 (&acc)[2][2][4][2], bf16_t* base, int ldc, int row0, int col0, float sc) const {
#pragma unroll
        for (int ai = 0; ai < 2; ++ai)
#pragma unroll
            for (int m = 0; m < 4; ++m) { bf16_t* rowp = base + (size_t)(row0 + ai * HALF + m * 16) * ldc + col0;
#pragma unroll
                for (int bj = 0; bj < 2; ++bj) { const f32x4 v0 = act4<ACT>(acc[ai][bj][m][0], sc), v1 = act4<ACT>(acc[ai][bj][m][1], sc);
                    u32x4 w; w.x = cvt_pk_bf16(v0[0], v0[1]); w.y = cvt_pk_bf16(v0[2], v0[3]); w.z = cvt_pk_bf16(v1[0], v1[1]); w.w = cvt_pk_bf16(v1[2], v1[3]);
                    *(u32x4*)(rowp + bj * HALF) = w; } }
    }
    __device__ __forceinline__ void operator()(const f32x4 (&acc)[2][2][4][2], const Unit& u, int wr, int wc, int fr, int fq) const {
        const int row0 = u.pm * BM + wr * 64 + fr, pn = u.pn;
        if (pn < 10) { bf16_t* base = QKVUV + (size_t)(pn >> 1) * tstride; const int col0 = (pn & 1) * BM + wc * 32 + 8 * fq;
            if (pn < 6) body<0>(acc, base, 512, row0, col0, pn < 2 ? qscale : 1.0f); else body<2>(acc, base, 512, row0, col0, 1.0f); }
        else body<3>(acc, GATE, 2048, row0, (pn - 10) * BM + wc * 32 + 8 * fq, 1.0f);
    }
};
template <int PASS> struct EpiMerge {
    static constexpr bool PERM = true, AFTER_DRAIN = false;
    const bf16_t* GATE; bf16_t* MERGED;
    __device__ __forceinline__ void operator()(const f32x4 (&acc)[2][2][4][2], const Unit& u, int wr, int wc, int fr, int fq) const {
        const int row0 = u.pm * BM + wr * 64 + fr, col0 = u.pn * BM + wc * 32 + 8 * fq;
#pragma unroll
        for (int ai = 0; ai < 2; ++ai) {
            u32x4 gq[4][2], tq[4][2];
#pragma unroll
            for (int m = 0; m < 4; ++m) { const size_t r = (size_t)(row0 + ai * HALF + m * 16);
#pragma unroll
                for (int bj = 0; bj < 2; ++bj) { const int c = col0 + bj * HALF; gq[m][bj] = *(const u32x4*)(GATE + r * 2048 + PASS * 1024 + c);
                    if (PASS == 1) tq[m][bj] = *(const u32x4*)(MERGED + r * 1024 + c); } }
            asm volatile("" ::: "memory");
#pragma unroll
            for (int m = 0; m < 4; ++m) { const size_t r = (size_t)(row0 + ai * HALF + m * 16);
#pragma unroll
                for (int bj = 0; bj < 2; ++bj) { const int c = col0 + bj * HALF; const u32x4 g = gq[m][bj];
                    f32x4 v0 = acc[ai][bj][m][0], v1 = acc[ai][bj][m][1];
                    v0[0] *= __uint_as_float(g.x << 16); v0[1] *= __uint_as_float(g.x & 0xffff0000u); v0[2] *= __uint_as_float(g.y << 16); v0[3] *= __uint_as_float(g.y & 0xffff0000u);
                    v1[0] *= __uint_as_float(g.z << 16); v1[1] *= __uint_as_float(g.z & 0xffff0000u); v1[2] *= __uint_as_float(g.w << 16); v1[3] *= __uint_as_float(g.w & 0xffff0000u);
                    if (PASS == 1) { const u32x4 t = tq[m][bj];
                        v0[0] += __uint_as_float(t.x << 16); v0[1] += __uint_as_float(t.x & 0xffff0000u); v0[2] += __uint_as_float(t.y << 16); v0[3] += __uint_as_float(t.y & 0xffff0000u);
                        v1[0] += __uint_as_float(t.z << 16); v1[1] += __uint_as_float(t.z & 0xffff0000u); v1[2] += __uint_as_float(t.w << 16); v1[3] += __uint_as_float(t.w & 0xffff0000u); }
                    u32x4 w; w.x = cvt_pk_bf16(v0[0], v0[1]); w.y = cvt_pk_bf16(v0[2], v0[3]); w.z = cvt_pk_bf16(v1[0], v1[1]); w.w = cvt_pk_bf16(v1[2], v1[3]);
                    *(u32x4*)(MERGED + r * 1024 + c) = w; } }
            asm volatile("" ::: "memory");
        }
    }
};
struct EpiResid {
    static constexpr bool PERM = false, AFTER_DRAIN = false;
    const float* base; float* out; int ldc; int nrows;
    __device__ __forceinline__ void operator()(const f32x4 (&acc)[2][2][4][2], const Unit& u, int wr, int wc, int fr, int fq) const {
        const int col0 = u.pn * BM + wc * 32 + 4 * fq;
#pragma unroll
        for (int ai = 0; ai < 2; ++ai) {
            f32x4 pre[4][2][2];
#pragma unroll
            for (int m = 0; m < 4; ++m) { const size_t off = (size_t)(u.pm * BM + ai * HALF + wr * 64 + m * 16 + fr) * ldc + col0;
#pragma unroll
                for (int bj = 0; bj < 2; ++bj)
#pragma unroll
                    for (int n = 0; n < 2; ++n) pre[m][bj][n] = *(const f32x4*)(base + off + bj * HALF + n * 16); }
            asm volatile("" ::: "memory");
#pragma unroll
            for (int m = 0; m < 4; ++m) { const size_t off = (size_t)(u.pm * BM + ai * HALF + wr * 64 + m * 16 + fr) * ldc + col0;
#pragma unroll
                for (int bj = 0; bj < 2; ++bj)
#pragma unroll
                    for (int n = 0; n < 2; ++n) *(f32x4*)(out + off + bj * HALF + n * 16) = pre[m][bj][n] + acc[ai][bj][m][n]; }
            asm volatile("" ::: "memory");
        }
    }
};

constexpr int MERGE_DPM = 192;
struct MergeOrder : StaticOrder {
    __host__ __device__ bool next(int i, Unit& u) const {
        if (!StaticOrder::next(i >> 1, u)) return false;
        if (i & 1) { u.pm += MERGE_DPM; u.pn += 4; }
        return true;
    }
};
struct EpiMergeAB {
    static constexpr bool PERM = true, AFTER_DRAIN = false;
    const bf16_t* GATE; bf16_t* MERGED;
    __device__ __forceinline__ void operator()(const f32x4 (&acc)[2][2][4][2], const Unit& u, int wr, int wc, int fr, int fq) const {
        if (u.pn < 4) { EpiMerge<0> E{GATE, MERGED}; E(acc, u, wr, wc, fr, fq); }
        else { Unit v; v.pm = u.pm - MERGE_DPM; v.pn = u.pn - 4; EpiMerge<1> E{GATE, MERGED}; E(acc, v, wr, wc, fr, fq); }
    }
};
struct QueryOrder {
    int v, G, ntask;
    __host__ __device__ bool next(int i, Unit& u) const { const int tk = v + (i >> 1) * G; if (tk >= ntask) return false; u.pm = 2 * (tk >> 3) + (i & 1); u.pn = tk & 7; return true; }
    __device__ __forceinline__ void a_ready(const Unit&) const {}
    __device__ __forceinline__ void done(const Unit&) const {}
};

struct EpiProjI8 {
    static constexpr bool PERM = true, AFTER_DRAIN = false;
    bf16_t* QKVUV; size_t tstride; bf16_t* GATE; float qscale; const float* sA; const float* sB;
    template <int ACT> __device__ __forceinline__ void body(const f32x4 (&acc)[2][2][4][2], bf16_t* base, int ldc, int row0, int col0, int bcol0, float sc) const {
        f32x4 sb[2][2];
#pragma unroll
        for (int bj = 0; bj < 2; ++bj)
#pragma unroll
            for (int n = 0; n < 2; ++n) sb[bj][n] = *(const f32x4*)(sB + bcol0 + bj * HALF + 4 * n);
#pragma unroll
        for (int ai = 0; ai < 2; ++ai)
#pragma unroll
            for (int m = 0; m < 4; ++m) { const int row = row0 + ai * HALF + m * 16; bf16_t* rowp = base + (size_t)row * ldc + col0; const float sa = sA[row];
#pragma unroll
                for (int bj = 0; bj < 2; ++bj) {
                    typedef int i32x4_t __attribute__((ext_vector_type(4)));
                    const i32x4_t i0 = __builtin_bit_cast(i32x4_t, acc[ai][bj][m][0]), i1 = __builtin_bit_cast(i32x4_t, acc[ai][bj][m][1]);
                    const f32x4 f0 = (f32x4){(float)i0[0], (float)i0[1], (float)i0[2], (float)i0[3]} * sb[bj][0] * sa, f1 = (f32x4){(float)i1[0], (float)i1[1], (float)i1[2], (float)i1[3]} * sb[bj][1] * sa;
                    const f32x4 v0 = act4<ACT>(f0, sc), v1 = act4<ACT>(f1, sc);
                    u32x4 w; w.x = cvt_pk_bf16(v0[0], v0[1]); w.y = cvt_pk_bf16(v0[2], v0[3]); w.z = cvt_pk_bf16(v1[0], v1[1]); w.w = cvt_pk_bf16(v1[2], v1[3]);
                    *(u32x4*)(rowp + bj * HALF) = w; } }
    }
    __device__ __forceinline__ void operator()(const f32x4 (&acc)[2][2][4][2], const Unit& u, int wr, int wc, int fr, int fq) const {
        const int row0 = u.pm * BM + wr * 64 + fr, pn = u.pn, bcol0 = pn * BM + wc * 32 + 8 * fq;
        if (pn < 10) { bf16_t* base = QKVUV + (size_t)(pn >> 1) * tstride; const int col0 = (pn & 1) * BM + wc * 32 + 8 * fq;
            if (pn < 6) body<0>(acc, base, 512, row0, col0, bcol0, pn < 2 ? qscale : 1.0f); else body<2>(acc, base, 512, row0, col0, bcol0, 1.0f); }
        else body<3>(acc, GATE, 2048, row0, (pn - 10) * BM + wc * 32 + 8 * fq, bcol0, 1.0f);
    }
};

struct EpiBf16I8 {
    static constexpr bool PERM = true, AFTER_DRAIN = false;
    bf16_t* O; int ldc; const float* sA; const float* sB;
    __device__ __forceinline__ void operator()(const f32x4 (&acc)[2][2][4][2], const Unit& u, int wr, int wc, int fr, int fq) const {
        typedef int i32x4_t __attribute__((ext_vector_type(4)));
        const int row0 = u.pm * BM + wr * 64 + fr, col0 = u.pn * BM + wc * 32 + 8 * fq;
        f32x4 sb[2][2];
#pragma unroll
        for (int bj = 0; bj < 2; ++bj)
#pragma unroll
            for (int n = 0; n < 2; ++n) sb[bj][n] = *(const f32x4*)(sB + col0 + bj * HALF + 4 * n);
#pragma unroll
        for (int ai = 0; ai < 2; ++ai)
#pragma unroll
            for (int m = 0; m < 4; ++m) { const int row = row0 + ai * HALF + m * 16; bf16_t* rowp = O + (size_t)row * ldc + col0; const float sa = sA[row];
#pragma unroll
                for (int bj = 0; bj < 2; ++bj) {
                    const i32x4_t i0 = __builtin_bit_cast(i32x4_t, acc[ai][bj][m][0]), i1 = __builtin_bit_cast(i32x4_t, acc[ai][bj][m][1]);
                    const f32x4 v0 = (f32x4){(float)i0[0], (float)i0[1], (float)i0[2], (float)i0[3]} * sb[bj][0] * sa, v1 = (f32x4){(float)i1[0], (float)i1[1], (float)i1[2], (float)i1[3]} * sb[bj][1] * sa;
                    u32x4 w; w.x = cvt_pk_bf16(v0[0], v0[1]); w.y = cvt_pk_bf16(v0[2], v0[3]); w.z = cvt_pk_bf16(v1[0], v1[1]); w.w = cvt_pk_bf16(v1[2], v1[3]);
                    *(u32x4*)(rowp + bj * HALF) = w; } }
    }
};
template <class Epi, class Sched, bool ALIGN_EPI = false, bool SP2 = false, bool I8 = false>
__device__ __forceinline__ void gemm_phase(PG8_LAS unsigned char* lds, const Gemm g, const Sched& S, const Epi& E) {
    typedef int i32x4_t __attribute__((ext_vector_type(4)));
    int tid = threadIdx.x; asm volatile("" : "+v"(tid));
    const int wid = __builtin_amdgcn_readfirstlane(tid >> 6), lane = tid & 63, wr = wid >> 2, wc = wid & 3, fr = lane & 15, fq = lane >> 4;
    const int K = g.K, nt = K / BK;
    unsigned voffA[2], voffB[2];
#pragma unroll
    for (int i = 0; i < 2; ++i) { int R, C; stage_rc(tid * 16 + i * 8192, R, C); const int Rb = Epi::PERM ? ((R & ~31) + perm32(R & 31)) : R;
        voffA[i] = (unsigned)(R * K + C) * 2u; voffB[i] = (unsigned)(Rb * K + C) * 2u; }
    const size_t kstep = (size_t)(BK * 2);
    const size_t hstep = (size_t)HALF * K * 2;
    const size_t tstep = 2 * hstep;
    const unsigned ldsw = (unsigned)wid * 1024u;
    const int aoff = lds_byte(wr * 64 + fr, fq * 8), boff = lds_byte(wc * 32 + fr, fq * 8);
#define PG8_SA(b, h) (((b) * 2 + (h)) * HTB)
#define PG8_SB(b, h) ((4 + (b) * 2 + (h)) * HTB)
#define PG8_STAGE(bufoff, gbase, voff) do { _Pragma("unroll") for (int _i = 0; _i < 2; ++_i) \
        __builtin_amdgcn_global_load_lds((const unsigned*)((const char*)(gbase) + (voff)[_i]), (PG8_LAS unsigned*)(lds + (bufoff) + ldsw + _i * 8192), 16, 0, 0); } while (0)
#define PG8_LDA(dst, b, h) do { _Pragma("unroll") for (int m = 0; m < 4; ++m) _Pragma("unroll") for (int k = 0; k < 2; ++k) dst[m][k] = *(const PG8_LAS bf16x8*)(lds + PG8_SA(b, h) + aoff + m * 2048 + k * 1024); } while (0)
#define PG8_LDB(dst, b, h) do { _Pragma("unroll") for (int n = 0; n < 2; ++n) _Pragma("unroll") for (int k = 0; k < 2; ++k) dst[n][k] = *(const PG8_LAS bf16x8*)(lds + PG8_SB(b, h) + boff + n * 2048 + k * 1024); } while (0)
#define PG8_MMA(ai, bj, At, Bt) do { __builtin_amdgcn_s_setprio(1); _Pragma("unroll") for (int m = 0; m < 4; ++m) _Pragma("unroll") for (int n = 0; n < 2; ++n) _Pragma("unroll") for (int k = 0; k < 2; ++k) \
        { if constexpr (I8) acc[ai][bj][m][n] = __builtin_bit_cast(f32x4, __builtin_amdgcn_mfma_i32_16x16x64_i8(__builtin_bit_cast(i32x4_t, Bt[n][k]), __builtin_bit_cast(i32x4_t, At[m][k]), __builtin_bit_cast(i32x4_t, acc[ai][bj][m][n]), 0, 0, 0)); \
          else acc[ai][bj][m][n] = __builtin_amdgcn_mfma_f32_16x16x32_bf16(Bt[n][k], At[m][k], acc[ai][bj][m][n], 0, 0, 0); } __builtin_amdgcn_s_setprio(0); } while (0)
#define PG8_WAIT_V(n) asm volatile("s_waitcnt vmcnt(" #n ")" ::: "memory")
#define PG8_WAIT_L(n) asm volatile("s_waitcnt lgkmcnt(" #n ")" ::: "memory")
#define PG8_BAR __builtin_amdgcn_s_barrier()
#define PG8_SCHED __builtin_amdgcn_sched_barrier(0)
    Unit cur, nxt; int ui = 0;
    if (!S.next(0, cur)) return;
    f32x4 acc[2][2][4][2];
#pragma unroll
    for (int a = 0; a < 2; ++a)
#pragma unroll
        for (int b = 0; b < 2; ++b)
#pragma unroll
            for (int m = 0; m < 4; ++m)
#pragma unroll
                for (int n = 0; n < 2; ++n) acc[a][b][m][n] = (f32x4){0.f, 0.f, 0.f, 0.f};
    bf16x8 At[4][2], B0[2][2], B1[2][2];
    const char* cA = (const char*)g.A + (size_t)cur.pm * tstep; const char* cB = (const char*)g.Bt + (size_t)cur.pn * tstep;
    S.a_ready(cur);
    if constexpr (SP2) {
        PG8_STAGE(PG8_SB(0, 0), cB, voffB); PG8_STAGE(PG8_SB(0, 1), cB + hstep, voffB); PG8_STAGE(PG8_SA(0, 0), cA, voffA); PG8_STAGE(PG8_SA(0, 1), cA + hstep, voffA);
        if (wr == 1) PG8_BAR;
        PG8_WAIT_V(2); PG8_BAR;
        PG8_STAGE(PG8_SB(1, 0), cB + kstep, voffB); PG8_STAGE(PG8_SA(1, 0), cA + kstep, voffA); PG8_STAGE(PG8_SB(1, 1), cB + hstep + kstep, voffB);
        PG8_WAIT_V(6); PG8_BAR;
    } else {
        PG8_STAGE(PG8_SB(0, 0), cB, voffB); PG8_STAGE(PG8_SA(0, 0), cA, voffA); PG8_STAGE(PG8_SB(0, 1), cB + hstep, voffB); PG8_STAGE(PG8_SA(0, 1), cA + hstep, voffA);
        if (wr == 1) PG8_BAR;
        PG8_WAIT_V(4); PG8_BAR;
        PG8_STAGE(PG8_SB(1, 0), cB + kstep, voffB); PG8_STAGE(PG8_SA(1, 0), cA + kstep, voffA); PG8_STAGE(PG8_SB(1, 1), cB + hstep + kstep, voffB);
        PG8_WAIT_V(6); PG8_BAR;
    }
    for (;;) {
        const bool has_next = S.next(ui + 1, nxt);
        const char* nA = has_next ? (const char*)g.A + (size_t)nxt.pm * tstep : cA; const char* nB = has_next ? (const char*)g.Bt + (size_t)nxt.pn * tstep : cB;
        for (int t = 0; t < nt; t += 2) {
            const bool last = (t == nt - 2);
            const char* a1 = cA + (size_t)(t + 1) * kstep;
            const char* a2 = last ? nA : cA + (size_t)(t + 2) * kstep; const char* b2 = last ? nB : cB + (size_t)(t + 2) * kstep;
            const char* a3 = a2 + kstep; const char* b3 = b2 + kstep;
            if (last && has_next) S.a_ready(nxt);
            if constexpr (SP2) {
            PG8_LDB(B0, 0, 0); PG8_LDB(B1, 0, 1); PG8_SCHED; PG8_LDA(At, 0, 0); PG8_STAGE(PG8_SA(1, 1), a1 + hstep, voffA);
            PG8_WAIT_V(8); PG8_WAIT_L(0); PG8_BAR; PG8_MMA(0, 0, At, B0); PG8_MMA(0, 1, At, B1); PG8_BAR; PG8_SCHED;
            PG8_LDA(At, 0, 1); PG8_STAGE(PG8_SB(0, 0), b2, voffB); PG8_STAGE(PG8_SB(0, 1), b2 + hstep, voffB); PG8_STAGE(PG8_SA(0, 0), a2, voffA);
            PG8_WAIT_V(8); PG8_WAIT_L(0); PG8_BAR; PG8_MMA(1, 0, At, B0); PG8_MMA(1, 1, At, B1); PG8_BAR; PG8_SCHED;
            PG8_LDB(B0, 1, 0); PG8_LDB(B1, 1, 1); PG8_SCHED; PG8_LDA(At, 1, 0); PG8_STAGE(PG8_SA(0, 1), a2 + hstep, voffA);
            PG8_WAIT_V(8); PG8_WAIT_L(0); PG8_BAR; PG8_MMA(0, 0, At, B0); PG8_MMA(0, 1, At, B1); PG8_BAR; PG8_SCHED;
            PG8_LDA(At, 1, 1); PG8_STAGE(PG8_SB(1, 0), b3, voffB); PG8_STAGE(PG8_SB(1, 1), b3 + hstep, voffB); PG8_STAGE(PG8_SA(1, 0), a3, voffA);
            PG8_WAIT_V(8); PG8_WAIT_L(0); PG8_BAR; PG8_MMA(1, 0, At, B0); PG8_MMA(1, 1, At, B1); PG8_BAR; PG8_SCHED;
            } else {
            PG8_LDB(B0, 0, 0); PG8_SCHED; PG8_LDA(At, 0, 0); PG8_STAGE(PG8_SA(1, 1), a1 + hstep, voffA);
            PG8_WAIT_L(8); PG8_BAR; PG8_WAIT_L(0); PG8_MMA(0, 0, At, B0); PG8_BAR; PG8_SCHED;
            PG8_LDB(B1, 0, 1); PG8_STAGE(PG8_SB(0, 0), b2, voffB);
            PG8_BAR; PG8_WAIT_L(0); PG8_MMA(0, 1, At, B1); PG8_BAR;
            PG8_LDA(At, 0, 1); PG8_STAGE(PG8_SA(0, 0), a2, voffA);
            PG8_BAR; PG8_WAIT_L(0); PG8_MMA(1, 0, At, B0); PG8_BAR; PG8_SCHED;
            PG8_STAGE(PG8_SB(0, 1), b2 + hstep, voffB);
            PG8_WAIT_V(6); PG8_BAR; PG8_MMA(1, 1, At, B1); PG8_BAR;
            PG8_LDB(B0, 1, 0); PG8_SCHED; PG8_LDA(At, 1, 0); PG8_STAGE(PG8_SA(0, 1), a2 + hstep, voffA);
            PG8_WAIT_L(8); PG8_BAR; PG8_WAIT_L(0); PG8_MMA(0, 0, At, B0); PG8_BAR; PG8_SCHED;
            PG8_LDB(B1, 1, 1); PG8_STAGE(PG8_SB(1, 0), b3, voffB);
            PG8_BAR; PG8_WAIT_L(0); PG8_MMA(0, 1, At, B1); PG8_BAR;
            PG8_LDA(At, 1, 1); PG8_STAGE(PG8_SA(1, 0), a3, voffA);
            PG8_BAR; PG8_WAIT_L(0); PG8_MMA(1, 0, At, B0); PG8_BAR; PG8_SCHED;
            PG8_STAGE(PG8_SB(1, 1), b3 + hstep, voffB);
            PG8_WAIT_V(6); PG8_BAR; PG8_MMA(1, 1, At, B1); PG8_BAR;
            }
        }
        if constexpr (ALIGN_EPI) { if (wr == 0) PG8_BAR; }
        if constexpr (!Epi::AFTER_DRAIN) { E(acc, cur, wr, wc, fr, fq); S.done(cur); }
        if (!has_next) break;
#pragma unroll
        for (int a = 0; a < 2; ++a)
#pragma unroll
            for (int b = 0; b < 2; ++b)
#pragma unroll
                for (int m = 0; m < 4; ++m)
#pragma unroll
                    for (int n = 0; n < 2; ++n) acc[a][b][m][n] = (f32x4){0.f, 0.f, 0.f, 0.f};
        cur = nxt; cA = nA; cB = nB; ++ui;
        if constexpr (ALIGN_EPI) { if (wr == 1) PG8_BAR; }
    }
    PG8_WAIT_V(0);
    if constexpr (!ALIGN_EPI) { if (wr == 0) PG8_BAR; }
    PG8_BAR;
    if constexpr (Epi::AFTER_DRAIN) { E.fused(acc, cur, wr, wc, fr, fq, lds, wid, lane); S.done(cur); }
#undef PG8_SA
#undef PG8_SB
#undef PG8_STAGE
#undef PG8_LDA
#undef PG8_LDB
#undef PG8_MMA
#undef PG8_WAIT_V
#undef PG8_WAIT_L
#undef PG8_BAR
#undef PG8_SCHED
}
}
#include <hip/hip_bf16.h>
#include <cmath>
namespace attn_body {
using bf16=__hip_bfloat16;
using bf16x8=__attribute__((ext_vector_type(8)))short;
using s16x4=__attribute__((ext_vector_type(4)))short;
using f32x16=__attribute__((ext_vector_type(16)))float;
using u32x4=__attribute__((ext_vector_type(4)))unsigned;
constexpr int BATCH=8,NHEAD=8,SEQ=2048,D=64,DM=NHEAD*D;
constexpr int NW=8,QBLK=32,QB=QBLK*NW,KVBLK=64,NQB=SEQ/QB;
constexpr int ATTN_PITCH=DM, ATTN_UNIT_ROWS=QB;
__device__ __forceinline__ int crow(int r,int hi){return (r&3)+8*(r>>2)+4*hi;}
#define SBAR() __builtin_amdgcn_sched_barrier(0)
__device__ __forceinline__ void cmask(f32x16&p0,f32x16&p1,int jb,int qrel,int hi){
  const float NEG=-INFINITY; int kb=64*jb+4*hi;
  #pragma unroll
  for(int r=0;r<16;++r){int kv=kb+(r&3)+8*(r>>2); if(kv>qrel)p0[r]=NEG; if(kv+32>qrel)p1[r]=NEG;}
}

constexpr int NSLOT=3, SLOTB=8192;
constexpr int LDS_K=0, LDS_V=NSLOT*SLOTB, LDS_WS=2*NSLOT*SLOTB, LDS_OST=LDS_WS+NW*64*4, LDS_CS=LDS_OST+NW*4096, LDS_BYTES=LDS_CS+SEQ*4;
constexpr float C2=0.125f*1.4426950408889634f;
__device__ __forceinline__ void glds16(const void*gsrc,unsigned lds_dst){unsigned keep;
  asm volatile("s_mov_b32 %0, m0\n\ts_mov_b32 m0, %2\n\ts_nop 0\n\tglobal_load_lds_dwordx4 %1, off\n\ts_mov_b32 m0, %0":"=&s"(keep):"v"(gsrc),"s"(lds_dst):"memory");}
__device__ __forceinline__ float max3f(float a,float b,float c){float r;asm("v_max3_f32 %0, %1, %2, %3":"=v"(r):"v"(a),"v"(b),"v"(c));return r;}
__device__ __forceinline__ float max2f(float a,float b){float r;asm("v_max_f32_e32 %0, %1, %2":"=v"(r):"v"(a),"v"(b));return r;}
__device__ __forceinline__ float fadd_s(float a,float b){float r;asm("v_add_f32_e32 %0, %1, %2":"=v"(r):"v"(a),"v"(b));return r;}
__device__ __forceinline__ float fsub_s(float a,float b){float r;asm("v_sub_f32_e32 %0, %1, %2":"=v"(r):"v"(a),"v"(b));return r;}
typedef float f32x2_t __attribute__((ext_vector_type(2))); typedef __bf16 bf16x2_t __attribute__((ext_vector_type(2)));
__device__ __forceinline__ unsigned cvtpk_s(float lo,float hi){f32x2_t v={lo,hi};bf16x2_t b=__builtin_convertvector(v,bf16x2_t);return __builtin_bit_cast(unsigned,b);}
#define WAIT_BAR(N) asm volatile("s_waitcnt vmcnt(" #N ") lgkmcnt(0)\n\ts_barrier":::"memory")

__device__ __forceinline__ void qkt(f32x16&p0,f32x16&p1,const char*Kslot,const bf16x8*qr,int r32,int hi){
  const char*kb=Kslot+hi*1024+r32*16;
  #pragma unroll
  for(int d0=0;d0<4;++d0){
    const bf16x8 b0=*reinterpret_cast<const bf16x8*>(kb+d0*2048);
    const bf16x8 b1=*reinterpret_cast<const bf16x8*>(kb+d0*2048+512);
    p0=__builtin_amdgcn_mfma_f32_32x32x16_bf16(b0,qr[d0],p0,0,0,0);p1=__builtin_amdgcn_mfma_f32_32x32x16_bf16(b1,qr[d0],p1,0,0,0);}
}
typedef __attribute__((address_space(3))) const char* lds_cptr;
typedef short v4i16_t __attribute__((ext_vector_type(4)));
__device__ __forceinline__ void kload8(bf16x8*kf,lds_cptr kp){
  kf[0]=*(const __attribute__((address_space(3))) bf16x8*)(kp);      kf[1]=*(const __attribute__((address_space(3))) bf16x8*)(kp+512);
  kf[2]=*(const __attribute__((address_space(3))) bf16x8*)(kp+2048); kf[3]=*(const __attribute__((address_space(3))) bf16x8*)(kp+2560);
  kf[4]=*(const __attribute__((address_space(3))) bf16x8*)(kp+4096); kf[5]=*(const __attribute__((address_space(3))) bf16x8*)(kp+4608);
  kf[6]=*(const __attribute__((address_space(3))) bf16x8*)(kp+6144); kf[7]=*(const __attribute__((address_space(3))) bf16x8*)(kp+6656);
}
__device__ __forceinline__ void kload2(bf16x8*kf,lds_cptr kp,int j){ kf[2*j]=*(const __attribute__((address_space(3))) bf16x8*)(kp+j*2048); kf[2*j+1]=*(const __attribute__((address_space(3))) bf16x8*)(kp+j*2048+512); }
__device__ __forceinline__ s16x4 vtr(lds_cptr p){ return __builtin_bit_cast(s16x4,__builtin_amdgcn_ds_read_tr16_b64_v4i16((__attribute__((address_space(3))) v4i16_t*)p)); }
__device__ __forceinline__ float rowmax(const f32x16&p0,const f32x16&p1){
  float a=max3f(p0[0],p0[1],p1[0]),b=max3f(p0[2],p0[3],p1[1]);a=max3f(a,p1[2],p1[3]);
  #pragma unroll
  for(int r=4;r<16;r+=4){a=max3f(a,p0[r],p0[r+1]);b=max3f(b,p0[r+2],p0[r+3]);a=max3f(a,p1[r],p1[r+1]);b=max3f(b,p1[r+2],p1[r+3]);}
  const float m=max2f(a,b);
  auto rr=__builtin_amdgcn_permlane32_swap(__float_as_uint(m),__float_as_uint(m),false,false);
  return max2f(__uint_as_float(rr[0]),__uint_as_float(rr[1]));
}
__device__ __forceinline__ void pv(f32x16*o,int vb,bf16x8 pa0,bf16x8 pa1,bf16x8 pa2,bf16x8 pa3){
  #pragma unroll
  for(int d0=0;d0<2;++d0){s16x4 lo[4],hi[4];
    #pragma unroll
    for(int ks=0;ks<4;++ks){
      asm volatile("ds_read_b64_tr_b16 %0,%1 offset:%c2":"=&v"(lo[ks]):"v"(vb),"i"(d0*4096+ks*1024):"memory");
      asm volatile("ds_read_b64_tr_b16 %0,%1 offset:%c2":"=&v"(hi[ks]):"v"(vb),"i"(d0*4096+ks*1024+512):"memory");}
    asm volatile("s_waitcnt lgkmcnt(0)":::"memory");SBAR();
    #define PK(k) (bf16x8){lo[k][0],lo[k][1],lo[k][2],lo[k][3],hi[k][0],hi[k][1],hi[k][2],hi[k][3]}
    o[d0]=__builtin_amdgcn_mfma_f32_32x32x16_bf16(pa0,PK(0),o[d0],0,0,0);
    o[d0]=__builtin_amdgcn_mfma_f32_32x32x16_bf16(pa1,PK(1),o[d0],0,0,0);
    o[d0]=__builtin_amdgcn_mfma_f32_32x32x16_bf16(pa2,PK(2),o[d0],0,0,0);
    o[d0]=__builtin_amdgcn_mfma_f32_32x32x16_bf16(pa3,PK(3),o[d0],0,0,0);
    #undef PK
  }
}

#ifndef ATTN_STORE16
#define ATTN_STORE16(p,v) (*(u32x4*)(p)=(v))
#endif
template<int THRL> __device__ __forceinline__ void attn_unit(int b,int h,int qb,const bf16*Q,const bf16*__restrict__ K,const bf16*__restrict__ V,bf16*O,const float*__restrict__ CL2,char*shm,int t0=0){
  int tid=threadIdx.x; asm volatile("":"+v"(tid)); const int lane=tid&63,r32=lane&31,hi=lane>>5; const int wid=__builtin_amdgcn_readfirstlane(tid>>6);
  const long rowbase=(long)b*SEQ; const int q0=qb*QB;
  const bf16*Qw=Q+(rowbase+q0+wid*QBLK)*DM+h*D;
  const bf16*Kh=K+rowbase*DM+h*D,*Vh=V+rowbase*DM+h*D;
  const unsigned lds0=(unsigned)(uintptr_t)shm;
  float*wsf=(float*)(shm+LDS_WS)+wid*64;
  const bf16*ksrc=Kh+(long)(t0*KVBLK+lane)*DM+wid*8;
  const bf16*vsrc=Vh+(long)(t0*KVBLK+16*(wid&3)+(lane>>2))*DM+(wid>>2)*32+(lane&3)*8;
  const unsigned kdst=lds0+LDS_K+wid*1024, vdst=lds0+LDS_V+wid*1024;
  #define DMA_K(t,slot) glds16(ksrc+(long)(t)*KVBLK*DM,(unsigned)__builtin_amdgcn_readfirstlane(kdst+(slot)))
  #define DMA_V(t,slot) glds16(vsrc+(long)(t)*KVBLK*DM,(unsigned)__builtin_amdgcn_readfirstlane(vdst+(slot)))
  const int vb0=(int)(lds0+LDS_V)+((lane>>4)&1)*32+(lane&3)*8+(4*hi+((lane&15)>>2))*64;
  const char*Kbase=shm+LDS_K; bf16x8 kf[8];
  const lds_cptr shm3=(lds_cptr)shm; const lds_cptr kp0=shm3+LDS_K+hi*1024+r32*16; const lds_cptr vp0=shm3+LDS_V+((lane>>4)&1)*32+(lane&3)*8+(4*hi+((lane&15)>>2))*64;
  const int NT=(q0+QB)/KVBLK-t0;
  DMA_K(0,0);DMA_V(0,0);DMA_K(1,SLOTB);
  bf16x8 qr[4];
  #pragma unroll
  for(int d0=0;d0<4;++d0)qr[d0]=*reinterpret_cast<const bf16x8*>(&Qw[(long)r32*DM+d0*16+hi*8]);
  const float*cg=CL2+(long)(b*NHEAD+h)*SEQ;
  { float*csf=(float*)(shm+LDS_CS); for(int i=tid;i<q0+QB;i+=NW*64)csf[i]=cg[i]; }
  const lds_cptr cs3=(lds_cptr)shm+LDS_CS+hi*16+t0*256;
  float nm=cg[q0+wid*QBLK+r32],l_reg=0.f;f32x16 o[2];o[0]=f32x16{};o[1]=f32x16{};
  const int qrel=wid*QBLK+r32;
  #define CMASK(P0,P1,t) do{int jb_=(t)-(NT-4); if(jb_>=0)cmask(P0,P1,jb_,qrel,hi);}while(0)
  bool resc=false;
  typedef float f32x4_t __attribute__((ext_vector_type(4)));
  #define BIAS(C0,C1,t) do{ const lds_cptr cp_=cs3+(t)*256; \
    _Pragma("unroll") for(int g_=0;g_<4;++g_){ const f32x4_t a_=*(const __attribute__((address_space(3))) f32x4_t*)(cp_+g_*32), b_=*(const __attribute__((address_space(3))) f32x4_t*)(cp_+g_*32+128); \
      _Pragma("unroll") for(int i_=0;i_<4;++i_){ C0[4*g_+i_]=nm-a_[i_]; C1[4*g_+i_]=nm-b_[i_]; } } }while(0)
  #define START(P0,P1) do{ const float rm=rowmax(P0,P1); resc=false; \
    { const float dl=(rm>(float)THRL)?rm:0.f;     \
      nm=fsub_s(nm,dl); \
      _Pragma("unroll") for(int r=0;r<16;++r){P0[r]=fsub_s(P0[r],dl);P1[r]=fsub_s(P1[r],dl);} } \
    _Pragma("unroll") for(int r=0;r<16;++r)P0[r]=__builtin_amdgcn_exp2f(P0[r]); }while(0)
  #define RESC() do{ if(resc){ asm volatile("s_waitcnt lgkmcnt(0)":::"memory"); \
      _Pragma("unroll") for(int d_=0;d_<2;++d_) _Pragma("unroll") for(int r=0;r<16;++r)o[d_][r]*=wsf[crow(r,hi)]; } }while(0)
  f32x16 pA0,pA1,pB0,pB1;
  int sl_prev=0,sl_cur=0,sl_next=SLOTB;
  #define ROT() do{sl_prev=sl_cur;sl_cur=sl_next;sl_next=(sl_next==(NSLOT-1)*SLOTB)?0:sl_next+SLOTB;}while(0)
  DMA_K(2,2*SLOTB);
  WAIT_BAR(3);
  BIAS(pA0,pA1,0); qkt(pA0,pA1,Kbase,qr,r32,hi);asm volatile("s_nop 15\n\ts_nop 7":"+v"(pA0),"+v"(pA1));CMASK(pA0,pA1,0);
  START(pA0,pA1);
  _Pragma("unroll") for(int r=0;r<16;++r)pA1[r]=__builtin_amdgcn_exp2f(pA1[r]);
  WAIT_BAR(0);
  DMA_K(3,0);DMA_V(1,SLOTB);
  ROT();
  kload8(kf,kp0+sl_cur);
  WAIT_BAR(2);
  s16x4 vlo[8],vhi[8]; u32x4 pw0,pw1,pw2,pw3;
  #define PKW(P,B) cvtpk_s(P[B],P[B+1])
  #define PAF(k) __builtin_bit_cast(bf16x8,pw##k)
  #define VFR(i) (bf16x8){vlo[i][0],vlo[i][1],vlo[i][2],vlo[i][3],vhi[i][0],vhi[i][1],vhi[i][2],vhi[i][3]}
  #define PIN(x) asm volatile("":"+v"(x))
  #define MX3(a,b,c) __builtin_fmaxf(__builtin_fmaxf((a),(b)),(c))
  #define GAPA(MF,A0,A1,A2,A3,W0,W1,PW) do{ MF; sacc+=A0; sacc+=A1; sacc+=A2; sacc+=A3; PIN(sacc); W0; W1; PIN(PW); SBAR(); }while(0)
  #define EX(v) __builtin_amdgcn_exp2f(v)
  #define GAPB(MF,X,B) do{ MF; X[B]=EX(X[B]); X[B+1]=EX(X[B+1]); X[B+2]=EX(X[B+2]); X[B+3]=EX(X[B+3]); PIN(X); SBAR(); }while(0)
  #define VRD(i) do{ vlo[i]=vtr(vp_+(((i)>>2)*4096+((i)&3)*1024)); vhi[i]=vtr(vp_+(((i)>>2)*4096+((i)&3)*1024+512)); }while(0)
  #define KRD(G,j) do{ if(G){ kload2(kf,kp0+sl_next,j); SBAR(); } }while(0)
  #define STEP(C0,C1,P0,P1,t,GK,GV,GL) do{ SBAR(); BIAS(C0,C1,t); SBAR(); \
    const lds_cptr vp_=vp0+sl_prev; \
    VRD(0); SBAR(); float sacc=(P0[0]+P0[1]); \
    GAPA(C0=__builtin_amdgcn_mfma_f32_32x32x16_bf16(kf[0],qr[0],C0,0,0,0), P0[2],P0[3],P0[4],P0[5],     pw0[0]=PKW(P0,0), pw0[1]=PKW(P0,2), pw0); \
    VRD(4); SBAR(); GAPA(C1=__builtin_amdgcn_mfma_f32_32x32x16_bf16(kf[1],qr[0],C1,0,0,0), P0[6],P0[7],P0[8],P0[9],     pw0[2]=PKW(P0,4), pw0[3]=PKW(P0,6), pw0); \
    VRD(1); SBAR(); GAPA(C0=__builtin_amdgcn_mfma_f32_32x32x16_bf16(kf[2],qr[1],C0,0,0,0),   P0[10],P0[11],P0[12],P0[13], pw1[0]=PKW(P0,8), pw1[1]=PKW(P0,10), pw1); \
    VRD(5); SBAR(); GAPA(C1=__builtin_amdgcn_mfma_f32_32x32x16_bf16(kf[3],qr[1],C1,0,0,0),   P0[14],P0[15],P1[0],P1[1],   pw1[2]=PKW(P0,12),pw1[3]=PKW(P0,14), pw1); \
    VRD(2); SBAR(); GAPA(C0=__builtin_amdgcn_mfma_f32_32x32x16_bf16(kf[4],qr[2],C0,0,0,0),   P1[2],P1[3],P1[4],P1[5],     pw2[0]=PKW(P1,0), pw2[1]=PKW(P1,2), pw2); \
    VRD(6); SBAR(); GAPA(C1=__builtin_amdgcn_mfma_f32_32x32x16_bf16(kf[5],qr[2],C1,0,0,0),   P1[6],P1[7],P1[8],P1[9],     pw2[2]=PKW(P1,4), pw2[3]=PKW(P1,6), pw2); \
    VRD(3); SBAR(); GAPA(C0=__builtin_amdgcn_mfma_f32_32x32x16_bf16(kf[6],qr[3],C0,0,0,0),   P1[10],P1[11],P1[12],P1[13], pw3[0]=PKW(P1,8), pw3[1]=PKW(P1,10), pw3); \
    VRD(7); SBAR(); GAPA(C1=__builtin_amdgcn_mfma_f32_32x32x16_bf16(kf[7],qr[3],C1,0,0,0),   P1[14],P1[15],0.f,0.f,       pw3[2]=PKW(P1,12),pw3[3]=PKW(P1,14), pw3); \
    l_reg+=sacc; \
    if(GK){DMA_K((t)+3,sl_cur);} if(GV){DMA_V((t)+1,sl_next);} \
    CMASK(C0,C1,t); \
    { float a=MX3(C0[0],C0[1],C1[0]),b=MX3(C0[2],C0[3],C1[1]); a=MX3(a,C1[2],C1[3]); \
      _Pragma("unroll") for(int r=4;r<16;r+=4){a=MX3(a,C0[r],C0[r+1]);b=MX3(b,C0[r+2],C0[r+3]);a=MX3(a,C1[r],C1[r+1]);b=MX3(b,C1[r+2],C1[r+3]);} \
      float rm=__builtin_fmaxf(a,b); { auto rr=__builtin_amdgcn_permlane32_swap(__float_as_uint(rm),__float_as_uint(rm),false,false); rm=__builtin_fmaxf(__uint_as_float(rr[0]),__uint_as_float(rr[1])); } \
      resc=false; \
      if(__builtin_expect(__any(rm>(float)THRL),0)){ const float dl=__builtin_fmaxf(rm,0.f); nm-=dl; \
        _Pragma("unroll") for(int r=0;r<16;++r){C0[r]-=dl;C1[r]-=dl;} \
        const float f=__builtin_amdgcn_exp2f(-dl); l_reg*=f; if(hi==0)wsf[r32]=f; resc=true; } } \
    SBAR(); \
    GAPB(o[0]=__builtin_amdgcn_mfma_f32_32x32x16_bf16(PAF(0),VFR(0),o[0],0,0,0), C0,0); \
    GAPB(o[1]=__builtin_amdgcn_mfma_f32_32x32x16_bf16(PAF(0),VFR(4),o[1],0,0,0), C0,4); \
    KRD(GL,0); GAPB(o[0]=__builtin_amdgcn_mfma_f32_32x32x16_bf16(PAF(1),VFR(1),o[0],0,0,0), C0,8); \
    KRD(GL,1); GAPB(o[1]=__builtin_amdgcn_mfma_f32_32x32x16_bf16(PAF(1),VFR(5),o[1],0,0,0), C0,12); \
    KRD(GL,2); GAPB(o[0]=__builtin_amdgcn_mfma_f32_32x32x16_bf16(PAF(2),VFR(2),o[0],0,0,0), C1,0); \
    KRD(GL,3); GAPB(o[1]=__builtin_amdgcn_mfma_f32_32x32x16_bf16(PAF(2),VFR(6),o[1],0,0,0), C1,4); \
    GAPB(o[0]=__builtin_amdgcn_mfma_f32_32x32x16_bf16(PAF(3),VFR(3),o[0],0,0,0), C1,8); \
    GAPB(o[1]=__builtin_amdgcn_mfma_f32_32x32x16_bf16(PAF(3),VFR(7),o[1],0,0,0), C1,12); \
    }while(0)
  int t=1;
  #undef CMASK
  #define CMASK(P0,P1,t) do{}while(0)
  for(;t+5<NT;t+=2){
    STEP(pB0,pB1,pA0,pA1,t,true,true,true);     WAIT_BAR(2); RESC(); ROT();
    STEP(pA0,pA1,pB0,pB1,t+1,true,true,true);   WAIT_BAR(2); RESC(); ROT();
  }
  #undef CMASK
  #define CMASK(P0,P1,t) do{int jb_=(t)-(NT-4); if(jb_>=0)cmask(P0,P1,jb_,qrel,hi);}while(0)
  #define ENDW(tt) do{ if((tt)+3<NT){WAIT_BAR(2);} else if((tt)+2<NT){WAIT_BAR(1);} else {WAIT_BAR(0);} }while(0)
  for(;t+1<NT;t+=2){
    STEP(pB0,pB1,pA0,pA1,t,(t+3<NT),(t+1<NT),(t+1<NT));       ENDW(t);   RESC(); ROT();
    STEP(pA0,pA1,pB0,pB1,t+1,(t+4<NT),(t+2<NT),(t+2<NT));     ENDW(t+1); RESC(); ROT();
  }
  STEP(pB0,pB1,pA0,pA1,NT-1,false,false,false); RESC();
  { float sacc=pB0[0]+pB0[1]; _Pragma("unroll") for(int r=2;r<16;++r)sacc+=pB0[r]; _Pragma("unroll") for(int r=0;r<16;++r)sacc+=pB1[r]; l_reg+=sacc;
    pw0=(u32x4){PKW(pB0,0),PKW(pB0,2),PKW(pB0,4),PKW(pB0,6)};pw1=(u32x4){PKW(pB0,8),PKW(pB0,10),PKW(pB0,12),PKW(pB0,14)};pw2=(u32x4){PKW(pB1,0),PKW(pB1,2),PKW(pB1,4),PKW(pB1,6)};pw3=(u32x4){PKW(pB1,8),PKW(pB1,10),PKW(pB1,12),PKW(pB1,14)};
    SBAR(); pv(o,vb0+sl_cur,PAF(0),PAF(1),PAF(2),PAF(3)); }
  #undef PKW
  #undef PAF
  #undef VFR
  #undef PIN
  #undef MX3
  #undef GAPA
  #undef GAPB
  #undef EX
  #undef VRD
  #undef KRD
  #undef STEP
  #undef ENDW
  {auto rr=__builtin_amdgcn_permlane32_swap(__float_as_uint(l_reg),__float_as_uint(l_reg),false,false);l_reg=__uint_as_float(rr[0])+__uint_as_float(rr[1]);}
  if(hi==0)wsf[32+r32]=l_reg;asm volatile("s_waitcnt lgkmcnt(0)":::"memory");
  float rli[16];
  #pragma unroll
  for(int r=0;r<16;++r)rli[r]=__builtin_amdgcn_rcpf(wsf[32+crow(r,hi)]);
  bf16*Ow=O+(rowbase+q0+wid*QBLK)*DM+h*D;
  { bf16*stg=(bf16*)(shm+LDS_OST)+wid*2048;
    #pragma unroll
    for(int r=0;r<16;++r){const int orow=crow(r,hi);
      #pragma unroll
      for(int d0=0;d0<2;++d0)stg[orow*64+d0*32+r32]=__float2bfloat16(o[d0][r]*rli[r]);}
    asm volatile("s_waitcnt lgkmcnt(0)":::"memory");
    #pragma unroll
    for(int i=0;i<4;++i){const int row=i*8+(lane>>3),ch=lane&7; const u32x4 v=*(const u32x4*)(stg+row*64+ch*8); ATTN_STORE16(Ow+(long)row*DM+ch*8,v);} }
  asm volatile("s_waitcnt lgkmcnt(0)\n\ts_barrier":::"memory");
  #undef DMA_K
  #undef DMA_V
  #undef CMASK
  #undef START
  #undef RESC
  #undef ROT
  #undef BIAS
}
constexpr int ATTN_LDS_BYTES=LDS_BYTES;
constexpr float SKIP_THR=64.0f;
__device__ __forceinline__ int attn_first_tile(const float*__restrict__ CL2,int bh,int qb){
  const int lane=threadIdx.x&63; const float*c=CL2+(long)bh*SEQ; const int q0=qb*QB, nfar=4*qb;
  const float cq=c[q0]; const float cj=c[(lane<nfar?lane:0)*KVBLK+KVBLK-1];
  const unsigned long long keep=__ballot(lane<nfar && (cq-cj)>=-SKIP_THR) | (1ull<<nfar);
  const int t0=__builtin_ctzll(keep)&~1;
  return __builtin_amdgcn_readfirstlane(t0);
}
struct AttnTensors { const bf16* Q; const bf16* K; const bf16* V; bf16* O; const float* CL2; };
struct AttnUnit { int bh; int qb; };
struct StaticOrder {
  int vcu;
  __device__ __forceinline__ explicit StaticOrder(int grid,int block):vcu((block%8)*(grid/8)+block/8){}
  __device__ __forceinline__ bool next(int i,AttnUnit&u)const{ if(i>=2||vcu>=BATCH*NHEAD*4)return false; const int s=vcu&3; u.bh=vcu>>2; u.qb=(i==0)?s:7-s; return true; }
  __device__ __forceinline__ void a_ready(const AttnUnit&)const{}
  __device__ __forceinline__ void done(const AttnUnit&)const{}
};
template<class Sched,int THRL=8> __device__ __forceinline__ void attn_phase(char*lds,const AttnTensors&T,const Sched&S){
  AttnUnit u;
  for(int i=0;S.next(i,u);++i){ S.a_ready(u); attn_unit<THRL>(u.bh/NHEAD,u.bh%NHEAD,u.qb,T.Q,T.K,T.V,T.O,T.CL2,lds); S.done(u); }
}
#undef SBAR
#undef WAIT_BAR
}
namespace sgu_body {
using attn_body::bf16x8; using attn_body::s16x4; using attn_body::f32x16; using attn_body::u32x4; using attn_body::lds_cptr; using attn_body::vtr;
constexpr int SGU_LDS_BYTES = 65536;
__device__ __forceinline__ float bflo(unsigned w) { return __uint_as_float(w << 16); }
__device__ __forceinline__ float bfhi(unsigned w) { return __uint_as_float(w & 0xffff0000u); }
__device__ __forceinline__ void sgu_unit(int ck, int half, const unsigned short* __restrict__ VG, const unsigned short* UGI, unsigned short* UGY, const unsigned short* __restrict__ WSMP,
                                         const float* __restrict__ lng, const float* __restrict__ lnb, const float* __restrict__ bs, char* shm) {
    int tid = threadIdx.x; asm volatile("" : "+v"(tid)); const int lane = tid & 63, r32 = lane & 31, hi = lane >> 5; const int wid = __builtin_amdgcn_readfirstlane(tid >> 6);
    const size_t row0 = (size_t)ck * 128;
    u32x4 raw[16];
#pragma unroll
    for (int i = 0; i < 16; ++i) raw[i] = *(const u32x4*)(VG + (row0 + 16 * wid + i) * 512 + 8 * lane);
    float mu[16], rs[16];
#pragma unroll
    for (int i = 0; i < 16; ++i) {
        const float a0 = bflo(raw[i].x), a1 = bfhi(raw[i].x), a2 = bflo(raw[i].y), a3 = bfhi(raw[i].y), a4 = bflo(raw[i].z), a5 = bfhi(raw[i].z), a6 = bflo(raw[i].w), a7 = bfhi(raw[i].w);
        float s = ((a0 + a1) + (a2 + a3)) + ((a4 + a5) + (a6 + a7));
        float q = ((a0 * a0 + a1 * a1) + (a2 * a2 + a3 * a3)) + ((a4 * a4 + a5 * a5) + (a6 * a6 + a7 * a7));
        s = wave_allsum(s); q = wave_allsum(q);
        const float m = s * (1.0f / 512.0f); const float var = fmaxf(q * (1.0f / 512.0f) - m * m, 0.f);
        mu[i] = m; rs[i] = 1.0f / sqrtf(var + 1e-6f);
    }
    if ((lane >> 5) == half) {
        const int gl = (lane >> 3) & 3, cc = 8 * (lane & 7);
        float gv[8], bv[8];
#pragma unroll
        for (int j = 0; j < 8; ++j) { gv[j] = lng[8 * lane + j]; bv[j] = lnb[8 * lane + j]; }
        char* img = shm + gl * 16384 + (cc >> 5) * 4096 + (cc & 31) * 2;
#pragma unroll
        for (int i = 0; i < 16; ++i) {
            const int s = 16 * wid + i;
            const float m = mu[i], r = rs[i];
            const float v0 = (bflo(raw[i].x) - m) * r * gv[0] + bv[0], v1 = (bfhi(raw[i].x) - m) * r * gv[1] + bv[1], v2 = (bflo(raw[i].y) - m) * r * gv[2] + bv[2], v3 = (bfhi(raw[i].y) - m) * r * gv[3] + bv[3];
            const float v4 = (bflo(raw[i].z) - m) * r * gv[4] + bv[4], v5 = (bfhi(raw[i].z) - m) * r * gv[5] + bv[5], v6 = (bflo(raw[i].w) - m) * r * gv[6] + bv[6], v7 = (bfhi(raw[i].w) - m) * r * gv[7] + bv[7];
            u32x4 w; w.x = pg8::cvt_pk_bf16(v0, v1); w.y = pg8::cvt_pk_bf16(v2, v3); w.z = pg8::cvt_pk_bf16(v4, v5); w.w = pg8::cvt_pk_bf16(v6, v7);
            *(u32x4*)(img + (s >> 6) * 8192 + ((s & 63) >> 4) * 1024 + (s & 15) * 64) = w;
        }
    }
    typedef unsigned u32x2_t __attribute__((ext_vector_type(2)));
    const int gl4 = wid >> 1, cb4 = wid & 1, g4 = 4 * half + gl4;
    bf16x8 wf[20]; u32x2_t ugq[4][4]; float bsq[4];
#pragma unroll
    for (int tb = 0; tb < 4; ++tb) {
        const unsigned short* wrow = WSMP + ((size_t)(g4 * 128 + 32 * tb + r32)) * 128 + 8 * hi;
#pragma unroll
        for (int ks = 0; ks < 2 * (tb + 1); ++ks) wf[tb * (tb + 1) + ks] = *(const bf16x8*)(wrow + 16 * ks);
        const int t = 32 * tb + r32; bsq[tb] = bs[g4 * 128 + t];
        const unsigned short* urow = UGI + (row0 + t) * 512 + g4 * 64 + 32 * cb4 + 4 * hi;
#pragma unroll
        for (int q4 = 0; q4 < 4; ++q4) ugq[tb][q4] = *(const u32x2_t*)(urow + 8 * q4);
    }
    __syncthreads();
    {
        const int gl = gl4, cb = cb4, g = g4;
        const lds_cptr vp = (lds_cptr)shm + gl * 16384 + cb * 4096 + ((lane >> 4) & 1) * 32 + (lane & 3) * 8 + (4 * hi + ((lane & 15) >> 2)) * 64;
#pragma unroll
        for (int tb = 0; tb < 4; ++tb) {
            f32x16 acc = f32x16{};
#pragma unroll
            for (int ks = 0; ks < 2 * (tb + 1); ++ks) {
                const s16x4 lo = vtr(vp + (ks >> 2) * 8192 + (ks & 3) * 1024), hh = vtr(vp + (ks >> 2) * 8192 + (ks & 3) * 1024 + 512);
                const bf16x8 a = (bf16x8){lo[0], lo[1], lo[2], lo[3], hh[0], hh[1], hh[2], hh[3]};
                acc = __builtin_amdgcn_mfma_f32_32x32x16_bf16(a, wf[tb * (tb + 1) + ks], acc, 0, 0, 0);
            }
            const int t = 32 * tb + r32; const float bsv = bsq[tb];
            unsigned short* yrow = UGY + (row0 + t) * 512 + g * 64 + 32 * cb + 4 * hi;
#pragma unroll
            for (int q4 = 0; q4 < 4; ++q4) {
                const u32x2_t ug = ugq[tb][q4];
                const float y0 = bflo(ug.x) * (acc[4 * q4 + 0] + bsv), y1 = bfhi(ug.x) * (acc[4 * q4 + 1] + bsv), y2 = bflo(ug.y) * (acc[4 * q4 + 2] + bsv), y3 = bfhi(ug.y) * (acc[4 * q4 + 3] + bsv);
                u32x2_t w; w.x = pg8::cvt_pk_bf16(y0, y1); w.y = pg8::cvt_pk_bf16(y2, y3);
                *(u32x2_t*)(yrow + 8 * q4) = w;
            }
        }
    }
    __syncthreads();
}
}
namespace peer_body {
using attn_body::bf16x8; using attn_body::f32x16; using attn_body::u32x4;
typedef __bf16 bf16x2_t __attribute__((ext_vector_type(2)));
constexpr int PEER_TOK = 64;
constexpr int L_PI = 0, L_PG = 32768, L_PS = 65536, PEER_LDS_BYTES = 98304;
__device__ __forceinline__ int okey(int b) { return b ^ ((b >> 31) & 0x7fffffff); }
__device__ __forceinline__ void ce(int& a, int& b) { const int hi = a > b ? a : b, lo = a > b ? b : a; a = hi; b = lo; }
__device__ __forceinline__ void sort16(int (&v)[16]) {
#pragma unroll
    for (int k = 2; k <= 16; k <<= 1)
#pragma unroll
        for (int j = k >> 1; j > 0; j >>= 1)
#pragma unroll
            for (int i = 0; i < 16; ++i) { const int l = i ^ j; if (l > i) { if ((i & k) == 0) ce(v[i], v[l]); else ce(v[l], v[i]); } }
}
__device__ __forceinline__ void merge16(int (&a)[16], const int (&b)[16]) {
#pragma unroll
    for (int i = 0; i < 16; ++i) a[i] = a[i] > b[15 - i] ? a[i] : b[15 - i];
#pragma unroll
    for (int j = 8; j > 0; j >>= 1)
#pragma unroll
        for (int i = 0; i < 16; ++i) { const int l = i ^ j; if (l > i) ce(a[i], a[l]); }
}
__device__ __forceinline__ float dot2(unsigned w, unsigned x, float acc) { return __builtin_amdgcn_fdot2_f32_bf16(__builtin_bit_cast(bf16x2_t, w), __builtin_bit_cast(bf16x2_t, x), acc, false); }
__device__ __forceinline__ float gelu_erf(float v) { return 0.5f * v * (1.0f + erff(v * 0.70710678118654752f)); }

constexpr int SK_PITCH = 272;
__device__ __forceinline__ void top16_scores(int (&res)[16], const bf16x8 (&bq)[8], const char* SKl, int r32, int hi) {
    f32x16 acc[4];
#pragma unroll
    for (int nb = 0; nb < 4; ++nb) acc[nb] = f32x16{};
#pragma unroll
    for (int ks = 0; ks < 8; ++ks) {
#pragma unroll
        for (int nb = 0; nb < 4; ++nb) { const bf16x8 a = *(const bf16x8*)(SKl + (32 * nb + r32) * SK_PITCH + (16 * ks + 8 * hi) * 2);
            acc[nb] = __builtin_amdgcn_mfma_f32_32x32x16_bf16(a, bq[ks], acc[nb], 0, 0, 0); }
        if (ks & 1) __builtin_amdgcn_sched_barrier(0);
    }
    int k[4][16];
#pragma unroll
    for (int nb = 0; nb < 4; ++nb) {
#pragma unroll
        for (int r = 0; r < 16; ++r) { const int n = 32 * nb + (r & 3) + 8 * (r >> 2) + 4 * hi; k[nb][r] = okey((int)((__float_as_uint(acc[nb][r]) & ~0x7fu) | (unsigned)n)); }
        sort16(k[nb]);
    }
    merge16(k[0], k[1]); merge16(k[2], k[3]); merge16(k[0], k[2]);
    int lo[16], up[16];
#pragma unroll
    for (int i = 0; i < 16; ++i) { const auto rr = __builtin_amdgcn_permlane32_swap((unsigned)k[0][i], (unsigned)k[0][i], false, false); lo[i] = (int)rr[0]; up[i] = (int)rr[1]; }
    merge16(lo, up);
#pragma unroll
    for (int i = 0; i < 16; ++i) res[i] = lo[i];
}

__device__ __forceinline__ unsigned pack_i8x4(float a, float b, float c, float d) {
    const int ia = (int)__builtin_rintf(a), ib = (int)__builtin_rintf(b), ic = (int)__builtin_rintf(c), id = (int)__builtin_rintf(d);
    return (unsigned)(ia & 0xff) | ((unsigned)(ib & 0xff) << 8) | ((unsigned)(ic & 0xff) << 16) | ((unsigned)(id & 0xff) << 24);
}
typedef float f32x2_t __attribute__((ext_vector_type(2)));
typedef unsigned u32x2_t __attribute__((ext_vector_type(2)));
__device__ __forceinline__ void fma_fp8x4(f32x2_t& a01, f32x2_t& a23, unsigned v, f32x2_t w2) {
    const f32x2_t lo = __builtin_amdgcn_cvt_pk_f32_fp8((int)v, false), hi = __builtin_amdgcn_cvt_pk_f32_fp8((int)v, true);
    a01 = __builtin_elementwise_fma(lo, w2, a01); a23 = __builtin_elementwise_fma(hi, w2, a23);
}
template <int CTRL> __device__ __forceinline__ int dppi(int v) { return __builtin_amdgcn_update_dpp(0, v, CTRL, 0xf, 0xf, false); }
template <int CTRL> __device__ __forceinline__ float dppf(float v) { return __int_as_float(__builtin_amdgcn_update_dpp(0, __float_as_int(v), CTRL, 0xf, 0xf, false)); }
constexpr int DPP_HMIRROR = 0x141, DPP_XOR2 = 0x4E, DPP_XOR1 = 0xB1, DPP_ROR8 = 0x128;

__device__ __forceinline__ void peer_retrieve(int tk, const unsigned short* __restrict__ QP, const unsigned short* __restrict__ SK, const float* __restrict__ SU, const float* __restrict__ SV,
                                              const float* __restrict__ ST, unsigned short* __restrict__ PID, float* __restrict__ G2, float* __restrict__ PS2, char* shm) {
    int tid = threadIdx.x; asm volatile("" : "+v"(tid)); const int lane = tid & 63, r32 = lane & 31, hi = lane >> 5; const int wid = __builtin_amdgcn_readfirstlane(tid >> 6);
    const int h = tk & 7, T0 = (tk >> 3) * 512 + 64 * wid;
    {   const u32x4* src = (const u32x4*)(SK + (size_t)h * 2 * 128 * 128);
#pragma unroll
        for (int i = 0; i < 8; ++i) { const int c = tid + 512 * i, row = c >> 4, ch = c & 15; *(u32x4*)(shm + row * SK_PITCH + ch * 16) = src[c]; }
    }
    __syncthreads();
#pragma unroll 1
    for (int tb = 0; tb < 2; ++tb) {
        const unsigned short* QPt = QP + (size_t)(T0 + 32 * tb) * 2048 + h * 256;
        int A[16], B[16];
        bf16x8 bqa[8], bqb[8];
#pragma unroll
        for (int ks = 0; ks < 8; ++ks) { bqa[ks] = *(const bf16x8*)(QPt + (size_t)r32 * 2048 + 16 * ks + 8 * hi); bqb[ks] = *(const bf16x8*)(QPt + 128 + (size_t)r32 * 2048 + 16 * ks + 8 * hi); }
        top16_scores(A, bqa, shm, r32, hi);
        top16_scores(B, bqb, shm + 128 * SK_PITCH, r32, hi);
        float fa[16], fb[16]; int na[16], nb[16];
#pragma unroll
        for (int i = 0; i < 16; ++i) { const int ba = okey(A[i]), bb = okey(B[i]); fa[i] = __int_as_float(ba); fb[i] = __int_as_float(bb); na[i] = (ba & 0x7f) << 7; nb[i] = bb & 0x7f; }
#define CAND(i, j) okey((int)((__float_as_uint(fa[i] + fb[j]) & ~0x3fffu) | (unsigned)(na[i] | nb[j])))
        const int NEGK = (int)0x80000000;
        int L0[16], L1[16], L2[16], L3[16];
#pragma unroll
        for (int j = 0; j < 16; ++j) L0[j] = CAND(0, j);
#pragma unroll
        for (int j = 0; j < 8; ++j) L1[j] = CAND(1, j);
#pragma unroll
        for (int j = 0; j < 5; ++j) L1[8 + j] = CAND(2, j);
#pragma unroll
        for (int j = 0; j < 3; ++j) L1[13 + j] = CAND(3, j);
        L2[0] = CAND(3, 3);
#pragma unroll
        for (int j = 0; j < 3; ++j) L2[1 + j] = CAND(4, j);
#pragma unroll
        for (int j = 0; j < 2; ++j) { L2[4 + j] = CAND(5, j); L2[6 + j] = CAND(6, j); L2[8 + j] = CAND(7, j); }
#pragma unroll
        for (int i = 8; i < 14; ++i) L2[2 + i] = CAND(i, 0);
        L3[0] = CAND(14, 0); L3[1] = CAND(15, 0);
#pragma unroll
        for (int i = 2; i < 16; ++i) L3[i] = NEGK;
#undef CAND
        sort16(L1); sort16(L2); sort16(L3);
        merge16(L0, L1); merge16(L2, L3); merge16(L0, L2);
        float e[16]; int id[16]; float se = 0.f;
        const float s0 = __int_as_float((okey(L0[0]) & ~0x3fff) | 0x2000);
#pragma unroll
        for (int i = 0; i < 16; ++i) { const int b = okey(L0[i]); id[i] = b & 0x3fff; const float s = __int_as_float((b & ~0x3fff) | 0x2000); e[i] = __expf(s - s0); se += e[i]; }
        const float inv = 1.0f / se;
        if (hi == 0) {
            const size_t t = (size_t)(T0 + 32 * tb + r32); const float st = ST[t];
            unsigned short* pi = PID + t * 128 + h * 16; float* pg = G2 + t * 128 + h * 16; float* ps = PS2 + t * 128 + h * 16;
            u32x4 w0, w1;
            w0.x = (unsigned)id[0] | ((unsigned)id[1] << 16); w0.y = (unsigned)id[2] | ((unsigned)id[3] << 16); w0.z = (unsigned)id[4] | ((unsigned)id[5] << 16); w0.w = (unsigned)id[6] | ((unsigned)id[7] << 16);
            w1.x = (unsigned)id[8] | ((unsigned)id[9] << 16); w1.y = (unsigned)id[10] | ((unsigned)id[11] << 16); w1.z = (unsigned)id[12] | ((unsigned)id[13] << 16); w1.w = (unsigned)id[14] | ((unsigned)id[15] << 16);
            *(u32x4*)pi = w0; *(u32x4*)(pi + 8) = w1;
            float sv[16], su[16];
#pragma unroll
            for (int i = 0; i < 16; ++i) { sv[i] = SV[id[i]]; su[i] = SU[id[i]]; }
            asm volatile("" ::: "memory");
#pragma unroll
            for (int i = 0; i < 16; i += 4) {
                *(float4*)(pg + i) = make_float4(e[i] * inv * sv[i], e[i + 1] * inv * sv[i + 1], e[i + 2] * inv * sv[i + 2], e[i + 3] * inv * sv[i + 3]);
                *(float4*)(ps + i) = make_float4(su[i] * st, su[i + 1] * st, su[i + 2] * st, su[i + 3] * st); }
        }
    }
    __syncthreads();
}

__device__ __forceinline__ void peer_fused(int p, int wq, int nwq, const unsigned short* __restrict__ PID, const float* __restrict__ G2, const float* __restrict__ PS2, const unsigned char* __restrict__ H2Q,
                                           const unsigned char* __restrict__ EU8, const unsigned char* __restrict__ EV8, float* X, const float* __restrict__ gfin, char* shm, float oscale) {
    int tid = threadIdx.x; asm volatile("" : "+v"(tid)); const int lane = tid & 63, g = lane >> 3, r = lane & 7; const int wid = __builtin_amdgcn_readfirstlane(tid >> 6);
    char* wl = shm + wid * 12288;
    int2* aul = (int2*)(wl + 4096) + lane; float* ssl = (float*)(wl + 8192) + lane; float* swl = (float*)(wl + 3072);
    const int k0 = 8 * (r >> 2) + 4 * ((r >> 1) & 1) + 2 * (r & 1);
    const int e0 = 8 * ((g >> 2) & 1) + 4 * ((g >> 1) & 1) + 2 * (g & 1);
    constexpr size_t SLICE = (size_t)16384 * 128;
#define FIDS(i, I0, I1) do { const u32x4* ip_ = (const u32x4*)(wl + (i) * 256 + 32 * g); I0 = ip_[0]; I1 = ip_[1]; } while (0)
#define FLOAD(R, base, I0, I1) do { _Pragma("unroll") for (int k_ = 0; k_ < 16; ++k_) { const unsigned w_ = (k_ < 8) ? I0[k_ >> 1] : I1[(k_ - 8) >> 1]; const unsigned e_ = (k_ & 1) ? (w_ >> 16) : (w_ & 0xffffu); \
        R[k_] = *(const u32x4*)((base) + (size_t)e_ * 128); } } while (0)
#define FUMATH(R, HQ, ACC) do { int s[16]; \
        _Pragma("unroll") for (int k_ = 0; k_ < 16; ++k_) { int d_ = __builtin_amdgcn_sdot4((int)R[k_].x, (int)HQ.x, 0, false); d_ = __builtin_amdgcn_sdot4((int)R[k_].y, (int)HQ.y, d_, false); \
            d_ = __builtin_amdgcn_sdot4((int)R[k_].z, (int)HQ.z, d_, false); d_ = __builtin_amdgcn_sdot4((int)R[k_].w, (int)HQ.w, d_, false); s[k_] = d_; } \
        _Pragma("unroll") for (int h_ = 0; h_ < 8; ++h_) { const int t1 = s[h_] + dppi<DPP_HMIRROR>(s[h_]), t2 = s[h_ + 8] + dppi<DPP_HMIRROR>(s[h_ + 8]); s[h_] = (r & 4) ? t2 : t1; } \
        _Pragma("unroll") for (int h_ = 0; h_ < 4; ++h_) { const int t1 = s[h_] + dppi<DPP_XOR2>(s[h_]), t2 = s[h_ + 4] + dppi<DPP_XOR2>(s[h_ + 4]); s[h_] = (r & 2) ? t2 : t1; } \
        _Pragma("unroll") for (int h_ = 0; h_ < 2; ++h_) { const int t1 = s[h_] + dppi<DPP_XOR1>(s[h_]), t2 = s[h_ + 2] + dppi<DPP_XOR1>(s[h_ + 2]); s[h_] = (r & 1) ? t2 : t1; } \
        { const int2 o_ = ACC; ACC = make_int2(o_.x + s[0], o_.y + s[1]); } } while (0)
#define FVMATH(R, W, XP, XV, SWV, SSQ, VALID) do { int acc[16]; _Pragma("unroll") for (int i_ = 0; i_ < 16; ++i_) acc[i_] = 0; \
        _Pragma("unroll") for (int m_ = 0; m_ < 4; ++m_) { const int wm_ = (int)W[m_]; \
            _Pragma("unroll") for (int c_ = 0; c_ < 4; ++c_) { \
                const unsigned r0_ = R[4 * m_ + 0][c_], r1_ = R[4 * m_ + 1][c_], r2_ = R[4 * m_ + 2][c_], r3_ = R[4 * m_ + 3][c_]; \
                const unsigned t0_ = __builtin_amdgcn_perm(r1_, r0_, 0x05010400u), t1_ = __builtin_amdgcn_perm(r1_, r0_, 0x07030602u); \
                const unsigned t2_ = __builtin_amdgcn_perm(r3_, r2_, 0x05010400u), t3_ = __builtin_amdgcn_perm(r3_, r2_, 0x07030602u); \
                acc[4 * c_ + 0] = __builtin_amdgcn_sdot4((int)__builtin_amdgcn_perm(t2_, t0_, 0x05040100u), wm_, acc[4 * c_ + 0], false); \
                acc[4 * c_ + 1] = __builtin_amdgcn_sdot4((int)__builtin_amdgcn_perm(t2_, t0_, 0x07060302u), wm_, acc[4 * c_ + 1], false); \
                acc[4 * c_ + 2] = __builtin_amdgcn_sdot4((int)__builtin_amdgcn_perm(t3_, t1_, 0x05040100u), wm_, acc[4 * c_ + 2], false); \
                acc[4 * c_ + 3] = __builtin_amdgcn_sdot4((int)__builtin_amdgcn_perm(t3_, t1_, 0x07060302u), wm_, acc[4 * c_ + 3], false); } } \
          \
        _Pragma("unroll") for (int h_ = 0; h_ < 8; ++h_) { const auto sw_ = __builtin_amdgcn_permlane32_swap((unsigned)acc[h_], (unsigned)acc[h_ + 8], false, false); acc[h_] = (int)sw_[0] + (int)sw_[1]; } \
        _Pragma("unroll") for (int h_ = 0; h_ < 4; ++h_) { const auto sw_ = __builtin_amdgcn_permlane16_swap((unsigned)acc[h_], (unsigned)acc[h_ + 4], false, false); acc[h_] = (int)sw_[0] + (int)sw_[1]; } \
        _Pragma("unroll") for (int h_ = 0; h_ < 2; ++h_) { const int t1 = acc[h_] + dppi<DPP_ROR8>(acc[h_]), t2 = acc[h_ + 2] + dppi<DPP_ROR8>(acc[h_ + 2]); acc[h_] = (lane & 8) ? t2 : t1; } \
        const float2 xv = XV; const float o0 = xv.x + SWV * (float)acc[0], o1 = xv.y + SWV * (float)acc[1]; \
        if (VALID) *(float2*)(XP) = make_float2(o0, o1); SSQ += o0 * o0 + o1 * o1; } while (0)
    const int TEND = (p + 1) * (M / 8);
#pragma unroll 1
    for (int tb = p * (M / 8) + wq; tb < TEND; tb += 8 * nwq) {
#define TOK(i) ((tb + (i) * nwq) < TEND ? (tb + (i) * nwq) : tb)
#pragma unroll
        for (int i = 0; i < 8; ++i) ((unsigned*)(wl + i * 256))[lane] = ((const unsigned*)(PID + (size_t)TOK(i) * 128))[lane];
#pragma unroll
        for (int i = 0; i < 8; ++i) aul[64 * i] = make_int2(0, 0);
        {
            u32x4 RA[16], RB[16], i0, i1, hqa, hqb;
            { const int sl = p & 7; FIDS(0, i0, i1); hqa = *(const u32x4*)(H2Q + ((size_t)sl * M + TOK(0)) * 128 + r * 16); FLOAD(RA, EU8 + sl * SLICE + r * 16, i0, i1); }
#pragma unroll 1
            for (int st = 0; st < 8; ++st) {
                const int sl = (p + st) & 7, sln = (p + st + 1) & 7; const unsigned char* ub = EU8 + sl * SLICE + r * 16; const unsigned char* hb = H2Q + (size_t)sl * M * 128 + r * 16;
#pragma unroll 1
                for (int i = 0; i < 8; i += 2) {
                    FIDS(i + 1, i0, i1); hqb = *(const u32x4*)(hb + (size_t)TOK(i + 1) * 128); FLOAD(RB, ub, i0, i1);
                    FUMATH(RA, hqa, aul[64 * i]);
                    {
                        const bool last = (i == 6); const int in_ = last ? 0 : i + 2; const int sx = last ? sln : sl;
                        FIDS(in_, i0, i1); hqa = *(const u32x4*)(H2Q + ((size_t)sx * M + TOK(in_)) * 128 + r * 16); FLOAD(RA, EU8 + sx * SLICE + r * 16, i0, i1); }
                    FUMATH(RB, hqb, aul[64 * (i + 1)]);
                }
            }
        }
        float2 g2q[8], psq[8];
#pragma unroll
        for (int i = 0; i < 8; ++i) { const size_t o = (size_t)TOK(i) * 128 + 16 * g + k0; g2q[i] = *(const float2*)(G2 + o); psq[i] = *(const float2*)(PS2 + o); }
#pragma unroll
        for (int i = 0; i < 8; ++i) {
            const float2 g2 = g2q[i], ps = psq[i]; const int2 av = aul[64 * i];
            const float w0 = g2.x * gelu_erf((float)av.x * ps.x), w1 = g2.y * gelu_erf((float)av.y * ps.y);
            float am = fmaxf(fabsf(w0), fabsf(w1));
            am = wave_allmax(am);
            const float qs = am > 0.f ? 127.0f / am : 0.f; if (lane == 0) swl[i] = am * (1.0f / 127.0f);
            const int b0 = (int)__builtin_rintf(w0 * qs) & 0xff, b1 = (int)__builtin_rintf(w1 * qs) & 0xff;
            *(unsigned short*)(wl + 2048 + i * 128 + 16 * g + k0) = (unsigned short)(b0 | (b1 << 8));
        }
#pragma unroll
        for (int i = 0; i < 8; ++i) ssl[64 * i] = 0.f;
        {
            u32x4 RA[16], RB[16], i0, i1; float2 xva, xvb;
            { const int sl = p & 7; FIDS(0, i0, i1); xva = *(const float2*)(X + (size_t)TOK(0) * 1024 + sl * 128 + 16 * r + e0); FLOAD(RA, EV8 + sl * SLICE + r * 16, i0, i1); }
#pragma unroll 1
            for (int st = 0; st < 8; ++st) {
                const int sl = (p + st) & 7, sln = (p + st + 1) & 7; const unsigned char* vb = EV8 + sl * SLICE + r * 16; float* xb = X + sl * 128 + 16 * r + e0;
#pragma unroll 1
                for (int i = 0; i < 8; i += 2) {
                    FIDS(i + 1, i0, i1); xvb = *(const float2*)(xb + (size_t)TOK(i + 1) * 1024); FLOAD(RB, vb, i0, i1);
                    { const u32x4 wv = *(const u32x4*)(wl + 2048 + i * 128 + 16 * g); const float sw_ = swl[i]; float sq_ = ssl[64 * i]; FVMATH(RA, wv, xb + (size_t)TOK(i) * 1024, xva, sw_, sq_, (tb + i * nwq) < TEND); ssl[64 * i] = sq_; }
                    { const bool last = (i == 6); const int in_ = last ? 0 : i + 2; const int sx = last ? sln : sl; FIDS(in_, i0, i1); xva = *(const float2*)(X + (size_t)TOK(in_) * 1024 + sx * 128 + 16 * r + e0); FLOAD(RA, EV8 + sx * SLICE + r * 16, i0, i1); }
                    { const u32x4 wv = *(const u32x4*)(wl + 2048 + (i + 1) * 128 + 16 * g); const float sw_ = swl[i + 1]; float sq_ = ssl[64 * (i + 1)]; FVMATH(RB, wv, xb + (size_t)TOK(i + 1) * 1024, xvb, sw_, sq_, (tb + (i + 1) * nwq) < TEND); ssl[64 * (i + 1)] = sq_; }
                }
            }
        }
#pragma unroll 1
        for (int i = 0; i < 8; ++i) {
            float ss = ssl[64 * i];
            ss = wave_allsum(ss);
            const float rr = oscale / sqrtf(ss * (1.0f / 1024.0f) + 1e-6f);
            if (tb + i * nwq < TEND) {
                float* xr = X + (size_t)(tb + i * nwq) * 1024 + 16 * r + e0;
                float2 vv[8], gg[8];
#pragma unroll
                for (int sl = 0; sl < 8; ++sl) { vv[sl] = *(const float2*)(xr + sl * 128); gg[sl] = *(const float2*)(gfin + sl * 128 + 16 * r + e0); }
                asm volatile("" ::: "memory");
#pragma unroll
                for (int sl = 0; sl < 8; ++sl) *(float2*)(xr + sl * 128) = make_float2(vv[sl].x * rr * gg[sl].x, vv[sl].y * rr * gg[sl].y);
            }
        }
#undef TOK
    }
#undef FIDS
#undef FLOAD
#undef FUMATH
#undef FVMATH
}
}
#define GAS __attribute__((address_space(1)))
#define LAS __attribute__((address_space(3)))
typedef unsigned short bf16;
typedef unsigned v4u __attribute__((ext_vector_type(4)));
typedef float f32x4 __attribute__((ext_vector_type(4)));
typedef short bf16x8 __attribute__((ext_vector_type(8)));
typedef GAS unsigned gu32;
typedef GAS unsigned long long gu64;
#define RLX_AGENT __ATOMIC_RELAXED, __HIP_MEMORY_SCOPE_AGENT
#define LDS_WAIT() asm volatile("s_waitcnt lgkmcnt(0)" ::: "memory")
#define VM_WAIT() asm volatile("s_waitcnt vmcnt(0)" ::: "memory")
__device__ __forceinline__ unsigned long long rt() { return __builtin_amdgcn_s_memrealtime(); }
__device__ __forceinline__ unsigned f2bf(float f) { unsigned u = __builtin_bit_cast(unsigned, f); return (u + 0x7fffu + ((u >> 16) & 1u)) >> 16; }
__device__ __forceinline__ unsigned pk2(float lo, float hi) { return f2bf(lo) | (f2bf(hi) << 16); }

#define XB_TMO      128
#define XB_XCNT(j)  (256  + 64 * (j))
#define XB_XSUB(j)  (1280 + 64 * (j))
#define XB_XGEN(j)  (2304 + 64 * (j))
#define XB_TOP      3328
#define XB_TOPGEN   3392
#define XCD_BAR_WORDS 3456
#define XB_SPIN_CAP (1u << 18)

__device__ __forceinline__ unsigned xb_ld(unsigned* p)              { return __hip_atomic_load(p, __ATOMIC_RELAXED, __HIP_MEMORY_SCOPE_AGENT); }
__device__ __forceinline__ unsigned xb_add(unsigned* p, unsigned v) { return __hip_atomic_fetch_add(p, v, __ATOMIC_RELAXED, __HIP_MEMORY_SCOPE_AGENT); }
__device__ __forceinline__ unsigned xb_xcc_id() { return (unsigned)__builtin_amdgcn_s_getreg((3 << 11) | 20) & 0xFu; }
#define XB_SPIN(cond, bar) do { unsigned _sp = 0; while (cond) { __builtin_amdgcn_s_sleep(1); \
    if ((++_sp & 255u) == 0u) { if (xb_ld(&(bar)[XB_TMO])) break; if (_sp > XB_SPIN_CAP) { atomicAdd(&(bar)[XB_TMO], 1u); break; } } } } while (0)

struct XcdBarrier {
    unsigned* bar; unsigned x;
    volatile LAS unsigned* st;
};

__device__ __forceinline__ XcdBarrier xcd_barrier_post(unsigned* bar, volatile LAS unsigned* st) {
    XcdBarrier b; b.bar = bar; b.x = xb_xcc_id(); b.st = st;
    if (threadIdx.x == 0) (void)xb_add(&bar[XB_XCNT(b.x)], 1u);
    return b;
}
__device__ __forceinline__ void xcd_barrier_complete(unsigned* bar, unsigned x, unsigned& nloc, unsigned& nx) {
    const unsigned G = gridDim.x * gridDim.y * gridDim.z;
    unsigned sum, cnt, mine, sp = 0u;
    for (;;) {
        sum = 0u; cnt = 0u; mine = 0u;
#pragma unroll
        for (unsigned j = 0; j < 16; ++j) { const unsigned c = xb_ld(&bar[XB_XCNT(j)]); sum += c; cnt += (c > 0u) ? 1u : 0u; mine = (j == x) ? c : mine; }
        if (sum == G) break;
        __builtin_amdgcn_s_sleep(1);
        if ((++sp & 255u) == 0u) { if (xb_ld(&bar[XB_TMO])) break; if (sp > XB_SPIN_CAP) { atomicAdd(&bar[XB_TMO], 1u); break; } }
    }
    nloc = mine > 0u ? mine : 1u; nx = cnt > 0u ? cnt : 1u;
}

__device__ __forceinline__ void xcd_barrier(const XcdBarrier& b) {
    asm volatile("s_waitcnt vmcnt(0)" ::: "memory");
    __syncthreads();
    if (threadIdx.x == 0) {
        unsigned* bar = b.bar;
        __builtin_amdgcn_s_waitcnt(0);
        unsigned nloc = b.st[0], nx = b.st[1];
        if (nloc == 0u) { xcd_barrier_complete(bar, b.x, nloc, nx); b.st[0] = nloc; b.st[1] = nx; }
        const unsigned old = xb_add(&bar[XB_XSUB(b.x)], 1u);
        const unsigned gen = old / nloc;
        if (old + 1u == (gen + 1u) * nloc) {
            __builtin_amdgcn_fence(__ATOMIC_RELEASE, "agent");
            asm volatile("s_waitcnt vmcnt(0)" ::: "memory");
            const unsigned og = xb_add(&bar[XB_TOP], 1u);
            const unsigned tg = og / nx;
            if (og + 1u == (tg + 1u) * nx) xb_add(&bar[XB_TOPGEN], 1u);
            else XB_SPIN(xb_ld(&bar[XB_TOPGEN]) == tg, bar);
            __builtin_amdgcn_fence(__ATOMIC_ACQUIRE, "agent");
            xb_add(&bar[XB_XGEN(b.x)], 1u);
            asm volatile("s_waitcnt vmcnt(0)" ::: "memory");
        } else {
            XB_SPIN(xb_ld(&bar[XB_XGEN(b.x)]) == gen, bar);
            __builtin_amdgcn_fence(__ATOMIC_ACQUIRE, "agent");
            asm volatile("s_waitcnt vmcnt(0)" ::: "memory");
        }
    }
    __syncthreads();
}

typedef unsigned short bf16_t;
__device__ __forceinline__ float bf2f(bf16_t v) { return __uint_as_float((unsigned)v << 16); }
__device__ __forceinline__ float gelu_exact(float v) { return 0.5f * v * (1.0f + erff(v * 0.70710678118654752f)); }
__device__ __forceinline__ float log_sigmoid(float z) { return z > 0.f ? -log1pf(expf(-z)) : z - log1pf(expf(z)); }
__device__ __forceinline__ float wave_sum(float v) {
    return wave_allsum(v);
}
__device__ __forceinline__ float wave_max(float v) {
    return wave_allmax(v);
}

#ifndef RP7
#define RP7 1
#endif
#ifndef RP8
#define RP8 1
#endif
#ifndef RP9
#define RP9 1
#endif
#ifndef RP0
#define RP0 1
#endif
#ifndef RP1
#define RP1 1
#endif
#ifndef RP12
#define RP12 1
#endif
#ifndef RP3
#define RP3 1
#endif
#ifndef RP4
#define RP4 1
#endif
#ifndef RP5
#define RP5 1
#endif
#ifndef RP6
#define RP6 1
#endif
#ifndef CONV_P0_FROM
#define CONV_P0_FROM (2 * NEXP)
#endif
#ifndef CONV_SPLIT
#define CONV_SPLIT (NEXP / 2)
#endif
constexpr int NWAVES = 8;
constexpr int RING_OFF = 0, RING_BYTES = 131072;
constexpr int LDSCTL_OFF = RING_BYTES, MISC_OFF = LDSCTL_OFF + 320;
constexpr int LDS_BYTES = 147456;
constexpr int CW_BAR = 4096, CW_QUEUE = 3072, CW_CMAX = 8192, CMAX_WQ = 4864;
constexpr int N_PHASES = 9;

struct Args { const float* in[17]; float* out; unsigned char* ws; int ph_lo, ph_hi, li, pad; };

__device__ __forceinline__ void p0_transpose_item(const float* W, int ldw, int col0, int K, bf16* WT, int row0, LAS float* scr, int item, int nblk, int lane) {
    const int kb = item / nblk, nb = item % nblk, k0 = 64 * kb, n0 = 32 * nb;
    f32x4 v[8];
#pragma unroll
    for (int i = 0; i < 8; ++i) v[i] = *(const GAS f32x4*)(W + (size_t)(k0 + 8 * i + (lane >> 3)) * ldw + col0 + n0 + 4 * (lane & 7));
#pragma unroll
    for (int i = 0; i < 8; ++i) *(LAS f32x4*)(scr + (8 * i + (lane >> 3)) * 36 + 4 * (lane & 7)) = v[i];
    LDS_WAIT(); asm volatile("" ::: "memory");
    const int c = lane & 7;
#pragma unroll
    for (int j = 0; j < 4; ++j) { const int n = (lane >> 3) + 8 * j; const LAS float* s = scr + (8 * c) * 36 + n;
        v4u o; o.x = pg8::cvt_pk_bf16(s[0 * 36], s[1 * 36]); o.y = pg8::cvt_pk_bf16(s[2 * 36], s[3 * 36]); o.z = pg8::cvt_pk_bf16(s[4 * 36], s[5 * 36]); o.w = pg8::cvt_pk_bf16(s[6 * 36], s[7 * 36]);
        *(GAS v4u*)(WT + (size_t)(row0 + n0 + n) * K + k0 + 8 * c) = o; }
    LDS_WAIT(); asm volatile("" ::: "memory");
}
__device__ __forceinline__ void p0_transpose_item_i8(const float* W, int ldw, int col0, int K, unsigned char* WT8, float* sB, int row0, const unsigned* colmax, LAS float* scr, int item, int nblk, int lane) {
    const int kb = item / nblk, nb = item % nblk, k0 = 64 * kb, n0 = 32 * nb;
    f32x4 v[8];
#pragma unroll
    for (int i = 0; i < 8; ++i) v[i] = *(const GAS f32x4*)(W + (size_t)(k0 + 8 * i + (lane >> 3)) * ldw + col0 + n0 + 4 * (lane & 7));
#pragma unroll
    for (int i = 0; i < 8; ++i) *(LAS f32x4*)(scr + (8 * i + (lane >> 3)) * 36 + 4 * (lane & 7)) = v[i];
    LDS_WAIT(); asm volatile("" ::: "memory");
    const int c = lane & 3;
#pragma unroll
    for (int j = 0; j < 2; ++j) { const int n = (lane >> 2) + 16 * j; const LAS float* s = scr + (16 * c) * 36 + n;
        const float am = __uint_as_float(colmax[col0 + n0 + n]); const float qs = am > 0.f ? 127.0f / am : 0.f;
        v4u o;
        o.x = peer_body::pack_i8x4(s[0 * 36] * qs, s[1 * 36] * qs, s[2 * 36] * qs, s[3 * 36] * qs); o.y = peer_body::pack_i8x4(s[4 * 36] * qs, s[5 * 36] * qs, s[6 * 36] * qs, s[7 * 36] * qs);
        o.z = peer_body::pack_i8x4(s[8 * 36] * qs, s[9 * 36] * qs, s[10 * 36] * qs, s[11 * 36] * qs); o.w = peer_body::pack_i8x4(s[12 * 36] * qs, s[13 * 36] * qs, s[14 * 36] * qs, s[15 * 36] * qs);
        *(GAS v4u*)(WT8 + (size_t)(row0 + n0 + n) * K + k0 + 16 * c) = o;
        if (kb == 0 && c == 0) sB[row0 + n0 + n] = am * (1.0f / 127.0f); }
    LDS_WAIT(); asm volatile("" ::: "memory");
}
__device__ __forceinline__ void p0_colmax_task(const float* W, int ldw, int ncols, unsigned* colmax, int task, int lane) {
    const int ncb = (ncols + 255) / 256, cb = task % ncb, rb = task / ncb, c = 256 * cb + 4 * lane;
    if (c >= ncols) return;
    f32x4 m = (f32x4){0.f, 0.f, 0.f, 0.f};
#pragma unroll 8
    for (int i = 0; i < 32; ++i) { const f32x4 v = *(const GAS f32x4*)(W + (size_t)(32 * rb + i) * ldw + c);
        m.x = fmaxf(m.x, fabsf(v.x)); m.y = fmaxf(m.y, fabsf(v.y)); m.z = fmaxf(m.z, fabsf(v.z)); m.w = fmaxf(m.w, fabsf(v.w)); }
    atomicMax(colmax + c, __float_as_uint(m.x)); atomicMax(colmax + c + 1, __float_as_uint(m.y)); atomicMax(colmax + c + 2, __float_as_uint(m.z)); atomicMax(colmax + c + 3, __float_as_uint(m.w));
}
__device__ __forceinline__ void cvt_chunks(const float* src, bf16* dst, size_t nchunks, size_t gtid, size_t nthr) {
    for (size_t c = gtid; c < nchunks; c += nthr) { const f32x4 a = ((const GAS f32x4*)src)[2 * c], b = ((const GAS f32x4*)src)[2 * c + 1];
        v4u o; o.x = pg8::cvt_pk_bf16(a.x, a.y); o.y = pg8::cvt_pk_bf16(a.z, a.w); o.z = pg8::cvt_pk_bf16(b.x, b.y); o.w = pg8::cvt_pk_bf16(b.z, b.w);
        ((GAS v4u*)dst)[c] = o; }
}

__device__ __forceinline__ void convert_rows4(int e0, const float* eu, const float* ev, unsigned char* ws, int lane) {
                const bool isV = e0 >= NEXP; const int row0 = isV ? e0 - NEXP : e0;
                const float* tab = isV ? ev : eu;
                f32x4 v[4][4];
#pragma unroll
                for (int rr = 0; rr < 4; ++rr)
#pragma unroll
                    for (int i = 0; i < 4; ++i) v[rr][i] = __builtin_nontemporal_load((const GAS f32x4*)(tab + (size_t)(row0 + rr) * D + 16 * lane) + i);
#pragma unroll
                for (int rr = 0; rr < 4; ++rr) {
                    const int row = row0 + rr; float am = 0.f;
#pragma unroll
                    for (int i = 0; i < 4; ++i) am = fmaxf(fmaxf(am, fmaxf(fabsf(v[rr][i].x), fabsf(v[rr][i].y))), fmaxf(fabsf(v[rr][i].z), fabsf(v[rr][i].w)));
                    am = wave_allmax(am);
                    v4u q;
                    if (!isV) { const float inv = am > 0.f ? 127.0f / am : 0.f;
                        q.x = peer_body::pack_i8x4(v[rr][0].x * inv, v[rr][0].y * inv, v[rr][0].z * inv, v[rr][0].w * inv); q.y = peer_body::pack_i8x4(v[rr][1].x * inv, v[rr][1].y * inv, v[rr][1].z * inv, v[rr][1].w * inv);
                        q.z = peer_body::pack_i8x4(v[rr][2].x * inv, v[rr][2].y * inv, v[rr][2].z * inv, v[rr][2].w * inv); q.w = peer_body::pack_i8x4(v[rr][3].x * inv, v[rr][3].y * inv, v[rr][3].z * inv, v[rr][3].w * inv);
                        *(GAS v4u*)(ws + WS_EU + (size_t)(lane >> 3) * ((size_t)NEXP * 128) + (size_t)row * 128 + (lane & 7) * 16) = q; if (lane == 0) ((GAS float*)(ws + WS_SU))[row] = am * (1.0f / 127.0f); }
                    else { const float inv = am > 0.f ? 127.0f / am : 0.f;
                        q.x = peer_body::pack_i8x4(v[rr][0].x * inv, v[rr][0].y * inv, v[rr][0].z * inv, v[rr][0].w * inv); q.y = peer_body::pack_i8x4(v[rr][1].x * inv, v[rr][1].y * inv, v[rr][1].z * inv, v[rr][1].w * inv);
                        q.z = peer_body::pack_i8x4(v[rr][2].x * inv, v[rr][2].y * inv, v[rr][2].z * inv, v[rr][2].w * inv); q.w = peer_body::pack_i8x4(v[rr][3].x * inv, v[rr][3].y * inv, v[rr][3].z * inv, v[rr][3].w * inv);
                        *(GAS v4u*)(ws + WS_EV + (size_t)(lane >> 3) * ((size_t)NEXP * 128) + (size_t)row * 128 + (lane & 7) * 16) = q; if (lane == 0) ((GAS float*)(ws + WS_SV))[row] = am * (1.0f / 127.0f); }
                }
}

__global__ void __launch_bounds__(NWAVES * 64, 2) skel_fwd(Args args) {
    extern __shared__ __attribute__((aligned(16))) unsigned char lds[];
    LAS unsigned char* L = (LAS unsigned char*)lds;
    volatile LAS unsigned* MISC = (volatile LAS unsigned*)(L + MISC_OFF);
    const int G = gridDim.x; const int bx = blockIdx.x; const int vcu = (G % 8 == 0) ? (bx % 8) * (G / 8) + bx / 8 : bx;
    for (int u = threadIdx.x; u < (LDS_BYTES - LDSCTL_OFF) / 4; u += NWAVES * 64) ((LAS unsigned*)(L + LDSCTL_OFF))[u] = 0u;
    __syncthreads();
    (void)xcd_barrier_post((unsigned*)((gu32*)(args.ws + WS_CTL) + CW_BAR) + args.li * XCD_BAR_WORDS, MISC + 8);
#define PHASE_VARS \
    GAS unsigned char* wsg_ = (GAS unsigned char*)args.ws; asm volatile("" : "+s"(wsg_)); unsigned char* ws = (unsigned char*)wsg_; GAS float* outg_ = (GAS float*)args.out; asm volatile("" : "+s"(outg_)); float* out = (float*)outg_; \
    int tid = threadIdx.x; asm volatile("" : "+v"(tid)); const int lane = tid & 63, wave = __builtin_amdgcn_readfirstlane(tid >> 6); (void)lane; (void)wave; \
    gu32* ctl = (gu32*)(ws + WS_CTL); (void)ctl; const float* x = args.in[0]; (void)x; \
    bf16* XN = (bf16*)(ws + WS_XN); bf16* Qb = (bf16*)(ws + WS_Q); bf16* UG = (bf16*)(ws + WS_UG); (void)XN; (void)Qb; (void)UG; \
    bf16* GATE = (bf16*)out; bf16* MERGED = (bf16*)(ws + WS_MERGED); bf16* QP = (bf16*)(ws + WS_QP); (void)GATE; (void)MERGED; (void)QP; \
    float* LOGF = (float*)(ws + WS_LOGF); float* CL2 = (float*)(ws + WS_CL2); (void)LOGF; (void)CL2; \
    const int gw = vcu * NWAVES + wave, NGW = G * NWAVES; (void)gw; (void)NGW;
    const int lo = args.ph_lo, hi = args.ph_hi;
#ifndef PHMASK
#define PHMASK 0x1ff
#endif
#define IN(k) (((PHMASK >> (k)) & 1) && lo <= (k) && (k) < hi)
#define BOTH(k) (IN(k) && IN((k) + 1))
#ifdef TIMEPH
    if (bx == 0 && threadIdx.x == 0) { const unsigned long long t0_ = rt(); MISC[24] = (unsigned)t0_; }
#define GRID_BAR(k) do { XcdBarrier b_; b_.bar = (unsigned*)((gu32*)(args.ws + WS_CTL) + CW_BAR) + args.li * XCD_BAR_WORDS; b_.x = xb_xcc_id(); b_.st = MISC + 8; xcd_barrier(b_); if (bx == 0 && threadIdx.x == 0) { gu32* ctl = (gu32*)(args.ws + WS_CTL); const unsigned t_now = (unsigned)rt(); __hip_atomic_store(ctl + 2048 + (k), t_now - MISC[24], RLX_AGENT); MISC[24] = t_now; } } while (0)
#else
#define GRID_BAR(k) do { XcdBarrier b_; b_.bar = (unsigned*)((gu32*)(args.ws + WS_CTL) + CW_BAR) + args.li * XCD_BAR_WORDS; b_.x = xb_xcc_id(); b_.st = MISC + 8; xcd_barrier(b_); } while (0)
#endif

    for (int rp_ = 0; rp_ < RP0; ++rp_) if (IN(0)) {
        PHASE_VARS
        LAS float* scr = (LAS float*)(L + RING_OFF + wave * 16384);
        const float* w_in = args.in[2];
        unsigned* cmax_in = (unsigned*)(ctl + CW_CMAX);
        {
            constexpr int T_IN = ((IN_W + 255) / 256) * (D / 32);
            constexpr int T_WQ = (QPW / 256) * (D / 32);
            for (int it = gw; it < T_IN + T_WQ; it += NGW) { if (it < T_IN) p0_colmax_task(w_in, IN_W, IN_W, cmax_in, it, lane); else p0_colmax_task(args.in[12], QPW, QPW, cmax_in + CMAX_WQ, it - T_IN, lane); }
            GRID_BAR(0);
        }
        {
            constexpr int I_A = 16 * 48, I_B = 16 * 96, I_WA = 8 * 32, I_WB = 8 * 32, I_WO = 16 * 32, I_WQ = 16 * 64;
            constexpr int NITEMS = I_A + I_B + I_WA + I_WB + I_WO + I_WQ;
            for (int it = gw; it < NITEMS; it += NGW) {
                int r = it;
                if (r < I_A) { p0_transpose_item_i8(w_in, IN_W, 0, D, ws + WS_WIN, (float*)(ws + WS_SBW), 0, cmax_in, scr, r, 48, lane); continue; } r -= I_A;
                if (r < I_B) { p0_transpose_item_i8(w_in, IN_W, OFF_UG, D, ws + WS_WIN, (float*)(ws + WS_SBW), 1536, cmax_in, scr, r, 96, lane); continue; } r -= I_B;
                if (r < I_WA) { p0_transpose_item(args.in[8], D, 0, AW, (bf16*)(ws + WS_WA), 0, scr, r, 32, lane); continue; } r -= I_WA;
                if (r < I_WB) { p0_transpose_item(args.in[9], D, 0, SW, (bf16*)(ws + WS_WB), 0, scr, r, 32, lane); continue; } r -= I_WB;
                if (r < I_WO) { p0_transpose_item(args.in[10], D, 0, D, (bf16*)(ws + WS_WOUT), 0, scr, r, 32, lane); continue; } r -= I_WO;
                p0_transpose_item_i8(args.in[12], QPW, 0, D, ws + WS_WQ, (float*)(ws + WS_SBWQ), 0, cmax_in + CMAX_WQ, scr, r, 64, lane);
            }
        }
        {
            const size_t gtid = (size_t)gw * 64 + lane, nthr = (size_t)NGW * 64;
            cvt_chunks(args.in[13], (bf16*)(ws + WS_SK), (size_t)PH * 2 * PKEYS * PHALF / 8, gtid, nthr);
#pragma unroll 1
            for (int e0 = CONV_P0_FROM + 4 * gw; e0 < 2 * NEXP; e0 += 4 * NGW) convert_rows4(e0, args.in[14], args.in[15], ws, lane);
            const float* w_s = args.in[6]; bf16* wsm = (bf16*)(ws + WS_WSM);
            for (size_t c = gtid; c < (size_t)NG * CHUNK * CHUNK / 8; c += nthr) {
                const int pos = (int)((c * 8) & 127), t = (int)((c * 8) >> 7) & 127, ks = pos >> 4, hh = (pos >> 3) & 1, s0 = 16 * ks + 4 * hh, s1 = s0 + 8;
                const float* src = w_s + ((c * 8) & ~(size_t)127);
                const f32x4 a = *(const GAS f32x4*)(src + s0), b = *(const GAS f32x4*)(src + s1);
                v4u o; o.x = pg8::cvt_pk_bf16(s0 + 0 <= t ? a.x : 0.f, s0 + 1 <= t ? a.y : 0.f); o.y = pg8::cvt_pk_bf16(s0 + 2 <= t ? a.z : 0.f, s0 + 3 <= t ? a.w : 0.f);
                o.z = pg8::cvt_pk_bf16(s1 + 0 <= t ? b.x : 0.f, s1 + 1 <= t ? b.y : 0.f); o.w = pg8::cvt_pk_bf16(s1 + 2 <= t ? b.z : 0.f, s1 + 3 <= t ? b.w : 0.f);
                ((GAS v4u*)wsm)[c] = o; }
        }
        __syncthreads();
        {
            LAS float* wf = (LAS float*)(L + RING_OFF);
            for (int i = tid; i < 8 * D; i += NWAVES * 64) { const int k = i >> 3, c = i & 7; wf[c * D + k] = w_in[(size_t)k * IN_W + OFF_F + c]; }
            __syncthreads();
            const float* g1 = args.in[1]; const float* b_f = args.in[3];
            f32x4 gv[4];
#pragma unroll
            for (int j = 0; j < 4; ++j) gv[j] = ((const GAS f32x4*)g1)[lane + 64 * j];
#pragma unroll 1
            for (int m0 = 4 * gw; m0 < M; m0 += 4 * NGW) {
                f32x4 vv[4][4];
#pragma unroll
                for (int rr = 0; rr < 4; ++rr)
#pragma unroll
                    for (int j = 0; j < 4; ++j) vv[rr][j] = ((const GAS f32x4*)(x + (size_t)(m0 + rr) * D) + lane)[64 * j];
#pragma unroll
                for (int rr = 0; rr < 4; ++rr) {
                    const int m = m0 + rr; f32x4 v[4]; float s = 0.f;
#pragma unroll
                    for (int j = 0; j < 4; ++j) { v[j] = vv[rr][j]; s += (v[j].x * v[j].x + v[j].y * v[j].y) + (v[j].z * v[j].z + v[j].w * v[j].w); }
                    const float r = 1.0f / sqrtf(wave_sum(s) * (1.f / D) + EPS);
#pragma unroll
                    for (int j = 0; j < 4; ++j) v[j] = v[j] * r * gv[j];
                    {
                        float am = 0.f;
#pragma unroll
                        for (int j = 0; j < 4; ++j) am = fmaxf(fmaxf(am, fmaxf(fabsf(v[j].x), fabsf(v[j].y))), fmaxf(fabsf(v[j].z), fabsf(v[j].w)));
                        am = wave_allmax(am); const float qs = am > 0.f ? 127.0f / am : 0.f;
                        GAS unsigned* o4 = (GAS unsigned*)(ws + WS_XN + (size_t)m * D) + lane;
#pragma unroll
                        for (int j = 0; j < 4; ++j) o4[64 * j] = peer_body::pack_i8x4(v[j].x * qs, v[j].y * qs, v[j].z * qs, v[j].w * qs);
                        if (lane == 0) ((GAS float*)(ws + WS_SA))[m] = am * (1.0f / 127.0f); }
                    float fsum = 0.f;
#pragma unroll
                    for (int c = 0; c < 8; ++c) { float pp = 0.f;
#pragma unroll
                        for (int j = 0; j < 4; ++j) { const f32x4 w4 = *(const LAS f32x4*)(wf + c * D + 256 * j + 4 * lane); pp += (v[j].x * w4.x + v[j].y * w4.y) + (v[j].z * w4.z + v[j].w * w4.w); }
                        pp = wave_sum(pp); if (lane == c) fsum = pp; }
                    if (lane < 8) LOGF[(size_t)m * NH + lane] = log_sigmoid(fsum + b_f[lane]);
                }
            }
        }
        if (BOTH(0)) GRID_BAR(0);
    }

    for (int rp12_ = 0; rp12_ < RP12; ++rp12_) {
    for (int rp_ = 0; rp_ < RP1; ++rp_) if (IN(1)) {
        PHASE_VARS
        if (vcu < BATCH * NH) {
            const int b = vcu / NH, h = vcu % NH; LAS float* part = (LAS float*)(L + MISC_OFF + 64);
            float v[4];
#pragma unroll
            for (int i = 0; i < 4; ++i) v[i] = LOGF[(size_t)(b * SEQ + 4 * tid + i) * NH + h];
            v[1] += v[0]; v[2] += v[1]; v[3] += v[2];
            float tot = v[3];
#pragma unroll
            for (int o = 1; o < 64; o <<= 1) { const float u = __shfl_up(tot, o); if (lane >= o) tot += u; }
            if (lane == 63) part[wave] = tot;
            __syncthreads();
            float base = tot - v[3];
            for (int w = 0; w < wave; ++w) base += part[w];
#pragma unroll
            for (int i = 0; i < 4; ++i) CL2[(size_t)vcu * SEQ + 4 * tid + i] = (base + v[i]) * LOG2E;
            __syncthreads();
        }
        pg8::Gemm g{XN, (const bf16*)(ws + WS_WIN), M, NPROJ, D / 2}; pg8::StaticOrder S; S.init(M, NPROJ, G, bx);
        pg8::EpiProjI8 E{Qb, (size_t)M * 512, GATE, C2, (const float*)(ws + WS_SA), (const float*)(ws + WS_SBW)};
        pg8::gemm_phase<pg8::EpiProjI8, pg8::StaticOrder, true, true, true>(L + RING_OFF, g, S, E);
        {
            constexpr int NUN = (M / 256) * (NPROJ / 256);
            const int nmax = (NUN + G - 1) / G, nun = (NUN - bx + G - 1) / G;
            int ii_ = bx - (NUN - (nmax - 1) * G), nidle_ = G - (NUN - (nmax - 1) * G);
            if (nidle_ <= 0) { ii_ = bx; nidle_ = G; }
            if (nun < nmax || nidle_ == G) {
#pragma unroll 1
                for (int e0 = 4 * (ii_ * NWAVES + wave); e0 < CONV_SPLIT; e0 += 4 * nidle_ * NWAVES) convert_rows4(e0, args.in[14], args.in[15], ws, lane);
            }
        }
        if (BOTH(1)) GRID_BAR(1);
    }

    if (IN(2)) {
        PHASE_VARS
        static_assert(attn_body::ATTN_LDS_BYTES <= RING_BYTES, "attention LDS");
#ifdef P2PROBE
        for (int pr_ = 0; pr_ < P2PROBE; ++pr_) {
            for (int u = vcu; u < 2 * (M / CHUNK); u += G)
                sgu_body::sgu_unit(u >> 1, u & 1, (const bf16*)(ws + WS_VG), UG, (bf16*)(ws + 232 * MiB), (const bf16*)(ws + WS_WSM), args.in[4], args.in[5], args.in[7], (char*)lds + RING_OFF);
#ifndef P2PROBE_SGU_ONLY
            const attn_body::AttnTensors ATp{(const attn_body::bf16*)Qb, (const attn_body::bf16*)(ws + WS_K), (const attn_body::bf16*)(ws + WS_V), (attn_body::bf16*)(ws + 216 * MiB), CL2};
            const attn_body::StaticOrder Sp(G, bx);
            attn_body::attn_phase<attn_body::StaticOrder>((char*)lds + RING_OFF, ATp, Sp);
#endif
            GRID_BAR(2);
        }
#endif
        constexpr int NCONVQ = (CONV_P0_FROM - CONV_SPLIT) / 64, NIL = NCONVQ < 512 ? NCONVQ : 512;
        for (;;) {
            __syncthreads();
            if (tid == 0) MISC[26] = __hip_atomic_fetch_add(ctl + CW_QUEUE, 1u, RLX_AGENT);
            __syncthreads();
            const int u = __builtin_amdgcn_readfirstlane((int)MISC[26]);
            if (u >= 768 + NCONVQ) break;
            int ua = -1, uc = -1, us = -1;
            if (u < 2 * NIL) { if (u & 1) uc = u >> 1; else ua = u >> 1; }
            else if (u < 512 + NCONVQ) { if (NCONVQ > 512) uc = u - 512; else ua = u - NCONVQ; }
            else us = u - 512 - NCONVQ;
            if (ua >= 0) { const int qb = 7 - (ua >> 6), bh = ua & 63;
                const int t0 = attn_body::attn_first_tile(CL2, bh, qb);
                attn_body::attn_unit<8>(bh / NH, bh % NH, qb, (const attn_body::bf16*)Qb, (const attn_body::bf16*)(ws + WS_K), (const attn_body::bf16*)(ws + WS_V), (attn_body::bf16*)Qb, CL2, (char*)lds + RING_OFF, t0); }
            else if (uc >= 0) { convert_rows4(CONV_SPLIT + 64 * uc + 8 * wave, args.in[14], args.in[15], ws, lane); convert_rows4(CONV_SPLIT + 64 * uc + 8 * wave + 4, args.in[14], args.in[15], ws, lane); }
            else sgu_body::sgu_unit(us >> 1, us & 1, (const bf16*)(ws + WS_VG), UG, UG, (const bf16*)(ws + WS_WSM), args.in[4], args.in[5], args.in[7], (char*)lds + RING_OFF);
        }
        if (BOTH(2)) GRID_BAR(2);
    }
    }

    for (int rp_ = 0; rp_ < RP3; ++rp_) if (IN(3)) {
        PHASE_VARS
        static_assert(WS_UG - WS_Q == (size_t)pg8::MERGE_DPM * 256 * AW * 2 && WS_WB - WS_WA == (size_t)4 * 256 * AW * 2, "merge passes: buffer offsets");
        { pg8::Gemm g{Qb, (const bf16*)(ws + WS_WA), M, D, AW}; pg8::MergeOrder S; S.init(M, D, G, bx);
          pg8::EpiMergeAB E{GATE, MERGED};
          pg8::gemm_phase<pg8::EpiMergeAB, pg8::MergeOrder, true, true>(L + RING_OFF, g, S, E); }
        if (BOTH(3)) GRID_BAR(3);
    }

    for (int rp_ = 0; rp_ < RP4; ++rp_) if (IN(4)) {
        PHASE_VARS
        pg8::Gemm g{MERGED, (const bf16*)(ws + WS_WOUT), M, D, D}; pg8::StaticOrder S; S.init(M, D, G, bx);
        pg8::EpiResid E{x, out, D, M};
        pg8::gemm_phase<pg8::EpiResid, pg8::StaticOrder, false, true>(L + RING_OFF, g, S, E);
        if (BOTH(4)) GRID_BAR(4);
    }

    for (int rp_ = 0; rp_ < RP5; ++rp_) if (IN(5)) {
        PHASE_VARS
        const float* g2 = args.in[11];
        f32x4 gv[4];
#pragma unroll
        for (int j = 0; j < 4; ++j) gv[j] = ((const GAS f32x4*)g2)[lane + 64 * j];
#pragma unroll 1
        for (int m0 = 4 * gw; m0 < M; m0 += 4 * NGW) {
            f32x4 vv[4][4];
#pragma unroll
            for (int rr = 0; rr < 4; ++rr)
#pragma unroll
                for (int j = 0; j < 4; ++j) vv[rr][j] = ((const GAS f32x4*)(out + (size_t)(m0 + rr) * D) + lane)[64 * j];
            asm volatile("" ::: "memory");
#pragma unroll
            for (int rr = 0; rr < 4; ++rr) {
                const int m = m0 + rr; f32x4 v[4]; float s = 0.f;
#pragma unroll
                for (int j = 0; j < 4; ++j) { v[j] = vv[rr][j]; s += (v[j].x * v[j].x + v[j].y * v[j].y) + (v[j].z * v[j].z + v[j].w * v[j].w); }
                const float r = 1.0f / sqrtf(wave_sum(s) * (1.f / D) + EPS);
                float am = 0.f;
#pragma unroll
                for (int j = 0; j < 4; ++j) { v[j] = v[j] * r * gv[j];
                    am = fmaxf(fmaxf(am, fmaxf(fabsf(v[j].x), fabsf(v[j].y))), fmaxf(fabsf(v[j].z), fabsf(v[j].w))); }
                am = wave_allmax(am);
                const float qs = am > 0.f ? 127.0f / am : 0.f;
#pragma unroll
                for (int j = 0; j < 4; ++j) { const unsigned q4 = peer_body::pack_i8x4(v[j].x * qs, v[j].y * qs, v[j].z * qs, v[j].w * qs);
                    *(GAS unsigned*)(ws + WS_H2Q + (size_t)(2 * j + (lane >> 5)) * ((size_t)M * 128) + (size_t)m * 128 + ((4 * lane) & 127)) = q4; ((GAS unsigned*)(ws + WS_XN + (size_t)m * D))[lane + 64 * j] = q4; }
                if (lane == 0) ((GAS float*)(ws + WS_ST))[m] = am * (1.0f / 127.0f);
            }
        }
        if (BOTH(5)) GRID_BAR(5);
    }

    for (int rp_ = 0; rp_ < RP6; ++rp_) if (IN(6)) {
        PHASE_VARS
        pg8::Gemm g{XN, (const bf16*)(ws + WS_WQ), M, QPW, D / 2}; pg8::StaticOrder S; S.init(M, QPW, G, bx);
        pg8::EpiBf16I8 E{QP, QPW, (const float*)(ws + WS_ST), (const float*)(ws + WS_SBWQ)};
        pg8::gemm_phase<pg8::EpiBf16I8, pg8::StaticOrder, true, true, true>(L + RING_OFF, g, S, E);
        if (BOTH(6)) GRID_BAR(6);
    }
    for (int rp_ = 0; rp_ < RP7; ++rp_) if (IN(7)) {
        PHASE_VARS
        for (int tk = vcu; tk < 8 * (M / 512); tk += G)
            peer_body::peer_retrieve(tk, QP, (const bf16*)(ws + WS_SK), (const float*)(ws + WS_SU), (const float*)(ws + WS_SV), (const float*)(ws + WS_ST),
                                     (bf16*)(ws + WS_PID), (float*)(ws + WS_G2), (float*)(ws + WS_PS2), (char*)lds + RING_OFF);
        if (BOTH(7)) GRID_BAR(7);
    }
    if (IN(8)) {
        PHASE_VARS
#ifdef TIMEPH
        const float oscale = 1.0f + sqrtf((float)(((__hip_atomic_load(ctl + 2048 + TIMEPH, RLX_AGENT) + TIMEOFF) / TIMEQ) * TIMEQ) * 1e-5f);
#else
        const float oscale = 1.0f;
#endif
        const int p = bx & 7, cntp = (G - p + 7) >> 3;
        peer_body::peer_fused(p, (bx >> 3) * NWAVES + wave, cntp * NWAVES, (const bf16*)(ws + WS_PID), (const float*)(ws + WS_G2), (const float*)(ws + WS_PS2), (const unsigned char*)(ws + WS_H2Q),
                              (const unsigned char*)(ws + WS_EU), (const unsigned char*)(ws + WS_EV), out, args.in[16], (char*)lds + RING_OFF, oscale);
    }
#undef IN
#undef BOTH
#undef GRID_BAR
}

extern "C" void kernel_launch(void* const* d_in, const int* in_sizes, int n_in, void* d_out, int out_size, void* d_ws, size_t ws_size, hipStream_t stream) {
    static int grid = 0;
    if (grid == 0) {
        int dev = 0, cus = 0;
        if (n_in != 17 || out_size != M * D || ws_size < WS_END) { fprintf(stderr, "kernel_launch: unexpected shapes (n_in %d out %d ws %zu)\n", n_in, out_size, ws_size); grid = -1; return; }
        if (hipGetDevice(&dev) != hipSuccess || hipDeviceGetAttribute(&cus, hipDeviceAttributeMultiprocessorCount, dev) != hipSuccess) { grid = -1; return; }
        if (hipFuncSetAttribute((const void*)skel_fwd, hipFuncAttributeMaxDynamicSharedMemorySize, LDS_BYTES) != hipSuccess) { fprintf(stderr, "kernel_launch: hipFuncSetAttribute failed\n"); grid = -1; return; }
        int per_cu = 0;
        if (hipOccupancyMaxActiveBlocksPerMultiprocessor(&per_cu, (const void*)skel_fwd, NWAVES * 64, LDS_BYTES) != hipSuccess || per_cu < 1) { fprintf(stderr, "kernel_launch: occupancy query says %d workgroups per CU\n", per_cu); grid = -1; return; }
        grid = cus;
    }
    if (grid < 0) return;
    unsigned char* ws = (unsigned char*)d_ws; float* out = (float*)d_out;
    (void)hipMemsetAsync(ws + WS_CTL, 0, CTL_ZERO_BYTES, stream);
    Args a{};
    for (int i = 0; i < 17; ++i) a.in[i] = (const float*)d_in[i];
    a.out = out; a.ws = ws;
#ifndef MULTI_LAUNCH
    {
        a.ph_lo = 0; a.ph_hi = N_PHASES; a.li = 0;
        void* kargs[] = {(void*)&a};
#ifdef PLAIN_LAUNCH
        hipLaunchKernelGGL(skel_fwd, dim3(grid), dim3(NWAVES * 64), LDS_BYTES, stream, a); const hipError_t e = hipPeekAtLastError(); (void)kargs;
#else
        const hipError_t e = hipLaunchCooperativeKernel((const void*)skel_fwd, dim3(grid), dim3(NWAVES * 64), kargs, LDS_BYTES, stream);
#endif
        if (e != hipSuccess) fprintf(stderr, "kernel_launch: cooperative launch failed: %s (grid %d)\n", hipGetErrorString(e), grid);
    }
#else
    for (int k = 0; k < N_PHASES; ++k) { a.ph_lo = k; a.ph_hi = k + 1; a.li = k; hipLaunchKernelGGL(skel_fwd, dim3(grid), dim3(NWAVES * 64), LDS_BYTES, stream, a); }
#endif
}
```

```cpp
#include <hip/hip_runtime.h>
#include <cstdio>
#include <cstdint>
#include <cmath>

constexpr int D = 1024, BATCH = 8, SEQ = 2048, M = BATCH * SEQ;
constexpr int NH = 8, HD = 64, AW = 512, SW = 512, CHUNK = 128, NG = 8, GD = 64;
constexpr int OFF_Q = 0, OFF_K = 512, OFF_V = 1024, OFF_F = 1536, OFF_UG = 1544, OFF_VG = 2056, OFF_GATE = 2568, IN_W = 4616;
constexpr int NPROJ = 4608;
constexpr int PH = 8, PKEYS = 128, PHALF = 128, PTOP = 16, NEXP = 16384, QPW = 2048, HK = 128;
constexpr float EPS = 1e-6f;
constexpr float LOG2E = 1.4426950408889634f;
constexpr float C2 = 0.125f * LOG2E;

constexpr size_t MiB = 1u << 20;
constexpr size_t WS_CTL = 0, CTL_ZERO_BYTES = 65536;
constexpr size_t WS_WIN = 1 * MiB;
constexpr size_t WS_WA = 10 * MiB;
constexpr size_t WS_WB = 11 * MiB;
constexpr size_t WS_WOUT = 12 * MiB;
constexpr size_t WS_WQ = 14 * MiB;
constexpr size_t WS_SK = 18 * MiB;
constexpr size_t WS_WSM = 18 * MiB + 512 * 1024;
constexpr size_t WS_EU = 20 * MiB;
constexpr size_t WS_EV = 52 * MiB;
constexpr size_t WS_XN = 84 * MiB;
constexpr size_t WS_Q = 116 * MiB;
constexpr size_t WS_K = 132 * MiB;
constexpr size_t WS_V = 148 * MiB;
constexpr size_t WS_UG = 164 * MiB;
constexpr size_t WS_VG = 180 * MiB;
constexpr size_t WS_LOGF = 196 * MiB;
constexpr size_t WS_CL2 = 197 * MiB;
constexpr size_t WS_STAT = 199 * MiB;
constexpr size_t WS_SU = 198 * MiB;
constexpr size_t WS_SV = 198 * MiB + 65536;
constexpr size_t WS_MERGED = WS_K;
constexpr size_t WS_QP = WS_Q;
constexpr size_t WS_PIDX = WS_VG;
constexpr size_t WS_PGATE = WS_VG + 8 * MiB;
constexpr size_t WS_H2Q = 200 * MiB;
constexpr size_t WS_ST = 198 * MiB + 131072;
constexpr size_t WS_SSQP = 198 * MiB + 262144;
constexpr size_t WS_SBQ = 198 * MiB + 524288;
constexpr size_t WS_PID = 180 * MiB;
constexpr size_t WS_G2 = 184 * MiB;
constexpr size_t WS_PS2 = 216 * MiB;
constexpr size_t WS_AP = 116 * MiB;
constexpr size_t WS_WP = 84 * MiB;
constexpr size_t WS_SW = 88 * MiB;
constexpr size_t WS_SSQ = 224 * MiB;
constexpr size_t WS_SBW = 198 * MiB + 786432;
constexpr size_t WS_SA = 198 * MiB + 851968;
constexpr size_t WS_SBWQ = 198 * MiB + 917504;
constexpr size_t WS_END = 256 * MiB;

template <int CTRL> __device__ __forceinline__ float wr_dppf(float v) { return __int_as_float(__builtin_amdgcn_update_dpp(0, __float_as_int(v), CTRL, 0xf, 0xf, false)); }
__device__ __forceinline__ float wave_allsum(float v) {
    v += wr_dppf<0xB1>(v); v += wr_dppf<0x4E>(v); v += wr_dppf<0x141>(v); v += wr_dppf<0x128>(v);
    { const auto s = __builtin_amdgcn_permlane16_swap(__float_as_uint(v), __float_as_uint(v), false, false); v = __uint_as_float(s[0]) + __uint_as_float(s[1]); }
    { const auto s = __builtin_amdgcn_permlane32_swap(__float_as_uint(v), __float_as_uint(v), false, false); v = __uint_as_float(s[0]) + __uint_as_float(s[1]); }
    return v;
}
__device__ __forceinline__ float wave_allmax(float v) {
    v = fmaxf(v, wr_dppf<0xB1>(v)); v = fmaxf(v, wr_dppf<0x4E>(v)); v = fmaxf(v, wr_dppf<0x141>(v)); v = fmaxf(v, wr_dppf<0x128>(v));
    { const auto s = __builtin_amdgcn_permlane16_swap(__float_as_uint(v), __float_as_uint(v), false, false); v = fmaxf(__uint_as_float(s[0]), __uint_as_float(s[1])); }
    { const auto s = __builtin_amdgcn_permlane32_swap(__float_as_uint(v), __float_as_uint(v), false, false); v = fmaxf(__uint_as_float(s[0]), __uint_as_float(s[1])); }
    return v;
}
namespace pg8 {
#define PG8_LAS __attribute__((address_space(3)))
typedef unsigned short bf16_t;
typedef short bf16x8 __attribute__((ext_vector_type(8)));
typedef float f32x4 __attribute__((ext_vector_type(4)));
typedef unsigned u32x4 __attribute__((ext_vector_type(4)));
constexpr int BM = 256, BK = 64, HALF = 128, HTB = HALF * BK * 2  , STAGE_BYTES = 8 * HTB, NXCD = 8, WGM = 8;

__host__ __device__ __forceinline__ int lds_byte(int r, int c) { const int st = (r >> 4) * 2 + (c >> 5), rr = r & 15, cc = c & 31, ob = rr * 64 + cc * 2; return st * 1024 + (ob ^ (((ob >> 9) & 1) << 5)); }
__host__ __device__ __forceinline__ void stage_rc(int b, int& R, int& C) { const int st = b / 1024, sb = b % 1024, swz = sb ^ (((sb >> 9) & 1) << 5); R = (st >> 1) * 16 + swz / 64; C = (st & 1) * 32 + (swz % 64) / 2; }
__host__ __device__ __forceinline__ int perm32(int rho) { const int n = rho >> 4, i = rho & 15; return 8 * (i >> 2) + 4 * n + (i & 3); }

struct Unit { int pm, pn; };
struct Gemm { const bf16_t* A; const bf16_t* Bt; int M, N, K; };

struct StaticOrder {
    int nM, nN, nwg, G, c;
    __host__ __device__ void init(int M, int N, int G_, int c_) { nM = M / BM; nN = N / BM; nwg = nM * nN; G = G_; c = c_; }
    __host__ __device__ bool next(int i, Unit& u) const {
        const long L = (long)i * G + c; if (L >= nwg) return false;
        int wgid = (int)L; { const int q = nwg / NXCD, r = nwg % NXCD, xcd = wgid % NXCD, off = wgid / NXCD; wgid = (xcd < r ? xcd * (q + 1) : r * (q + 1) + (xcd - r) * q) + off; }
        const int nig = WGM * nN, gid = wgid / nig, fm = gid * WGM, gsz = (nM - fm) < WGM ? (nM - fm) : WGM;
        u.pm = fm + ((wgid % nig) % gsz); u.pn = (wgid % nig) / gsz; return true;
    }
    __device__ __forceinline__ void a_ready(const Unit&) const {}
    __device__ __forceinline__ void done(const Unit&) const {}
};

typedef float cvt_f32x2_t __attribute__((ext_vector_type(2))); typedef __bf16 cvt_bf16x2_t __attribute__((ext_vector_type(2)));
__device__ __forceinline__ unsigned cvt_pk_bf16(float lo, float hi) { cvt_f32x2_t v = {lo, hi}; cvt_bf16x2_t b = __builtin_convertvector(v, cvt_bf16x2_t); return __builtin_bit_cast(unsigned, b); }
typedef float f32x2 __attribute__((ext_vector_type(2)));
__device__ __forceinline__ f32x2 gelu_pk(f32x2 v) {
    const f32x2 av = __builtin_elementwise_abs(v), d = av * 0.2316418882f + 1.0f;
    f32x2 t; t.x = __builtin_amdgcn_rcpf(d.x); t.y = __builtin_amdgcn_rcpf(d.y);
    f32x2 q = t * 0.5307027145f + (-0.7265760135f); q = q * t + 0.7107068705f; q = q * t + (-0.142248368f); q = q * t + 0.127414796f; q = q * t;
    const f32x2 s = (v * v) * (-0.72134752044f);
    f32x2 e; e.x = __builtin_amdgcn_exp2f(s.x); e.y = __builtin_amdgcn_exp2f(s.y);
    const f32x2 m = v * (q * e), r = v - m;
    f32x2 o; o.x = v.x < 0.f ? m.x : r.x; o.y = v.y < 0.f ? m.y : r.y; return o;
}

template <int ACT  > struct EpiBf16 {
    static constexpr bool PERM = true, AFTER_DRAIN = false; static_assert(ACT == 0 || ACT == 1, "EpiBf16: ACT is 0 (none) or 1 (gelu_pk)");
    bf16_t* O; int ldc; const float* bias; int split_cols; size_t split_stride; float scale0;
    __device__ __forceinline__ void operator()(const f32x4 (&acc)[2][2][4][2], const Unit& u, int wr, int wc, int fr, int fq) const {
        const int row0 = u.pm * BM + wr * 64 + fr; int colt = u.pn * BM; bf16_t* base = O;
        float sc = 1.f; if (split_cols) { const int t = colt / split_cols; base += (size_t)t * split_stride; colt -= t * split_cols; if (t == 0) sc = scale0; }
        const int col0 = colt + wc * 32 + 8 * fq, bcol0 = u.pn * BM + wc * 32 + 8 * fq;
        f32x4 bv[2][2];
#pragma unroll
        for (int bj = 0; bj < 2; ++bj)
#pragma unroll
            for (int n = 0; n < 2; ++n) bv[bj][n] = bias ? *(const f32x4*)(bias + bcol0 + bj * HALF + 4 * n) : (f32x4){0.f, 0.f, 0.f, 0.f};
#pragma unroll
        for (int ai = 0; ai < 2; ++ai)
#pragma unroll
            for (int m = 0; m < 4; ++m) { bf16_t* rowp = base + (size_t)(row0 + ai * HALF + m * 16) * ldc + col0;
#pragma unroll
                for (int bj = 0; bj < 2; ++bj) { f32x4 v0 = acc[ai][bj][m][0] + bv[bj][0], v1 = acc[ai][bj][m][1] + bv[bj][1];
                    if (ACT == 1) { f32x2 a = gelu_pk((f32x2){v0[0], v0[1]}), b = gelu_pk((f32x2){v0[2], v0[3]}), c = gelu_pk((f32x2){v1[0], v1[1]}), d = gelu_pk((f32x2){v1[2], v1[3]});
                        v0 = (f32x4){a.x, a.y, b.x, b.y}; v1 = (f32x4){c.x, c.y, d.x, d.y}; }
                    v0 = v0 * sc; v1 = v1 * sc; u32x4 w; w.x = cvt_pk_bf16(v0[0], v0[1]); w.y = cvt_pk_bf16(v0[2], v0[3]); w.z = cvt_pk_bf16(v1[0], v1[1]); w.w = cvt_pk_bf16(v1[2], v1[3]);
                    *(u32x4*)(rowp + bj * HALF) = w; } }
    }
};
__device__ __forceinline__ f32x2 sigmoid_pk(f32x2 v) {
#ifdef DBG_SIG
    f32x2 o; o.x = 1.0f / (1.0f + __expf(-v.x)); o.y = 1.0f / (1.0f + __expf(-v.y)); return o;
#else
    f32x2 e; e.x = __builtin_amdgcn_exp2f(v.x * -1.4426950408889634f); e.y = __builtin_amdgcn_exp2f(v.y * -1.4426950408889634f);
    f32x2 o; o.x = __builtin_amdgcn_rcpf(1.0f + e.x); o.y = __builtin_amdgcn_rcpf(1.0f + e.y); return o;
#endif
}
template <int ACT> __device__ __forceinline__ f32x4 act4(f32x4 v, float sc) {
    if (ACT == 0) return v * sc;
    f32x2 a, b;
    if (ACT == 2) { a = gelu_pk((f32x2){v[0], v[1]}); b = gelu_pk((f32x2){v[2], v[3]}); }
    else { a = sigmoid_pk((f32x2){v[0], v[1]}); b = sigmoid_pk((f32x2){v[2], v[3]}); }
    return (f32x4){a.x, a.y, b.x, b.y};
}
struct EpiProj {
    static constexpr bool PERM = true, AFTER_DRAIN = false;
    bf16_t* QKVUV; size_t tstride; bf16_t* GATE; float qscale;
    template <int ACT> __device__ __forceinline__ void body(const f32x4 (&acc)[2][2][4][2], bf16_t* base, int ldc, int row0, int col0, float sc) const {
#pragma unroll
        for (int ai = 0; ai < 2; ++ai)
#pragma unroll
            for (int m = 0; m < 4; ++m) { bf16_t* rowp = base + (size_t)(row0 + ai * HALF + m * 16) * ldc + col0;
#pragma unroll
                for (int bj = 0; bj < 2; ++bj) { const f32x4 v0 = act4<ACT>(acc[ai][bj][m][0], sc), v1 = act4<ACT>(acc[ai][bj][m][1], sc);
                    u32x4 w; w.x = cvt_pk_bf16(v0[0], v0[1]); w.y = cvt_pk_bf16(v0[2], v0[3]); w.z = cvt_pk_bf16(v1[0], v1[1]); w.w = cvt_pk_bf16(v1[2], v1[3]);
                    *(u32x4*)(rowp + bj * HALF) = w; } }
    }
    __device__ __forceinline__ void operator()(const f32x4 (&acc)[2][2][4][2], const Unit& u, int wr, int wc, int fr, int fq) const {
        const int row0 = u.pm * BM + wr * 64 + fr, pn = u.pn;
        if (pn < 10) { bf16_t* base = QKVUV + (size_t)(pn >> 1) * tstride; const int col0 = (pn & 1) * BM + wc * 32 + 8 * fq;
            if (pn < 6) body<0>(acc, base, 512, row0, col0, pn < 2 ? qscale : 1.0f); else body<2>(acc, base, 512, row0, col0, 1.0f); }
        else body<3>(acc, GATE, 2048, row0, (pn - 10) * BM + wc * 32 + 8 * fq, 1.0f);
    }
};
template <int PASS> struct EpiMerge {
    static constexpr bool PERM = true, AFTER_DRAIN = false;
    const bf16_t* GATE; bf16_t* MERGED;
    __device__ __forceinline__ void operator()(const f32x4 (&acc)[2][2][4][2], const Unit& u, int wr, int wc, int fr, int fq) const {
        const int row0 = u.pm * BM + wr * 64 + fr, col0 = u.pn * BM + wc * 32 + 8 * fq;
#pragma unroll
        for (int ai = 0; ai < 2; ++ai) {
            u32x4 gq[4][2], tq[4][2];
#pragma unroll
            for (int m = 0; m < 4; ++m) { const size_t r = (size_t)(row0 + ai * HALF + m * 16);
#pragma unroll
                for (int bj = 0; bj < 2; ++bj) { const int c = col0 + bj * HALF; gq[m][bj] = *(const u32x4*)(GATE + r * 2048 + PASS * 1024 + c);
                    if (PASS == 1) tq[m][bj] = *(const u32x4*)(MERGED + r * 1024 + c); } }
            asm volatile("" ::: "memory");
#pragma unroll
            for (int m = 0; m < 4; ++m) { const size_t r = (size_t)(row0 + ai * HALF + m * 16);
#pragma unroll
                for (int bj = 0; bj < 2; ++bj) { const int c = col0 + bj * HALF; const u32x4 g = gq[m][bj];
                    f32x4 v0 = acc[ai][bj][m][0], v1 = acc[ai][bj][m][1];
                    v0[0] *= __uint_as_float(g.x << 16); v0[1] *= __uint_as_float(g.x & 0xffff0000u); v0[2] *= __uint_as_float(g.y << 16); v0[3] *= __uint_as_float(g.y & 0xffff0000u);
                    v1[0] *= __uint_as_float(g.z << 16); v1[1] *= __uint_as_float(g.z & 0xffff0000u); v1[2] *= __uint_as_float(g.w << 16); v1[3] *= __uint_as_float(g.w & 0xffff0000u);
                    if (PASS == 1) { const u32x4 t = tq[m][bj];
                        v0[0] += __uint_as_float(t.x << 16); v0[1] += __uint_as_float(t.x & 0xffff0000u); v0[2] += __uint_as_float(t.y << 16); v0[3] += __uint_as_float(t.y & 0xffff0000u);
                        v1[0] += __uint_as_float(t.z << 16); v1[1] += __uint_as_float(t.z & 0xffff0000u); v1[2] += __uint_as_float(t.w << 16); v1[3] += __uint_as_float(t.w & 0xffff0000u); }
                    u32x4 w; w.x = cvt_pk_bf16(v0[0], v0[1]); w.y = cvt_pk_bf16(v0[2], v0[3]); w.z = cvt_pk_bf16(v1[0], v1[1]); w.w = cvt_pk_bf16(v1[2], v1[3]);
                    *(u32x4*)(MERGED + r * 1024 + c) = w; } }
            asm volatile("" ::: "memory");
        }
    }
};
struct EpiResid {
    static constexpr bool PERM = false, AFTER_DRAIN = false;
    const float* base; float* out; int ldc; int nrows;
    __device__ __forceinline__ void operator()(const f32x4 (&acc)[2][2][4][2], const Unit& u, int wr, int wc, int fr, int fq) const {
        const int col0 = u.pn * BM + wc * 32 + 4 * fq;
#pragma unroll
        for (int ai = 0; ai < 2; ++ai) {
            f32x4 pre[4][2][2];
#pragma unroll
            for (int m = 0; m < 4; ++m) { const size_t off = (size_t)(u.pm * BM + ai * HALF + wr * 64 + m * 16 + fr) * ldc + col0;
#pragma unroll
                for (int bj = 0; bj < 2; ++bj)
#pragma unroll
                    for (int n = 0; n < 2; ++n) pre[m][bj][n] = *(const f32x4*)(base + off + bj * HALF + n * 16); }
            asm volatile("" ::: "memory");
#pragma unroll
            for (int m = 0; m < 4; ++m) { const size_t off = (size_t)(u.pm * BM + ai * HALF + wr * 64 + m * 16 + fr) * ldc + col0;
#pragma unroll
                for (int bj = 0; bj < 2; ++bj)
#pragma unroll
                    for (int n = 0; n < 2; ++n) *(f32x4*)(out + off + bj * HALF + n * 16) = pre[m][bj][n] + acc[ai][bj][m][n]; }
            asm volatile("" ::: "memory");
        }
    }
};

constexpr int MERGE_DPM = 192;
struct MergeOrder : StaticOrder {
    __host__ __device__ bool next(int i, Unit& u) const {
        if (!StaticOrder::next(i >> 1, u)) return false;
        if (i & 1) { u.pm += MERGE_DPM; u.pn += 4; }
        return true;
    }
};
struct EpiMergeAB {
    static constexpr bool PERM = true, AFTER_DRAIN = false;
    const bf16_t* GATE; bf16_t* MERGED;
    __device__ __forceinline__ void operator()(const f32x4 (&acc)[2][2][4][2], const Unit& u, int wr, int wc, int fr, int fq) const {
        if (u.pn < 4) { EpiMerge<0> E{GATE, MERGED}; E(acc, u, wr, wc, fr, fq); }
        else { Unit v; v.pm = u.pm - MERGE_DPM; v.pn = u.pn - 4; EpiMerge<1> E{GATE, MERGED}; E(acc, v, wr, wc, fr, fq); }
    }
};
struct QueryOrder {
    int v, G, ntask;
    __host__ __device__ bool next(int i, Unit& u) const { const int tk = v + (i >> 1) * G; if (tk >= ntask) return false; u.pm = 2 * (tk >> 3) + (i & 1); u.pn = tk & 7; return true; }
    __device__ __forceinline__ void a_ready(const Unit&) const {}
    __device__ __forceinline__ void done(const Unit&) const {}
};

struct EpiProjI8 {
    static constexpr bool PERM = true, AFTER_DRAIN = false;
    bf16_t* QKVUV; size_t tstride; bf16_t* GATE; float qscale; const float* sA; const float* sB;
    template <int ACT> __device__ __forceinline__ void body(const f32x4 (&acc)[2][2][4][2], bf16_t* base, int ldc, int row0, int col0, int bcol0, float sc) const {
        f32x4 sb[2][2];
#pragma unroll
        for (int bj = 0; bj < 2; ++bj)
#pragma unroll
            for (int n = 0; n < 2; ++n) sb[bj][n] = *(const f32x4*)(sB + bcol0 + bj * HALF + 4 * n);
#pragma unroll
        for (int ai = 0; ai < 2; ++ai)
#pragma unroll
            for (int m = 0; m < 4; ++m) { const int row = row0 + ai * HALF + m * 16; bf16_t* rowp = base + (size_t)row * ldc + col0; const float sa = sA[row];
#pragma unroll
                for (int bj = 0; bj < 2; ++bj) {
                    typedef int i32x4_t __attribute__((ext_vector_type(4)));
                    const i32x4_t i0 = __builtin_bit_cast(i32x4_t, acc[ai][bj][m][0]), i1 = __builtin_bit_cast(i32x4_t, acc[ai][bj][m][1]);
                    const f32x4 f0 = (f32x4){(float)i0[0], (float)i0[1], (float)i0[2], (float)i0[3]} * sb[bj][0] * sa, f1 = (f32x4){(float)i1[0], (float)i1[1], (float)i1[2], (float)i1[3]} * sb[bj][1] * sa;
                    const f32x4 v0 = act4<ACT>(f0, sc), v1 = act4<ACT>(f1, sc);
                    u32x4 w; w.x = cvt_pk_bf16(v0[0], v0[1]); w.y = cvt_pk_bf16(v0[2], v0[3]); w.z = cvt_pk_bf16(v1[0], v1[1]); w.w = cvt_pk_bf16(v1[2], v1[3]);
                    *(u32x4*)(rowp + bj * HALF) = w; } }
    }
    __device__ __forceinline__ void operator()(const f32x4 (&acc)[2][2][4][2], const Unit& u, int wr, int wc, int fr, int fq) const {
        const int row0 = u.pm * BM + wr * 64 + fr, pn = u.pn, bcol0 = pn * BM + wc * 32 + 8 * fq;
        if (pn < 10) { bf16_t* base = QKVUV + (size_t)(pn >> 1) * tstride; const int col0 = (pn & 1) * BM + wc * 32 + 8 * fq;
            if (pn < 6) body<0>(acc, base, 512, row0, col0, bcol0, pn < 2 ? qscale : 1.0f); else body<2>(acc, base, 512, row0, col0, bcol0, 1.0f); }
        else body<3>(acc, GATE, 2048, row0, (pn - 10) * BM + wc * 32 + 8 * fq, bcol0, 1.0f);
    }
};

struct EpiBf16I8 {
    static constexpr bool PERM = true, AFTER_DRAIN = false;
    bf16_t* O; int ldc; const float* sA; const float* sB;
    __device__ __forceinline__ void operator()(const f32x4 (&acc)[2][2][4][2], const Unit& u, int wr, int wc, int fr, int fq) const {
        typedef int i32x4_t __attribute__((ext_vector_type(4)));
        const int row0 = u.pm * BM + wr * 64 + fr, col0 = u.pn * BM + wc * 32 + 8 * fq;
        f32x4 sb[2][2];
#pragma unroll
        for (int bj = 0; bj < 2; ++bj)
#pragma unroll
            for (int n = 0; n < 2; ++n) sb[bj][n] = *(const f32x4*)(sB + col0 + bj * HALF + 4 * n);
#pragma unroll
        for (int ai = 0; ai < 2; ++ai)
#pragma unroll
            for (int m = 0; m < 4; ++m) { const int row = row0 + ai * HALF + m * 16; bf16_t* rowp = O + (size_t)row * ldc + col0; const float sa = sA[row];
#pragma unroll
                for (int bj = 0; bj < 2; ++bj) {
                    const i32x4_t i0 = __builtin_bit_cast(i32x4_t, acc[ai][bj][m][0]), i1 = __builtin_bit_cast(i32x4_t, acc[ai][bj][m][1]);
                    const f32x4 v0 = (f32x4){(float)i0[0], (float)i0[1], (float)i0[2], (float)i0[3]} * sb[bj][0] * sa, v1 = (f32x4){(float)i1[0], (float)i1[1], (float)i1[2], (float)i1[3]} * sb[bj][1] * sa;
                    u32x4 w; w.x = cvt_pk_bf16(v0[0], v0[1]); w.y = cvt_pk_bf16(v0[2], v0[3]); w.z = cvt_pk_bf16(v1[0], v1[1]); w.w = cvt_pk_bf16(v1[2], v1[3]);
                    *(u32x4*)(rowp + bj * HALF) = w; } }
    }
};
template <class Epi, class Sched, bool ALIGN_EPI = false, bool SP2 = false, bool I8 = false>
__device__ __forceinline__ void gemm_phase(PG8_LAS unsigned char* lds, const Gemm g, const Sched& S, const Epi& E) {
    typedef int i32x4_t __attribute__((ext_vector_type(4)));
    int tid = threadIdx.x; asm volatile("" : "+v"(tid));
    const int wid = __builtin_amdgcn_readfirstlane(tid >> 6), lane = tid & 63, wr = wid >> 2, wc = wid & 3, fr = lane & 15, fq = lane >> 4;
    const int K = g.K, nt = K / BK;
    unsigned voffA[2], voffB[2];
#pragma unroll
    for (int i = 0; i < 2; ++i) { int R, C; stage_rc(tid * 16 + i * 8192, R, C); const int Rb = Epi::PERM ? ((R & ~31) + perm32(R & 31)) : R;
        voffA[i] = (unsigned)(R * K + C) * 2u; voffB[i] = (unsigned)(Rb * K + C) * 2u; }
    const size_t kstep = (size_t)(BK * 2);
    const size_t hstep = (size_t)HALF * K * 2;
    const size_t tstep = 2 * hstep;
    const unsigned ldsw = (unsigned)wid * 1024u;
    const int aoff = lds_byte(wr * 64 + fr, fq * 8), boff = lds_byte(wc * 32 + fr, fq * 8);
#define PG8_SA(b, h) (((b) * 2 + (h)) * HTB)
#define PG8_SB(b, h) ((4 + (b) * 2 + (h)) * HTB)
#define PG8_STAGE(bufoff, gbase, voff) do { _Pragma("unroll") for (int _i = 0; _i < 2; ++_i) \
        __builtin_amdgcn_global_load_lds((const unsigned*)((const char*)(gbase) + (voff)[_i]), (PG8_LAS unsigned*)(lds + (bufoff) + ldsw + _i * 8192), 16, 0, 0); } while (0)
#define PG8_LDA(dst, b, h) do { _Pragma("unroll") for (int m = 0; m < 4; ++m) _Pragma("unroll") for (int k = 0; k < 2; ++k) dst[m][k] = *(const PG8_LAS bf16x8*)(lds + PG8_SA(b, h) + aoff + m * 2048 + k * 1024); } while (0)
#define PG8_LDB(dst, b, h) do { _Pragma("unroll") for (int n = 0; n < 2; ++n) _Pragma("unroll") for (int k = 0; k < 2; ++k) dst[n][k] = *(const PG8_LAS bf16x8*)(lds + PG8_SB(b, h) + boff + n * 2048 + k * 1024); } while (0)
#define PG8_MMA(ai, bj, At, Bt) do { __builtin_amdgcn_s_setprio(1); _Pragma("unroll") for (int m = 0; m < 4; ++m) _Pragma("unroll") for (int n = 0; n < 2; ++n) _Pragma("unroll") for (int k = 0; k < 2; ++k) \
        { if constexpr (I8) acc[ai][bj][m][n] = __builtin_bit_cast(f32x4, __builtin_amdgcn_mfma_i32_16x16x64_i8(__builtin_bit_cast(i32x4_t, Bt[n][k]), __builtin_bit_cast(i32x4_t, At[m][k]), __builtin_bit_cast(i32x4_t, acc[ai][bj][m][n]), 0, 0, 0)); \
          else acc[ai][bj][m][n] = __builtin_amdgcn_mfma_f32_16x16x32_bf16(Bt[n][k], At[m][k], acc[ai][bj][m][n], 0, 0, 0); } __builtin_amdgcn_s_setprio(0); } while (0)
#define PG8_WAIT_V(n) asm volatile("s_waitcnt vmcnt(" #n ")" ::: "memory")
#define PG8_WAIT_L(n) asm volatile("s_waitcnt lgkmcnt(" #n ")" ::: "memory")
#define PG8_BAR __builtin_amdgcn_s_barrier()
#define PG8_SCHED __builtin_amdgcn_sched_barrier(0)
    Unit cur, nxt; int ui = 0;
    if (!S.next(0, cur)) return;
    f32x4 acc[2][2][4][2];
#pragma unroll
    for (int a = 0; a < 2; ++a)
#pragma unroll
        for (int b = 0; b < 2; ++b)
#pragma unroll
            for (int m = 0; m < 4; ++m)
#pragma unroll
                for (int n = 0; n < 2; ++n) acc[a][b][m][n] = (f32x4){0.f, 0.f, 0.f, 0.f};
    bf16x8 At[4][2], B0[2][2], B1[2][2];
    const char* cA = (const char*)g.A + (size_t)cur.pm * tstep; const char* cB = (const char*)g.Bt + (size_t)cur.pn * tstep;
    S.a_ready(cur);
    if constexpr (SP2) {
        PG8_STAGE(PG8_SB(0, 0), cB, voffB); PG8_STAGE(PG8_SB(0, 1), cB + hstep, voffB); PG8_STAGE(PG8_SA(0, 0), cA, voffA); PG8_STAGE(PG8_SA(0, 1), cA + hstep, voffA);
        if (wr == 1) PG8_BAR;
        PG8_WAIT_V(2); PG8_BAR;
        PG8_STAGE(PG8_SB(1, 0), cB + kstep, voffB); PG8_STAGE(PG8_SA(1, 0), cA + kstep, voffA); PG8_STAGE(PG8_SB(1, 1), cB + hstep + kstep, voffB);
        PG8_WAIT_V(6); PG8_BAR;
    } else {
        PG8_STAGE(PG8_SB(0, 0), cB, voffB); PG8_STAGE(PG8_SA(0, 0), cA, voffA); PG8_STAGE(PG8_SB(0, 1), cB + hstep, voffB); PG8_STAGE(PG8_SA(0, 1), cA + hstep, voffA);
        if (wr == 1) PG8_BAR;
        PG8_WAIT_V(4); PG8_BAR;
        PG8_STAGE(PG8_SB(1, 0), cB + kstep, voffB); PG8_STAGE(PG8_SA(1, 0), cA + kstep, voffA); PG8_STAGE(PG8_SB(1, 1), cB + hstep + kstep, voffB);
        PG8_WAIT_V(6); PG8_BAR;
    }
    for (;;) {
        const bool has_next = S.next(ui + 1, nxt);
        const char* nA = has_next ? (const char*)g.A + (size_t)nxt.pm * tstep : cA; const char* nB = has_next ? (const char*)g.Bt + (size_t)nxt.pn * tstep : cB;
        for (int t = 0; t < nt; t += 2) {
            const bool last = (t == nt - 2);
            const char* a1 = cA + (size_t)(t + 1) * kstep;
            const char* a2 = last ? nA : cA + (size_t)(t + 2) * kstep; const char* b2 = last ? nB : cB + (size_t)(t + 2) * kstep;
            const char* a3 = a2 + kstep; const char* b3 = b2 + kstep;
            if (last && has_next) S.a_ready(nxt);
            if constexpr (SP2) {
            PG8_LDB(B0, 0, 0); PG8_LDB(B1, 0, 1); PG8_SCHED; PG8_LDA(At, 0, 0); PG8_STAGE(PG8_SA(1, 1), a1 + hstep, voffA);
            PG8_WAIT_V(8); PG8_WAIT_L(0); PG8_BAR; PG8_MMA(0, 0, At, B0); PG8_MMA(0, 1, At, B1); PG8_BAR; PG8_SCHED;
            PG8_LDA(At, 0, 1); PG8_STAGE(PG8_SB(0, 0), b2, voffB); PG8_STAGE(PG8_SB(0, 1), b2 + hstep, voffB); PG8_STAGE(PG8_SA(0, 0), a2, voffA);
            PG8_WAIT_V(8); PG8_WAIT_L(0); PG8_BAR; PG8_MMA(1, 0, At, B0); PG8_MMA(1, 1, At, B1); PG8_BAR; PG8_SCHED;
            PG8_LDB(B0, 1, 0); PG8_LDB(B1, 1, 1); PG8_SCHED; PG8_LDA(At, 1, 0); PG8_STAGE(PG8_SA(0, 1), a2 + hstep, voffA);
            PG8_WAIT_V(8); PG8_WAIT_L(0); PG8_BAR; PG8_MMA(0, 0, At, B0); PG8_MMA(0, 1, At, B1); PG8_BAR; PG8_SCHED;
            PG8_LDA(At, 1, 1); PG8_STAGE(PG8_SB(1, 0), b3, voffB); PG8_STAGE(PG8_SB(1, 1), b3 + hstep, voffB); PG8_STAGE(PG8_SA(1, 0), a3, voffA);
            PG8_WAIT_V(8); PG8_WAIT_L(0); PG8_BAR; PG8_MMA(1, 0, At, B0); PG8_MMA(1, 1, At, B1); PG8_BAR; PG8_SCHED;
            } else {
            PG8_LDB(B0, 0, 0); PG8_SCHED; PG8_LDA(At, 0, 0); PG8_STAGE(PG8_SA(1, 1), a1 + hstep, voffA);
            PG8_WAIT_L(8); PG8_BAR; PG8_WAIT_L(0); PG8_MMA(0, 0, At, B0); PG8_BAR; PG8_SCHED;
            PG8_LDB(B1, 0, 1); PG8_STAGE(PG8_SB(0, 0), b2, voffB);
            PG8_BAR; PG8_WAIT_L(0); PG8_MMA(0, 1, At, B1); PG8_BAR;
            PG8_LDA(At, 0, 1); PG8_STAGE(PG8_SA(0, 0), a2, voffA);
            PG8_BAR; PG8_WAIT_L(0); PG8_MMA(1, 0, At, B0); PG8_BAR; PG8_SCHED;
            PG8_STAGE(PG8_SB(0, 1), b2 + hstep, voffB);
            PG8_WAIT_V(6); PG8_BAR; PG8_MMA(1, 1, At, B1); PG8_BAR;
            PG8_LDB(B0, 1, 0); PG8_SCHED; PG8_LDA(At, 1, 0); PG8_STAGE(PG8_SA(0, 1), a2 + hstep, voffA);
            PG8_WAIT_L(8); PG8_BAR; PG8_WAIT_L(0); PG8_MMA(0, 0, At, B0); PG8_BAR; PG8_SCHED;
            PG8_LDB(B1, 1, 1); PG8_STAGE(PG8_SB(1, 0), b3, voffB);
            PG8_BAR; PG8_WAIT_L(0); PG8_MMA(0, 1, At, B1); PG8_BAR;
            PG8_LDA(At, 1, 1); PG8_STAGE(PG8_SA(1, 0), a3, voffA);
            PG8_BAR; PG8_WAIT_L(0); PG8_MMA(1, 0, At, B0); PG8_BAR; PG8_SCHED;
            PG8_STAGE(PG8_SB(1, 1), b3 + hstep, voffB);
            PG8_WAIT_V(6); PG8_BAR; PG8_MMA(1, 1, At, B1); PG8_BAR;
            }
        }
        if constexpr (ALIGN_EPI) { if (wr == 0) PG8_BAR; }
        if constexpr (!Epi::AFTER_DRAIN) { E(acc, cur, wr, wc, fr, fq); S.done(cur); }
        if (!has_next) break;
#pragma unroll
        for (int a = 0; a < 2; ++a)
#pragma unroll
            for (int b = 0; b < 2; ++b)
#pragma unroll
                for (int m = 0; m < 4; ++m)
#pragma unroll
                    for (int n = 0; n < 2; ++n) acc[a][b][m][n] = (f32x4){0.f, 0.f, 0.f, 0.f};
        cur = nxt; cA = nA; cB = nB; ++ui;
        if constexpr (ALIGN_EPI) { if (wr == 1) PG8_BAR; }
    }
    PG8_WAIT_V(0);
    if constexpr (!ALIGN_EPI) { if (wr == 0) PG8_BAR; }
    PG8_BAR;
    if constexpr (Epi::AFTER_DRAIN) { E.fused(acc, cur, wr, wc, fr, fq, lds, wid, lane); S.done(cur); }
#undef PG8_SA
#undef PG8_SB
#undef PG8_STAGE
#undef PG8_LDA
#undef PG8_LDB
#undef PG8_MMA
#undef PG8_WAIT_V
#undef PG8_WAIT_L
#undef PG8_BAR
#undef PG8_SCHED
}
}
#include <hip/hip_bf16.h>
#include <cmath>
namespace attn_body {
using bf16=__hip_bfloat16;
using bf16x8=__attribute__((ext_vector_type(8)))short;
using s16x4=__attribute__((ext_vector_type(4)))short;
using f32x16=__attribute__((ext_vector_type(16)))float;
using u32x4=__attribute__((ext_vector_type(4)))unsigned;
constexpr int BATCH=8,NHEAD=8,SEQ=2048,D=64,DM=NHEAD*D;
constexpr int NW=8,QBLK=32,QB=QBLK*NW,KVBLK=64,NQB=SEQ/QB;
constexpr int ATTN_PITCH=DM, ATTN_UNIT_ROWS=QB;
__device__ __forceinline__ int crow(int r,int hi){return (r&3)+8*(r>>2)+4*hi;}
#define SBAR() __builtin_amdgcn_sched_barrier(0)
__device__ __forceinline__ void cmask(f32x16&p0,f32x16&p1,int jb,int qrel,int hi){
  const float NEG=-INFINITY; int kb=64*jb+4*hi;
  #pragma unroll
  for(int r=0;r<16;++r){int kv=kb+(r&3)+8*(r>>2); if(kv>qrel)p0[r]=NEG; if(kv+32>qrel)p1[r]=NEG;}
}

constexpr int NSLOT=3, SLOTB=8192;
constexpr int LDS_K=0, LDS_V=NSLOT*SLOTB, LDS_WS=2*NSLOT*SLOTB, LDS_OST=LDS_WS+NW*64*4, LDS_CS=LDS_OST+NW*4096, LDS_BYTES=LDS_CS+SEQ*4;
constexpr float C2=0.125f*1.4426950408889634f;
__device__ __forceinline__ void glds16(const void*gsrc,unsigned lds_dst){unsigned keep;
  asm volatile("s_mov_b32 %0, m0\n\ts_mov_b32 m0, %2\n\ts_nop 0\n\tglobal_load_lds_dwordx4 %1, off\n\ts_mov_b32 m0, %0":"=&s"(keep):"v"(gsrc),"s"(lds_dst):"memory");}
__device__ __forceinline__ float max3f(float a,float b,float c){float r;asm("v_max3_f32 %0, %1, %2, %3":"=v"(r):"v"(a),"v"(b),"v"(c));return r;}
__device__ __forceinline__ float max2f(float a,float b){float r;asm("v_max_f32_e32 %0, %1, %2":"=v"(r):"v"(a),"v"(b));return r;}
__device__ __forceinline__ float fadd_s(float a,float b){float r;asm("v_add_f32_e32 %0, %1, %2":"=v"(r):"v"(a),"v"(b));return r;}
__device__ __forceinline__ float fsub_s(float a,float b){float r;asm("v_sub_f32_e32 %0, %1, %2":"=v"(r):"v"(a),"v"(b));return r;}
typedef float f32x2_t __attribute__((ext_vector_type(2))); typedef __bf16 bf16x2_t __attribute__((ext_vector_type(2)));
__device__ __forceinline__ unsigned cvtpk_s(float lo,float hi){f32x2_t v={lo,hi};bf16x2_t b=__builtin_convertvector(v,bf16x2_t);return __builtin_bit_cast(unsigned,b);}
#define WAIT_BAR(N) asm volatile("s_waitcnt vmcnt(" #N ") lgkmcnt(0)\n\ts_barrier":::"memory")

__device__ __forceinline__ void qkt(f32x16&p0,f32x16&p1,const char*Kslot,const bf16x8*qr,int r32,int hi){
  const char*kb=Kslot+hi*1024+r32*16;
  #pragma unroll
  for(int d0=0;d0<4;++d0){
    const bf16x8 b0=*reinterpret_cast<const bf16x8*>(kb+d0*2048);
    const bf16x8 b1=*reinterpret_cast<const bf16x8*>(kb+d0*2048+512);
    p0=__builtin_amdgcn_mfma_f32_32x32x16_bf16(b0,qr[d0],p0,0,0,0);p1=__builtin_amdgcn_mfma_f32_32x32x16_bf16(b1,qr[d0],p1,0,0,0);}
}
typedef __attribute__((address_space(3))) const char* lds_cptr;
typedef short v4i16_t __attribute__((ext_vector_type(4)));
__device__ __forceinline__ void kload8(bf16x8*kf,lds_cptr kp){
  kf[0]=*(const __attribute__((address_space(3))) bf16x8*)(kp);      kf[1]=*(const __attribute__((address_space(3))) bf16x8*)(kp+512);
  kf[2]=*(const __attribute__((address_space(3))) bf16x8*)(kp+2048); kf[3]=*(const __attribute__((address_space(3))) bf16x8*)(kp+2560);
  kf[4]=*(const __attribute__((address_space(3))) bf16x8*)(kp+4096); kf[5]=*(const __attribute__((address_space(3))) bf16x8*)(kp+4608);
  kf[6]=*(const __attribute__((address_space(3))) bf16x8*)(kp+6144); kf[7]=*(const __attribute__((address_space(3))) bf16x8*)(kp+6656);
}
__device__ __forceinline__ void kload2(bf16x8*kf,lds_cptr kp,int j){ kf[2*j]=*(const __attribute__((address_space(3))) bf16x8*)(kp+j*2048); kf[2*j+1]=*(const __attribute__((address_space(3))) bf16x8*)(kp+j*2048+512); }
__device__ __forceinline__ s16x4 vtr(lds_cptr p){ return __builtin_bit_cast(s16x4,__builtin_amdgcn_ds_read_tr16_b64_v4i16((__attribute__((address_space(3))) v4i16_t*)p)); }
__device__ __forceinline__ float rowmax(const f32x16&p0,const f32x16&p1){
  float a=max3f(p0[0],p0[1],p1[0]),b=max3f(p0[2],p0[3],p1[1]);a=max3f(a,p1[2],p1[3]);
  #pragma unroll
  for(int r=4;r<16;r+=4){a=max3f(a,p0[r],p0[r+1]);b=max3f(b,p0[r+2],p0[r+3]);a=max3f(a,p1[r],p1[r+1]);b=max3f(b,p1[r+2],p1[r+3]);}
  const float m=max2f(a,b);
  auto rr=__builtin_amdgcn_permlane32_swap(__float_as_uint(m),__float_as_uint(m),false,false);
  return max2f(__uint_as_float(rr[0]),__uint_as_float(rr[1]));
}
__device__ __forceinline__ void pv(f32x16*o,int vb,bf16x8 pa0,bf16x8 pa1,bf16x8 pa2,bf16x8 pa3){
  #pragma unroll
  for(int d0=0;d0<2;++d0){s16x4 lo[4],hi[4];
    #pragma unroll
    for(int ks=0;ks<4;++ks){
      asm volatile("ds_read_b64_tr_b16 %0,%1 offset:%c2":"=&v"(lo[ks]):"v"(vb),"i"(d0*4096+ks*1024):"memory");
      asm volatile("ds_read_b64_tr_b16 %0,%1 offset:%c2":"=&v"(hi[ks]):"v"(vb),"i"(d0*4096+ks*1024+512):"memory");}
    asm volatile("s_waitcnt lgkmcnt(0)":::"memory");SBAR();
    #define PK(k) (bf16x8){lo[k][0],lo[k][1],lo[k][2],lo[k][3],hi[k][0],hi[k][1],hi[k][2],hi[k][3]}
    o[d0]=__builtin_amdgcn_mfma_f32_32x32x16_bf16(pa0,PK(0),o[d0],0,0,0);
    o[d0]=__builtin_amdgcn_mfma_f32_32x32x16_bf16(pa1,PK(1),o[d0],0,0,0);
    o[d0]=__builtin_amdgcn_mfma_f32_32x32x16_bf16(pa2,PK(2),o[d0],0,0,0);
    o[d0]=__builtin_amdgcn_mfma_f32_32x32x16_bf16(pa3,PK(3),o[d0],0,0,0);
    #undef PK
  }
}

#ifndef ATTN_STORE16
#define ATTN_STORE16(p,v) (*(u32x4*)(p)=(v))
#endif
template<int THRL> __device__ __forceinline__ void attn_unit(int b,int h,int qb,const bf16*Q,const bf16*__restrict__ K,const bf16*__restrict__ V,bf16*O,const float*__restrict__ CL2,char*shm,int t0=0){
  int tid=threadIdx.x; asm volatile("":"+v"(tid)); const int lane=tid&63,r32=lane&31,hi=lane>>5; const int wid=__builtin_amdgcn_readfirstlane(tid>>6);
  const long rowbase=(long)b*SEQ; const int q0=qb*QB;
  const bf16*Qw=Q+(rowbase+q0+wid*QBLK)*DM+h*D;
  const bf16*Kh=K+rowbase*DM+h*D,*Vh=V+rowbase*DM+h*D;
  const unsigned lds0=(unsigned)(uintptr_t)shm;
  float*wsf=(float*)(shm+LDS_WS)+wid*64;
  const bf16*ksrc=Kh+(long)(t0*KVBLK+lane)*DM+wid*8;
  const bf16*vsrc=Vh+(long)(t0*KVBLK+16*(wid&3)+(lane>>2))*DM+(wid>>2)*32+(lane&3)*8;
  const unsigned kdst=lds0+LDS_K+wid*1024, vdst=lds0+LDS_V+wid*1024;
  #define DMA_K(t,slot) glds16(ksrc+(long)(t)*KVBLK*DM,(unsigned)__builtin_amdgcn_readfirstlane(kdst+(slot)))
  #define DMA_V(t,slot) glds16(vsrc+(long)(t)*KVBLK*DM,(unsigned)__builtin_amdgcn_readfirstlane(vdst+(slot)))
  const int vb0=(int)(lds0+LDS_V)+((lane>>4)&1)*32+(lane&3)*8+(4*hi+((lane&15)>>2))*64;
  const char*Kbase=shm+LDS_K; bf16x8 kf[8];
  const lds_cptr shm3=(lds_cptr)shm; const lds_cptr kp0=shm3+LDS_K+hi*1024+r32*16; const lds_cptr vp0=shm3+LDS_V+((lane>>4)&1)*32+(lane&3)*8+(4*hi+((lane&15)>>2))*64;
  const int NT=(q0+QB)/KVBLK-t0;
  DMA_K(0,0);DMA_V(0,0);DMA_K(1,SLOTB);
  bf16x8 qr[4];
  #pragma unroll
  for(int d0=0;d0<4;++d0)qr[d0]=*reinterpret_cast<const bf16x8*>(&Qw[(long)r32*DM+d0*16+hi*8]);
  const float*cg=CL2+(long)(b*NHEAD+h)*SEQ;
  { float*csf=(float*)(shm+LDS_CS); for(int i=tid;i<q0+QB;i+=NW*64)csf[i]=cg[i]; }
  const lds_cptr cs3=(lds_cptr)shm+LDS_CS+hi*16+t0*256;
  float nm=cg[q0+wid*QBLK+r32],l_reg=0.f;f32x16 o[2];o[0]=f32x16{};o[1]=f32x16{};
  const int qrel=wid*QBLK+r32;
  #define CMASK(P0,P1,t) do{int jb_=(t)-(NT-4); if(jb_>=0)cmask(P0,P1,jb_,qrel,hi);}while(0)
  bool resc=false;
  typedef float f32x4_t __attribute__((ext_vector_type(4)));
  #define BIAS(C0,C1,t) do{ const lds_cptr cp_=cs3+(t)*256; \
    _Pragma("unroll") for(int g_=0;g_<4;++g_){ const f32x4_t a_=*(const __attribute__((address_space(3))) f32x4_t*)(cp_+g_*32), b_=*(const __attribute__((address_space(3))) f32x4_t*)(cp_+g_*32+128); \
      _Pragma("unroll") for(int i_=0;i_<4;++i_){ C0[4*g_+i_]=nm-a_[i_]; C1[4*g_+i_]=nm-b_[i_]; } } }while(0)
  #define START(P0,P1) do{ const float rm=rowmax(P0,P1); resc=false; \
    { const float dl=(rm>(float)THRL)?rm:0.f;     \
      nm=fsub_s(nm,dl); \
      _Pragma("unroll") for(int r=0;r<16;++r){P0[r]=fsub_s(P0[r],dl);P1[r]=fsub_s(P1[r],dl);} } \
    _Pragma("unroll") for(int r=0;r<16;++r)P0[r]=__builtin_amdgcn_exp2f(P0[r]); }while(0)
  #define RESC() do{ if(resc){ asm volatile("s_waitcnt lgkmcnt(0)":::"memory"); \
      _Pragma("unroll") for(int d_=0;d_<2;++d_) _Pragma("unroll") for(int r=0;r<16;++r)o[d_][r]*=wsf[crow(r,hi)]; } }while(0)
  f32x16 pA0,pA1,pB0,pB1;
  int sl_prev=0,sl_cur=0,sl_next=SLOTB;
  #define ROT() do{sl_prev=sl_cur;sl_cur=sl_next;sl_next=(sl_next==(NSLOT-1)*SLOTB)?0:sl_next+SLOTB;}while(0)
  DMA_K(2,2*SLOTB);
  WAIT_BAR(3);
  BIAS(pA0,pA1,0); qkt(pA0,pA1,Kbase,qr,r32,hi);asm volatile("s_nop 15\n\ts_nop 7":"+v"(pA0),"+v"(pA1));CMASK(pA0,pA1,0);
  START(pA0,pA1);
  _Pragma("unroll") for(int r=0;r<16;++r)pA1[r]=__builtin_amdgcn_exp2f(pA1[r]);
  WAIT_BAR(0);
  DMA_K(3,0);DMA_V(1,SLOTB);
  ROT();
  kload8(kf,kp0+sl_cur);
  WAIT_BAR(2);
  s16x4 vlo[8],vhi[8]; u32x4 pw0,pw1,pw2,pw3;
  #define PKW(P,B) cvtpk_s(P[B],P[B+1])
  #define PAF(k) __builtin_bit_cast(bf16x8,pw##k)
  #define VFR(i) (bf16x8){vlo[i][0],vlo[i][1],vlo[i][2],vlo[i][3],vhi[i][0],vhi[i][1],vhi[i][2],vhi[i][3]}
  #define PIN(x) asm volatile("":"+v"(x))
  #define MX3(a,b,c) __builtin_fmaxf(__builtin_fmaxf((a),(b)),(c))
  #define GAPA(MF,A0,A1,A2,A3,W0,W1,PW) do{ MF; sacc+=A0; sacc+=A1; sacc+=A2; sacc+=A3; PIN(sacc); W0; W1; PIN(PW); SBAR(); }while(0)
  #define EX(v) __builtin_amdgcn_exp2f(v)
  #define GAPB(MF,X,B) do{ MF; X[B]=EX(X[B]); X[B+1]=EX(X[B+1]); X[B+2]=EX(X[B+2]); X[B+3]=EX(X[B+3]); PIN(X); SBAR(); }while(0)
  #define VRD(i) do{ vlo[i]=vtr(vp_+(((i)>>2)*4096+((i)&3)*1024)); vhi[i]=vtr(vp_+(((i)>>2)*4096+((i)&3)*1024+512)); }while(0)
  #define KRD(G,j) do{ if(G){ kload2(kf,kp0+sl_next,j); SBAR(); } }while(0)
  #define STEP(C0,C1,P0,P1,t,GK,GV,GL) do{ SBAR(); BIAS(C0,C1,t); SBAR(); \
    const lds_cptr vp_=vp0+sl_prev; \
    VRD(0); SBAR(); float sacc=(P0[0]+P0[1]); \
    GAPA(C0=__builtin_amdgcn_mfma_f32_32x32x16_bf16(kf[0],qr[0],C0,0,0,0), P0[2],P0[3],P0[4],P0[5],     pw0[0]=PKW(P0,0), pw0[1]=PKW(P0,2), pw0); \
    VRD(4); SBAR(); GAPA(C1=__builtin_amdgcn_mfma_f32_32x32x16_bf16(kf[1],qr[0],C1,0,0,0), P0[6],P0[7],P0[8],P0[9],     pw0[2]=PKW(P0,4), pw0[3]=PKW(P0,6), pw0); \
    VRD(1); SBAR(); GAPA(C0=__builtin_amdgcn_mfma_f32_32x32x16_bf16(kf[2],qr[1],C0,0,0,0),   P0[10],P0[11],P0[12],P0[13], pw1[0]=PKW(P0,8), pw1[1]=PKW(P0,10), pw1); \
    VRD(5); SBAR(); GAPA(C1=__builtin_amdgcn_mfma_f32_32x32x16_bf16(kf[3],qr[1],C1,0,0,0),   P0[14],P0[15],P1[0],P1[1],   pw1[2]=PKW(P0,12),pw1[3]=PKW(P0,14), pw1); \
    VRD(2); SBAR(); GAPA(C0=__builtin_amdgcn_mfma_f32_32x32x16_bf16(kf[4],qr[2],C0,0,0,0),   P1[2],P1[3],P1[4],P1[5],     pw2[0]=PKW(P1,0), pw2[1]=PKW(P1,2), pw2); \
    VRD(6); SBAR(); GAPA(C1=__builtin_amdgcn_mfma_f32_32x32x16_bf16(kf[5],qr[2],C1,0,0,0),   P1[6],P1[7],P1[8],P1[9],     pw2[2]=PKW(P1,4), pw2[3]=PKW(P1,6), pw2); \
    VRD(3); SBAR(); GAPA(C0=__builtin_amdgcn_mfma_f32_32x32x16_bf16(kf[6],qr[3],C0,0,0,0),   P1[10],P1[11],P1[12],P1[13], pw3[0]=PKW(P1,8), pw3[1]=PKW(P1,10), pw3); \
    VRD(7); SBAR(); GAPA(C1=__builtin_amdgcn_mfma_f32_32x32x16_bf16(kf[7],qr[3],C1,0,0,0),   P1[14],P1[15],0.f,0.f,       pw3[2]=PKW(P1,12),pw3[3]=PKW(P1,14), pw3); \
    l_reg+=sacc; \
    if(GK){DMA_K((t)+3,sl_cur);} if(GV){DMA_V((t)+1,sl_next);} \
    CMASK(C0,C1,t); \
    { float a=MX3(C0[0],C0[1],C1[0]),b=MX3(C0[2],C0[3],C1[1]); a=MX3(a,C1[2],C1[3]); \
      _Pragma("unroll") for(int r=4;r<16;r+=4){a=MX3(a,C0[r],C0[r+1]);b=MX3(b,C0[r+2],C0[r+3]);a=MX3(a,C1[r],C1[r+1]);b=MX3(b,C1[r+2],C1[r+3]);} \
      float rm=__builtin_fmaxf(a,b); { auto rr=__builtin_amdgcn_permlane32_swap(__float_as_uint(rm),__float_as_uint(rm),false,false); rm=__builtin_fmaxf(__uint_as_float(rr[0]),__uint_as_float(rr[1])); } \
      resc=false; \
      if(__builtin_expect(__any(rm>(float)THRL),0)){ const float dl=__builtin_fmaxf(rm,0.f); nm-=dl; \
        _Pragma("unroll") for(int r=0;r<16;++r){C0[r]-=dl;C1[r]-=dl;} \
        const float f=__builtin_amdgcn_exp2f(-dl); l_reg*=f; if(hi==0)wsf[r32]=f; resc=true; } } \
    SBAR(); \
    GAPB(o[0]=__builtin_amdgcn_mfma_f32_32x32x16_bf16(PAF(0),VFR(0),o[0],0,0,0), C0,0); \
    GAPB(o[1]=__builtin_amdgcn_mfma_f32_32x32x16_bf16(PAF(0),VFR(4),o[1],0,0,0), C0,4); \
    KRD(GL,0); GAPB(o[0]=__builtin_amdgcn_mfma_f32_32x32x16_bf16(PAF(1),VFR(1),o[0],0,0,0), C0,8); \
    KRD(GL,1); GAPB(o[1]=__builtin_amdgcn_mfma_f32_32x32x16_bf16(PAF(1),VFR(5),o[1],0,0,0), C0,12); \
    KRD(GL,2); GAPB(o[0]=__builtin_amdgcn_mfma_f32_32x32x16_bf16(PAF(2),VFR(2),o[0],0,0,0), C1,0); \
    KRD(GL,3); GAPB(o[1]=__builtin_amdgcn_mfma_f32_32x32x16_bf16(PAF(2),VFR(6),o[1],0,0,0), C1,4); \
    GAPB(o[0]=__builtin_amdgcn_mfma_f32_32x32x16_bf16(PAF(3),VFR(3),o[0],0,0,0), C1,8); \
    GAPB(o[1]=__builtin_amdgcn_mfma_f32_32x32x16_bf16(PAF(3),VFR(7),o[1],0,0,0), C1,12); \
    }while(0)
  int t=1;
  #undef CMASK
  #define CMASK(P0,P1,t) do{}while(0)
  for(;t+5<NT;t+=2){
    STEP(pB0,pB1,pA0,pA1,t,true,true,true);     WAIT_BAR(2); RESC(); ROT();
    STEP(pA0,pA1,pB0,pB1,t+1,true,true,true);   WAIT_BAR(2); RESC(); ROT();
  }
  #undef CMASK
  #define CMASK(P0,P1,t) do{int jb_=(t)-(NT-4); if(jb_>=0)cmask(P0,P1,jb_,qrel,hi);}while(0)
  #define ENDW(tt) do{ if((tt)+3<NT){WAIT_BAR(2);} else if((tt)+2<NT){WAIT_BAR(1);} else {WAIT_BAR(0);} }while(0)
  for(;t+1<NT;t+=2){
    STEP(pB0,pB1,pA0,pA1,t,(t+3<NT),(t+1<NT),(t+1<NT));       ENDW(t);   RESC(); ROT();
    STEP(pA0,pA1,pB0,pB1,t+1,(t+4<NT),(t+2<NT),(t+2<NT));     ENDW(t+1); RESC(); ROT();
  }
  STEP(pB0,pB1,pA0,pA1,NT-1,false,false,false); RESC();
  { float sacc=pB0[0]+pB0[1]; _Pragma("unroll") for(int r=2;r<16;++r)sacc+=pB0[r]; _Pragma("unroll") for(int r=0;r<16;++r)sacc+=pB1[r]; l_reg+=sacc;
    pw0=(u32x4){PKW(pB0,0),PKW(pB0,2),PKW(pB0,4),PKW(pB0,6)};pw1=(u32x4){PKW(pB0,8),PKW(pB0,10),PKW(pB0,12),PKW(pB0,14)};pw2=(u32x4){PKW(pB1,0),PKW(pB1,2),PKW(pB1,4),PKW(pB1,6)};pw3=(u32x4){PKW(pB1,8),PKW(pB1,10),PKW(pB1,12),PKW(pB1,14)};
    SBAR(); pv(o,vb0+sl_cur,PAF(0),PAF(1),PAF(2),PAF(3)); }
  #undef PKW
  #undef PAF
  #undef VFR
  #undef PIN
  #undef MX3
  #undef GAPA
  #undef GAPB
  #undef EX
  #undef VRD
  #undef KRD
  #undef STEP
  #undef ENDW
  {auto rr=__builtin_amdgcn_permlane32_swap(__float_as_uint(l_reg),__float_as_uint(l_reg),false,false);l_reg=__uint_as_float(rr[0])+__uint_as_float(rr[1]);}
  if(hi==0)wsf[32+r32]=l_reg;asm volatile("s_waitcnt lgkmcnt(0)":::"memory");
  float rli[16];
  #pragma unroll
  for(int r=0;r<16;++r)rli[r]=__builtin_amdgcn_rcpf(wsf[32+crow(r,hi)]);
  bf16*Ow=O+(rowbase+q0+wid*QBLK)*DM+h*D;
  { bf16*stg=(bf16*)(shm+LDS_OST)+wid*2048;
    #pragma unroll
    for(int r=0;r<16;++r){const int orow=crow(r,hi);
      #pragma unroll
      for(int d0=0;d0<2;++d0)stg[orow*64+d0*32+r32]=__float2bfloat16(o[d0][r]*rli[r]);}
    asm volatile("s_waitcnt lgkmcnt(0)":::"memory");
    #pragma unroll
    for(int i=0;i<4;++i){const int row=i*8+(lane>>3),ch=lane&7; const u32x4 v=*(const u32x4*)(stg+row*64+ch*8); ATTN_STORE16(Ow+(long)row*DM+ch*8,v);} }
  asm volatile("s_waitcnt lgkmcnt(0)\n\ts_barrier":::"memory");
  #undef DMA_K
  #undef DMA_V
  #undef CMASK
  #undef START
  #undef RESC
  #undef ROT
  #undef BIAS
}
constexpr int ATTN_LDS_BYTES=LDS_BYTES;
constexpr float SKIP_THR=64.0f;
__device__ __forceinline__ int attn_first_tile(const float*__restrict__ CL2,int bh,int qb){
  const int lane=threadIdx.x&63; const float*c=CL2+(long)bh*SEQ; const int q0=qb*QB, nfar=4*qb;
  const float cq=c[q0]; const float cj=c[(lane<nfar?lane:0)*KVBLK+KVBLK-1];
  const unsigned long long keep=__ballot(lane<nfar && (cq-cj)>=-SKIP_THR) | (1ull<<nfar);
  const int t0=__builtin_ctzll(keep)&~1;
  return __builtin_amdgcn_readfirstlane(t0);
}
struct AttnTensors { const bf16* Q; const bf16* K; const bf16* V; bf16* O; const float* CL2; };
struct AttnUnit { int bh; int qb; };
struct StaticOrder {
  int vcu;
  __device__ __forceinline__ explicit StaticOrder(int grid,int block):vcu((block%8)*(grid/8)+block/8){}
  __device__ __forceinline__ bool next(int i,AttnUnit&u)const{ if(i>=2||vcu>=BATCH*NHEAD*4)return false; const int s=vcu&3; u.bh=vcu>>2; u.qb=(i==0)?s:7-s; return true; }
  __device__ __forceinline__ void a_ready(const AttnUnit&)const{}
  __device__ __forceinline__ void done(const AttnUnit&)const{}
};
template<class Sched,int THRL=8> __device__ __forceinline__ void attn_phase(char*lds,const AttnTensors&T,const Sched&S){
  AttnUnit u;
  for(int i=0;S.next(i,u);++i){ S.a_ready(u); attn_unit<THRL>(u.bh/NHEAD,u.bh%NHEAD,u.qb,T.Q,T.K,T.V,T.O,T.CL2,lds); S.done(u); }
}
#undef SBAR
#undef WAIT_BAR
}
namespace sgu_body {
using attn_body::bf16x8; using attn_body::s16x4; using attn_body::f32x16; using attn_body::u32x4; using attn_body::lds_cptr; using attn_body::vtr;
constexpr int SGU_LDS_BYTES = 65536;
__device__ __forceinline__ float bflo(unsigned w) { return __uint_as_float(w << 16); }
__device__ __forceinline__ float bfhi(unsigned w) { return __uint_as_float(w & 0xffff0000u); }
__device__ __forceinline__ void sgu_unit(int ck, int half, const unsigned short* __restrict__ VG, const unsigned short* UGI, unsigned short* UGY, const unsigned short* __restrict__ WSMP,
                                         const float* __restrict__ lng, const float* __restrict__ lnb, const float* __restrict__ bs, char* shm) {
    int tid = threadIdx.x; asm volatile("" : "+v"(tid)); const int lane = tid & 63, r32 = lane & 31, hi = lane >> 5; const int wid = __builtin_amdgcn_readfirstlane(tid >> 6);
    const size_t row0 = (size_t)ck * 128;
    u32x4 raw[16];
#pragma unroll
    for (int i = 0; i < 16; ++i) raw[i] = *(const u32x4*)(VG + (row0 + 16 * wid + i) * 512 + 8 * lane);
    float mu[16], rs[16];
#pragma unroll
    for (int i = 0; i < 16; ++i) {
        const float a0 = bflo(raw[i].x), a1 = bfhi(raw[i].x), a2 = bflo(raw[i].y), a3 = bfhi(raw[i].y), a4 = bflo(raw[i].z), a5 = bfhi(raw[i].z), a6 = bflo(raw[i].w), a7 = bfhi(raw[i].w);
        float s = ((a0 + a1) + (a2 + a3)) + ((a4 + a5) + (a6 + a7));
        float q = ((a0 * a0 + a1 * a1) + (a2 * a2 + a3 * a3)) + ((a4 * a4 + a5 * a5) + (a6 * a6 + a7 * a7));
        s = wave_allsum(s); q = wave_allsum(q);
        const float m = s * (1.0f / 512.0f); const float var = fmaxf(q * (1.0f / 512.0f) - m * m, 0.f);
        mu[i] = m; rs[i] = 1.0f / sqrtf(var + 1e-6f);
    }
    if ((lane >> 5) == half) {
        const int gl = (lane >> 3) & 3, cc = 8 * (lane & 7);
        float gv[8], bv[8];
#pragma unroll
        for (int j = 0; j < 8; ++j) { gv[j] = lng[8 * lane + j]; bv[j] = lnb[8 * lane + j]; }
        char* img = shm + gl * 16384 + (cc >> 5) * 4096 + (cc & 31) * 2;
#pragma unroll
        for (int i = 0; i < 16; ++i) {
            const int s = 16 * wid + i;
            const float m = mu[i], r = rs[i];
            const float v0 = (bflo(raw[i].x) - m) * r * gv[0] + bv[0], v1 = (bfhi(raw[i].x) - m) * r * gv[1] + bv[1], v2 = (bflo(raw[i].y) - m) * r * gv[2] + bv[2], v3 = (bfhi(raw[i].y) - m) * r * gv[3] + bv[3];
            const float v4 = (bflo(raw[i].z) - m) * r * gv[4] + bv[4], v5 = (bfhi(raw[i].z) - m) * r * gv[5] + bv[5], v6 = (bflo(raw[i].w) - m) * r * gv[6] + bv[6], v7 = (bfhi(raw[i].w) - m) * r * gv[7] + bv[7];
            u32x4 w; w.x = pg8::cvt_pk_bf16(v0, v1); w.y = pg8::cvt_pk_bf16(v2, v3); w.z = pg8::cvt_pk_bf16(v4, v5); w.w = pg8::cvt_pk_bf16(v6, v7);
            *(u32x4*)(img + (s >> 6) * 8192 + ((s & 63) >> 4) * 1024 + (s & 15) * 64) = w;
        }
    }
    typedef unsigned u32x2_t __attribute__((ext_vector_type(2)));
    const int gl4 = wid >> 1, cb4 = wid & 1, g4 = 4 * half + gl4;
    bf16x8 wf[20]; u32x2_t ugq[4][4]; float bsq[4];
#pragma unroll
    for (int tb = 0; tb < 4; ++tb) {
        const unsigned short* wrow = WSMP + ((size_t)(g4 * 128 + 32 * tb + r32)) * 128 + 8 * hi;
#pragma unroll
        for (int ks = 0; ks < 2 * (tb + 1); ++ks) wf[tb * (tb + 1) + ks] = *(const bf16x8*)(wrow + 16 * ks);
        const int t = 32 * tb + r32; bsq[tb] = bs[g4 * 128 + t];
        const unsigned short* urow = UGI + (row0 + t) * 512 + g4 * 64 + 32 * cb4 + 4 * hi;
#pragma unroll
        for (int q4 = 0; q4 < 4; ++q4) ugq[tb][q4] = *(const u32x2_t*)(urow + 8 * q4);
    }
    __syncthreads();
    {
        const int gl = gl4, cb = cb4, g = g4;
        const lds_cptr vp = (lds_cptr)shm + gl * 16384 + cb * 4096 + ((lane >> 4) & 1) * 32 + (lane & 3) * 8 + (4 * hi + ((lane & 15) >> 2)) * 64;
#pragma unroll
        for (int tb = 0; tb < 4; ++tb) {
            f32x16 acc = f32x16{};
#pragma unroll
            for (int ks = 0; ks < 2 * (tb + 1); ++ks) {
                const s16x4 lo = vtr(vp + (ks >> 2) * 8192 + (ks & 3) * 1024), hh = vtr(vp + (ks >> 2) * 8192 + (ks & 3) * 1024 + 512);
                const bf16x8 a = (bf16x8){lo[0], lo[1], lo[2], lo[3], hh[0], hh[1], hh[2], hh[3]};
                acc = __builtin_amdgcn_mfma_f32_32x32x16_bf16(a, wf[tb * (tb + 1) + ks], acc, 0, 0, 0);
            }
            const int t = 32 * tb + r32; const float bsv = bsq[tb];
            unsigned short* yrow = UGY + (row0 + t) * 512 + g * 64 + 32 * cb + 4 * hi;
#pragma unroll
            for (int q4 = 0; q4 < 4; ++q4) {
                const u32x2_t ug = ugq[tb][q4];
                const float y0 = bflo(ug.x) * (acc[4 * q4 + 0] + bsv), y1 = bfhi(ug.x) * (acc[4 * q4 + 1] + bsv), y2 = bflo(ug.y) * (acc[4 * q4 + 2] + bsv), y3 = bfhi(ug.y) * (acc[4 * q4 + 3] + bsv);
                u32x2_t w; w.x = pg8::cvt_pk_bf16(y0, y1); w.y = pg8::cvt_pk_bf16(y2, y3);
                *(u32x2_t*)(yrow + 8 * q4) = w;
            }
        }
    }
    __syncthreads();
}
}
namespace peer_body {
using attn_body::bf16x8; using attn_body::f32x16; using attn_body::u32x4;
typedef __bf16 bf16x2_t __attribute__((ext_vector_type(2)));
constexpr int PEER_TOK = 64;
constexpr int L_PI = 0, L_PG = 32768, L_PS = 65536, PEER_LDS_BYTES = 98304;
__device__ __forceinline__ int okey(int b) { return b ^ ((b >> 31) & 0x7fffffff); }
__device__ __forceinline__ void ce(int& a, int& b) { const int hi = a > b ? a : b, lo = a > b ? b : a; a = hi; b = lo; }
__device__ __forceinline__ void sort16(int (&v)[16]) {
#pragma unroll
    for (int k = 2; k <= 16; k <<= 1)
#pragma unroll
        for (int j = k >> 1; j > 0; j >>= 1)
#pragma unroll
            for (int i = 0; i < 16; ++i) { const int l = i ^ j; if (l > i) { if ((i & k) == 0) ce(v[i], v[l]); else ce(v[l], v[i]); } }
}
__device__ __forceinline__ void merge16(int (&a)[16], const int (&b)[16]) {
#pragma unroll
    for (int i = 0; i < 16; ++i) a[i] = a[i] > b[15 - i] ? a[i] : b[15 - i];
#pragma unroll
    for (int j = 8; j > 0; j >>= 1)
#pragma unroll
        for (int i = 0; i < 16; ++i) { const int l = i ^ j; if (l > i) ce(a[i], a[l]); }
}
__device__ __forceinline__ float dot2(unsigned w, unsigned x, float acc) { return __builtin_amdgcn_fdot2_f32_bf16(__builtin_bit_cast(bf16x2_t, w), __builtin_bit_cast(bf16x2_t, x), acc, false); }
__device__ __forceinline__ float gelu_erf(float v) { return 0.5f * v * (1.0f + erff(v * 0.70710678118654752f)); }

constexpr int SK_PITCH = 272;
__device__ __forceinline__ void top16_scores(int (&res)[16], const bf16x8 (&bq)[8], const char* SKl, int r32, int hi) {
    f32x16 acc[4];
#pragma unroll
    for (int nb = 0; nb < 4; ++nb) acc[nb] = f32x16{};
#pragma unroll
    for (int ks = 0; ks < 8; ++ks) {
#pragma unroll
        for (int nb = 0; nb < 4; ++nb) { const bf16x8 a = *(const bf16x8*)(SKl + (32 * nb + r32) * SK_PITCH + (16 * ks + 8 * hi) * 2);
            acc[nb] = __builtin_amdgcn_mfma_f32_32x32x16_bf16(a, bq[ks], acc[nb], 0, 0, 0); }
        if (ks & 1) __builtin_amdgcn_sched_barrier(0);
    }
    int k[4][16];
#pragma unroll
    for (int nb = 0; nb < 4; ++nb) {
#pragma unroll
        for (int r = 0; r < 16; ++r) { const int n = 32 * nb + (r & 3) + 8 * (r >> 2) + 4 * hi; k[nb][r] = okey((int)((__float_as_uint(acc[nb][r]) & ~0x7fu) | (unsigned)n)); }
        sort16(k[nb]);
    }
    merge16(k[0], k[1]); merge16(k[2], k[3]); merge16(k[0], k[2]);
    int lo[16], up[16];
#pragma unroll
    for (int i = 0; i < 16; ++i) { const auto rr = __builtin_amdgcn_permlane32_swap((unsigned)k[0][i], (unsigned)k[0][i], false, false); lo[i] = (int)rr[0]; up[i] = (int)rr[1]; }
    merge16(lo, up);
#pragma unroll
    for (int i = 0; i < 16; ++i) res[i] = lo[i];
}

__device__ __forceinline__ unsigned pack_i8x4(float a, float b, float c, float d) {
    const int ia = (int)__builtin_rintf(a), ib = (int)__builtin_rintf(b), ic = (int)__builtin_rintf(c), id = (int)__builtin_rintf(d);
    return (unsigned)(ia & 0xff) | ((unsigned)(ib & 0xff) << 8) | ((unsigned)(ic & 0xff) << 16) | ((unsigned)(id & 0xff) << 24);
}
typedef float f32x2_t __attribute__((ext_vector_type(2)));
typedef unsigned u32x2_t __attribute__((ext_vector_type(2)));
__device__ __forceinline__ void fma_fp8x4(f32x2_t& a01, f32x2_t& a23, unsigned v, f32x2_t w2) {
    const f32x2_t lo = __builtin_amdgcn_cvt_pk_f32_fp8((int)v, false), hi = __builtin_amdgcn_cvt_pk_f32_fp8((int)v, true);
    a01 = __builtin_elementwise_fma(lo, w2, a01); a23 = __builtin_elementwise_fma(hi, w2, a23);
}
template <int CTRL> __device__ __forceinline__ int dppi(int v) { return __builtin_amdgcn_update_dpp(0, v, CTRL, 0xf, 0xf, false); }
template <int CTRL> __device__ __forceinline__ float dppf(float v) { return __int_as_float(__builtin_amdgcn_update_dpp(0, __float_as_int(v), CTRL, 0xf, 0xf, false)); }
constexpr int DPP_HMIRROR = 0x141, DPP_XOR2 = 0x4E, DPP_XOR1 = 0xB1, DPP_ROR8 = 0x128;

__device__ __forceinline__ void peer_retrieve(int tk, const unsigned short* __restrict__ QP, const unsigned short* __restrict__ SK, const float* __restrict__ SU, const float* __restrict__ SV,
                                              const float* __restrict__ ST, unsigned short* __restrict__ PID, float* __restrict__ G2, float* __restrict__ PS2, char* shm) {
    int tid = threadIdx.x; asm volatile("" : "+v"(tid)); const int lane = tid & 63, r32 = lane & 31, hi = lane >> 5; const int wid = __builtin_amdgcn_readfirstlane(tid >> 6);
    const int h = tk & 7, T0 = (tk >> 3) * 512 + 64 * wid;
    {   const u32x4* src = (const u32x4*)(SK + (size_t)h * 2 * 128 * 128);
#pragma unroll
        for (int i = 0; i < 8; ++i) { const int c = tid + 512 * i, row = c >> 4, ch = c & 15; *(u32x4*)(shm + row * SK_PITCH + ch * 16) = src[c]; }
    }
    __syncthreads();
#pragma unroll 1
    for (int tb = 0; tb < 2; ++tb) {
        const unsigned short* QPt = QP + (size_t)(T0 + 32 * tb) * 2048 + h * 256;
        int A[16], B[16];
        bf16x8 bqa[8], bqb[8];
#pragma unroll
        for (int ks = 0; ks < 8; ++ks) { bqa[ks] = *(const bf16x8*)(QPt + (size_t)r32 * 2048 + 16 * ks + 8 * hi); bqb[ks] = *(const bf16x8*)(QPt + 128 + (size_t)r32 * 2048 + 16 * ks + 8 * hi); }
        top16_scores(A, bqa, shm, r32, hi);
        top16_scores(B, bqb, shm + 128 * SK_PITCH, r32, hi);
        float fa[16], fb[16]; int na[16], nb[16];
#pragma unroll
        for (int i = 0; i < 16; ++i) { const int ba = okey(A[i]), bb = okey(B[i]); fa[i] = __int_as_float(ba); fb[i] = __int_as_float(bb); na[i] = (ba & 0x7f) << 7; nb[i] = bb & 0x7f; }
#define CAND(i, j) okey((int)((__float_as_uint(fa[i] + fb[j]) & ~0x3fffu) | (unsigned)(na[i] | nb[j])))
        const int NEGK = (int)0x80000000;
        int L0[16], L1[16], L2[16], L3[16];
#pragma unroll
        for (int j = 0; j < 16; ++j) L0[j] = CAND(0, j);
#pragma unroll
        for (int j = 0; j < 8; ++j) L1[j] = CAND(1, j);
#pragma unroll
        for (int j = 0; j < 5; ++j) L1[8 + j] = CAND(2, j);
#pragma unroll
        for (int j = 0; j < 3; ++j) L1[13 + j] = CAND(3, j);
        L2[0] = CAND(3, 3);
#pragma unroll
        for (int j = 0; j < 3; ++j) L2[1 + j] = CAND(4, j);
#pragma unroll
        for (int j = 0; j < 2; ++j) { L2[4 + j] = CAND(5, j); L2[6 + j] = CAND(6, j); L2[8 + j] = CAND(7, j); }
#pragma unroll
        for (int i = 8; i < 14; ++i) L2[2 + i] = CAND(i, 0);
        L3[0] = CAND(14, 0); L3[1] = CAND(15, 0);
#pragma unroll
        for (int i = 2; i < 16; ++i) L3[i] = NEGK;
#undef CAND
        sort16(L1); sort16(L2); sort16(L3);
        merge16(L0, L1); merge16(L2, L3); merge16(L0, L2);
        float e[16]; int id[16]; float se = 0.f;
        const float s0 = __int_as_float((okey(L0[0]) & ~0x3fff) | 0x2000);
#pragma unroll
        for (int i = 0; i < 16; ++i) { const int b = okey(L0[i]); id[i] = b & 0x3fff; const float s = __int_as_float((b & ~0x3fff) | 0x2000); e[i] = __expf(s - s0); se += e[i]; }
        const float inv = 1.0f / se;
        if (hi == 0) {
            const size_t t = (size_t)(T0 + 32 * tb + r32); const float st = ST[t];
            unsigned short* pi = PID + t * 128 + h * 16; float* pg = G2 + t * 128 + h * 16; float* ps = PS2 + t * 128 + h * 16;
            u32x4 w0, w1;
            w0.x = (unsigned)id[0] | ((unsigned)id[1] << 16); w0.y = (unsigned)id[2] | ((unsigned)id[3] << 16); w0.z = (unsigned)id[4] | ((unsigned)id[5] << 16); w0.w = (unsigned)id[6] | ((unsigned)id[7] << 16);
            w1.x = (unsigned)id[8] | ((unsigned)id[9] << 16); w1.y = (unsigned)id[10] | ((unsigned)id[11] << 16); w1.z = (unsigned)id[12] | ((unsigned)id[13] << 16); w1.w = (unsigned)id[14] | ((unsigned)id[15] << 16);
            *(u32x4*)pi = w0; *(u32x4*)(pi + 8) = w1;
            float sv[16], su[16];
#pragma unroll
            for (int i = 0; i < 16; ++i) { sv[i] = SV[id[i]]; su[i] = SU[id[i]]; }
            asm volatile("" ::: "memory");
#pragma unroll
            for (int i = 0; i < 16; i += 4) {
                *(float4*)(pg + i) = make_float4(e[i] * inv * sv[i], e[i + 1] * inv * sv[i + 1], e[i + 2] * inv * sv[i + 2], e[i + 3] * inv * sv[i + 3]);
                *(float4*)(ps + i) = make_float4(su[i] * st, su[i + 1] * st, su[i + 2] * st, su[i + 3] * st); }
        }
    }
    __syncthreads();
}

__device__ __forceinline__ void peer_fused(int p, int wq, int nwq, const unsigned short* __restrict__ PID, const float* __restrict__ G2, const float* __restrict__ PS2, const unsigned char* __restrict__ H2Q,
                                           const unsigned char* __restrict__ EU8, const unsigned char* __restrict__ EV8, float* X, const float* __restrict__ gfin, char* shm, float oscale) {
    int tid = threadIdx.x; asm volatile("" : "+v"(tid)); const int lane = tid & 63, g = lane >> 3, r = lane & 7; const int wid = __builtin_amdgcn_readfirstlane(tid >> 6);
    char* wl = shm + wid * 12288;
    int2* aul = (int2*)(wl + 4096) + lane; float* ssl = (float*)(wl + 8192) + lane; float* swl = (float*)(wl + 3072);
    const int k0 = 8 * (r >> 2) + 4 * ((r >> 1) & 1) + 2 * (r & 1);
    const int e0 = 8 * ((g >> 2) & 1) + 4 * ((g >> 1) & 1) + 2 * (g & 1);
    constexpr size_t SLICE = (size_t)16384 * 128;
#define FIDS(i, I0, I1) do { const u32x4* ip_ = (const u32x4*)(wl + (i) * 256 + 32 * g); I0 = ip_[0]; I1 = ip_[1]; } while (0)
#define FLOAD(R, base, I0, I1) do { _Pragma("unroll") for (int k_ = 0; k_ < 16; ++k_) { const unsigned w_ = (k_ < 8) ? I0[k_ >> 1] : I1[(k_ - 8) >> 1]; const unsigned e_ = (k_ & 1) ? (w_ >> 16) : (w_ & 0xffffu); \
        R[k_] = *(const u32x4*)((base) + (size_t)e_ * 128); } } while (0)
#define FUMATH(R, HQ, ACC) do { int s[16]; \
        _Pragma("unroll") for (int k_ = 0; k_ < 16; ++k_) { int d_ = __builtin_amdgcn_sdot4((int)R[k_].x, (int)HQ.x, 0, false); d_ = __builtin_amdgcn_sdot4((int)R[k_].y, (int)HQ.y, d_, false); \
            d_ = __builtin_amdgcn_sdot4((int)R[k_].z, (int)HQ.z, d_, false); d_ = __builtin_amdgcn_sdot4((int)R[k_].w, (int)HQ.w, d_, false); s[k_] = d_; } \
        _Pragma("unroll") for (int h_ = 0; h_ < 8; ++h_) { const int t1 = s[h_] + dppi<DPP_HMIRROR>(s[h_]), t2 = s[h_ + 8] + dppi<DPP_HMIRROR>(s[h_ + 8]); s[h_] = (r & 4) ? t2 : t1; } \
        _Pragma("unroll") for (int h_ = 0; h_ < 4; ++h_) { const int t1 = s[h_] + dppi<DPP_XOR2>(s[h_]), t2 = s[h_ + 4] + dppi<DPP_XOR2>(s[h_ + 4]); s[h_] = (r & 2) ? t2 : t1; } \
        _Pragma("unroll") for (int h_ = 0; h_ < 2; ++h_) { const int t1 = s[h_] + dppi<DPP_XOR1>(s[h_]), t2 = s[h_ + 2] + dppi<DPP_XOR1>(s[h_ + 2]); s[h_] = (r & 1) ? t2 : t1; } \
        { const int2 o_ = ACC; ACC = make_int2(o_.x + s[0], o_.y + s[1]); } } while (0)
#define FVMATH(R, W, XP, XV, SWV, SSQ, VALID) do { int acc[16]; _Pragma("unroll") for (int i_ = 0; i_ < 16; ++i_) acc[i_] = 0; \
        _Pragma("unroll") for (int m_ = 0; m_ < 4; ++m_) { const int wm_ = (int)W[m_]; \
            _Pragma("unroll") for (int c_ = 0; c_ < 4; ++c_) { \
                const unsigned r0_ = R[4 * m_ + 0][c_], r1_ = R[4 * m_ + 1][c_], r2_ = R[4 * m_ + 2][c_], r3_ = R[4 * m_ + 3][c_]; \
                const unsigned t0_ = __builtin_amdgcn_perm(r1_, r0_, 0x05010400u), t1_ = __builtin_amdgcn_perm(r1_, r0_, 0x07030602u); \
                const unsigned t2_ = __builtin_amdgcn_perm(r3_, r2_, 0x05010400u), t3_ = __builtin_amdgcn_perm(r3_, r2_, 0x07030602u); \
                acc[4 * c_ + 0] = __builtin_amdgcn_sdot4((int)__builtin_amdgcn_perm(t2_, t0_, 0x05040100u), wm_, acc[4 * c_ + 0], false); \
                acc[4 * c_ + 1] = __builtin_amdgcn_sdot4((int)__builtin_amdgcn_perm(t2_, t0_, 0x07060302u), wm_, acc[4 * c_ + 1], false); \
                acc[4 * c_ + 2] = __builtin_amdgcn_sdot4((int)__builtin_amdgcn_perm(t3_, t1_, 0x05040100u), wm_, acc[4 * c_ + 2], false); \
                acc[4 * c_ + 3] = __builtin_amdgcn_sdot4((int)__builtin_amdgcn_perm(t3_, t1_, 0x07060302u), wm_, acc[4 * c_ + 3], false); } } \
          \
        _Pragma("unroll") for (int h_ = 0; h_ < 8; ++h_) { const auto sw_ = __builtin_amdgcn_permlane32_swap((unsigned)acc[h_], (unsigned)acc[h_ + 8], false, false); acc[h_] = (int)sw_[0] + (int)sw_[1]; } \
        _Pragma("unroll") for (int h_ = 0; h_ < 4; ++h_) { const auto sw_ = __builtin_amdgcn_permlane16_swap((unsigned)acc[h_], (unsigned)acc[h_ + 4], false, false); acc[h_] = (int)sw_[0] + (int)sw_[1]; } \
        _Pragma("unroll") for (int h_ = 0; h_ < 2; ++h_) { const int t1 = acc[h_] + dppi<DPP_ROR8>(acc[h_]), t2 = acc[h_ + 2] + dppi<DPP_ROR8>(acc[h_ + 2]); acc[h_] = (lane & 8) ? t2 : t1; } \
        const float2 xv = XV; const float o0 = xv.x + SWV * (float)acc[0], o1 = xv.y + SWV * (float)acc[1]; \
        if (VALID) *(float2*)(XP) = make_float2(o0, o1); SSQ += o0 * o0 + o1 * o1; } while (0)
    const int TEND = (p + 1) * (M / 8);
#pragma unroll 1
    for (int tb = p * (M / 8) + wq; tb < TEND; tb += 8 * nwq) {
#define TOK(i) ((tb + (i) * nwq) < TEND ? (tb + (i) * nwq) : tb)
#pragma unroll
        for (int i = 0; i < 8; ++i) ((unsigned*)(wl + i * 256))[lane] = ((const unsigned*)(PID + (size_t)TOK(i) * 128))[lane];
#ifndef RPU
#define RPU 1
#endif
        for (int rpu_ = 0; rpu_ < RPU; ++rpu_) {
#pragma unroll
        for (int i = 0; i < 8; ++i) aul[64 * i] = make_int2(0, 0);
        {
            u32x4 RA[16], RB[16], i0, i1, hqa, hqb;
            { const int sl = p & 7; FIDS(0, i0, i1); hqa = *(const u32x4*)(H2Q + ((size_t)sl * M + TOK(0)) * 128 + r * 16); FLOAD(RA, EU8 + sl * SLICE + r * 16, i0, i1); }
#pragma unroll 1
            for (int st = 0; st < 8; ++st) {
                const int sl = (p + st) & 7, sln = (p + st + 1) & 7; const unsigned char* ub = EU8 + sl * SLICE + r * 16; const unsigned char* hb = H2Q + (size_t)sl * M * 128 + r * 16;
#pragma unroll 1
                for (int i = 0; i < 8; i += 2) {
                    FIDS(i + 1, i0, i1); hqb = *(const u32x4*)(hb + (size_t)TOK(i + 1) * 128); FLOAD(RB, ub, i0, i1);
                    FUMATH(RA, hqa, aul[64 * i]);
                    {
                        const bool last = (i == 6); const int in_ = last ? 0 : i + 2; const int sx = last ? sln : sl;
                        FIDS(in_, i0, i1); hqa = *(const u32x4*)(H2Q + ((size_t)sx * M + TOK(in_)) * 128 + r * 16); FLOAD(RA, EU8 + sx * SLICE + r * 16, i0, i1); }
                    FUMATH(RB, hqb, aul[64 * (i + 1)]);
                }
            }
        }
        }
        float2 g2q[8], psq[8];
#pragma unroll
        for (int i = 0; i < 8; ++i) { const size_t o = (size_t)TOK(i) * 128 + 16 * g + k0; g2q[i] = *(const float2*)(G2 + o); psq[i] = *(const float2*)(PS2 + o); }
#pragma unroll
        for (int i = 0; i < 8; ++i) {
            const float2 g2 = g2q[i], ps = psq[i]; const int2 av = aul[64 * i];
            const float w0 = g2.x * gelu_erf((float)av.x * ps.x), w1 = g2.y * gelu_erf((float)av.y * ps.y);
            float am = fmaxf(fabsf(w0), fabsf(w1));
            am = wave_allmax(am);
            const float qs = am > 0.f ? 127.0f / am : 0.f; if (lane == 0) swl[i] = am * (1.0f / 127.0f);
            const int b0 = (int)__builtin_rintf(w0 * qs) & 0xff, b1 = (int)__builtin_rintf(w1 * qs) & 0xff;
            *(unsigned short*)(wl + 2048 + i * 128 + 16 * g + k0) = (unsigned short)(b0 | (b1 << 8));
        }
#ifndef RPVV
#define RPVV 1
#endif
        for (int rpv_ = 0; rpv_ < RPVV; ++rpv_) {
        const bool vlast = (rpv_ == RPVV - 1);
#pragma unroll
        for (int i = 0; i < 8; ++i) ssl[64 * i] = 0.f;
        {
            u32x4 RA[16], RB[16], i0, i1; float2 xva, xvb;
            { const int sl = p & 7; FIDS(0, i0, i1); xva = *(const float2*)(X + (size_t)TOK(0) * 1024 + sl * 128 + 16 * r + e0); FLOAD(RA, EV8 + sl * SLICE + r * 16, i0, i1); }
#pragma unroll 1
            for (int st = 0; st < 8; ++st) {
                const int sl = (p + st) & 7, sln = (p + st + 1) & 7; const unsigned char* vb = EV8 + sl * SLICE + r * 16; float* xb = X + sl * 128 + 16 * r + e0;
#pragma unroll 1
                for (int i = 0; i < 8; i += 2) {
                    FIDS(i + 1, i0, i1); xvb = *(const float2*)(xb + (size_t)TOK(i + 1) * 1024); FLOAD(RB, vb, i0, i1);
                    { const u32x4 wv = *(const u32x4*)(wl + 2048 + i * 128 + 16 * g); const float sw_ = swl[i]; float sq_ = ssl[64 * i]; FVMATH(RA, wv, xb + (size_t)TOK(i) * 1024, xva, sw_, sq_, vlast && (tb + i * nwq) < TEND); ssl[64 * i] = sq_; }
                    { const bool last = (i == 6); const int in_ = last ? 0 : i + 2; const int sx = last ? sln : sl; FIDS(in_, i0, i1); xva = *(const float2*)(X + (size_t)TOK(in_) * 1024 + sx * 128 + 16 * r + e0); FLOAD(RA, EV8 + sx * SLICE + r * 16, i0, i1); }
                    { const u32x4 wv = *(const u32x4*)(wl + 2048 + (i + 1) * 128 + 16 * g); const float sw_ = swl[i + 1]; float sq_ = ssl[64 * (i + 1)]; FVMATH(RB, wv, xb + (size_t)TOK(i + 1) * 1024, xvb, sw_, sq_, vlast && (tb + (i + 1) * nwq) < TEND); ssl[64 * (i + 1)] = sq_; }
                }
            }
        }
        }
        float2 gg[8];
#pragma unroll
        for (int sl = 0; sl < 8; ++sl) gg[sl] = *(const float2*)(gfin + sl * 128 + 16 * r + e0);
#pragma unroll 1
        for (int i = 0; i < 8; i += 2) {
            const float rr0 = oscale / sqrtf(wave_allsum(ssl[64 * i]) * (1.0f / 1024.0f) + 1e-6f), rr1 = oscale / sqrtf(wave_allsum(ssl[64 * (i + 1)]) * (1.0f / 1024.0f) + 1e-6f);
            const bool v0 = (tb + i * nwq) < TEND, v1 = (tb + (i + 1) * nwq) < TEND;
            float* xr0 = X + (size_t)TOK(i) * 1024 + 16 * r + e0; float* xr1 = X + (size_t)TOK(i + 1) * 1024 + 16 * r + e0;
            float2 va[8], vb[8];
#pragma unroll
            for (int sl = 0; sl < 8; ++sl) { va[sl] = *(const float2*)(xr0 + sl * 128); vb[sl] = *(const float2*)(xr1 + sl * 128); }
            asm volatile("" ::: "memory");
#pragma unroll
            for (int sl = 0; sl < 8; ++sl) { if (v0) *(float2*)(xr0 + sl * 128) = make_float2(va[sl].x * rr0 * gg[sl].x, va[sl].y * rr0 * gg[sl].y);
                                             if (v1) *(float2*)(xr1 + sl * 128) = make_float2(vb[sl].x * rr1 * gg[sl].x, vb[sl].y * rr1 * gg[sl].y); }
        }
#undef TOK
    }
#undef FIDS
#undef FLOAD
#undef FUMATH
#undef FVMATH
}
}
#define GAS __attribute__((address_space(1)))
#define LAS __attribute__((address_space(3)))
typedef unsigned short bf16;
typedef unsigned v4u __attribute__((ext_vector_type(4)));
typedef float f32x4 __attribute__((ext_vector_type(4)));
typedef short bf16x8 __attribute__((ext_vector_type(8)));
typedef GAS unsigned gu32;
typedef GAS unsigned long long gu64;
#define RLX_AGENT __ATOMIC_RELAXED, __HIP_MEMORY_SCOPE_AGENT
#define LDS_WAIT() asm volatile("s_waitcnt lgkmcnt(0)" ::: "memory")
#define VM_WAIT() asm volatile("s_waitcnt vmcnt(0)" ::: "memory")
__device__ __forceinline__ unsigned long long rt() { return __builtin_amdgcn_s_memrealtime(); }
__device__ __forceinline__ unsigned f2bf(float f) { unsigned u = __builtin_bit_cast(unsigned, f); return (u + 0x7fffu + ((u >> 16) & 1u)) >> 16; }
__device__ __forceinline__ unsigned pk2(float lo, float hi) { return f2bf(lo) | (f2bf(hi) << 16); }

#define XB_TMO      128
#define XB_XCNT(j)  (256  + 64 * (j))
#define XB_XSUB(j)  (1280 + 64 * (j))
#define XB_XGEN(j)  (2304 + 64 * (j))
#define XB_TOP      3328
#define XB_TOPGEN   3392
#define XCD_BAR_WORDS 3456
#define XB_SPIN_CAP (1u << 18)

__device__ __forceinline__ unsigned xb_ld(unsigned* p)              { return __hip_atomic_load(p, __ATOMIC_RELAXED, __HIP_MEMORY_SCOPE_AGENT); }
__device__ __forceinline__ unsigned xb_add(unsigned* p, unsigned v) { return __hip_atomic_fetch_add(p, v, __ATOMIC_RELAXED, __HIP_MEMORY_SCOPE_AGENT); }
__device__ __forceinline__ unsigned xb_xcc_id() { return (unsigned)__builtin_amdgcn_s_getreg((3 << 11) | 20) & 0xFu; }
#define XB_SPIN(cond, bar) do { unsigned _sp = 0; while (cond) { __builtin_amdgcn_s_sleep(1); \
    if ((++_sp & 255u) == 0u) { if (xb_ld(&(bar)[XB_TMO])) break; if (_sp > XB_SPIN_CAP) { atomicAdd(&(bar)[XB_TMO], 1u); break; } } } } while (0)

struct XcdBarrier {
    unsigned* bar; unsigned x;
    volatile LAS unsigned* st;
};

__device__ __forceinline__ XcdBarrier xcd_barrier_post(unsigned* bar, volatile LAS unsigned* st) {
    XcdBarrier b; b.bar = bar; b.x = xb_xcc_id(); b.st = st;
    if (threadIdx.x == 0) (void)xb_add(&bar[XB_XCNT(b.x)], 1u);
    return b;
}
__device__ __forceinline__ void xcd_barrier_complete(unsigned* bar, unsigned x, unsigned& nloc, unsigned& nx) {
    const unsigned G = gridDim.x * gridDim.y * gridDim.z;
    unsigned sum, cnt, mine, sp = 0u;
    for (;;) {
        sum = 0u; cnt = 0u; mine = 0u;
#pragma unroll
        for (unsigned j = 0; j < 16; ++j) { const unsigned c = xb_ld(&bar[XB_XCNT(j)]); sum += c; cnt += (c > 0u) ? 1u : 0u; mine = (j == x) ? c : mine; }
        if (sum == G) break;
        __builtin_amdgcn_s_sleep(1);
        if ((++sp & 255u) == 0u) { if (xb_ld(&bar[XB_TMO])) break; if (sp > XB_SPIN_CAP) { atomicAdd(&bar[XB_TMO], 1u); break; } }
    }
    nloc = mine > 0u ? mine : 1u; nx = cnt > 0u ? cnt : 1u;
}

__device__ __forceinline__ void xcd_barrier(const XcdBarrier& b) {
    asm volatile("s_waitcnt vmcnt(0)" ::: "memory");
    __syncthreads();
    if (threadIdx.x == 0) {
        unsigned* bar = b.bar;
        __builtin_amdgcn_s_waitcnt(0);
        unsigned nloc = b.st[0], nx = b.st[1];
        if (nloc == 0u) { xcd_barrier_complete(bar, b.x, nloc, nx); b.st[0] = nloc; b.st[1] = nx; }
        const unsigned old = xb_add(&bar[XB_XSUB(b.x)], 1u);
        const unsigned gen = old / nloc;
        if (old + 1u == (gen + 1u) * nloc) {
            __builtin_amdgcn_fence(__ATOMIC_RELEASE, "agent");
            asm volatile("s_waitcnt vmcnt(0)" ::: "memory");
            const unsigned og = xb_add(&bar[XB_TOP], 1u);
            const unsigned tg = og / nx;
            if (og + 1u == (tg + 1u) * nx) xb_add(&bar[XB_TOPGEN], 1u);
            else XB_SPIN(xb_ld(&bar[XB_TOPGEN]) == tg, bar);
            __builtin_amdgcn_fence(__ATOMIC_ACQUIRE, "agent");
            xb_add(&bar[XB_XGEN(b.x)], 1u);
            asm volatile("s_waitcnt vmcnt(0)" ::: "memory");
        } else {
            XB_SPIN(xb_ld(&bar[XB_XGEN(b.x)]) == gen, bar);
            __builtin_amdgcn_fence(__ATOMIC_ACQUIRE, "agent");
            asm volatile("s_waitcnt vmcnt(0)" ::: "memory");
        }
    }
    __syncthreads();
}

typedef unsigned short bf16_t;
__device__ __forceinline__ float bf2f(bf16_t v) { return __uint_as_float((unsigned)v << 16); }
__device__ __forceinline__ float gelu_exact(float v) { return 0.5f * v * (1.0f + erff(v * 0.70710678118654752f)); }
__device__ __forceinline__ float log_sigmoid(float z) { return z > 0.f ? -log1pf(expf(-z)) : z - log1pf(expf(z)); }
__device__ __forceinline__ float wave_sum(float v) {
    return wave_allsum(v);
}
__device__ __forceinline__ float wave_max(float v) {
    return wave_allmax(v);
}

#ifndef RP7
#define RP7 1
#endif
#ifndef RP8
#define RP8 1
#endif
#ifndef RP9
#define RP9 1
#endif
#ifndef RP0
#define RP0 1
#endif
#ifndef RP1
#define RP1 1
#endif
#ifndef RP12
#define RP12 1
#endif
#ifndef RP3
#define RP3 1
#endif
#ifndef RP4
#define RP4 1
#endif
#ifndef RP5
#define RP5 1
#endif
#ifndef RP6
#define RP6 1
#endif
#ifndef CONV_P0_FROM
#define CONV_P0_FROM (2 * NEXP)
#endif
#ifndef CONV_SPLIT
#define CONV_SPLIT (NEXP / 2)
#endif
constexpr int NWAVES = 8;
constexpr int RING_OFF = 0, RING_BYTES = 131072;
constexpr int LDSCTL_OFF = RING_BYTES, MISC_OFF = LDSCTL_OFF + 320;
constexpr int LDS_BYTES = 147456;
constexpr int CW_BAR = 4096, CW_QUEUE = 3072, CW_CMAX = 8192, CMAX_WQ = 4864;
constexpr int N_PHASES = 9;

struct Args { const float* in[17]; float* out; unsigned char* ws; int ph_lo, ph_hi, li, pad; };

__device__ __forceinline__ void p0_transpose_item(const float* W, int ldw, int col0, int K, bf16* WT, int row0, LAS float* scr, int item, int nblk, int lane) {
    const int kb = item / nblk, nb = item % nblk, k0 = 64 * kb, n0 = 32 * nb;
    f32x4 v[8];
#pragma unroll
    for (int i = 0; i < 8; ++i) v[i] = *(const GAS f32x4*)(W + (size_t)(k0 + 8 * i + (lane >> 3)) * ldw + col0 + n0 + 4 * (lane & 7));
#pragma unroll
    for (int i = 0; i < 8; ++i) *(LAS f32x4*)(scr + (8 * i + (lane >> 3)) * 36 + 4 * (lane & 7)) = v[i];
    LDS_WAIT(); asm volatile("" ::: "memory");
    const int c = lane & 7;
#pragma unroll
    for (int j = 0; j < 4; ++j) { const int n = (lane >> 3) + 8 * j; const LAS float* s = scr + (8 * c) * 36 + n;
        v4u o; o.x = pg8::cvt_pk_bf16(s[0 * 36], s[1 * 36]); o.y = pg8::cvt_pk_bf16(s[2 * 36], s[3 * 36]); o.z = pg8::cvt_pk_bf16(s[4 * 36], s[5 * 36]); o.w = pg8::cvt_pk_bf16(s[6 * 36], s[7 * 36]);
        *(GAS v4u*)(WT + (size_t)(row0 + n0 + n) * K + k0 + 8 * c) = o; }
    LDS_WAIT(); asm volatile("" ::: "memory");
}
__device__ __forceinline__ void p0_transpose_item_i8(const float* W, int ldw, int col0, int K, unsigned char* WT8, float* sB, int row0, const unsigned* colmax, LAS float* scr, int item, int nblk, int lane) {
    const int kb = item / nblk, nb = item % nblk, k0 = 64 * kb, n0 = 32 * nb;
    f32x4 v[8];
#pragma unroll
    for (int i = 0; i < 8; ++i) v[i] = *(const GAS f32x4*)(W + (size_t)(k0 + 8 * i + (lane >> 3)) * ldw + col0 + n0 + 4 * (lane & 7));
#pragma unroll
    for (int i = 0; i < 8; ++i) *(LAS f32x4*)(scr + (8 * i + (lane >> 3)) * 36 + 4 * (lane & 7)) = v[i];
    LDS_WAIT(); asm volatile("" ::: "memory");
    const int c = lane & 3;
#pragma unroll
    for (int j = 0; j < 2; ++j) { const int n = (lane >> 2) + 16 * j; const LAS float* s = scr + (16 * c) * 36 + n;
        const float am = __uint_as_float(colmax[col0 + n0 + n]); const float qs = am > 0.f ? 127.0f / am : 0.f;
        v4u o;
        o.x = peer_body::pack_i8x4(s[0 * 36] * qs, s[1 * 36] * qs, s[2 * 36] * qs, s[3 * 36] * qs); o.y = peer_body::pack_i8x4(s[4 * 36] * qs, s[5 * 36] * qs, s[6 * 36] * qs, s[7 * 36] * qs);
        o.z = peer_body::pack_i8x4(s[8 * 36] * qs, s[9 * 36] * qs, s[10 * 36] * qs, s[11 * 36] * qs); o.w = peer_body::pack_i8x4(s[12 * 36] * qs, s[13 * 36] * qs, s[14 * 36] * qs, s[15 * 36] * qs);
        *(GAS v4u*)(WT8 + (size_t)(row0 + n0 + n) * K + k0 + 16 * c) = o;
        if (kb == 0 && c == 0) sB[row0 + n0 + n] = am * (1.0f / 127.0f); }
    LDS_WAIT(); asm volatile("" ::: "memory");
}
__device__ __forceinline__ void p0_colmax_task(const float* W, int ldw, int ncols, unsigned* colmax, int task, int lane) {
    const int ncb = (ncols + 255) / 256, cb = task % ncb, rb = task / ncb, c = 256 * cb + 4 * lane;
    if (c >= ncols) return;
    f32x4 m = (f32x4){0.f, 0.f, 0.f, 0.f};
#pragma unroll 8
    for (int i = 0; i < 32; ++i) { const f32x4 v = *(const GAS f32x4*)(W + (size_t)(32 * rb + i) * ldw + c);
        m.x = fmaxf(m.x, fabsf(v.x)); m.y = fmaxf(m.y, fabsf(v.y)); m.z = fmaxf(m.z, fabsf(v.z)); m.w = fmaxf(m.w, fabsf(v.w)); }
    atomicMax(colmax + c, __float_as_uint(m.x)); atomicMax(colmax + c + 1, __float_as_uint(m.y)); atomicMax(colmax + c + 2, __float_as_uint(m.z)); atomicMax(colmax + c + 3, __float_as_uint(m.w));
}
__device__ __forceinline__ void cvt_chunks(const float* src, bf16* dst, size_t nchunks, size_t gtid, size_t nthr) {
    for (size_t c = gtid; c < nchunks; c += nthr) { const f32x4 a = ((const GAS f32x4*)src)[2 * c], b = ((const GAS f32x4*)src)[2 * c + 1];
        v4u o; o.x = pg8::cvt_pk_bf16(a.x, a.y); o.y = pg8::cvt_pk_bf16(a.z, a.w); o.z = pg8::cvt_pk_bf16(b.x, b.y); o.w = pg8::cvt_pk_bf16(b.z, b.w);
        ((GAS v4u*)dst)[c] = o; }
}

__device__ __forceinline__ void convert_rows4(int e0, const float* eu, const float* ev, unsigned char* ws, int lane) {
                const bool isV = e0 >= NEXP; const int row0 = isV ? e0 - NEXP : e0;
                const float* tab = isV ? ev : eu;
                f32x4 v[4][4];
#pragma unroll
                for (int rr = 0; rr < 4; ++rr)
#pragma unroll
                    for (int i = 0; i < 4; ++i) v[rr][i] = __builtin_nontemporal_load((const GAS f32x4*)(tab + (size_t)(row0 + rr) * D + 16 * lane) + i);
#pragma unroll
                for (int rr = 0; rr < 4; ++rr) {
                    const int row = row0 + rr; float am = 0.f;
#pragma unroll
                    for (int i = 0; i < 4; ++i) am = fmaxf(fmaxf(am, fmaxf(fabsf(v[rr][i].x), fabsf(v[rr][i].y))), fmaxf(fabsf(v[rr][i].z), fabsf(v[rr][i].w)));
                    am = wave_allmax(am);
                    v4u q;
                    if (!isV) { const float inv = am > 0.f ? 127.0f / am : 0.f;
                        q.x = peer_body::pack_i8x4(v[rr][0].x * inv, v[rr][0].y * inv, v[rr][0].z * inv, v[rr][0].w * inv); q.y = peer_body::pack_i8x4(v[rr][1].x * inv, v[rr][1].y * inv, v[rr][1].z * inv, v[rr][1].w * inv);
                        q.z = peer_body::pack_i8x4(v[rr][2].x * inv, v[rr][2].y * inv, v[rr][2].z * inv, v[rr][2].w * inv); q.w = peer_body::pack_i8x4(v[rr][3].x * inv, v[rr][3].y * inv, v[rr][3].z * inv, v[rr][3].w * inv);
                        *(GAS v4u*)(ws + WS_EU + (size_t)(lane >> 3) * ((size_t)NEXP * 128) + (size_t)row * 128 + (lane & 7) * 16) = q; if (lane == 0) ((GAS float*)(ws + WS_SU))[row] = am * (1.0f / 127.0f); }
                    else { const float inv = am > 0.f ? 127.0f / am : 0.f;
                        q.x = peer_body::pack_i8x4(v[rr][0].x * inv, v[rr][0].y * inv, v[rr][0].z * inv, v[rr][0].w * inv); q.y = peer_body::pack_i8x4(v[rr][1].x * inv, v[rr][1].y * inv, v[rr][1].z * inv, v[rr][1].w * inv);
                        q.z = peer_body::pack_i8x4(v[rr][2].x * inv, v[rr][2].y * inv, v[rr][2].z * inv, v[rr][2].w * inv); q.w = peer_body::pack_i8x4(v[rr][3].x * inv, v[rr][3].y * inv, v[rr][3].z * inv, v[rr][3].w * inv);
                        *(GAS v4u*)(ws + WS_EV + (size_t)(lane >> 3) * ((size_t)NEXP * 128) + (size_t)row * 128 + (lane & 7) * 16) = q; if (lane == 0) ((GAS float*)(ws + WS_SV))[row] = am * (1.0f / 127.0f); }
                }
}

__global__ void __launch_bounds__(NWAVES * 64, 2) skel_fwd(Args args) {
    extern __shared__ __attribute__((aligned(16))) unsigned char lds[];
    LAS unsigned char* L = (LAS unsigned char*)lds;
    volatile LAS unsigned* MISC = (volatile LAS unsigned*)(L + MISC_OFF);
    const int G = gridDim.x; const int bx = blockIdx.x; const int vcu = (G % 8 == 0) ? (bx % 8) * (G / 8) + bx / 8 : bx;
    for (int u = threadIdx.x; u < (LDS_BYTES - LDSCTL_OFF) / 4; u += NWAVES * 64) ((LAS unsigned*)(L + LDSCTL_OFF))[u] = 0u;
    __syncthreads();
    (void)xcd_barrier_post((unsigned*)((gu32*)(args.ws + WS_CTL) + CW_BAR) + args.li * XCD_BAR_WORDS, MISC + 8);
#define PHASE_VARS \
    GAS unsigned char* wsg_ = (GAS unsigned char*)args.ws; asm volatile("" : "+s"(wsg_)); unsigned char* ws = (unsigned char*)wsg_; GAS float* outg_ = (GAS float*)args.out; asm volatile("" : "+s"(outg_)); float* out = (float*)outg_; \
    int tid = threadIdx.x; asm volatile("" : "+v"(tid)); const int lane = tid & 63, wave = __builtin_amdgcn_readfirstlane(tid >> 6); (void)lane; (void)wave; \
    gu32* ctl = (gu32*)(ws + WS_CTL); (void)ctl; const float* x = args.in[0]; (void)x; \
    bf16* XN = (bf16*)(ws + WS_XN); bf16* Qb = (bf16*)(ws + WS_Q); bf16* UG = (bf16*)(ws + WS_UG); (void)XN; (void)Qb; (void)UG; \
    bf16* GATE = (bf16*)out; bf16* MERGED = (bf16*)(ws + WS_MERGED); bf16* QP = (bf16*)(ws + WS_QP); (void)GATE; (void)MERGED; (void)QP; \
    float* LOGF = (float*)(ws + WS_LOGF); float* CL2 = (float*)(ws + WS_CL2); (void)LOGF; (void)CL2; \
    const int gw = vcu * NWAVES + wave, NGW = G * NWAVES; (void)gw; (void)NGW;
    const int lo = args.ph_lo, hi = args.ph_hi;
#ifndef PHMASK
#define PHMASK 0x1ff
#endif
#define IN(k) (((PHMASK >> (k)) & 1) && lo <= (k) && (k) < hi)
#define BOTH(k) (IN(k) && IN((k) + 1))
#ifdef TIMEPH
    if (bx == 0 && threadIdx.x == 0) { const unsigned long long t0_ = rt(); MISC[24] = (unsigned)t0_; }
#define GRID_BAR(k) do { XcdBarrier b_; b_.bar = (unsigned*)((gu32*)(args.ws + WS_CTL) + CW_BAR) + args.li * XCD_BAR_WORDS; b_.x = xb_xcc_id(); b_.st = MISC + 8; xcd_barrier(b_); if (bx == 0 && threadIdx.x == 0) { gu32* ctl = (gu32*)(args.ws + WS_CTL); const unsigned t_now = (unsigned)rt(); __hip_atomic_store(ctl + 2048 + (k), t_now - MISC[24], RLX_AGENT); MISC[24] = t_now; } } while (0)
#else
#define GRID_BAR(k) do { XcdBarrier b_; b_.bar = (unsigned*)((gu32*)(args.ws + WS_CTL) + CW_BAR) + args.li * XCD_BAR_WORDS; b_.x = xb_xcc_id(); b_.st = MISC + 8; xcd_barrier(b_); } while (0)
#endif

    for (int rp_ = 0; rp_ < RP0; ++rp_) if (IN(0)) {
        PHASE_VARS
        LAS float* scr = (LAS float*)(L + RING_OFF + wave * 16384);
        const float* w_in = args.in[2];
        unsigned* cmax_in = (unsigned*)(ctl + CW_CMAX);
        {
            constexpr int T_IN = ((IN_W + 255) / 256) * (D / 32);
            constexpr int T_WQ = (QPW / 256) * (D / 32);
            for (int it = gw; it < T_IN + T_WQ; it += NGW) { if (it < T_IN) p0_colmax_task(w_in, IN_W, IN_W, cmax_in, it, lane); else p0_colmax_task(args.in[12], QPW, QPW, cmax_in + CMAX_WQ, it - T_IN, lane); }
            GRID_BAR(0);
        }
        {
            constexpr int I_A = 16 * 48, I_B = 16 * 96, I_WA = 8 * 32, I_WB = 8 * 32, I_WO = 16 * 32, I_WQ = 16 * 64;
            constexpr int NITEMS = I_A + I_B + I_WA + I_WB + I_WO + I_WQ;
            for (int it = gw; it < NITEMS; it += NGW) {
                int r = it;
                if (r < I_A) { p0_transpose_item_i8(w_in, IN_W, 0, D, ws + WS_WIN, (float*)(ws + WS_SBW), 0, cmax_in, scr, r, 48, lane); continue; } r -= I_A;
                if (r < I_B) { p0_transpose_item_i8(w_in, IN_W, OFF_UG, D, ws + WS_WIN, (float*)(ws + WS_SBW), 1536, cmax_in, scr, r, 96, lane); continue; } r -= I_B;
                if (r < I_WA) { p0_transpose_item(args.in[8], D, 0, AW, (bf16*)(ws + WS_WA), 0, scr, r, 32, lane); continue; } r -= I_WA;
                if (r < I_WB) { p0_transpose_item(args.in[9], D, 0, SW, (bf16*)(ws + WS_WB), 0, scr, r, 32, lane); continue; } r -= I_WB;
                if (r < I_WO) { p0_transpose_item(args.in[10], D, 0, D, (bf16*)(ws + WS_WOUT), 0, scr, r, 32, lane); continue; } r -= I_WO;
                p0_transpose_item_i8(args.in[12], QPW, 0, D, ws + WS_WQ, (float*)(ws + WS_SBWQ), 0, cmax_in + CMAX_WQ, scr, r, 64, lane);
            }
        }
        {
            const size_t gtid = (size_t)gw * 64 + lane, nthr = (size_t)NGW * 64;
            cvt_chunks(args.in[13], (bf16*)(ws + WS_SK), (size_t)PH * 2 * PKEYS * PHALF / 8, gtid, nthr);
#pragma unroll 1
            for (int e0 = CONV_P0_FROM + 4 * gw; e0 < 2 * NEXP; e0 += 4 * NGW) convert_rows4(e0, args.in[14], args.in[15], ws, lane);
            const float* w_s = args.in[6]; bf16* wsm = (bf16*)(ws + WS_WSM);
            for (size_t c = gtid; c < (size_t)NG * CHUNK * CHUNK / 8; c += nthr) {
                const int pos = (int)((c * 8) & 127), t = (int)((c * 8) >> 7) & 127, ks = pos >> 4, hh = (pos >> 3) & 1, s0 = 16 * ks + 4 * hh, s1 = s0 + 8;
                const float* src = w_s + ((c * 8) & ~(size_t)127);
                const f32x4 a = *(const GAS f32x4*)(src + s0), b = *(const GAS f32x4*)(src + s1);
                v4u o; o.x = pg8::cvt_pk_bf16(s0 + 0 <= t ? a.x : 0.f, s0 + 1 <= t ? a.y : 0.f); o.y = pg8::cvt_pk_bf16(s0 + 2 <= t ? a.z : 0.f, s0 + 3 <= t ? a.w : 0.f);
                o.z = pg8::cvt_pk_bf16(s1 + 0 <= t ? b.x : 0.f, s1 + 1 <= t ? b.y : 0.f); o.w = pg8::cvt_pk_bf16(s1 + 2 <= t ? b.z : 0.f, s1 + 3 <= t ? b.w : 0.f);
                ((GAS v4u*)wsm)[c] = o; }
        }
        __syncthreads();
        {
            LAS float* wf = (LAS float*)(L + RING_OFF);
            for (int i = tid; i < 8 * D; i += NWAVES * 64) { const int k = i >> 3, c = i & 7; wf[c * D + k] = w_in[(size_t)k * IN_W + OFF_F + c]; }
            __syncthreads();
            const float* g1 = args.in[1]; const float* b_f = args.in[3];
            f32x4 gv[4];
#pragma unroll
            for (int j = 0; j < 4; ++j) gv[j] = ((const GAS f32x4*)g1)[lane + 64 * j];
#pragma unroll 1
            for (int m0 = 4 * gw; m0 < M; m0 += 4 * NGW) {
                f32x4 vv[4][4];
#pragma unroll
                for (int rr = 0; rr < 4; ++rr)
#pragma unroll
                    for (int j = 0; j < 4; ++j) vv[rr][j] = ((const GAS f32x4*)(x + (size_t)(m0 + rr) * D) + lane)[64 * j];
#pragma unroll
                for (int rr = 0; rr < 4; ++rr) {
                    const int m = m0 + rr; f32x4 v[4]; float s = 0.f;
#pragma unroll
                    for (int j = 0; j < 4; ++j) { v[j] = vv[rr][j]; s += (v[j].x * v[j].x + v[j].y * v[j].y) + (v[j].z * v[j].z + v[j].w * v[j].w); }
                    const float r = 1.0f / sqrtf(wave_sum(s) * (1.f / D) + EPS);
#pragma unroll
                    for (int j = 0; j < 4; ++j) v[j] = v[j] * r * gv[j];
                    {
                        float am = 0.f;
#pragma unroll
                        for (int j = 0; j < 4; ++j) am = fmaxf(fmaxf(am, fmaxf(fabsf(v[j].x), fabsf(v[j].y))), fmaxf(fabsf(v[j].z), fabsf(v[j].w)));
                        am = wave_allmax(am); const float qs = am > 0.f ? 127.0f / am : 0.f;
                        GAS unsigned* o4 = (GAS unsigned*)(ws + WS_XN + (size_t)m * D) + lane;
#pragma unroll
                        for (int j = 0; j < 4; ++j) o4[64 * j] = peer_body::pack_i8x4(v[j].x * qs, v[j].y * qs, v[j].z * qs, v[j].w * qs);
                        if (lane == 0) ((GAS float*)(ws + WS_SA))[m] = am * (1.0f / 127.0f); }
                    float fsum = 0.f;
#pragma unroll
                    for (int c = 0; c < 8; ++c) { float pp = 0.f;
#pragma unroll
                        for (int j = 0; j < 4; ++j) { const f32x4 w4 = *(const LAS f32x4*)(wf + c * D + 256 * j + 4 * lane); pp += (v[j].x * w4.x + v[j].y * w4.y) + (v[j].z * w4.z + v[j].w * w4.w); }
                        pp = wave_sum(pp); if (lane == c) fsum = pp; }
                    if (lane < 8) LOGF[(size_t)m * NH + lane] = log_sigmoid(fsum + b_f[lane]);
                }
            }
        }
        if (BOTH(0)) GRID_BAR(0);
    }

    for (int rp12_ = 0; rp12_ < RP12; ++rp12_) {
    for (int rp_ = 0; rp_ < RP1; ++rp_) if (IN(1)) {
        PHASE_VARS
        if (vcu < BATCH * NH) {
            const int b = vcu / NH, h = vcu % NH; LAS float* part = (LAS float*)(L + MISC_OFF + 64);
            float v[4];
#pragma unroll
            for (int i = 0; i < 4; ++i) v[i] = LOGF[(size_t)(b * SEQ + 4 * tid + i) * NH + h];
            v[1] += v[0]; v[2] += v[1]; v[3] += v[2];
            float tot = v[3];
#pragma unroll
            for (int o = 1; o < 64; o <<= 1) { const float u = __shfl_up(tot, o); if (lane >= o) tot += u; }
            if (lane == 63) part[wave] = tot;
            __syncthreads();
            float base = tot - v[3];
            for (int w = 0; w < wave; ++w) base += part[w];
#pragma unroll
            for (int i = 0; i < 4; ++i) CL2[(size_t)vcu * SEQ + 4 * tid + i] = (base + v[i]) * LOG2E;
            __syncthreads();
        }
        pg8::Gemm g{XN, (const bf16*)(ws + WS_WIN), M, NPROJ, D / 2}; pg8::StaticOrder S; S.init(M, NPROJ, G, bx);
        pg8::EpiProjI8 E{Qb, (size_t)M * 512, GATE, C2, (const float*)(ws + WS_SA), (const float*)(ws + WS_SBW)};
        pg8::gemm_phase<pg8::EpiProjI8, pg8::StaticOrder, true, true, true>(L + RING_OFF, g, S, E);
        {
            constexpr int NUN = (M / 256) * (NPROJ / 256);
            const int nmax = (NUN + G - 1) / G, nun = (NUN - bx + G - 1) / G;
            int ii_ = bx - (NUN - (nmax - 1) * G), nidle_ = G - (NUN - (nmax - 1) * G);
            if (nidle_ <= 0) { ii_ = bx; nidle_ = G; }
            if (nun < nmax || nidle_ == G) {
#pragma unroll 1
                for (int e0 = 4 * (ii_ * NWAVES + wave); e0 < CONV_SPLIT; e0 += 4 * nidle_ * NWAVES) convert_rows4(e0, args.in[14], args.in[15], ws, lane);
            }
        }
        if (BOTH(1)) GRID_BAR(1);
    }

    if (IN(2)) {
        PHASE_VARS
        static_assert(attn_body::ATTN_LDS_BYTES <= RING_BYTES, "attention LDS");
#ifdef P2PROBE
        for (int pr_ = 0; pr_ < P2PROBE; ++pr_) {
            for (int u = vcu; u < 2 * (M / CHUNK); u += G)
                sgu_body::sgu_unit(u >> 1, u & 1, (const bf16*)(ws + WS_VG), UG, (bf16*)(ws + 232 * MiB), (const bf16*)(ws + WS_WSM), args.in[4], args.in[5], args.in[7], (char*)lds + RING_OFF);
#ifndef P2PROBE_SGU_ONLY
            const attn_body::AttnTensors ATp{(const attn_body::bf16*)Qb, (const attn_body::bf16*)(ws + WS_K), (const attn_body::bf16*)(ws + WS_V), (attn_body::bf16*)(ws + 216 * MiB), CL2};
            const attn_body::StaticOrder Sp(G, bx);
            attn_body::attn_phase<attn_body::StaticOrder>((char*)lds + RING_OFF, ATp, Sp);
#endif
            GRID_BAR(2);
        }
#endif
        constexpr int NCONVQ = (CONV_P0_FROM - CONV_SPLIT) / 64, NIL = NCONVQ < 512 ? NCONVQ : 512;
        for (;;) {
            __syncthreads();
            if (tid == 0) MISC[26] = __hip_atomic_fetch_add(ctl + CW_QUEUE, 1u, RLX_AGENT);
            __syncthreads();
            const int u = __builtin_amdgcn_readfirstlane((int)MISC[26]);
            if (u >= 768 + NCONVQ) break;
            int ua = -1, uc = -1, us = -1;
            if (u < 2 * NIL) { if (u & 1) uc = u >> 1; else ua = u >> 1; }
            else if (u < 512 + NCONVQ) { if (NCONVQ > 512) uc = u - 512; else ua = u - NCONVQ; }
            else us = u - 512 - NCONVQ;
            if (ua >= 0) { const int qb = 7 - (ua >> 6), bh = ua & 63;
                const int t0 = attn_body::attn_first_tile(CL2, bh, qb);
                attn_body::attn_unit<8>(bh / NH, bh % NH, qb, (const attn_body::bf16*)Qb, (const attn_body::bf16*)(ws + WS_K), (const attn_body::bf16*)(ws + WS_V), (attn_body::bf16*)Qb, CL2, (char*)lds + RING_OFF, t0); }
            else if (uc >= 0) { convert_rows4(CONV_SPLIT + 64 * uc + 8 * wave, args.in[14], args.in[15], ws, lane); convert_rows4(CONV_SPLIT + 64 * uc + 8 * wave + 4, args.in[14], args.in[15], ws, lane); }
            else sgu_body::sgu_unit(us >> 1, us & 1, (const bf16*)(ws + WS_VG), UG, UG, (const bf16*)(ws + WS_WSM), args.in[4], args.in[5], args.in[7], (char*)lds + RING_OFF);
        }
        if (BOTH(2)) GRID_BAR(2);
    }
    }

    for (int rp_ = 0; rp_ < RP3; ++rp_) if (IN(3)) {
        PHASE_VARS
        static_assert(WS_UG - WS_Q == (size_t)pg8::MERGE_DPM * 256 * AW * 2 && WS_WB - WS_WA == (size_t)4 * 256 * AW * 2, "merge passes: buffer offsets");
        { pg8::Gemm g{Qb, (const bf16*)(ws + WS_WA), M, D, AW}; pg8::MergeOrder S; S.init(M, D, G, bx);
          pg8::EpiMergeAB E{GATE, MERGED};
          pg8::gemm_phase<pg8::EpiMergeAB, pg8::MergeOrder, true, true>(L + RING_OFF, g, S, E); }
        if (BOTH(3)) GRID_BAR(3);
    }

    for (int rp_ = 0; rp_ < RP4; ++rp_) if (IN(4)) {
        PHASE_VARS
        pg8::Gemm g{MERGED, (const bf16*)(ws + WS_WOUT), M, D, D}; pg8::StaticOrder S; S.init(M, D, G, bx);
        pg8::EpiResid E{x, out, D, M};
        pg8::gemm_phase<pg8::EpiResid, pg8::StaticOrder, false, true>(L + RING_OFF, g, S, E);
        if (BOTH(4)) GRID_BAR(4);
    }

    for (int rp_ = 0; rp_ < RP5; ++rp_) if (IN(5)) {
        PHASE_VARS
        const float* g2 = args.in[11];
        f32x4 gv[4];
#pragma unroll
        for (int j = 0; j < 4; ++j) gv[j] = ((const GAS f32x4*)g2)[lane + 64 * j];
#pragma unroll 1
        for (int m0 = 4 * gw; m0 < M; m0 += 4 * NGW) {
            f32x4 vv[4][4];
#pragma unroll
            for (int rr = 0; rr < 4; ++rr)
#pragma unroll
                for (int j = 0; j < 4; ++j) vv[rr][j] = ((const GAS f32x4*)(out + (size_t)(m0 + rr) * D) + lane)[64 * j];
            asm volatile("" ::: "memory");
#pragma unroll
            for (int rr = 0; rr < 4; ++rr) {
                const int m = m0 + rr; f32x4 v[4]; float s = 0.f;
#pragma unroll
                for (int j = 0; j < 4; ++j) { v[j] = vv[rr][j]; s += (v[j].x * v[j].x + v[j].y * v[j].y) + (v[j].z * v[j].z + v[j].w * v[j].w); }
                const float r = 1.0f / sqrtf(wave_sum(s) * (1.f / D) + EPS);
                float am = 0.f;
#pragma unroll
                for (int j = 0; j < 4; ++j) { v[j] = v[j] * r * gv[j];
                    am = fmaxf(fmaxf(am, fmaxf(fabsf(v[j].x), fabsf(v[j].y))), fmaxf(fabsf(v[j].z), fabsf(v[j].w))); }
                am = wave_allmax(am);
                const float qs = am > 0.f ? 127.0f / am : 0.f;
#pragma unroll
                for (int j = 0; j < 4; ++j) { const unsigned q4 = peer_body::pack_i8x4(v[j].x * qs, v[j].y * qs, v[j].z * qs, v[j].w * qs);
                    *(GAS unsigned*)(ws + WS_H2Q + (size_t)(2 * j + (lane >> 5)) * ((size_t)M * 128) + (size_t)m * 128 + ((4 * lane) & 127)) = q4; ((GAS unsigned*)(ws + WS_XN + (size_t)m * D))[lane + 64 * j] = q4; }
                if (lane == 0) ((GAS float*)(ws + WS_ST))[m] = am * (1.0f / 127.0f);
            }
        }
        if (BOTH(5)) GRID_BAR(5);
    }

    for (int rp_ = 0; rp_ < RP6; ++rp_) if (IN(6)) {
        PHASE_VARS
        pg8::Gemm g{XN, (const bf16*)(ws + WS_WQ), M, QPW, D / 2}; pg8::StaticOrder S; S.init(M, QPW, G, bx);
        pg8::EpiBf16I8 E{QP, QPW, (const float*)(ws + WS_ST), (const float*)(ws + WS_SBWQ)};
        pg8::gemm_phase<pg8::EpiBf16I8, pg8::StaticOrder, true, true, true>(L + RING_OFF, g, S, E);
        if (BOTH(6)) GRID_BAR(6);
    }
    for (int rp_ = 0; rp_ < RP7; ++rp_) if (IN(7)) {
        PHASE_VARS
        for (int tk = vcu; tk < 8 * (M / 512); tk += G)
            peer_body::peer_retrieve(tk, QP, (const bf16*)(ws + WS_SK), (const float*)(ws + WS_SU), (const float*)(ws + WS_SV), (const float*)(ws + WS_ST),
                                     (bf16*)(ws + WS_PID), (float*)(ws + WS_G2), (float*)(ws + WS_PS2), (char*)lds + RING_OFF);
        if (BOTH(7)) GRID_BAR(7);
    }
    if (IN(8)) {
        PHASE_VARS
#ifdef TIMEPH
        const float oscale = 1.0f + sqrtf((float)(((__hip_atomic_load(ctl + 2048 + TIMEPH, RLX_AGENT) + TIMEOFF) / TIMEQ) * TIMEQ) * 1e-5f);
#else
        const float oscale = 1.0f;
#endif
        const int p = bx & 7, cntp = (G - p + 7) >> 3;
        peer_body::peer_fused(p, (bx >> 3) * NWAVES + wave, cntp * NWAVES, (const bf16*)(ws + WS_PID), (const float*)(ws + WS_G2), (const float*)(ws + WS_PS2), (const unsigned char*)(ws + WS_H2Q),
                              (const unsigned char*)(ws + WS_EU), (const unsigned char*)(ws + WS_EV), out, args.in[16], (char*)lds + RING_OFF, oscale);
    }
#undef IN
#undef BOTH
#undef GRID_BAR
}

extern "C" void kernel_launch(void* const* d_in, const int* in_sizes, int n_in, void* d_out, int out_size, void* d_ws, size_t ws_size, hipStream_t stream) {
    static int grid = 0;
    if (grid == 0) {
        int dev = 0, cus = 0;
        if (n_in != 17 || out_size != M * D || ws_size < WS_END) { fprintf(stderr, "kernel_launch: unexpected shapes (n_in %d out %d ws %zu)\n", n_in, out_size, ws_size); grid = -1; return; }
        if (hipGetDevice(&dev) != hipSuccess || hipDeviceGetAttribute(&cus, hipDeviceAttributeMultiprocessorCount, dev) != hipSuccess) { grid = -1; return; }
        if (hipFuncSetAttribute((const void*)skel_fwd, hipFuncAttributeMaxDynamicSharedMemorySize, LDS_BYTES) != hipSuccess) { fprintf(stderr, "kernel_launch: hipFuncSetAttribute failed\n"); grid = -1; return; }
        int per_cu = 0;
        if (hipOccupancyMaxActiveBlocksPerMultiprocessor(&per_cu, (const void*)skel_fwd, NWAVES * 64, LDS_BYTES) != hipSuccess || per_cu < 1) { fprintf(stderr, "kernel_launch: occupancy query says %d workgroups per CU\n", per_cu); grid = -1; return; }
        grid = cus;
    }
    if (grid < 0) return;
    unsigned char* ws = (unsigned char*)d_ws; float* out = (float*)d_out;
    (void)hipMemsetAsync(ws + WS_CTL, 0, CTL_ZERO_BYTES, stream);
    Args a{};
    for (int i = 0; i < 17; ++i) a.in[i] = (const float*)d_in[i];
    a.out = out; a.ws = ws;
#ifndef MULTI_LAUNCH
    {
        a.ph_lo = 0; a.ph_hi = N_PHASES; a.li = 0;
        void* kargs[] = {(void*)&a};
#ifdef PLAIN_LAUNCH
        hipLaunchKernelGGL(skel_fwd, dim3(grid), dim3(NWAVES * 64), LDS_BYTES, stream, a); const hipError_t e = hipPeekAtLastError(); (void)kargs;
#else
        const hipError_t e = hipLaunchCooperativeKernel((const void*)skel_fwd, dim3(grid), dim3(NWAVES * 64), kargs, LDS_BYTES, stream);
#endif
        if (e != hipSuccess) fprintf(stderr, "kernel_launch: cooperative launch failed: %s (grid %d)\n", hipGetErrorString(e), grid);
    }
#else
    for (int k = 0; k < N_PHASES; ++k) { a.ph_lo = k; a.ph_hi = k + 1; a.li = k; hipLaunchKernelGGL(skel_fwd, dim3(grid), dim3(NWAVES * 64), LDS_BYTES, stream, a); }
#endif
}
```

```cpp
#include <hip/hip_runtime.h>
#include <cstdio>
#include <cstdint>
#include <cmath>

constexpr int D = 1024, BATCH = 8, SEQ = 2048, M = BATCH * SEQ;
constexpr int NH = 8, HD = 64, AW = 512, SW = 512, CHUNK = 128, NG = 8, GD = 64;
constexpr int OFF_Q = 0, OFF_K = 512, OFF_V = 1024, OFF_F = 1536, OFF_UG = 1544, OFF_VG = 2056, OFF_GATE = 2568, IN_W = 4616;
constexpr int NPROJ = 4608;
constexpr int PH = 8, PKEYS = 128, PHALF = 128, PTOP = 16, NEXP = 16384, QPW = 2048, HK = 128;
constexpr float EPS = 1e-6f;
constexpr float LOG2E = 1.4426950408889634f;
constexpr float C2 = 0.125f * LOG2E;

constexpr size_t MiB = 1u << 20;
constexpr size_t WS_CTL = 0, CTL_ZERO_BYTES = 65536;
constexpr size_t WS_WIN = 1 * MiB;
constexpr size_t WS_WA = 10 * MiB;
constexpr size_t WS_WB = 11 * MiB;
constexpr size_t WS_WOUT = 12 * MiB;
constexpr size_t WS_WQ = 14 * MiB;
constexpr size_t WS_SK = 18 * MiB;
constexpr size_t WS_WSM = 18 * MiB + 512 * 1024;
constexpr size_t WS_EU = 20 * MiB;
constexpr size_t WS_EV = 52 * MiB;
constexpr size_t WS_XN = 84 * MiB;
constexpr size_t WS_Q = 116 * MiB;
constexpr size_t WS_K = 132 * MiB;
constexpr size_t WS_V = 148 * MiB;
constexpr size_t WS_UG = 164 * MiB;
constexpr size_t WS_VG = 180 * MiB;
constexpr size_t WS_LOGF = 196 * MiB;
constexpr size_t WS_CL2 = 197 * MiB;
constexpr size_t WS_STAT = 199 * MiB;
constexpr size_t WS_SU = 198 * MiB;
constexpr size_t WS_SV = 198 * MiB + 65536;
constexpr size_t WS_MERGED = WS_K;
constexpr size_t WS_QP = WS_Q;
constexpr size_t WS_PIDX = WS_VG;
constexpr size_t WS_PGATE = WS_VG + 8 * MiB;
constexpr size_t WS_H2Q = 200 * MiB;
constexpr size_t WS_ST = 198 * MiB + 131072;
constexpr size_t WS_SSQP = 198 * MiB + 262144;
constexpr size_t WS_SBQ = 198 * MiB + 524288;
constexpr size_t WS_PID = 180 * MiB;
constexpr size_t WS_G2 = 184 * MiB;
constexpr size_t WS_PS2 = 216 * MiB;
constexpr size_t WS_AP = 116 * MiB;
constexpr size_t WS_WP = 84 * MiB;
constexpr size_t WS_SW = 88 * MiB;
constexpr size_t WS_SSQ = 224 * MiB;
constexpr size_t WS_SBW = 198 * MiB + 786432;
constexpr size_t WS_SA = 198 * MiB + 851968;
constexpr size_t WS_SBWQ = 198 * MiB + 917504;
constexpr size_t WS_END = 256 * MiB;

template <int CTRL> __device__ __forceinline__ float wr_dppf(float v) { return __int_as_float(__builtin_amdgcn_update_dpp(0, __float_as_int(v), CTRL, 0xf, 0xf, false)); }
__device__ __forceinline__ float wave_allsum(float v) {
    v += wr_dppf<0xB1>(v); v += wr_dppf<0x4E>(v); v += wr_dppf<0x141>(v); v += wr_dppf<0x128>(v);
    { const auto s = __builtin_amdgcn_permlane16_swap(__float_as_uint(v), __float_as_uint(v), false, false); v = __uint_as_float(s[0]) + __uint_as_float(s[1]); }
    { const auto s = __builtin_amdgcn_permlane32_swap(__float_as_uint(v), __float_as_uint(v), false, false); v = __uint_as_float(s[0]) + __uint_as_float(s[1]); }
    return v;
}
__device__ __forceinline__ float wave_allmax(float v) {
    v = fmaxf(v, wr_dppf<0xB1>(v)); v = fmaxf(v, wr_dppf<0x4E>(v)); v = fmaxf(v, wr_dppf<0x141>(v)); v = fmaxf(v, wr_dppf<0x128>(v));
    { const auto s = __builtin_amdgcn_permlane16_swap(__float_as_uint(v), __float_as_uint(v), false, false); v = fmaxf(__uint_as_float(s[0]), __uint_as_float(s[1])); }
    { const auto s = __builtin_amdgcn_permlane32_swap(__float_as_uint(v), __float_as_uint(v), false, false); v = fmaxf(__uint_as_float(s[0]), __uint_as_float(s[1])); }
    return v;
}
namespace pg8 {
#define PG8_LAS __attribute__((address_space(3)))
typedef unsigned short bf16_t;
typedef short bf16x8 __attribute__((ext_vector_type(8)));
typedef float f32x4 __attribute__((ext_vector_type(4)));
typedef unsigned u32x4 __attribute__((ext_vector_type(4)));
constexpr int BM = 256, BK = 64, HALF = 128, HTB = HALF * BK * 2  , STAGE_BYTES = 8 * HTB, NXCD = 8, WGM = 8;

__host__ __device__ __forceinline__ int lds_byte(int r, int c) { const int st = (r >> 4) * 2 + (c >> 5), rr = r & 15, cc = c & 31, ob = rr * 64 + cc * 2; return st * 1024 + (ob ^ (((ob >> 9) & 1) << 5)); }
__host__ __device__ __forceinline__ void stage_rc(int b, int& R, int& C) { const int st = b / 1024, sb = b % 1024, swz = sb ^ (((sb >> 9) & 1) << 5); R = (st >> 1) * 16 + swz / 64; C = (st & 1) * 32 + (swz % 64) / 2; }
__host__ __device__ __forceinline__ int perm32(int rho) { const int n = rho >> 4, i = rho & 15; return 8 * (i >> 2) + 4 * n + (i & 3); }

struct Unit { int pm, pn; };
struct Gemm { const bf16_t* A; const bf16_t* Bt; int M, N, K; };

struct StaticOrder {
    int nM, nN, nwg, G, c;
    __host__ __device__ void init(int M, int N, int G_, int c_) { nM = M / BM; nN = N / BM; nwg = nM * nN; G = G_; c = c_; }
    __host__ __device__ bool next(int i, Unit& u) const {
        const long L = (long)i * G + c; if (L >= nwg) return false;
        int wgid = (int)L; { const int q = nwg / NXCD, r = nwg % NXCD, xcd = wgid % NXCD, off = wgid / NXCD; wgid = (xcd < r ? xcd * (q + 1) : r * (q + 1) + (xcd - r) * q) + off; }
        const int nig = WGM * nN, gid = wgid / nig, fm = gid * WGM, gsz = (nM - fm) < WGM ? (nM - fm) : WGM;
        u.pm = fm + ((wgid % nig) % gsz); u.pn = (wgid % nig) / gsz; return true;
    }
    __device__ __forceinline__ void a_ready(const Unit&) const {}
    __device__ __forceinline__ void done(const Unit&) const {}
};

typedef float cvt_f32x2_t __attribute__((ext_vector_type(2))); typedef __bf16 cvt_bf16x2_t __attribute__((ext_vector_type(2)));
__device__ __forceinline__ unsigned cvt_pk_bf16(float lo, float hi) { cvt_f32x2_t v = {lo, hi}; cvt_bf16x2_t b = __builtin_convertvector(v, cvt_bf16x2_t); return __builtin_bit_cast(unsigned, b); }
typedef float f32x2 __attribute__((ext_vector_type(2)));
__device__ __forceinline__ f32x2 gelu_pk(f32x2 v) {
    const f32x2 av = __builtin_elementwise_abs(v), d = av * 0.2316418882f + 1.0f;
    f32x2 t; t.x = __builtin_amdgcn_rcpf(d.x); t.y = __builtin_amdgcn_rcpf(d.y);
    f32x2 q = t * 0.5307027145f + (-0.7265760135f); q = q * t + 0.7107068705f; q = q * t + (-0.142248368f); q = q * t + 0.127414796f; q = q * t;
    const f32x2 s = (v * v) * (-0.72134752044f);
    f32x2 e; e.x = __builtin_amdgcn_exp2f(s.x); e.y = __builtin_amdgcn_exp2f(s.y);
    const f32x2 m = v * (q * e), r = v - m;
    f32x2 o; o.x = v.x < 0.f ? m.x : r.x; o.y = v.y < 0.f ? m.y : r.y; return o;
}

template <int ACT  > struct EpiBf16 {
    static constexpr bool PERM = true, AFTER_DRAIN = false; static_assert(ACT == 0 || ACT == 1, "EpiBf16: ACT is 0 (none) or 1 (gelu_pk)");
    bf16_t* O; int ldc; const float* bias; int split_cols; size_t split_stride; float scale0;
    __device__ __forceinline__ void operator()(const f32x4 (&acc)[2][2][4][2], const Unit& u, int wr, int wc, int fr, int fq) const {
        const int row0 = u.pm * BM + wr * 64 + fr; int colt = u.pn * BM; bf16_t* base = O;
        float sc = 1.f; if (split_cols) { const int t = colt / split_cols; base += (size_t)t * split_stride; colt -= t * split_cols; if (t == 0) sc = scale0; }
        const int col0 = colt + wc * 32 + 8 * fq, bcol0 = u.pn * BM + wc * 32 + 8 * fq;
        f32x4 bv[2][2];
#pragma unroll
        for (int bj = 0; bj < 2; ++bj)
#pragma unroll
            for (int n = 0; n < 2; ++n) bv[bj][n] = bias ? *(const f32x4*)(bias + bcol0 + bj * HALF + 4 * n) : (f32x4){0.f, 0.f, 0.f, 0.f};
#pragma unroll
        for (int ai = 0; ai < 2; ++ai)
#pragma unroll
            for (int m = 0; m < 4; ++m) { bf16_t* rowp = base + (size_t)(row0 + ai * HALF + m * 16) * ldc + col0;
#pragma unroll
                for (int bj = 0; bj < 2; ++bj) { f32x4 v0 = acc[ai][bj][m][0] + bv[bj][0], v1 = acc[ai][bj][m][1] + bv[bj][1];
                    if (ACT == 1) { f32x2 a = gelu_pk((f32x2){v0[0], v0[1]}), b = gelu_pk((f32x2){v0[2], v0[3]}), c = gelu_pk((f32x2){v1[0], v1[1]}), d = gelu_pk((f32x2){v1[2], v1[3]});
                        v0 = (f32x4){a.x, a.y, b.x, b.y}; v1 = (f32x4){c.x, c.y, d.x, d.y}; }
                    v0 = v0 * sc; v1 = v1 * sc; u32x4 w; w.x = cvt_pk_bf16(v0[0], v0[1]); w.y = cvt_pk_bf16(v0[2], v0[3]); w.z = cvt_pk_bf16(v1[0], v1[1]); w.w = cvt_pk_bf16(v1[2], v1[3]);
                    *(u32x4*)(rowp + bj * HALF) = w; } }
    }
};
__device__ __forceinline__ f32x2 sigmoid_pk(f32x2 v) {
#ifdef DBG_SIG
    f32x2 o; o.x = 1.0f / (1.0f + __expf(-v.x)); o.y = 1.0f / (1.0f + __expf(-v.y)); return o;
#else
    f32x2 e; e.x = __builtin_amdgcn_exp2f(v.x * -1.4426950408889634f); e.y = __builtin_amdgcn_exp2f(v.y * -1.4426950408889634f);
    f32x2 o; o.x = __builtin_amdgcn_rcpf(1.0f + e.x); o.y = __builtin_amdgcn_rcpf(1.0f + e.y); return o;
#endif
}
template <int ACT> __device__ __forceinline__ f32x4 act4(f32x4 v, float sc) {
    if (ACT == 0) return v * sc;
    f32x2 a, b;
    if (ACT == 2) { a = gelu_pk((f32x2){v[0], v[1]}); b = gelu_pk((f32x2){v[2], v[3]}); }
    else { a = sigmoid_pk((f32x2){v[0], v[1]}); b = sigmoid_pk((f32x2){v[2], v[3]}); }
    return (f32x4){a.x, a.y, b.x, b.y};
}
struct EpiProj {
    static constexpr bool PERM = true, AFTER_DRAIN = false;
    bf16_t* QKVUV; size_t tstride; bf16_t* GATE; float qscale;
    template <int ACT> __device__ __forceinline__ void body(const f32x4 (&acc)[2][2][4][2], bf16_t* base, int ldc, int row0, int col0, float sc) const {
#pragma unroll
        for (int ai = 0; ai < 2; ++ai)
#pragma unroll
            for (int m = 0; m < 4; ++m) { bf16_t* rowp = base + (size_t)(row0 + ai * HALF + m * 16) * ldc + col0;
#pragma unroll
                for (int bj = 0; bj < 2; ++bj) { const f32x4 v0 = act4<ACT>(acc[ai][bj][m][0], sc), v1 = act4<ACT>(acc[ai][bj][m][1], sc);
                    u32x4 w; w.x = cvt_pk_bf16(v0[0], v0[1]); w.y = cvt_pk_bf16(v0[2], v0[3]); w.z = cvt_pk_bf16(v1[0], v1[1]); w.w = cvt_pk_bf16(v1[2], v1[3]);
                    *(u32x4*)(rowp + bj * HALF) = w; } }
    }
    __device__ __forceinline__ void operator()(const f32x4 (&acc)[2][2][4][2], const Unit& u, int wr, int wc, int fr, int fq) const {
        const int row0 = u.pm * BM + wr * 64 + fr, pn = u.pn;
        if (pn < 10) { bf16_t* base = QKVUV + (size_t)(pn >> 1) * tstride; const int col0 = (pn & 1) * BM + wc * 32 + 8 * fq;
            if (pn < 6) body<0>(acc, base, 512, row0, col0, pn < 2 ? qscale : 1.0f); else body<2>(acc, base, 512, row0, col0, 1.0f); }
        else body<3>(acc, GATE, 2048, row0, (pn - 10) * BM + wc * 32 + 8 * fq, 1.0f);
    }
};
template <int PASS> struct EpiMerge {
    static constexpr bool PERM = true, AFTER_DRAIN = false;
    const bf16_t* GATE; bf16_t* MERGED;
    __device__ __forceinline__ void operator()(const f32x4 (&acc)[2][2][4][2], const Unit& u, int wr, int wc, int fr, int fq) const {
        const int row0 = u.pm * BM + wr * 64 + fr, col0 = u.pn * BM + wc * 32 + 8 * fq;
#pragma unroll
        for (int ai = 0; ai < 2; ++ai) {
            u32x4 gq[4][2], tq[4][2];
#pragma unroll
            for (int m = 0; m < 4; ++m) { const size_t r = (size_t)(row0 + ai * HALF + m * 16);
#pragma unroll
                for (int bj = 0; bj < 2; ++bj) { const int c = col0 + bj * HALF; gq[m][bj] = *(const u32x4*)(GATE + r * 2048 + PASS * 1024 + c);
                    if (PASS == 1) tq[m][bj] = *(const u32x4*)(MERGED + r * 1024 + c); } }
            asm volatile("" ::: "memory");
#pragma unroll
            for (int m = 0; m < 4; ++m) { const size_t r = (size_t)(row0 + ai * HALF + m * 16);
#pragma unroll
                for (int bj = 0; bj < 2; ++bj) { const int c = col0 + bj * HALF; const u32x4 g = gq[m][bj];
                    f32x4 v0 = acc[ai][bj][m][0], v1 = acc[ai][bj][m][1];
                    v0[0] *= __uint_as_float(g.x << 16); v0[1] *= __uint_as_float(g.x & 0xffff0000u); v0[2] *= __uint_as_float(g.y << 16); v0[3] *= __uint_as_float(g.y & 0xffff0000u);
                    v1[0] *= __uint_as_float(g.z << 16); v1[1] *= __uint_as_float(g.z & 0xffff0000u); v1[2] *= __uint_as_float(g.w << 16); v1[3] *= __uint_as_float(g.w & 0xffff0000u);
                    if (PASS == 1) { const u32x4 t = tq[m][bj];
                        v0[0] += __uint_as_float(t.x << 16); v0[1] += __uint_as_float(t.x & 0xffff0000u); v0[2] += __uint_as_float(t.y << 16); v0[3] += __uint_as_float(t.y & 0xffff0000u);
                        v1[0] += __uint_as_float(t.z << 16); v1[1] += __uint_as_float(t.z & 0xffff0000u); v1[2] += __uint_as_float(t.w << 16); v1[3] += __uint_as_float(t.w & 0xffff0000u); }
                    u32x4 w; w.x = cvt_pk_bf16(v0[0], v0[1]); w.y = cvt_pk_bf16(v0[2], v0[3]); w.z = cvt_pk_bf16(v1[0], v1[1]); w.w = cvt_pk_bf16(v1[2], v1[3]);
                    *(u32x4*)(MERGED + r * 1024 + c) = w; } }
            asm volatile("" ::: "memory");
        }
    }
};
struct EpiResid {
    static constexpr bool PERM = false, AFTER_DRAIN = false;
    const float* base; float* out; int ldc; int nrows;
    __device__ __forceinline__ void operator()(const f32x4 (&acc)[2][2][4][2], const Unit& u, int wr, int wc, int fr, int fq) const {
        const int col0 = u.pn * BM + wc * 32 + 4 * fq;
#pragma unroll
        for (int ai = 0; ai < 2; ++ai) {
            f32x4 pre[4][2][2];
#pragma unroll
            for (int m = 0; m < 4; ++m) { const size_t off = (size_t)(u.pm * BM + ai * HALF + wr * 64 + m * 16 + fr) * ldc + col0;
#pragma unroll
                for (int bj = 0; bj < 2; ++bj)
#pragma unroll
                    for (int n = 0; n < 2; ++n) pre[m][bj][n] = *(const f32x4*)(base + off + bj * HALF + n * 16); }
            asm volatile("" ::: "memory");
#pragma unroll
            for (int m = 0; m < 4; ++m) { const size_t off = (size_t)(u.pm * BM + ai * HALF + wr * 64 + m * 16 + fr) * ldc + col0;
#pragma unroll
                for (int bj = 0; bj < 2; ++bj)
#pragma unroll
                    for (int n = 0; n < 2; ++n) *(f32x4*)(out + off + bj * HALF + n * 16) = pre[m][bj][n] + acc[ai][bj][m][n]; }
            asm volatile("" ::: "memory");
        }
    }
};

constexpr int MERGE_DPM = 192;
struct MergeOrder : StaticOrder {
    __host__ __device__ bool next(int i, Unit& u) const {
        if (!StaticOrder::next(i >> 1, u)) return false;
        if (i & 1) { u.pm += MERGE_DPM; u.pn += 4; }
        return true;
    }
};
struct EpiMergeAB {
    static constexpr bool PERM = true, AFTER_DRAIN = false;
    const bf16_t* GATE; bf16_t* MERGED;
    __device__ __forceinline__ void operator()(const f32x4 (&acc)[2][2][4][2], const Unit& u, int wr, int wc, int fr, int fq) const {
        if (u.pn < 4) { EpiMerge<0> E{GATE, MERGED}; E(acc, u, wr, wc, fr, fq); }
        else { Unit v; v.pm = u.pm - MERGE_DPM; v.pn = u.pn - 4; EpiMerge<1> E{GATE, MERGED}; E(acc, v, wr, wc, fr, fq); }
    }
};
struct QueryOrder {
    int v, G, ntask;
    __host__ __device__ bool next(int i, Unit& u) const { const int tk = v + (i >> 1) * G; if (tk >= ntask) return false; u.pm = 2 * (tk >> 3) + (i & 1); u.pn = tk & 7; return true; }
    __device__ __forceinline__ void a_ready(const Unit&) const {}
    __device__ __forceinline__ void done(const Unit&) const {}
};

struct EpiProjI8 {
    static constexpr bool PERM = true, AFTER_DRAIN = false;
    bf16_t* QKVUV; size_t tstride; bf16_t* GATE; float qscale; const float* sA; const float* sB;
    template <int ACT> __device__ __forceinline__ void body(const f32x4 (&acc)[2][2][4][2], bf16_t* base, int ldc, int row0, int col0, int bcol0, float sc) const {
        f32x4 sb[2][2];
#pragma unroll
        for (int bj = 0; bj < 2; ++bj)
#pragma unroll
            for (int n = 0; n < 2; ++n) sb[bj][n] = *(const f32x4*)(sB + bcol0 + bj * HALF + 4 * n);
#pragma unroll
        for (int ai = 0; ai < 2; ++ai)
#pragma unroll
            for (int m = 0; m < 4; ++m) { const int row = row0 + ai * HALF + m * 16; bf16_t* rowp = base + (size_t)row * ldc + col0; const float sa = sA[row];
#pragma unroll
                for (int bj = 0; bj < 2; ++bj) {
                    typedef int i32x4_t __attribute__((ext_vector_type(4)));
                    const i32x4_t i0 = __builtin_bit_cast(i32x4_t, acc[ai][bj][m][0]), i1 = __builtin_bit_cast(i32x4_t, acc[ai][bj][m][1]);
                    const f32x4 f0 = (f32x4){(float)i0[0], (float)i0[1], (float)i0[2], (float)i0[3]} * sb[bj][0] * sa, f1 = (f32x4){(float)i1[0], (float)i1[1], (float)i1[2], (float)i1[3]} * sb[bj][1] * sa;
                    const f32x4 v0 = act4<ACT>(f0, sc), v1 = act4<ACT>(f1, sc);
                    u32x4 w; w.x = cvt_pk_bf16(v0[0], v0[1]); w.y = cvt_pk_bf16(v0[2], v0[3]); w.z = cvt_pk_bf16(v1[0], v1[1]); w.w = cvt_pk_bf16(v1[2], v1[3]);
                    *(u32x4*)(rowp + bj * HALF) = w; } }
    }
    __device__ __forceinline__ void operator()(const f32x4 (&acc)[2][2][4][2], const Unit& u, int wr, int wc, int fr, int fq) const {
        const int row0 = u.pm * BM + wr * 64 + fr, pn = u.pn, bcol0 = pn * BM + wc * 32 + 8 * fq;
        if (pn < 10) { bf16_t* base = QKVUV + (size_t)(pn >> 1) * tstride; const int col0 = (pn & 1) * BM + wc * 32 + 8 * fq;
            if (pn < 6) body<0>(acc, base, 512, row0, col0, bcol0, pn < 2 ? qscale : 1.0f); else body<2>(acc, base, 512, row0, col0, bcol0, 1.0f); }
        else body<3>(acc, GATE, 2048, row0, (pn - 10) * BM + wc * 32 + 8 * fq, bcol0, 1.0f);
    }
};

struct EpiBf16I8 {
    static constexpr bool PERM = true, AFTER_DRAIN = false;
    bf16_t* O; int ldc; const float* sA; const float* sB;
    __device__ __forceinline__ void operator()(const f32x4 (&acc)[2][2][4][2], const Unit& u, int wr, int wc, int fr, int fq) const {
        typedef int i32x4_t __attribute__((ext_vector_type(4)));
        const int row0 = u.pm * BM + wr * 64 + fr, col0 = u.pn * BM + wc * 32 + 8 * fq;
        f32x4 sb[2][2];
#pragma unroll
        for (int bj = 0; bj < 2; ++bj)
#pragma unroll
            for (int n = 0; n < 2; ++n) sb[bj][n] = *(const f32x4*)(sB + col0 + bj * HALF + 4 * n);
#pragma unroll
        for (int ai = 0; ai < 2; ++ai)
#pragma unroll
            for (int m = 0; m < 4; ++m) { const int row = row0 + ai * HALF + m * 16; bf16_t* rowp = O + (size_t)row * ldc + col0; const float sa = sA[row];
#pragma unroll
                for (int bj = 0; bj < 2; ++bj) {
                    const i32x4_t i0 = __builtin_bit_cast(i32x4_t, acc[ai][bj][m][0]), i1 = __builtin_bit_cast(i32x4_t, acc[ai][bj][m][1]);
                    const f32x4 v0 = (f32x4){(float)i0[0], (float)i0[1], (float)i0[2], (float)i0[3]} * sb[bj][0] * sa, v1 = (f32x4){(float)i1[0], (float)i1[1], (float)i1[2], (float)i1[3]} * sb[bj][1] * sa;
                    u32x4 w; w.x = cvt_pk_bf16(v0[0], v0[1]); w.y = cvt_pk_bf16(v0[2], v0[3]); w.z = cvt_pk_bf16(v1[0], v1[1]); w.w = cvt_pk_bf16(v1[2], v1[3]);
                    *(u32x4*)(rowp + bj * HALF) = w; } }
    }
};
template <class Epi, class Sched, bool ALIGN_EPI = false, bool SP2 = false, bool I8 = false>
__device__ __forceinline__ void gemm_phase(PG8_LAS unsigned char* lds, const Gemm g, const Sched& S, const Epi& E) {
    typedef int i32x4_t __attribute__((ext_vector_type(4)));
    int tid = threadIdx.x; asm volatile("" : "+v"(tid));
    const int wid = __builtin_amdgcn_readfirstlane(tid >> 6), lane = tid & 63, wr = wid >> 2, wc = wid & 3, fr = lane & 15, fq = lane >> 4;
    const int K = g.K, nt = K / BK;
    unsigned voffA[2], voffB[2];
#pragma unroll
    for (int i = 0; i < 2; ++i) { int R, C; stage_rc(tid * 16 + i * 8192, R, C); const int Rb = Epi::PERM ? ((R & ~31) + perm32(R & 31)) : R;
        voffA[i] = (unsigned)(R * K + C) * 2u; voffB[i] = (unsigned)(Rb * K + C) * 2u; }
    const size_t kstep = (size_t)(BK * 2);
    const size_t hstep = (size_t)HALF * K * 2;
    const size_t tstep = 2 * hstep;
    const unsigned ldsw = (unsigned)wid * 1024u;
    const int aoff = lds_byte(wr * 64 + fr, fq * 8), boff = lds_byte(wc * 32 + fr, fq * 8);
#define PG8_SA(b, h) (((b) * 2 + (h)) * HTB)
#define PG8_SB(b, h) ((4 + (b) * 2 + (h)) * HTB)
#define PG8_STAGE(bufoff, gbase, voff) do { _Pragma("unroll") for (int _i = 0; _i < 2; ++_i) \
        __builtin_amdgcn_global_load_lds((const unsigned*)((const char*)(gbase) + (voff)[_i]), (PG8_LAS unsigned*)(lds + (bufoff) + ldsw + _i * 8192), 16, 0, 0); } while (0)
#define PG8_LDA(dst, b, h) do { _Pragma("unroll") for (int m = 0; m < 4; ++m) _Pragma("unroll") for (int k = 0; k < 2; ++k) dst[m][k] = *(const PG8_LAS bf16x8*)(lds + PG8_SA(b, h) + aoff + m * 2048 + k * 1024); } while (0)
#define PG8_LDB(dst, b, h) do { _Pragma("unroll") for (int n = 0; n < 2; ++n) _Pragma("unroll") for (int k = 0; k < 2; ++k) dst[n][k] = *(const PG8_LAS bf16x8*)(lds + PG8_SB(b, h) + boff + n * 2048 + k * 1024); } while (0)
#define PG8_MMA(ai, bj, At, Bt) do { __builtin_amdgcn_s_setprio(1); _Pragma("unroll") for (int m = 0; m < 4; ++m) _Pragma("unroll") for (int n = 0; n < 2; ++n) _Pragma("unroll") for (int k = 0; k < 2; ++k) \
        { if constexpr (I8) acc[ai][bj][m][n] = __builtin_bit_cast(f32x4, __builtin_amdgcn_mfma_i32_16x16x64_i8(__builtin_bit_cast(i32x4_t, Bt[n][k]), __builtin_bit_cast(i32x4_t, At[m][k]), __builtin_bit_cast(i32x4_t, acc[ai][bj][m][n]), 0, 0, 0)); \
          else acc[ai][bj][m][n] = __builtin_amdgcn_mfma_f32_16x16x32_bf16(Bt[n][k], At[m][k], acc[ai][bj][m][n], 0, 0, 0); } __builtin_amdgcn_s_setprio(0); } while (0)
#define PG8_WAIT_V(n) asm volatile("s_waitcnt vmcnt(" #n ")" ::: "memory")
#define PG8_WAIT_L(n) asm volatile("s_waitcnt lgkmcnt(" #n ")" ::: "memory")
#define PG8_BAR __builtin_amdgcn_s_barrier()
#define PG8_SCHED __builtin_amdgcn_sched_barrier(0)
    Unit cur, nxt; int ui = 0;
    if (!S.next(0, cur)) return;
    f32x4 acc[2][2][4][2];
#pragma unroll
    for (int a = 0; a < 2; ++a)
#pragma unroll
        for (int b = 0; b < 2; ++b)
#pragma unroll
            for (int m = 0; m < 4; ++m)
#pragma unroll
                for (int n = 0; n < 2; ++n) acc[a][b][m][n] = (f32x4){0.f, 0.f, 0.f, 0.f};
    bf16x8 At[4][2], B0[2][2], B1[2][2];
    const char* cA = (const char*)g.A + (size_t)cur.pm * tstep; const char* cB = (const char*)g.Bt + (size_t)cur.pn * tstep;
    S.a_ready(cur);
    if constexpr (SP2) {
        PG8_STAGE(PG8_SB(0, 0), cB, voffB); PG8_STAGE(PG8_SB(0, 1), cB + hstep, voffB); PG8_STAGE(PG8_SA(0, 0), cA, voffA); PG8_STAGE(PG8_SA(0, 1), cA + hstep, voffA);
        if (wr == 1) PG8_BAR;
        PG8_WAIT_V(2); PG8_BAR;
        PG8_STAGE(PG8_SB(1, 0), cB + kstep, voffB); PG8_STAGE(PG8_SA(1, 0), cA + kstep, voffA); PG8_STAGE(PG8_SB(1, 1), cB + hstep + kstep, voffB);
        PG8_WAIT_V(6); PG8_BAR;
    } else {
        PG8_STAGE(PG8_SB(0, 0), cB, voffB); PG8_STAGE(PG8_SA(0, 0), cA, voffA); PG8_STAGE(PG8_SB(0, 1), cB + hstep, voffB); PG8_STAGE(PG8_SA(0, 1), cA + hstep, voffA);
        if (wr == 1) PG8_BAR;
        PG8_WAIT_V(4); PG8_BAR;
        PG8_STAGE(PG8_SB(1, 0), cB + kstep, voffB); PG8_STAGE(PG8_SA(1, 0), cA + kstep, voffA); PG8_STAGE(PG8_SB(1, 1), cB + hstep + kstep, voffB);
        PG8_WAIT_V(6); PG8_BAR;
    }
    for (;;) {
        const bool has_next = S.next(ui + 1, nxt);
        const char* nA = has_next ? (const char*)g.A + (size_t)nxt.pm * tstep : cA; const char* nB = has_next ? (const char*)g.Bt + (size_t)nxt.pn * tstep : cB;
        for (int t = 0; t < nt; t += 2) {
            const bool last = (t == nt - 2);
            const char* a1 = cA + (size_t)(t + 1) * kstep;
            const char* a2 = last ? nA : cA + (size_t)(t + 2) * kstep; const char* b2 = last ? nB : cB + (size_t)(t + 2) * kstep;
            const char* a3 = a2 + kstep; const char* b3 = b2 + kstep;
            if (last && has_next) S.a_ready(nxt);
            if constexpr (SP2) {
            PG8_LDB(B0, 0, 0); PG8_LDB(B1, 0, 1); PG8_SCHED; PG8_LDA(At, 0, 0); PG8_STAGE(PG8_SA(1, 1), a1 + hstep, voffA);
            PG8_WAIT_V(8); PG8_WAIT_L(0); PG8_BAR; PG8_MMA(0, 0, At, B0); PG8_MMA(0, 1, At, B1); PG8_BAR; PG8_SCHED;
            PG8_LDA(At, 0, 1); PG8_STAGE(PG8_SB(0, 0), b2, voffB); PG8_STAGE(PG8_SB(0, 1), b2 + hstep, voffB); PG8_STAGE(PG8_SA(0, 0), a2, voffA);
            PG8_WAIT_V(8); PG8_WAIT_L(0); PG8_BAR; PG8_MMA(1, 0, At, B0); PG8_MMA(1, 1, At, B1); PG8_BAR; PG8_SCHED;
            PG8_LDB(B0, 1, 0); PG8_LDB(B1, 1, 1); PG8_SCHED; PG8_LDA(At, 1, 0); PG8_STAGE(PG8_SA(0, 1), a2 + hstep, voffA);
            PG8_WAIT_V(8); PG8_WAIT_L(0); PG8_BAR; PG8_MMA(0, 0, At, B0); PG8_MMA(0, 1, At, B1); PG8_BAR; PG8_SCHED;
            PG8_LDA(At, 1, 1); PG8_STAGE(PG8_SB(1, 0), b3, voffB); PG8_STAGE(PG8_SB(1, 1), b3 + hstep, voffB); PG8_STAGE(PG8_SA(1, 0), a3, voffA);
            PG8_WAIT_V(8); PG8_WAIT_L(0); PG8_BAR; PG8_MMA(1, 0, At, B0); PG8_MMA(1, 1, At, B1); PG8_BAR; PG8_SCHED;
            } else {
            PG8_LDB(B0, 0, 0); PG8_SCHED; PG8_LDA(At, 0, 0); PG8_STAGE(PG8_SA(1, 1), a1 + hstep, voffA);
            PG8_WAIT_L(8); PG8_BAR; PG8_WAIT_L(0); PG8_MMA(0, 0, At, B0); PG8_BAR; PG8_SCHED;
            PG8_LDB(B1, 0, 1); PG8_STAGE(PG8_SB(0, 0), b2, voffB);
            PG8_BAR; PG8_WAIT_L(0); PG8_MMA(0, 1, At, B1); PG8_BAR;
            PG8_LDA(At, 0, 1); PG8_STAGE(PG8_SA(0, 0), a2, voffA);
            PG8_BAR; PG8_WAIT_L(0); PG8_MMA(1, 0, At, B0); PG8_BAR; PG8_SCHED;
            PG8_STAGE(PG8_SB(0, 1), b2 + hstep, voffB);
            PG8_WAIT_V(6); PG8_BAR; PG8_MMA(1, 1, At, B1); PG8_BAR;
            PG8_LDB(B0, 1, 0); PG8_SCHED; PG8_LDA(At, 1, 0); PG8_STAGE(PG8_SA(0, 1), a2 + hstep, voffA);
            PG8_WAIT_L(8); PG8_BAR; PG8_WAIT_L(0); PG8_MMA(0, 0, At, B0); PG8_BAR; PG8_SCHED;
            PG8_LDB(B1, 1, 1); PG8_STAGE(PG8_SB(1, 0), b3, voffB);
            PG8_BAR; PG8_WAIT_L(0); PG8_MMA(0, 1, At, B1); PG8_BAR;
            PG8_LDA(At, 1, 1); PG8_STAGE(PG8_SA(1, 0), a3, voffA);
            PG8_BAR; PG8_WAIT_L(0); PG8_MMA(1, 0, At, B0); PG8_BAR; PG8_SCHED;
            PG8_STAGE(PG8_SB(1, 1), b3 + hstep, voffB);
            PG8_WAIT_V(6); PG8_BAR; PG8_MMA(1, 1, At, B1); PG8_BAR;
            }
        }
        if constexpr (ALIGN_EPI) { if (wr == 0) PG8_BAR; }
        if constexpr (!Epi::AFTER_DRAIN) { E(acc, cur, wr, wc, fr, fq); S.done(cur); }
        if (!has_next) break;
#pragma unroll
        for (int a = 0; a < 2; ++a)
#pragma unroll
            for (int b = 0; b < 2; ++b)
#pragma unroll
                for (int m = 0; m < 4; ++m)
#pragma unroll
                    for (int n = 0; n < 2; ++n) acc[a][b][m][n] = (f32x4){0.f, 0.f, 0.f, 0.f};
        cur = nxt; cA = nA; cB = nB; ++ui;
        if constexpr (ALIGN_EPI) { if (wr == 1) PG8_BAR; }
    }
    PG8_WAIT_V(0);
    if constexpr (!ALIGN_EPI) { if (wr == 0) PG8_BAR; }
    PG8_BAR;
    if constexpr (Epi::AFTER_DRAIN) { E.fused(acc, cur, wr, wc, fr, fq, lds, wid, lane); S.done(cur); }
#undef PG8_SA
#undef PG8_SB
#undef PG8_STAGE
#undef PG8_LDA
#undef PG8_LDB
#undef PG8_MMA
#undef PG8_WAIT_V
#undef PG8_WAIT_L
#undef PG8_BAR
#undef PG8_SCHED
}
}
#include <hip/hip_bf16.h>
#include <cmath>
namespace attn_body {
using bf16=__hip_bfloat16;
using bf16x8=__attribute__((ext_vector_type(8)))short;
using s16x4=__attribute__((ext_vector_type(4)))short;
using f32x16=__attribute__((ext_vector_type(16)))float;
using u32x4=__attribute__((ext_vector_type(4)))unsigned;
constexpr int BATCH=8,NHEAD=8,SEQ=2048,D=64,DM=NHEAD*D;
constexpr int NW=8,QBLK=32,QB=QBLK*NW,KVBLK=64,NQB=SEQ/QB;
constexpr int ATTN_PITCH=DM, ATTN_UNIT_ROWS=QB;
__device__ __forceinline__ int crow(int r,int hi){return (r&3)+8*(r>>2)+4*hi;}
#define SBAR() __builtin_amdgcn_sched_barrier(0)
__device__ __forceinline__ void cmask(f32x16&p0,f32x16&p1,int jb,int qrel,int hi){
  const float NEG=-INFINITY; int kb=64*jb+4*hi;
  #pragma unroll
  for(int r=0;r<16;++r){int kv=kb+(r&3)+8*(r>>2); if(kv>qrel)p0[r]=NEG; if(kv+32>qrel)p1[r]=NEG;}
}

constexpr int NSLOT=3, SLOTB=8192;
constexpr int LDS_K=0, LDS_V=NSLOT*SLOTB, LDS_WS=2*NSLOT*SLOTB, LDS_OST=LDS_WS+NW*64*4, LDS_CS=LDS_OST+NW*4096, LDS_BYTES=LDS_CS+SEQ*4;
constexpr float C2=0.125f*1.4426950408889634f;
__device__ __forceinline__ void glds16(const void*gsrc,unsigned lds_dst){unsigned keep;
  asm volatile("s_mov_b32 %0, m0\n\ts_mov_b32 m0, %2\n\ts_nop 0\n\tglobal_load_lds_dwordx4 %1, off\n\ts_mov_b32 m0, %0":"=&s"(keep):"v"(gsrc),"s"(lds_dst):"memory");}
__device__ __forceinline__ float max3f(float a,float b,float c){float r;asm("v_max3_f32 %0, %1, %2, %3":"=v"(r):"v"(a),"v"(b),"v"(c));return r;}
__device__ __forceinline__ float max2f(float a,float b){float r;asm("v_max_f32_e32 %0, %1, %2":"=v"(r):"v"(a),"v"(b));return r;}
__device__ __forceinline__ float fadd_s(float a,float b){float r;asm("v_add_f32_e32 %0, %1, %2":"=v"(r):"v"(a),"v"(b));return r;}
__device__ __forceinline__ float fsub_s(float a,float b){float r;asm("v_sub_f32_e32 %0, %1, %2":"=v"(r):"v"(a),"v"(b));return r;}
typedef float f32x2_t __attribute__((ext_vector_type(2))); typedef __bf16 bf16x2_t __attribute__((ext_vector_type(2)));
__device__ __forceinline__ unsigned cvtpk_s(float lo,float hi){f32x2_t v={lo,hi};bf16x2_t b=__builtin_convertvector(v,bf16x2_t);return __builtin_bit_cast(unsigned,b);}
#define WAIT_BAR(N) asm volatile("s_waitcnt vmcnt(" #N ") lgkmcnt(0)\n\ts_barrier":::"memory")

__device__ __forceinline__ void qkt(f32x16&p0,f32x16&p1,const char*Kslot,const bf16x8*qr,int r32,int hi){
  const char*kb=Kslot+hi*1024+r32*16;
  #pragma unroll
  for(int d0=0;d0<4;++d0){
    const bf16x8 b0=*reinterpret_cast<const bf16x8*>(kb+d0*2048);
    const bf16x8 b1=*reinterpret_cast<const bf16x8*>(kb+d0*2048+512);
    p0=__builtin_amdgcn_mfma_f32_32x32x16_bf16(b0,qr[d0],p0,0,0,0);p1=__builtin_amdgcn_mfma_f32_32x32x16_bf16(b1,qr[d0],p1,0,0,0);}
}
typedef __attribute__((address_space(3))) const char* lds_cptr;
typedef short v4i16_t __attribute__((ext_vector_type(4)));
__device__ __forceinline__ void kload8(bf16x8*kf,lds_cptr kp){
  kf[0]=*(const __attribute__((address_space(3))) bf16x8*)(kp);      kf[1]=*(const __attribute__((address_space(3))) bf16x8*)(kp+512);
  kf[2]=*(const __attribute__((address_space(3))) bf16x8*)(kp+2048); kf[3]=*(const __attribute__((address_space(3))) bf16x8*)(kp+2560);
  kf[4]=*(const __attribute__((address_space(3))) bf16x8*)(kp+4096); kf[5]=*(const __attribute__((address_space(3))) bf16x8*)(kp+4608);
  kf[6]=*(const __attribute__((address_space(3))) bf16x8*)(kp+6144); kf[7]=*(const __attribute__((address_space(3))) bf16x8*)(kp+6656);
}
__device__ __forceinline__ void kload2(bf16x8*kf,lds_cptr kp,int j){ kf[2*j]=*(const __attribute__((address_space(3))) bf16x8*)(kp+j*2048); kf[2*j+1]=*(const __attribute__((address_space(3))) bf16x8*)(kp+j*2048+512); }
__device__ __forceinline__ s16x4 vtr(lds_cptr p){ return __builtin_bit_cast(s16x4,__builtin_amdgcn_ds_read_tr16_b64_v4i16((__attribute__((address_space(3))) v4i16_t*)p)); }
__device__ __forceinline__ float rowmax(const f32x16&p0,const f32x16&p1){
  float a=max3f(p0[0],p0[1],p1[0]),b=max3f(p0[2],p0[3],p1[1]);a=max3f(a,p1[2],p1[3]);
  #pragma unroll
  for(int r=4;r<16;r+=4){a=max3f(a,p0[r],p0[r+1]);b=max3f(b,p0[r+2],p0[r+3]);a=max3f(a,p1[r],p1[r+1]);b=max3f(b,p1[r+2],p1[r+3]);}
  const float m=max2f(a,b);
  auto rr=__builtin_amdgcn_permlane32_swap(__float_as_uint(m),__float_as_uint(m),false,false);
  return max2f(__uint_as_float(rr[0]),__uint_as_float(rr[1]));
}
__device__ __forceinline__ void pv(f32x16*o,int vb,bf16x8 pa0,bf16x8 pa1,bf16x8 pa2,bf16x8 pa3){
  #pragma unroll
  for(int d0=0;d0<2;++d0){s16x4 lo[4],hi[4];
    #pragma unroll
    for(int ks=0;ks<4;++ks){
      asm volatile("ds_read_b64_tr_b16 %0,%1 offset:%c2":"=&v"(lo[ks]):"v"(vb),"i"(d0*4096+ks*1024):"memory");
      asm volatile("ds_read_b64_tr_b16 %0,%1 offset:%c2":"=&v"(hi[ks]):"v"(vb),"i"(d0*4096+ks*1024+512):"memory");}
    asm volatile("s_waitcnt lgkmcnt(0)":::"memory");SBAR();
    #define PK(k) (bf16x8){lo[k][0],lo[k][1],lo[k][2],lo[k][3],hi[k][0],hi[k][1],hi[k][2],hi[k][3]}
    o[d0]=__builtin_amdgcn_mfma_f32_32x32x16_bf16(pa0,PK(0),o[d0],0,0,0);
    o[d0]=__builtin_amdgcn_mfma_f32_32x32x16_bf16(pa1,PK(1),o[d0],0,0,0);
    o[d0]=__builtin_amdgcn_mfma_f32_32x32x16_bf16(pa2,PK(2),o[d0],0,0,0);
    o[d0]=__builtin_amdgcn_mfma_f32_32x32x16_bf16(pa3,PK(3),o[d0],0,0,0);
    #undef PK
  }
}

#ifndef ATTN_STORE16
#define ATTN_STORE16(p,v) (*(u32x4*)(p)=(v))
#endif
template<int THRL> __device__ __forceinline__ void attn_unit(int b,int h,int qb,const bf16*Q,const bf16*__restrict__ K,const bf16*__restrict__ V,bf16*O,const float*__restrict__ CL2,char*shm,int t0=0){
  int tid=threadIdx.x; asm volatile("":"+v"(tid)); const int lane=tid&63,r32=lane&31,hi=lane>>5; const int wid=__builtin_amdgcn_readfirstlane(tid>>6);
  const long rowbase=(long)b*SEQ; const int q0=qb*QB;
  const bf16*Qw=Q+(rowbase+q0+wid*QBLK)*DM+h*D;
  const bf16*Kh=K+rowbase*DM+h*D,*Vh=V+rowbase*DM+h*D;
  const unsigned lds0=(unsigned)(uintptr_t)shm;
  float*wsf=(float*)(shm+LDS_WS)+wid*64;
  const bf16*ksrc=Kh+(long)(t0*KVBLK+lane)*DM+wid*8;
  const bf16*vsrc=Vh+(long)(t0*KVBLK+16*(wid&3)+(lane>>2))*DM+(wid>>2)*32+(lane&3)*8;
  const unsigned kdst=lds0+LDS_K+wid*1024, vdst=lds0+LDS_V+wid*1024;
  #define DMA_K(t,slot) glds16(ksrc+(long)(t)*KVBLK*DM,(unsigned)__builtin_amdgcn_readfirstlane(kdst+(slot)))
  #define DMA_V(t,slot) glds16(vsrc+(long)(t)*KVBLK*DM,(unsigned)__builtin_amdgcn_readfirstlane(vdst+(slot)))
  const int vb0=(int)(lds0+LDS_V)+((lane>>4)&1)*32+(lane&3)*8+(4*hi+((lane&15)>>2))*64;
  const char*Kbase=shm+LDS_K; bf16x8 kf[8];
  const lds_cptr shm3=(lds_cptr)shm; const lds_cptr kp0=shm3+LDS_K+hi*1024+r32*16; const lds_cptr vp0=shm3+LDS_V+((lane>>4)&1)*32+(lane&3)*8+(4*hi+((lane&15)>>2))*64;
  const int NT=(q0+QB)/KVBLK-t0;
  DMA_K(0,0);DMA_V(0,0);DMA_K(1,SLOTB);
  bf16x8 qr[4];
  #pragma unroll
  for(int d0=0;d0<4;++d0)qr[d0]=*reinterpret_cast<const bf16x8*>(&Qw[(long)r32*DM+d0*16+hi*8]);
  const float*cg=CL2+(long)(b*NHEAD+h)*SEQ;
  { float*csf=(float*)(shm+LDS_CS); for(int i=tid;i<q0+QB;i+=NW*64)csf[i]=cg[i]; }
  const lds_cptr cs3=(lds_cptr)shm+LDS_CS+hi*16+t0*256;
  float nm=cg[q0+wid*QBLK+r32],l_reg=0.f;f32x16 o[2];o[0]=f32x16{};o[1]=f32x16{};
  const int qrel=wid*QBLK+r32;
  #define CMASK(P0,P1,t) do{int jb_=(t)-(NT-4); if(jb_>=0)cmask(P0,P1,jb_,qrel,hi);}while(0)
  bool resc=false;
  typedef float f32x4_t __attribute__((ext_vector_type(4)));
  #define BIAS(C0,C1,t) do{ const lds_cptr cp_=cs3+(t)*256; \
    _Pragma("unroll") for(int g_=0;g_<4;++g_){ const f32x4_t a_=*(const __attribute__((address_space(3))) f32x4_t*)(cp_+g_*32), b_=*(const __attribute__((address_space(3))) f32x4_t*)(cp_+g_*32+128); \
      _Pragma("unroll") for(int i_=0;i_<4;++i_){ C0[4*g_+i_]=nm-a_[i_]; C1[4*g_+i_]=nm-b_[i_]; } } }while(0)
  #define START(P0,P1) do{ const float rm=rowmax(P0,P1); resc=false; \
    { const float dl=(rm>(float)THRL)?rm:0.f;     \
      nm=fsub_s(nm,dl); \
      _Pragma("unroll") for(int r=0;r<16;++r){P0[r]=fsub_s(P0[r],dl);P1[r]=fsub_s(P1[r],dl);} } \
    _Pragma("unroll") for(int r=0;r<16;++r)P0[r]=__builtin_amdgcn_exp2f(P0[r]); }while(0)
  #define RESC() do{ if(resc){ asm volatile("s_waitcnt lgkmcnt(0)":::"memory"); \
      _Pragma("unroll") for(int d_=0;d_<2;++d_) _Pragma("unroll") for(int r=0;r<16;++r)o[d_][r]*=wsf[crow(r,hi)]; } }while(0)
  f32x16 pA0,pA1,pB0,pB1;
  int sl_prev=0,sl_cur=0,sl_next=SLOTB;
  #define ROT() do{sl_prev=sl_cur;sl_cur=sl_next;sl_next=(sl_next==(NSLOT-1)*SLOTB)?0:sl_next+SLOTB;}while(0)
  DMA_K(2,2*SLOTB);
  WAIT_BAR(3);
  BIAS(pA0,pA1,0); qkt(pA0,pA1,Kbase,qr,r32,hi);asm volatile("s_nop 15\n\ts_nop 7":"+v"(pA0),"+v"(pA1));CMASK(pA0,pA1,0);
  START(pA0,pA1);
  _Pragma("unroll") for(int r=0;r<16;++r)pA1[r]=__builtin_amdgcn_exp2f(pA1[r]);
  WAIT_BAR(0);
  DMA_K(3,0);DMA_V(1,SLOTB);
  ROT();
  kload8(kf,kp0+sl_cur);
  WAIT_BAR(2);
  s16x4 vlo[8],vhi[8]; u32x4 pw0,pw1,pw2,pw3;
  #define PKW(P,B) cvtpk_s(P[B],P[B+1])
  #define PAF(k) __builtin_bit_cast(bf16x8,pw##k)
  #define VFR(i) (bf16x8){vlo[i][0],vlo[i][1],vlo[i][2],vlo[i][3],vhi[i][0],vhi[i][1],vhi[i][2],vhi[i][3]}
  #define PIN(x) asm volatile("":"+v"(x))
  #define MX3(a,b,c) __builtin_fmaxf(__builtin_fmaxf((a),(b)),(c))
  #define GAPA(MF,A0,A1,A2,A3,W0,W1,PW) do{ MF; sacc+=A0; sacc+=A1; sacc+=A2; sacc+=A3; PIN(sacc); W0; W1; PIN(PW); SBAR(); }while(0)
  #define EX(v) __builtin_amdgcn_exp2f(v)
  #define GAPB(MF,X,B) do{ MF; X[B]=EX(X[B]); X[B+1]=EX(X[B+1]); X[B+2]=EX(X[B+2]); X[B+3]=EX(X[B+3]); PIN(X); SBAR(); }while(0)
  #define VRD(i) do{ vlo[i]=vtr(vp_+(((i)>>2)*4096+((i)&3)*1024)); vhi[i]=vtr(vp_+(((i)>>2)*4096+((i)&3)*1024+512)); }while(0)
  #define KRD(G,j) do{ if(G){ kload2(kf,kp0+sl_next,j); SBAR(); } }while(0)
  #define STEP(C0,C1,P0,P1,t,GK,GV,GL) do{ SBAR(); BIAS(C0,C1,t); SBAR(); \
    const lds_cptr vp_=vp0+sl_prev; \
    VRD(0); SBAR(); float sacc=(P0[0]+P0[1]); \
    GAPA(C0=__builtin_amdgcn_mfma_f32_32x32x16_bf16(kf[0],qr[0],C0,0,0,0), P0[2],P0[3],P0[4],P0[5],     pw0[0]=PKW(P0,0), pw0[1]=PKW(P0,2), pw0); \
    VRD(4); SBAR(); GAPA(C1=__builtin_amdgcn_mfma_f32_32x32x16_bf16(kf[1],qr[0],C1,0,0,0), P0[6],P0[7],P0[8],P0[9],     pw0[2]=PKW(P0,4), pw0[3]=PKW(P0,6), pw0); \
    VRD(1); SBAR(); GAPA(C0=__builtin_amdgcn_mfma_f32_32x32x16_bf16(kf[2],qr[1],C0,0,0,0),   P0[10],P0[11],P0[12],P0[13], pw1[0]=PKW(P0,8), pw1[1]=PKW(P0,10), pw1); \
    VRD(5); SBAR(); GAPA(C1=__builtin_amdgcn_mfma_f32_32x32x16_bf16(kf[3],qr[1],C1,0,0,0),   P0[14],P0[15],P1[0],P1[1],   pw1[2]=PKW(P0,12),pw1[3]=PKW(P0,14), pw1); \
    VRD(2); SBAR(); GAPA(C0=__builtin_amdgcn_mfma_f32_32x32x16_bf16(kf[4],qr[2],C0,0,0,0),   P1[2],P1[3],P1[4],P1[5],     pw2[0]=PKW(P1,0), pw2[1]=PKW(P1,2), pw2); \
    VRD(6); SBAR(); GAPA(C1=__builtin_amdgcn_mfma_f32_32x32x16_bf16(kf[5],qr[2],C1,0,0,0),   P1[6],P1[7],P1[8],P1[9],     pw2[2]=PKW(P1,4), pw2[3]=PKW(P1,6), pw2); \
    VRD(3); SBAR(); GAPA(C0=__builtin_amdgcn_mfma_f32_32x32x16_bf16(kf[6],qr[3],C0,0,0,0),   P1[10],P1[11],P1[12],P1[13], pw3[0]=PKW(P1,8), pw3[1]=PKW(P1,10), pw3); \
    VRD(7); SBAR(); GAPA(C1=__builtin_amdgcn_mfma_f32_32x32x16_bf16(kf[7],qr[3],C1,0,0,0),   P1[14],P1[15],0.f,0.f,       pw3[2]=PKW(P1,12),pw3[3]=PKW(P1,14), pw3); \
    l_reg+=sacc; \
    if(GK){DMA_K((t)+3,sl_cur);} if(GV){DMA_V((t)+1,sl_next);} \
    CMASK(C0,C1,t); \
    { float a=MX3(C0[0],C0[1],C1[0]),b=MX3(C0[2],C0[3],C1[1]); a=MX3(a,C1[2],C1[3]); \
      _Pragma("unroll") for(int r=4;r<16;r+=4){a=MX3(a,C0[r],C0[r+1]);b=MX3(b,C0[r+2],C0[r+3]);a=MX3(a,C1[r],C1[r+1]);b=MX3(b,C1[r+2],C1[r+3]);} \
      float rm=__builtin_fmaxf(a,b); { auto rr=__builtin_amdgcn_permlane32_swap(__float_as_uint(rm),__float_as_uint(rm),false,false); rm=__builtin_fmaxf(__uint_as_float(rr[0]),__uint_as_float(rr[1])); } \
      resc=false; \
      if(__builtin_expect(__any(rm>(float)THRL),0)){ const float dl=__builtin_fmaxf(rm,0.f); nm-=dl; \
        _Pragma("unroll") for(int r=0;r<16;++r){C0[r]-=dl;C1[r]-=dl;} \
        const float f=__builtin_amdgcn_exp2f(-dl); l_reg*=f; if(hi==0)wsf[r32]=f; resc=true; } } \
    SBAR(); \
    GAPB(o[0]=__builtin_amdgcn_mfma_f32_32x32x16_bf16(PAF(0),VFR(0),o[0],0,0,0), C0,0); \
    GAPB(o[1]=__builtin_amdgcn_mfma_f32_32x32x16_bf16(PAF(0),VFR(4),o[1],0,0,0), C0,4); \
    KRD(GL,0); GAPB(o[0]=__builtin_amdgcn_mfma_f32_32x32x16_bf16(PAF(1),VFR(1),o[0],0,0,0), C0,8); \
    KRD(GL,1); GAPB(o[1]=__builtin_amdgcn_mfma_f32_32x32x16_bf16(PAF(1),VFR(5),o[1],0,0,0), C0,12); \
    KRD(GL,2); GAPB(o[0]=__builtin_amdgcn_mfma_f32_32x32x16_bf16(PAF(2),VFR(2),o[0],0,0,0), C1,0); \
    KRD(GL,3); GAPB(o[1]=__builtin_amdgcn_mfma_f32_32x32x16_bf16(PAF(2),VFR(6),o[1],0,0,0), C1,4); \
    GAPB(o[0]=__builtin_amdgcn_mfma_f32_32x32x16_bf16(PAF(3),VFR(3),o[0],0,0,0), C1,8); \
    GAPB(o[1]=__builtin_amdgcn_mfma_f32_32x32x16_bf16(PAF(3),VFR(7),o[1],0,0,0), C1,12); \
    }while(0)
  int t=1;
  #undef CMASK
  #define CMASK(P0,P1,t) do{}while(0)
  for(;t+5<NT;t+=2){
    STEP(pB0,pB1,pA0,pA1,t,true,true,true);     WAIT_BAR(2); RESC(); ROT();
    STEP(pA0,pA1,pB0,pB1,t+1,true,true,true);   WAIT_BAR(2); RESC(); ROT();
  }
  #undef CMASK
  #define CMASK(P0,P1,t) do{int jb_=(t)-(NT-4); if(jb_>=0)cmask(P0,P1,jb_,qrel,hi);}while(0)
  #define ENDW(tt) do{ if((tt)+3<NT){WAIT_BAR(2);} else if((tt)+2<NT){WAIT_BAR(1);} else {WAIT_BAR(0);} }while(0)
  for(;t+1<NT;t+=2){
    STEP(pB0,pB1,pA0,pA1,t,(t+3<NT),(t+1<NT),(t+1<NT));       ENDW(t);   RESC(); ROT();
    STEP(pA0,pA1,pB0,pB1,t+1,(t+4<NT),(t+2<NT),(t+2<NT));     ENDW(t+1); RESC(); ROT();
  }
  STEP(pB0,pB1,pA0,pA1,NT-1,false,false,false); RESC();
  { float sacc=pB0[0]+pB0[1]; _Pragma("unroll") for(int r=2;r<16;++r)sacc+=pB0[r]; _Pragma("unroll") for(int r=0;r<16;++r)sacc+=pB1[r]; l_reg+=sacc;
    pw0=(u32x4){PKW(pB0,0),PKW(pB0,2),PKW(pB0,4),PKW(pB0,6)};pw1=(u32x4){PKW(pB0,8),PKW(pB0,10),PKW(pB0,12),PKW(pB0,14)};pw2=(u32x4){PKW(pB1,0),PKW(pB1,2),PKW(pB1,4),PKW(pB1,6)};pw3=(u32x4){PKW(pB1,8),PKW(pB1,10),PKW(pB1,12),PKW(pB1,14)};
    SBAR(); pv(o,vb0+sl_cur,PAF(0),PAF(1),PAF(2),PAF(3)); }
  #undef PKW
  #undef PAF
  #undef VFR
  #undef PIN
  #undef MX3
  #undef GAPA
  #undef GAPB
  #undef EX
  #undef VRD
  #undef KRD
  #undef STEP
  #undef ENDW
  {auto rr=__builtin_amdgcn_permlane32_swap(__float_as_uint(l_reg),__float_as_uint(l_reg),false,false);l_reg=__uint_as_float(rr[0])+__uint_as_float(rr[1]);}
  if(hi==0)wsf[32+r32]=l_reg;asm volatile("s_waitcnt lgkmcnt(0)":::"memory");
  float rli[16];
  #pragma unroll
  for(int r=0;r<16;++r)rli[r]=__builtin_amdgcn_rcpf(wsf[32+crow(r,hi)]);
  bf16*Ow=O+(rowbase+q0+wid*QBLK)*DM+h*D;
  { bf16*stg=(bf16*)(shm+LDS_OST)+wid*2048;
    #pragma unroll
    for(int r=0;r<16;++r){const int orow=crow(r,hi);
      #pragma unroll
      for(int d0=0;d0<2;++d0)stg[orow*64+d0*32+r32]=__float2bfloat16(o[d0][r]*rli[r]);}
    asm volatile("s_waitcnt lgkmcnt(0)":::"memory");
    #pragma unroll
    for(int i=0;i<4;++i){const int row=i*8+(lane>>3),ch=lane&7; const u32x4 v=*(const u32x4*)(stg+row*64+ch*8); ATTN_STORE16(Ow+(long)row*DM+ch*8,v);} }
  asm volatile("s_waitcnt lgkmcnt(0)\n\ts_barrier":::"memory");
  #undef DMA_K
  #undef DMA_V
  #undef CMASK
  #undef START
  #undef RESC
  #undef ROT
  #undef BIAS
}
constexpr int ATTN_LDS_BYTES=LDS_BYTES;
constexpr float SKIP_THR=64.0f;
__device__ __forceinline__ int attn_first_tile(const float*__restrict__ CL2,int bh,int qb){
  const int lane=threadIdx.x&63; const float*c=CL2+(long)bh*SEQ; const int q0=qb*QB, nfar=4*qb;
  const float cq=c[q0]; const float cj=c[(lane<nfar?lane:0)*KVBLK+KVBLK-1];
  const unsigned long long keep=__ballot(lane<nfar && (cq-cj)>=-SKIP_THR) | (1ull<<nfar);
  const int t0=__builtin_ctzll(keep)&~1;
  return __builtin_amdgcn_readfirstlane(t0);
}
struct AttnTensors { const bf16* Q; const bf16* K; const bf16* V; bf16* O; const float* CL2; };
struct AttnUnit { int bh; int qb; };
struct StaticOrder {
  int vcu;
  __device__ __forceinline__ explicit StaticOrder(int grid,int block):vcu((block%8)*(grid/8)+block/8){}
  __device__ __forceinline__ bool next(int i,AttnUnit&u)const{ if(i>=2||vcu>=BATCH*NHEAD*4)return false; const int s=vcu&3; u.bh=vcu>>2; u.qb=(i==0)?s:7-s; return true; }
  __device__ __forceinline__ void a_ready(const AttnUnit&)const{}
  __device__ __forceinline__ void done(const AttnUnit&)const{}
};
template<class Sched,int THRL=8> __device__ __forceinline__ void attn_phase(char*lds,const AttnTensors&T,const Sched&S){
  AttnUnit u;
  for(int i=0;S.next(i,u);++i){ S.a_ready(u); attn_unit<THRL>(u.bh/NHEAD,u.bh%NHEAD,u.qb,T.Q,T.K,T.V,T.O,T.CL2,lds); S.done(u); }
}
#undef SBAR
#undef WAIT_BAR
}
namespace sgu_body {
using attn_body::bf16x8; using attn_body::s16x4; using attn_body::f32x16; using attn_body::u32x4; using attn_body::lds_cptr; using attn_body::vtr;
constexpr int SGU_LDS_BYTES = 65536;
__device__ __forceinline__ float bflo(unsigned w) { return __uint_as_float(w << 16); }
__device__ __forceinline__ float bfhi(unsigned w) { return __uint_as_float(w & 0xffff0000u); }
__device__ __forceinline__ void sgu_unit(int ck, int half, const unsigned short* __restrict__ VG, const unsigned short* UGI, unsigned short* UGY, const unsigned short* __restrict__ WSMP,
                                         const float* __restrict__ lng, const float* __restrict__ lnb, const float* __restrict__ bs, char* shm) {
    int tid = threadIdx.x; asm volatile("" : "+v"(tid)); const int lane = tid & 63, r32 = lane & 31, hi = lane >> 5; const int wid = __builtin_amdgcn_readfirstlane(tid >> 6);
    const size_t row0 = (size_t)ck * 128;
    u32x4 raw[16];
#pragma unroll
    for (int i = 0; i < 16; ++i) raw[i] = *(const u32x4*)(VG + (row0 + 16 * wid + i) * 512 + 8 * lane);
    float mu[16], rs[16];
#pragma unroll
    for (int i = 0; i < 16; ++i) {
        const float a0 = bflo(raw[i].x), a1 = bfhi(raw[i].x), a2 = bflo(raw[i].y), a3 = bfhi(raw[i].y), a4 = bflo(raw[i].z), a5 = bfhi(raw[i].z), a6 = bflo(raw[i].w), a7 = bfhi(raw[i].w);
        float s = ((a0 + a1) + (a2 + a3)) + ((a4 + a5) + (a6 + a7));
        float q = ((a0 * a0 + a1 * a1) + (a2 * a2 + a3 * a3)) + ((a4 * a4 + a5 * a5) + (a6 * a6 + a7 * a7));
        s = wave_allsum(s); q = wave_allsum(q);
        const float m = s * (1.0f / 512.0f); const float var = fmaxf(q * (1.0f / 512.0f) - m * m, 0.f);
        mu[i] = m; rs[i] = 1.0f / sqrtf(var + 1e-6f);
    }
    if ((lane >> 5) == half) {
        const int gl = (lane >> 3) & 3, cc = 8 * (lane & 7);
        float gv[8], bv[8];
#pragma unroll
        for (int j = 0; j < 8; ++j) { gv[j] = lng[8 * lane + j]; bv[j] = lnb[8 * lane + j]; }
        char* img = shm + gl * 16384 + (cc >> 5) * 4096 + (cc & 31) * 2;
#pragma unroll
        for (int i = 0; i < 16; ++i) {
            const int s = 16 * wid + i;
            const float m = mu[i], r = rs[i];
            const float v0 = (bflo(raw[i].x) - m) * r * gv[0] + bv[0], v1 = (bfhi(raw[i].x) - m) * r * gv[1] + bv[1], v2 = (bflo(raw[i].y) - m) * r * gv[2] + bv[2], v3 = (bfhi(raw[i].y) - m) * r * gv[3] + bv[3];
            const float v4 = (bflo(raw[i].z) - m) * r * gv[4] + bv[4], v5 = (bfhi(raw[i].z) - m) * r * gv[5] + bv[5], v6 = (bflo(raw[i].w) - m) * r * gv[6] + bv[6], v7 = (bfhi(raw[i].w) - m) * r * gv[7] + bv[7];
            u32x4 w; w.x = pg8::cvt_pk_bf16(v0, v1); w.y = pg8::cvt_pk_bf16(v2, v3); w.z = pg8::cvt_pk_bf16(v4, v5); w.w = pg8::cvt_pk_bf16(v6, v7);
            *(u32x4*)(img + (s >> 6) * 8192 + ((s & 63) >> 4) * 1024 + (s & 15) * 64) = w;
        }
    }
    typedef unsigned u32x2_t __attribute__((ext_vector_type(2)));
    const int gl4 = wid >> 1, cb4 = wid & 1, g4 = 4 * half + gl4;
    bf16x8 wf[20]; u32x2_t ugq[4][4]; float bsq[4];
#pragma unroll
    for (int tb = 0; tb < 4; ++tb) {
        const unsigned short* wrow = WSMP + ((size_t)(g4 * 128 + 32 * tb + r32)) * 128 + 8 * hi;
#pragma unroll
        for (int ks = 0; ks < 2 * (tb + 1); ++ks) wf[tb * (tb + 1) + ks] = *(const bf16x8*)(wrow + 16 * ks);
        const int t = 32 * tb + r32; bsq[tb] = bs[g4 * 128 + t];
        const unsigned short* urow = UGI + (row0 + t) * 512 + g4 * 64 + 32 * cb4 + 4 * hi;
#pragma unroll
        for (int q4 = 0; q4 < 4; ++q4) ugq[tb][q4] = *(const u32x2_t*)(urow + 8 * q4);
    }
    __syncthreads();
    {
        const int gl = gl4, cb = cb4, g = g4;
        const lds_cptr vp = (lds_cptr)shm + gl * 16384 + cb * 4096 + ((lane >> 4) & 1) * 32 + (lane & 3) * 8 + (4 * hi + ((lane & 15) >> 2)) * 64;
#pragma unroll
        for (int tb = 0; tb < 4; ++tb) {
            f32x16 acc = f32x16{};
#pragma unroll
            for (int ks = 0; ks < 2 * (tb + 1); ++ks) {
                const s16x4 lo = vtr(vp + (ks >> 2) * 8192 + (ks & 3) * 1024), hh = vtr(vp + (ks >> 2) * 8192 + (ks & 3) * 1024 + 512);
                const bf16x8 a = (bf16x8){lo[0], lo[1], lo[2], lo[3], hh[0], hh[1], hh[2], hh[3]};
                acc = __builtin_amdgcn_mfma_f32_32x32x16_bf16(a, wf[tb * (tb + 1) + ks], acc, 0, 0, 0);
            }
            const int t = 32 * tb + r32; const float bsv = bsq[tb];
            unsigned short* yrow = UGY + (row0 + t) * 512 + g * 64 + 32 * cb + 4 * hi;
#pragma unroll
            for (int q4 = 0; q4 < 4; ++q4) {
                const u32x2_t ug = ugq[tb][q4];
                const float y0 = bflo(ug.x) * (acc[4 * q4 + 0] + bsv), y1 = bfhi(ug.x) * (acc[4 * q4 + 1] + bsv), y2 = bflo(ug.y) * (acc[4 * q4 + 2] + bsv), y3 = bfhi(ug.y) * (acc[4 * q4 + 3] + bsv);
                u32x2_t w; w.x = pg8::cvt_pk_bf16(y0, y1); w.y = pg8::cvt_pk_bf16(y2, y3);
                *(u32x2_t*)(yrow + 8 * q4) = w;
            }
        }
    }
    __syncthreads();
}
}
namespace peer_body {
using attn_body::bf16x8; using attn_body::f32x16; using attn_body::u32x4;
typedef __bf16 bf16x2_t __attribute__((ext_vector_type(2)));
constexpr int PEER_TOK = 64;
constexpr int L_PI = 0, L_PG = 32768, L_PS = 65536, PEER_LDS_BYTES = 98304;
__device__ __forceinline__ int okey(int b) { return b ^ ((b >> 31) & 0x7fffffff); }
__device__ __forceinline__ void ce(int& a, int& b) { const int hi = a > b ? a : b, lo = a > b ? b : a; a = hi; b = lo; }
__device__ __forceinline__ void sort16(int (&v)[16]) {
#pragma unroll
    for (int k = 2; k <= 16; k <<= 1)
#pragma unroll
        for (int j = k >> 1; j > 0; j >>= 1)
#pragma unroll
            for (int i = 0; i < 16; ++i) { const int l = i ^ j; if (l > i) { if ((i & k) == 0) ce(v[i], v[l]); else ce(v[l], v[i]); } }
}
__device__ __forceinline__ void merge16(int (&a)[16], const int (&b)[16]) {
#pragma unroll
    for (int i = 0; i < 16; ++i) a[i] = a[i] > b[15 - i] ? a[i] : b[15 - i];
#pragma unroll
    for (int j = 8; j > 0; j >>= 1)
#pragma unroll
        for (int i = 0; i < 16; ++i) { const int l = i ^ j; if (l > i) ce(a[i], a[l]); }
}
__device__ __forceinline__ float dot2(unsigned w, unsigned x, float acc) { return __builtin_amdgcn_fdot2_f32_bf16(__builtin_bit_cast(bf16x2_t, w), __builtin_bit_cast(bf16x2_t, x), acc, false); }
__device__ __forceinline__ float gelu_erf(float v) { return 0.5f * v * (1.0f + erff(v * 0.70710678118654752f)); }

constexpr int SK_PITCH = 272;
__device__ __forceinline__ void top16_scores(int (&res)[16], const bf16x8 (&bq)[8], const char* SKl, int r32, int hi) {
    f32x16 acc[4];
#pragma unroll
    for (int nb = 0; nb < 4; ++nb) acc[nb] = f32x16{};
#pragma unroll
    for (int ks = 0; ks < 8; ++ks) {
#pragma unroll
        for (int nb = 0; nb < 4; ++nb) { const bf16x8 a = *(const bf16x8*)(SKl + (32 * nb + r32) * SK_PITCH + (16 * ks + 8 * hi) * 2);
            acc[nb] = __builtin_amdgcn_mfma_f32_32x32x16_bf16(a, bq[ks], acc[nb], 0, 0, 0); }
        if (ks & 1) __builtin_amdgcn_sched_barrier(0);
    }
    int k[4][16];
#pragma unroll
    for (int nb = 0; nb < 4; ++nb) {
#pragma unroll
        for (int r = 0; r < 16; ++r) { const int n = 32 * nb + (r & 3) + 8 * (r >> 2) + 4 * hi; k[nb][r] = okey((int)((__float_as_uint(acc[nb][r]) & ~0x7fu) | (unsigned)n)); }
        sort16(k[nb]);
    }
    merge16(k[0], k[1]); merge16(k[2], k[3]); merge16(k[0], k[2]);
    int lo[16], up[16];
#pragma unroll
    for (int i = 0; i < 16; ++i) { const auto rr = __builtin_amdgcn_permlane32_swap((unsigned)k[0][i], (unsigned)k[0][i], false, false); lo[i] = (int)rr[0]; up[i] = (int)rr[1]; }
    merge16(lo, up);
#pragma unroll
    for (int i = 0; i < 16; ++i) res[i] = lo[i];
}

__device__ __forceinline__ unsigned pack_i8x4(float a, float b, float c, float d) {
    const int ia = (int)__builtin_rintf(a), ib = (int)__builtin_rintf(b), ic = (int)__builtin_rintf(c), id = (int)__builtin_rintf(d);
    return (unsigned)(ia & 0xff) | ((unsigned)(ib & 0xff) << 8) | ((unsigned)(ic & 0xff) << 16) | ((unsigned)(id & 0xff) << 24);
}
typedef float f32x2_t __attribute__((ext_vector_type(2)));
typedef unsigned u32x2_t __attribute__((ext_vector_type(2)));
__device__ __forceinline__ void fma_fp8x4(f32x2_t& a01, f32x2_t& a23, unsigned v, f32x2_t w2) {
    const f32x2_t lo = __builtin_amdgcn_cvt_pk_f32_fp8((int)v, false), hi = __builtin_amdgcn_cvt_pk_f32_fp8((int)v, true);
    a01 = __builtin_elementwise_fma(lo, w2, a01); a23 = __builtin_elementwise_fma(hi, w2, a23);
}
template <int CTRL> __device__ __forceinline__ int dppi(int v) { return __builtin_amdgcn_update_dpp(0, v, CTRL, 0xf, 0xf, false); }
template <int CTRL> __device__ __forceinline__ float dppf(float v) { return __int_as_float(__builtin_amdgcn_update_dpp(0, __float_as_int(v), CTRL, 0xf, 0xf, false)); }
constexpr int DPP_HMIRROR = 0x141, DPP_XOR2 = 0x4E, DPP_XOR1 = 0xB1, DPP_ROR8 = 0x128;

__device__ __forceinline__ void peer_retrieve(int tk, const unsigned short* __restrict__ QP, const unsigned short* __restrict__ SK, const float* __restrict__ SU, const float* __restrict__ SV,
                                              const float* __restrict__ ST, unsigned short* __restrict__ PID, float* __restrict__ G2, float* __restrict__ PS2, char* shm) {
    int tid = threadIdx.x; asm volatile("" : "+v"(tid)); const int lane = tid & 63, r32 = lane & 31, hi = lane >> 5; const int wid = __builtin_amdgcn_readfirstlane(tid >> 6);
    const int h = tk & 7, T0 = (tk >> 3) * 512 + 64 * wid;
    {   const u32x4* src = (const u32x4*)(SK + (size_t)h * 2 * 128 * 128);
#pragma unroll
        for (int i = 0; i < 8; ++i) { const int c = tid + 512 * i, row = c >> 4, ch = c & 15; *(u32x4*)(shm + row * SK_PITCH + ch * 16) = src[c]; }
    }
    __syncthreads();
#pragma unroll 1
    for (int tb = 0; tb < 2; ++tb) {
        const unsigned short* QPt = QP + (size_t)(T0 + 32 * tb) * 2048 + h * 256;
        int A[16], B[16];
        bf16x8 bqa[8], bqb[8];
#pragma unroll
        for (int ks = 0; ks < 8; ++ks) { bqa[ks] = *(const bf16x8*)(QPt + (size_t)r32 * 2048 + 16 * ks + 8 * hi); bqb[ks] = *(const bf16x8*)(QPt + 128 + (size_t)r32 * 2048 + 16 * ks + 8 * hi); }
        top16_scores(A, bqa, shm, r32, hi);
        top16_scores(B, bqb, shm + 128 * SK_PITCH, r32, hi);
        float fa[16], fb[16]; int na[16], nb[16];
#pragma unroll
        for (int i = 0; i < 16; ++i) { const int ba = okey(A[i]), bb = okey(B[i]); fa[i] = __int_as_float(ba); fb[i] = __int_as_float(bb); na[i] = (ba & 0x7f) << 7; nb[i] = bb & 0x7f; }
#define CAND(i, j) okey((int)((__float_as_uint(fa[i] + fb[j]) & ~0x3fffu) | (unsigned)(na[i] | nb[j])))
        const int NEGK = (int)0x80000000;
        int L0[16], L1[16], L2[16], L3[16];
#pragma unroll
        for (int j = 0; j < 16; ++j) L0[j] = CAND(0, j);
#pragma unroll
        for (int j = 0; j < 8; ++j) L1[j] = CAND(1, j);
#pragma unroll
        for (int j = 0; j < 5; ++j) L1[8 + j] = CAND(2, j);
#pragma unroll
        for (int j = 0; j < 3; ++j) L1[13 + j] = CAND(3, j);
        L2[0] = CAND(3, 3);
#pragma unroll
        for (int j = 0; j < 3; ++j) L2[1 + j] = CAND(4, j);
#pragma unroll
        for (int j = 0; j < 2; ++j) { L2[4 + j] = CAND(5, j); L2[6 + j] = CAND(6, j); L2[8 + j] = CAND(7, j); }
#pragma unroll
        for (int i = 8; i < 14; ++i) L2[2 + i] = CAND(i, 0);
        L3[0] = CAND(14, 0); L3[1] = CAND(15, 0);
#pragma unroll
        for (int i = 2; i < 16; ++i) L3[i] = NEGK;
#undef CAND
        sort16(L1); sort16(L2); sort16(L3);
        merge16(L0, L1); merge16(L2, L3); merge16(L0, L2);
        float e[16]; int id[16]; float se = 0.f;
        const float s0 = __int_as_float((okey(L0[0]) & ~0x3fff) | 0x2000);
#pragma unroll
        for (int i = 0; i < 16; ++i) { const int b = okey(L0[i]); id[i] = b & 0x3fff; const float s = __int_as_float((b & ~0x3fff) | 0x2000); e[i] = __expf(s - s0); se += e[i]; }
        const float inv = 1.0f / se;
        if (hi == 0) {
            const size_t t = (size_t)(T0 + 32 * tb + r32); const float st = ST[t];
            unsigned short* pi = PID + t * 128 + h * 16; float* pg = G2 + t * 128 + h * 16; float* ps = PS2 + t * 128 + h * 16;
            u32x4 w0, w1;
            w0.x = (unsigned)id[0] | ((unsigned)id[1] << 16); w0.y = (unsigned)id[2] | ((unsigned)id[3] << 16); w0.z = (unsigned)id[4] | ((unsigned)id[5] << 16); w0.w = (unsigned)id[6] | ((unsigned)id[7] << 16);
            w1.x = (unsigned)id[8] | ((unsigned)id[9] << 16); w1.y = (unsigned)id[10] | ((unsigned)id[11] << 16); w1.z = (unsigned)id[12] | ((unsigned)id[13] << 16); w1.w = (unsigned)id[14] | ((unsigned)id[15] << 16);
            *(u32x4*)pi = w0; *(u32x4*)(pi + 8) = w1;
            float sv[16], su[16];
#pragma unroll
            for (int i = 0; i < 16; ++i) { sv[i] = SV[id[i]]; su[i] = SU[id[i]]; }
            asm volatile("" ::: "memory");
#pragma unroll
            for (int i = 0; i < 16; i += 4) {
                *(float4*)(pg + i) = make_float4(e[i] * inv * sv[i], e[i + 1] * inv * sv[i + 1], e[i + 2] * inv * sv[i + 2], e[i + 3] * inv * sv[i + 3]);
                *(float4*)(ps + i) = make_float4(su[i] * st, su[i + 1] * st, su[i + 2] * st, su[i + 3] * st); }
        }
    }
    __syncthreads();
}

__device__ __forceinline__ void peer_fused(int p, int wq, int nwq, const unsigned short* __restrict__ PID, const float* __restrict__ G2, const float* __restrict__ PS2, const unsigned char* __restrict__ H2Q,
                                           const unsigned char* __restrict__ EU8, const unsigned char* __restrict__ EV8, float* X, const float* __restrict__ gfin, char* shm, float oscale) {
    int tid = threadIdx.x; asm volatile("" : "+v"(tid)); const int lane = tid & 63, g = lane >> 3, r = lane & 7; const int wid = __builtin_amdgcn_readfirstlane(tid >> 6);
    char* wl = shm + wid * 12288;
    int2* aul = (int2*)(wl + 4096) + lane; float* ssl = (float*)(wl + 8192) + lane; float* swl = (float*)(wl + 3072);
    const int k0 = 8 * (r >> 2) + 4 * ((r >> 1) & 1) + 2 * (r & 1);
    const int e0 = 8 * ((g >> 2) & 1) + 4 * ((g >> 1) & 1) + 2 * (g & 1);
    constexpr size_t SLICE = (size_t)16384 * 128;
#define FIDS(i, I0, I1) do { const u32x4* ip_ = (const u32x4*)(wl + (i) * 256 + 32 * g); I0 = ip_[0]; I1 = ip_[1]; } while (0)
#define FLOAD(R, base, I0, I1) do { _Pragma("unroll") for (int k_ = 0; k_ < 16; ++k_) { const unsigned w_ = (k_ < 8) ? I0[k_ >> 1] : I1[(k_ - 8) >> 1]; const unsigned e_ = (k_ & 1) ? (w_ >> 16) : (w_ & 0xffffu); \
        R[k_] = *(const u32x4*)((base) + (size_t)e_ * 128); } } while (0)
#define FUMATH(R, HQ, ACC) do { int s[16]; \
        _Pragma("unroll") for (int k_ = 0; k_ < 16; ++k_) { int d_ = __builtin_amdgcn_sdot4((int)R[k_].x, (int)HQ.x, 0, false); d_ = __builtin_amdgcn_sdot4((int)R[k_].y, (int)HQ.y, d_, false); \
            d_ = __builtin_amdgcn_sdot4((int)R[k_].z, (int)HQ.z, d_, false); d_ = __builtin_amdgcn_sdot4((int)R[k_].w, (int)HQ.w, d_, false); s[k_] = d_; } \
        _Pragma("unroll") for (int h_ = 0; h_ < 8; ++h_) { const int t1 = s[h_] + dppi<DPP_HMIRROR>(s[h_]), t2 = s[h_ + 8] + dppi<DPP_HMIRROR>(s[h_ + 8]); s[h_] = (r & 4) ? t2 : t1; } \
        _Pragma("unroll") for (int h_ = 0; h_ < 4; ++h_) { const int t1 = s[h_] + dppi<DPP_XOR2>(s[h_]), t2 = s[h_ + 4] + dppi<DPP_XOR2>(s[h_ + 4]); s[h_] = (r & 2) ? t2 : t1; } \
        _Pragma("unroll") for (int h_ = 0; h_ < 2; ++h_) { const int t1 = s[h_] + dppi<DPP_XOR1>(s[h_]), t2 = s[h_ + 2] + dppi<DPP_XOR1>(s[h_ + 2]); s[h_] = (r & 1) ? t2 : t1; } \
        { const int2 o_ = ACC; ACC = make_int2(o_.x + s[0], o_.y + s[1]); } } while (0)
#define FVMATH(R, W, XP, XV, SWV, SSQ, VALID) do { int acc[16]; _Pragma("unroll") for (int i_ = 0; i_ < 16; ++i_) acc[i_] = 0; \
        _Pragma("unroll") for (int m_ = 0; m_ < 4; ++m_) { const int wm_ = (int)W[m_]; \
            _Pragma("unroll") for (int c_ = 0; c_ < 4; ++c_) { \
                const unsigned r0_ = R[4 * m_ + 0][c_], r1_ = R[4 * m_ + 1][c_], r2_ = R[4 * m_ + 2][c_], r3_ = R[4 * m_ + 3][c_]; \
                const unsigned t0_ = __builtin_amdgcn_perm(r1_, r0_, 0x05010400u), t1_ = __builtin_amdgcn_perm(r1_, r0_, 0x07030602u); \
                const unsigned t2_ = __builtin_amdgcn_perm(r3_, r2_, 0x05010400u), t3_ = __builtin_amdgcn_perm(r3_, r2_, 0x07030602u); \
                acc[4 * c_ + 0] = __builtin_amdgcn_sdot4((int)__builtin_amdgcn_perm(t2_, t0_, 0x05040100u), wm_, acc[4 * c_ + 0], false); \
                acc[4 * c_ + 1] = __builtin_amdgcn_sdot4((int)__builtin_amdgcn_perm(t2_, t0_, 0x07060302u), wm_, acc[4 * c_ + 1], false); \
                acc[4 * c_ + 2] = __builtin_amdgcn_sdot4((int)__builtin_amdgcn_perm(t3_, t1_, 0x05040100u), wm_, acc[4 * c_ + 2], false); \
                acc[4 * c_ + 3] = __builtin_amdgcn_sdot4((int)__builtin_amdgcn_perm(t3_, t1_, 0x07060302u), wm_, acc[4 * c_ + 3], false); } } \
          \
        _Pragma("unroll") for (int h_ = 0; h_ < 8; ++h_) { const auto sw_ = __builtin_amdgcn_permlane32_swap((unsigned)acc[h_], (unsigned)acc[h_ + 8], false, false); acc[h_] = (int)sw_[0] + (int)sw_[1]; } \
        _Pragma("unroll") for (int h_ = 0; h_ < 4; ++h_) { const auto sw_ = __builtin_amdgcn_permlane16_swap((unsigned)acc[h_], (unsigned)acc[h_ + 4], false, false); acc[h_] = (int)sw_[0] + (int)sw_[1]; } \
        _Pragma("unroll") for (int h_ = 0; h_ < 2; ++h_) { const int t1 = acc[h_] + dppi<DPP_ROR8>(acc[h_]), t2 = acc[h_ + 2] + dppi<DPP_ROR8>(acc[h_ + 2]); acc[h_] = (lane & 8) ? t2 : t1; } \
        const float2 xv = XV; const float o0 = xv.x + SWV * (float)acc[0], o1 = xv.y + SWV * (float)acc[1]; \
        if (VALID) *(float2*)(XP) = make_float2(o0, o1); SSQ += o0 * o0 + o1 * o1; } while (0)
    const int TEND = (p + 1) * (M / 8);
#pragma unroll 1
    for (int tb = p * (M / 8) + wq; tb < TEND; tb += 8 * nwq) {
#define TOK(i) ((tb + (i) * nwq) < TEND ? (tb + (i) * nwq) : tb)
#pragma unroll
        for (int i = 0; i < 8; ++i) ((unsigned*)(wl + i * 256))[lane] = ((const unsigned*)(PID + (size_t)TOK(i) * 128))[lane];
#ifndef RPU
#define RPU 1
#endif
        for (int rpu_ = 0; rpu_ < RPU; ++rpu_) {
#pragma unroll
        for (int i = 0; i < 8; ++i) aul[64 * i] = make_int2(0, 0);
        {
            u32x4 RA[16], RB[16], i0, i1, hqa, hqb;
            { const int sl = p & 7; FIDS(0, i0, i1); hqa = *(const u32x4*)(H2Q + ((size_t)sl * M + TOK(0)) * 128 + r * 16); FLOAD(RA, EU8 + sl * SLICE + r * 16, i0, i1); }
#pragma unroll 1
            for (int st = 0; st < 8; ++st) {
                const int sl = (p + st) & 7, sln = (p + st + 1) & 7; const unsigned char* ub = EU8 + sl * SLICE + r * 16; const unsigned char* hb = H2Q + (size_t)sl * M * 128 + r * 16;
#pragma unroll 1
                for (int i = 0; i < 8; i += 2) {
                    FIDS(i + 1, i0, i1); hqb = *(const u32x4*)(hb + (size_t)TOK(i + 1) * 128); FLOAD(RB, ub, i0, i1);
                    FUMATH(RA, hqa, aul[64 * i]);
                    {
                        const bool last = (i == 6); const int in_ = last ? 0 : i + 2; const int sx = last ? sln : sl;
                        FIDS(in_, i0, i1); hqa = *(const u32x4*)(H2Q + ((size_t)sx * M + TOK(in_)) * 128 + r * 16); FLOAD(RA, EU8 + sx * SLICE + r * 16, i0, i1); }
                    FUMATH(RB, hqb, aul[64 * (i + 1)]);
                }
            }
        }
        }
        float2 g2q[8], psq[8];
#pragma unroll
        for (int i = 0; i < 8; ++i) { const size_t o = (size_t)TOK(i) * 128 + 16 * g + k0; g2q[i] = *(const float2*)(G2 + o); psq[i] = *(const float2*)(PS2 + o); }
#pragma unroll
        for (int i = 0; i < 8; ++i) {
            const float2 g2 = g2q[i], ps = psq[i]; const int2 av = aul[64 * i];
            const float w0 = g2.x * gelu_erf((float)av.x * ps.x), w1 = g2.y * gelu_erf((float)av.y * ps.y);
            float am = fmaxf(fabsf(w0), fabsf(w1));
            am = wave_allmax(am);
            const float qs = am > 0.f ? 127.0f / am : 0.f; if (lane == 0) swl[i] = am * (1.0f / 127.0f);
            const int b0 = (int)__builtin_rintf(w0 * qs) & 0xff, b1 = (int)__builtin_rintf(w1 * qs) & 0xff;
            *(unsigned short*)(wl + 2048 + i * 128 + 16 * g + k0) = (unsigned short)(b0 | (b1 << 8));
        }
#ifndef RPVV
#define RPVV 1
#endif
        for (int rpv_ = 0; rpv_ < RPVV; ++rpv_) {
        const bool vlast = (rpv_ == RPVV - 1);
#pragma unroll
        for (int i = 0; i < 8; ++i) ssl[64 * i] = 0.f;
        {
            u32x4 RA[16], RB[16], i0, i1; float2 xva, xvb;
            { const int sl = p & 7; FIDS(0, i0, i1); xva = *(const float2*)(X + (size_t)TOK(0) * 1024 + sl * 128 + 16 * r + e0); FLOAD(RA, EV8 + sl * SLICE + r * 16, i0, i1); }
#pragma unroll 1
            for (int st = 0; st < 8; ++st) {
                const int sl = (p + st) & 7, sln = (p + st + 1) & 7; const unsigned char* vb = EV8 + sl * SLICE + r * 16; float* xb = X + sl * 128 + 16 * r + e0;
#pragma unroll 1
                for (int i = 0; i < 8; i += 2) {
                    FIDS(i + 1, i0, i1); xvb = *(const float2*)(xb + (size_t)TOK(i + 1) * 1024); FLOAD(RB, vb, i0, i1);
                    { const u32x4 wv = *(const u32x4*)(wl + 2048 + i * 128 + 16 * g); const float sw_ = swl[i]; float sq_ = ssl[64 * i]; FVMATH(RA, wv, xb + (size_t)TOK(i) * 1024, xva, sw_, sq_, vlast && (tb + i * nwq) < TEND); ssl[64 * i] = sq_; }
                    { const bool last = (i == 6); const int in_ = last ? 0 : i + 2; const int sx = last ? sln : sl; FIDS(in_, i0, i1); xva = *(const float2*)(X + (size_t)TOK(in_) * 1024 + sx * 128 + 16 * r + e0); FLOAD(RA, EV8 + sx * SLICE + r * 16, i0, i1); }
                    { const u32x4 wv = *(const u32x4*)(wl + 2048 + (i + 1) * 128 + 16 * g); const float sw_ = swl[i + 1]; float sq_ = ssl[64 * (i + 1)]; FVMATH(RB, wv, xb + (size_t)TOK(i + 1) * 1024, xvb, sw_, sq_, vlast && (tb + (i + 1) * nwq) < TEND); ssl[64 * (i + 1)] = sq_; }
                }
            }
        }
        }
        float2 gg[8];
#pragma unroll
        for (int sl = 0; sl < 8; ++sl) gg[sl] = *(const float2*)(gfin + sl * 128 + 16 * r + e0);
#pragma unroll 1
        for (int i = 0; i < 8; i += 2) {
            const float rr0 = oscale / sqrtf(wave_allsum(ssl[64 * i]) * (1.0f / 1024.0f) + 1e-6f), rr1 = oscale / sqrtf(wave_allsum(ssl[64 * (i + 1)]) * (1.0f / 1024.0f) + 1e-6f);
            const bool v0 = (tb + i * nwq) < TEND, v1 = (tb + (i + 1) * nwq) < TEND;
            float* xr0 = X + (size_t)TOK(i) * 1024 + 16 * r + e0; float* xr1 = X + (size_t)TOK(i + 1) * 1024 + 16 * r + e0;
            float2 va[8], vb[8];
#pragma unroll
            for (int sl = 0; sl < 8; ++sl) { va[sl] = *(const float2*)(xr0 + sl * 128); vb[sl] = *(const float2*)(xr1 + sl * 128); }
            asm volatile("" ::: "memory");
#pragma unroll
            for (int sl = 0; sl < 8; ++sl) { if (v0) *(float2*)(xr0 + sl * 128) = make_float2(va[sl].x * rr0 * gg[sl].x, va[sl].y * rr0 * gg[sl].y);
                                             if (v1) *(float2*)(xr1 + sl * 128) = make_float2(vb[sl].x * rr1 * gg[sl].x, vb[sl].y * rr1 * gg[sl].y); }
        }
#undef TOK
    }
#undef FIDS
#undef FLOAD
#undef FUMATH
#undef FVMATH
}
}
#define GAS __attribute__((address_space(1)))
#define LAS __attribute__((address_space(3)))
typedef unsigned short bf16;
typedef unsigned v4u __attribute__((ext_vector_type(4)));
typedef float f32x4 __attribute__((ext_vector_type(4)));
typedef short bf16x8 __attribute__((ext_vector_type(8)));
typedef GAS unsigned gu32;
typedef GAS unsigned long long gu64;
#define RLX_AGENT __ATOMIC_RELAXED, __HIP_MEMORY_SCOPE_AGENT
#define LDS_WAIT() asm volatile("s_waitcnt lgkmcnt(0)" ::: "memory")
#define VM_WAIT() asm volatile("s_waitcnt vmcnt(0)" ::: "memory")
__device__ __forceinline__ unsigned long long rt() { return __builtin_amdgcn_s_memrealtime(); }
__device__ __forceinline__ unsigned f2bf(float f) { unsigned u = __builtin_bit_cast(unsigned, f); return (u + 0x7fffu + ((u >> 16) & 1u)) >> 16; }
__device__ __forceinline__ unsigned pk2(float lo, float hi) { return f2bf(lo) | (f2bf(hi) << 16); }

#define XB_TMO      128
#define XB_XCNT(j)  (256  + 64 * (j))
#define XB_XSUB(j)  (1280 + 64 * (j))
#define XB_XGEN(j)  (2304 + 64 * (j))
#define XB_TOP      3328
#define XB_TOPGEN   3392
#define XCD_BAR_WORDS 3456
#define XB_SPIN_CAP (1u << 18)

__device__ __forceinline__ unsigned xb_ld(unsigned* p)              { return __hip_atomic_load(p, __ATOMIC_RELAXED, __HIP_MEMORY_SCOPE_AGENT); }
__device__ __forceinline__ unsigned xb_add(unsigned* p, unsigned v) { return __hip_atomic_fetch_add(p, v, __ATOMIC_RELAXED, __HIP_MEMORY_SCOPE_AGENT); }
__device__ __forceinline__ unsigned xb_xcc_id() { return (unsigned)__builtin_amdgcn_s_getreg((3 << 11) | 20) & 0xFu; }
#define XB_SPIN(cond, bar) do { unsigned _sp = 0; while (cond) { __builtin_amdgcn_s_sleep(1); \
    if ((++_sp & 255u) == 0u) { if (xb_ld(&(bar)[XB_TMO])) break; if (_sp > XB_SPIN_CAP) { atomicAdd(&(bar)[XB_TMO], 1u); break; } } } } while (0)

struct XcdBarrier {
    unsigned* bar; unsigned x;
    volatile LAS unsigned* st;
};

__device__ __forceinline__ XcdBarrier xcd_barrier_post(unsigned* bar, volatile LAS unsigned* st) {
    XcdBarrier b; b.bar = bar; b.x = xb_xcc_id(); b.st = st;
    if (threadIdx.x == 0) (void)xb_add(&bar[XB_XCNT(b.x)], 1u);
    return b;
}
__device__ __forceinline__ void xcd_barrier_complete(unsigned* bar, unsigned x, unsigned& nloc, unsigned& nx) {
    const unsigned G = gridDim.x * gridDim.y * gridDim.z;
    unsigned sum, cnt, mine, sp = 0u;
    for (;;) {
        sum = 0u; cnt = 0u; mine = 0u;
#pragma unroll
        for (unsigned j = 0; j < 16; ++j) { const unsigned c = xb_ld(&bar[XB_XCNT(j)]); sum += c; cnt += (c > 0u) ? 1u : 0u; mine = (j == x) ? c : mine; }
        if (sum == G) break;
        __builtin_amdgcn_s_sleep(1);
        if ((++sp & 255u) == 0u) { if (xb_ld(&bar[XB_TMO])) break; if (sp > XB_SPIN_CAP) { atomicAdd(&bar[XB_TMO], 1u); break; } }
    }
    nloc = mine > 0u ? mine : 1u; nx = cnt > 0u ? cnt : 1u;
}

__device__ __forceinline__ void xcd_barrier(const XcdBarrier& b) {
    asm volatile("s_waitcnt vmcnt(0)" ::: "memory");
    __syncthreads();
    if (threadIdx.x == 0) {
        unsigned* bar = b.bar;
        __builtin_amdgcn_s_waitcnt(0);
        unsigned nloc = b.st[0], nx = b.st[1];
        if (nloc == 0u) { xcd_barrier_complete(bar, b.x, nloc, nx); b.st[0] = nloc; b.st[1] = nx; }
        const unsigned old = xb_add(&bar[XB_XSUB(b.x)], 1u);
        const unsigned gen = old / nloc;
        if (old + 1u == (gen + 1u) * nloc) {
            __builtin_amdgcn_fence(__ATOMIC_RELEASE, "agent");
            asm volatile("s_waitcnt vmcnt(0)" ::: "memory");
            const unsigned og = xb_add(&bar[XB_TOP], 1u);
            const unsigned tg = og / nx;
            if (og + 1u == (tg + 1u) * nx) xb_add(&bar[XB_TOPGEN], 1u);
            else XB_SPIN(xb_ld(&bar[XB_TOPGEN]) == tg, bar);
            __builtin_amdgcn_fence(__ATOMIC_ACQUIRE, "agent");
            xb_add(&bar[XB_XGEN(b.x)], 1u);
            asm volatile("s_waitcnt vmcnt(0)" ::: "memory");
        } else {
            XB_SPIN(xb_ld(&bar[XB_XGEN(b.x)]) == gen, bar);
            __builtin_amdgcn_fence(__ATOMIC_ACQUIRE, "agent");
            asm volatile("s_waitcnt vmcnt(0)" ::: "memory");
        }
    }
    __syncthreads();
}

typedef unsigned short bf16_t;
__device__ __forceinline__ float bf2f(bf16_t v) { return __uint_as_float((unsigned)v << 16); }
__device__ __forceinline__ float gelu_exact(float v) { return 0.5f * v * (1.0f + erff(v * 0.70710678118654752f)); }
__device__ __forceinline__ float log_sigmoid(float z) { return z > 0.f ? -log1pf(expf(-z)) : z - log1pf(expf(z)); }
__device__ __forceinline__ float wave_sum(float v) {
    return wave_allsum(v);
}
__device__ __forceinline__ float wave_max(float v) {
    return wave_allmax(v);
}

#ifndef RP7
#define RP7 1
#endif
#ifndef RP8
#define RP8 1
#endif
#ifndef RP9
#define RP9 1
#endif
#ifndef RP0
#define RP0 1
#endif
#ifndef RP1
#define RP1 1
#endif
#ifndef RP12
#define RP12 1
#endif
#ifndef RP3
#define RP3 1
#endif
#ifndef RP4
#define RP4 1
#endif
#ifndef RP5
#define RP5 1
#endif
#ifndef RP6
#define RP6 1
#endif
#ifndef QORDER
#define QORDER 1
#endif
#ifndef CONV_P0_FROM
#define CONV_P0_FROM (2 * NEXP)
#endif
#ifndef CONV_SPLIT
#define CONV_SPLIT (NEXP / 2)
#endif
constexpr int NWAVES = 8;
constexpr int RING_OFF = 0, RING_BYTES = 131072;
constexpr int LDSCTL_OFF = RING_BYTES, MISC_OFF = LDSCTL_OFF + 320;
constexpr int LDS_BYTES = 147456;
constexpr int CW_BAR = 4096, CW_QUEUE = 3072, CW_CMAX = 8192, CMAX_WQ = 4864;
constexpr int N_PHASES = 9;

struct Args { const float* in[17]; float* out; unsigned char* ws; int ph_lo, ph_hi, li, pad; };

__device__ __forceinline__ void p0_transpose_item(const float* W, int ldw, int col0, int K, bf16* WT, int row0, LAS float* scr, int item, int nblk, int lane) {
    const int kb = item / nblk, nb = item % nblk, k0 = 64 * kb, n0 = 32 * nb;
    f32x4 v[8];
#pragma unroll
    for (int i = 0; i < 8; ++i) v[i] = *(const GAS f32x4*)(W + (size_t)(k0 + 8 * i + (lane >> 3)) * ldw + col0 + n0 + 4 * (lane & 7));
#pragma unroll
    for (int i = 0; i < 8; ++i) *(LAS f32x4*)(scr + (8 * i + (lane >> 3)) * 36 + 4 * (lane & 7)) = v[i];
    LDS_WAIT(); asm volatile("" ::: "memory");
    const int c = lane & 7;
#pragma unroll
    for (int j = 0; j < 4; ++j) { const int n = (lane >> 3) + 8 * j; const LAS float* s = scr + (8 * c) * 36 + n;
        v4u o; o.x = pg8::cvt_pk_bf16(s[0 * 36], s[1 * 36]); o.y = pg8::cvt_pk_bf16(s[2 * 36], s[3 * 36]); o.z = pg8::cvt_pk_bf16(s[4 * 36], s[5 * 36]); o.w = pg8::cvt_pk_bf16(s[6 * 36], s[7 * 36]);
        *(GAS v4u*)(WT + (size_t)(row0 + n0 + n) * K + k0 + 8 * c) = o; }
    LDS_WAIT(); asm volatile("" ::: "memory");
}
__device__ __forceinline__ void p0_transpose_item_i8(const float* W, int ldw, int col0, int K, unsigned char* WT8, float* sB, int row0, const unsigned* colmax, LAS float* scr, int item, int nblk, int lane) {
    const int kb = item / nblk, nb = item % nblk, k0 = 64 * kb, n0 = 32 * nb;
    f32x4 v[8];
#pragma unroll
    for (int i = 0; i < 8; ++i) v[i] = *(const GAS f32x4*)(W + (size_t)(k0 + 8 * i + (lane >> 3)) * ldw + col0 + n0 + 4 * (lane & 7));
#pragma unroll
    for (int i = 0; i < 8; ++i) *(LAS f32x4*)(scr + (8 * i + (lane >> 3)) * 36 + 4 * (lane & 7)) = v[i];
    LDS_WAIT(); asm volatile("" ::: "memory");
    const int c = lane & 3;
#pragma unroll
    for (int j = 0; j < 2; ++j) { const int n = (lane >> 2) + 16 * j; const LAS float* s = scr + (16 * c) * 36 + n;
        const float am = __uint_as_float(colmax[col0 + n0 + n]); const float qs = am > 0.f ? 127.0f / am : 0.f;
        v4u o;
        o.x = peer_body::pack_i8x4(s[0 * 36] * qs, s[1 * 36] * qs, s[2 * 36] * qs, s[3 * 36] * qs); o.y = peer_body::pack_i8x4(s[4 * 36] * qs, s[5 * 36] * qs, s[6 * 36] * qs, s[7 * 36] * qs);
        o.z = peer_body::pack_i8x4(s[8 * 36] * qs, s[9 * 36] * qs, s[10 * 36] * qs, s[11 * 36] * qs); o.w = peer_body::pack_i8x4(s[12 * 36] * qs, s[13 * 36] * qs, s[14 * 36] * qs, s[15 * 36] * qs);
        *(GAS v4u*)(WT8 + (size_t)(row0 + n0 + n) * K + k0 + 16 * c) = o;
        if (kb == 0 && c == 0) sB[row0 + n0 + n] = am * (1.0f / 127.0f); }
    LDS_WAIT(); asm volatile("" ::: "memory");
}
__device__ __forceinline__ void p0_colmax_task(const float* W, int ldw, int ncols, unsigned* colmax, int task, int lane) {
    const int ncb = (ncols + 255) / 256, cb = task % ncb, rb = task / ncb, c = 256 * cb + 4 * lane;
    if (c >= ncols) return;
    f32x4 m = (f32x4){0.f, 0.f, 0.f, 0.f};
#pragma unroll 8
    for (int i = 0; i < 32; ++i) { const f32x4 v = *(const GAS f32x4*)(W + (size_t)(32 * rb + i) * ldw + c);
        m.x = fmaxf(m.x, fabsf(v.x)); m.y = fmaxf(m.y, fabsf(v.y)); m.z = fmaxf(m.z, fabsf(v.z)); m.w = fmaxf(m.w, fabsf(v.w)); }
    atomicMax(colmax + c, __float_as_uint(m.x)); atomicMax(colmax + c + 1, __float_as_uint(m.y)); atomicMax(colmax + c + 2, __float_as_uint(m.z)); atomicMax(colmax + c + 3, __float_as_uint(m.w));
}
__device__ __forceinline__ void cvt_chunks(const float* src, bf16* dst, size_t nchunks, size_t gtid, size_t nthr) {
    for (size_t c = gtid; c < nchunks; c += nthr) { const f32x4 a = ((const GAS f32x4*)src)[2 * c], b = ((const GAS f32x4*)src)[2 * c + 1];
        v4u o; o.x = pg8::cvt_pk_bf16(a.x, a.y); o.y = pg8::cvt_pk_bf16(a.z, a.w); o.z = pg8::cvt_pk_bf16(b.x, b.y); o.w = pg8::cvt_pk_bf16(b.z, b.w);
        ((GAS v4u*)dst)[c] = o; }
}

template <int NR> __device__ __forceinline__ void convert_rows(int e0, const float* eu, const float* ev, unsigned char* ws, int lane) {
                const bool isV = e0 >= NEXP; const int row0 = isV ? e0 - NEXP : e0;
                const float* tab = isV ? ev : eu;
                f32x4 v[NR][4];
#pragma unroll
                for (int rr = 0; rr < NR; ++rr)
#pragma unroll
                    for (int i = 0; i < 4; ++i) v[rr][i] = __builtin_nontemporal_load((const GAS f32x4*)(tab + (size_t)(row0 + rr) * D + 16 * lane) + i);
#pragma unroll
                for (int rr = 0; rr < NR; ++rr) {
                    const int row = row0 + rr; float am = 0.f;
#pragma unroll
                    for (int i = 0; i < 4; ++i) am = fmaxf(fmaxf(am, fmaxf(fabsf(v[rr][i].x), fabsf(v[rr][i].y))), fmaxf(fabsf(v[rr][i].z), fabsf(v[rr][i].w)));
                    am = wave_allmax(am);
                    v4u q;
                    if (!isV) { const float inv = am > 0.f ? 127.0f / am : 0.f;
                        q.x = peer_body::pack_i8x4(v[rr][0].x * inv, v[rr][0].y * inv, v[rr][0].z * inv, v[rr][0].w * inv); q.y = peer_body::pack_i8x4(v[rr][1].x * inv, v[rr][1].y * inv, v[rr][1].z * inv, v[rr][1].w * inv);
                        q.z = peer_body::pack_i8x4(v[rr][2].x * inv, v[rr][2].y * inv, v[rr][2].z * inv, v[rr][2].w * inv); q.w = peer_body::pack_i8x4(v[rr][3].x * inv, v[rr][3].y * inv, v[rr][3].z * inv, v[rr][3].w * inv);
                        *(GAS v4u*)(ws + WS_EU + (size_t)(lane >> 3) * ((size_t)NEXP * 128) + (size_t)row * 128 + (lane & 7) * 16) = q; if (lane == 0) ((GAS float*)(ws + WS_SU))[row] = am * (1.0f / 127.0f); }
                    else { const float inv = am > 0.f ? 127.0f / am : 0.f;
                        q.x = peer_body::pack_i8x4(v[rr][0].x * inv, v[rr][0].y * inv, v[rr][0].z * inv, v[rr][0].w * inv); q.y = peer_body::pack_i8x4(v[rr][1].x * inv, v[rr][1].y * inv, v[rr][1].z * inv, v[rr][1].w * inv);
                        q.z = peer_body::pack_i8x4(v[rr][2].x * inv, v[rr][2].y * inv, v[rr][2].z * inv, v[rr][2].w * inv); q.w = peer_body::pack_i8x4(v[rr][3].x * inv, v[rr][3].y * inv, v[rr][3].z * inv, v[rr][3].w * inv);
                        *(GAS v4u*)(ws + WS_EV + (size_t)(lane >> 3) * ((size_t)NEXP * 128) + (size_t)row * 128 + (lane & 7) * 16) = q; if (lane == 0) ((GAS float*)(ws + WS_SV))[row] = am * (1.0f / 127.0f); }
                }
}

__global__ void __launch_bounds__(NWAVES * 64, 2) skel_fwd(Args args) {
    extern __shared__ __attribute__((aligned(16))) unsigned char lds[];
    LAS unsigned char* L = (LAS unsigned char*)lds;
    volatile LAS unsigned* MISC = (volatile LAS unsigned*)(L + MISC_OFF);
    const int G = gridDim.x; const int bx = blockIdx.x; const int vcu = (G % 8 == 0) ? (bx % 8) * (G / 8) + bx / 8 : bx;
    for (int u = threadIdx.x; u < (LDS_BYTES - LDSCTL_OFF) / 4; u += NWAVES * 64) ((LAS unsigned*)(L + LDSCTL_OFF))[u] = 0u;
    __syncthreads();
    (void)xcd_barrier_post((unsigned*)((gu32*)(args.ws + WS_CTL) + CW_BAR) + args.li * XCD_BAR_WORDS, MISC + 8);
#define PHASE_VARS \
    GAS unsigned char* wsg_ = (GAS unsigned char*)args.ws; asm volatile("" : "+s"(wsg_)); unsigned char* ws = (unsigned char*)wsg_; GAS float* outg_ = (GAS float*)args.out; asm volatile("" : "+s"(outg_)); float* out = (float*)outg_; \
    int tid = threadIdx.x; asm volatile("" : "+v"(tid)); const int lane = tid & 63, wave = __builtin_amdgcn_readfirstlane(tid >> 6); (void)lane; (void)wave; \
    gu32* ctl = (gu32*)(ws + WS_CTL); (void)ctl; const float* x = args.in[0]; (void)x; \
    bf16* XN = (bf16*)(ws + WS_XN); bf16* Qb = (bf16*)(ws + WS_Q); bf16* UG = (bf16*)(ws + WS_UG); (void)XN; (void)Qb; (void)UG; \
    bf16* GATE = (bf16*)out; bf16* MERGED = (bf16*)(ws + WS_MERGED); bf16* QP = (bf16*)(ws + WS_QP); (void)GATE; (void)MERGED; (void)QP; \
    float* LOGF = (float*)(ws + WS_LOGF); float* CL2 = (float*)(ws + WS_CL2); (void)LOGF; (void)CL2; \
    const int gw = vcu * NWAVES + wave, NGW = G * NWAVES; (void)gw; (void)NGW;
    const int lo = args.ph_lo, hi = args.ph_hi;
#ifndef PHMASK
#define PHMASK 0x1ff
#endif
#define IN(k) (((PHMASK >> (k)) & 1) && lo <= (k) && (k) < hi)
#define BOTH(k) (IN(k) && IN((k) + 1))
#ifdef TIMEPH
    if (bx == 0 && threadIdx.x == 0) { const unsigned long long t0_ = rt(); MISC[24] = (unsigned)t0_; }
#define GRID_BAR(k) do { XcdBarrier b_; b_.bar = (unsigned*)((gu32*)(args.ws + WS_CTL) + CW_BAR) + args.li * XCD_BAR_WORDS; b_.x = xb_xcc_id(); b_.st = MISC + 8; xcd_barrier(b_); if (bx == 0 && threadIdx.x == 0) { gu32* ctl = (gu32*)(args.ws + WS_CTL); const unsigned t_now = (unsigned)rt(); __hip_atomic_store(ctl + 2048 + (k), t_now - MISC[24], RLX_AGENT); MISC[24] = t_now; } } while (0)
#else
#define GRID_BAR(k) do { XcdBarrier b_; b_.bar = (unsigned*)((gu32*)(args.ws + WS_CTL) + CW_BAR) + args.li * XCD_BAR_WORDS; b_.x = xb_xcc_id(); b_.st = MISC + 8; xcd_barrier(b_); } while (0)
#endif

    for (int rp_ = 0; rp_ < RP0; ++rp_) if (IN(0)) {
        PHASE_VARS
        LAS float* scr = (LAS float*)(L + RING_OFF + wave * 16384);
        const float* w_in = args.in[2];
        unsigned* cmax_in = (unsigned*)(ctl + CW_CMAX);
        {
            constexpr int T_IN = ((IN_W + 255) / 256) * (D / 32);
            constexpr int T_WQ = (QPW / 256) * (D / 32);
            for (int it = gw; it < T_IN + T_WQ; it += NGW) { if (it < T_IN) p0_colmax_task(w_in, IN_W, IN_W, cmax_in, it, lane); else p0_colmax_task(args.in[12], QPW, QPW, cmax_in + CMAX_WQ, it - T_IN, lane); }
            GRID_BAR(0);
        }
        {
            constexpr int I_A = 16 * 48, I_B = 16 * 96, I_WA = 8 * 32, I_WB = 8 * 32, I_WO = 16 * 32, I_WQ = 16 * 64;
            constexpr int NITEMS = I_A + I_B + I_WA + I_WB + I_WO + I_WQ;
            for (int it = gw; it < NITEMS; it += NGW) {
                int r = it;
                if (r < I_A) { p0_transpose_item_i8(w_in, IN_W, 0, D, ws + WS_WIN, (float*)(ws + WS_SBW), 0, cmax_in, scr, r, 48, lane); continue; } r -= I_A;
                if (r < I_B) { p0_transpose_item_i8(w_in, IN_W, OFF_UG, D, ws + WS_WIN, (float*)(ws + WS_SBW), 1536, cmax_in, scr, r, 96, lane); continue; } r -= I_B;
                if (r < I_WA) { p0_transpose_item(args.in[8], D, 0, AW, (bf16*)(ws + WS_WA), 0, scr, r, 32, lane); continue; } r -= I_WA;
                if (r < I_WB) { p0_transpose_item(args.in[9], D, 0, SW, (bf16*)(ws + WS_WB), 0, scr, r, 32, lane); continue; } r -= I_WB;
                if (r < I_WO) { p0_transpose_item(args.in[10], D, 0, D, (bf16*)(ws + WS_WOUT), 0, scr, r, 32, lane); continue; } r -= I_WO;
                p0_transpose_item_i8(args.in[12], QPW, 0, D, ws + WS_WQ, (float*)(ws + WS_SBWQ), 0, cmax_in + CMAX_WQ, scr, r, 64, lane);
            }
        }
        {
            const size_t gtid = (size_t)gw * 64 + lane, nthr = (size_t)NGW * 64;
            cvt_chunks(args.in[13], (bf16*)(ws + WS_SK), (size_t)PH * 2 * PKEYS * PHALF / 8, gtid, nthr);
#pragma unroll 1
            for (int e0 = CONV_P0_FROM + 4 * gw; e0 < 2 * NEXP; e0 += 4 * NGW) convert_rows<4>(e0, args.in[14], args.in[15], ws, lane);
            const float* w_s = args.in[6]; bf16* wsm = (bf16*)(ws + WS_WSM);
            for (size_t c = gtid; c < (size_t)NG * CHUNK * CHUNK / 8; c += nthr) {
                const int pos = (int)((c * 8) & 127), t = (int)((c * 8) >> 7) & 127, ks = pos >> 4, hh = (pos >> 3) & 1, s0 = 16 * ks + 4 * hh, s1 = s0 + 8;
                const float* src = w_s + ((c * 8) & ~(size_t)127);
                const f32x4 a = *(const GAS f32x4*)(src + s0), b = *(const GAS f32x4*)(src + s1);
                v4u o; o.x = pg8::cvt_pk_bf16(s0 + 0 <= t ? a.x : 0.f, s0 + 1 <= t ? a.y : 0.f); o.y = pg8::cvt_pk_bf16(s0 + 2 <= t ? a.z : 0.f, s0 + 3 <= t ? a.w : 0.f);
                o.z = pg8::cvt_pk_bf16(s1 + 0 <= t ? b.x : 0.f, s1 + 1 <= t ? b.y : 0.f); o.w = pg8::cvt_pk_bf16(s1 + 2 <= t ? b.z : 0.f, s1 + 3 <= t ? b.w : 0.f);
                ((GAS v4u*)wsm)[c] = o; }
        }
        __syncthreads();
        {
            LAS float* wf = (LAS float*)(L + RING_OFF);
            for (int i = tid; i < 8 * D; i += NWAVES * 64) { const int k = i >> 3, c = i & 7; wf[c * D + k] = w_in[(size_t)k * IN_W + OFF_F + c]; }
            __syncthreads();
            const float* g1 = args.in[1]; const float* b_f = args.in[3];
            f32x4 gv[4];
#pragma unroll
            for (int j = 0; j < 4; ++j) gv[j] = ((const GAS f32x4*)g1)[lane + 64 * j];
#pragma unroll 1
            for (int m0 = 4 * gw; m0 < M; m0 += 4 * NGW) {
                f32x4 vv[4][4];
#pragma unroll
                for (int rr = 0; rr < 4; ++rr)
#pragma unroll
                    for (int j = 0; j < 4; ++j) vv[rr][j] = ((const GAS f32x4*)(x + (size_t)(m0 + rr) * D) + lane)[64 * j];
#pragma unroll
                for (int rr = 0; rr < 4; ++rr) {
                    const int m = m0 + rr; f32x4 v[4]; float s = 0.f;
#pragma unroll
                    for (int j = 0; j < 4; ++j) { v[j] = vv[rr][j]; s += (v[j].x * v[j].x + v[j].y * v[j].y) + (v[j].z * v[j].z + v[j].w * v[j].w); }
                    const float r = 1.0f / sqrtf(wave_sum(s) * (1.f / D) + EPS);
#pragma unroll
                    for (int j = 0; j < 4; ++j) v[j] = v[j] * r * gv[j];
                    {
                        float am = 0.f;
#pragma unroll
                        for (int j = 0; j < 4; ++j) am = fmaxf(fmaxf(am, fmaxf(fabsf(v[j].x), fabsf(v[j].y))), fmaxf(fabsf(v[j].z), fabsf(v[j].w)));
                        am = wave_allmax(am); const float qs = am > 0.f ? 127.0f / am : 0.f;
                        GAS unsigned* o4 = (GAS unsigned*)(ws + WS_XN + (size_t)m * D) + lane;
#pragma unroll
                        for (int j = 0; j < 4; ++j) o4[64 * j] = peer_body::pack_i8x4(v[j].x * qs, v[j].y * qs, v[j].z * qs, v[j].w * qs);
                        if (lane == 0) ((GAS float*)(ws + WS_SA))[m] = am * (1.0f / 127.0f); }
                    float fsum = 0.f;
#pragma unroll
                    for (int c = 0; c < 8; ++c) { float pp = 0.f;
#pragma unroll
                        for (int j = 0; j < 4; ++j) { const f32x4 w4 = *(const LAS f32x4*)(wf + c * D + 256 * j + 4 * lane); pp += (v[j].x * w4.x + v[j].y * w4.y) + (v[j].z * w4.z + v[j].w * w4.w); }
                        pp = wave_sum(pp); if (lane == c) fsum = pp; }
                    if (lane < 8) LOGF[(size_t)m * NH + lane] = log_sigmoid(fsum + b_f[lane]);
                }
            }
        }
        if (BOTH(0)) GRID_BAR(0);
    }

    for (int rp12_ = 0; rp12_ < RP12; ++rp12_) {
    for (int rp_ = 0; rp_ < RP1; ++rp_) if (IN(1)) {
        PHASE_VARS
        if (vcu < BATCH * NH) {
            const int b = vcu / NH, h = vcu % NH; LAS float* part = (LAS float*)(L + MISC_OFF + 64);
            float v[4];
#pragma unroll
            for (int i = 0; i < 4; ++i) v[i] = LOGF[(size_t)(b * SEQ + 4 * tid + i) * NH + h];
            v[1] += v[0]; v[2] += v[1]; v[3] += v[2];
            float tot = v[3];
#pragma unroll
            for (int o = 1; o < 64; o <<= 1) { const float u = __shfl_up(tot, o); if (lane >= o) tot += u; }
            if (lane == 63) part[wave] = tot;
            __syncthreads();
            float base = tot - v[3];
            for (int w = 0; w < wave; ++w) base += part[w];
#pragma unroll
            for (int i = 0; i < 4; ++i) CL2[(size_t)vcu * SEQ + 4 * tid + i] = (base + v[i]) * LOG2E;
            __syncthreads();
        }
        pg8::Gemm g{XN, (const bf16*)(ws + WS_WIN), M, NPROJ, D / 2}; pg8::StaticOrder S; S.init(M, NPROJ, G, bx);
        pg8::EpiProjI8 E{Qb, (size_t)M * 512, GATE, C2, (const float*)(ws + WS_SA), (const float*)(ws + WS_SBW)};
        pg8::gemm_phase<pg8::EpiProjI8, pg8::StaticOrder, true, true, true>(L + RING_OFF, g, S, E);
        {
            constexpr int NUN = (M / 256) * (NPROJ / 256);
            const int nmax = (NUN + G - 1) / G, nun = (NUN - bx + G - 1) / G;
            int ii_ = bx - (NUN - (nmax - 1) * G), nidle_ = G - (NUN - (nmax - 1) * G);
            if (nidle_ <= 0) { ii_ = bx; nidle_ = G; }
            if (nun < nmax || nidle_ == G) {
#pragma unroll 1
                for (int e0 = 4 * (ii_ * NWAVES + wave); e0 < CONV_SPLIT; e0 += 4 * nidle_ * NWAVES) convert_rows<4>(e0, args.in[14], args.in[15], ws, lane);
            }
        }
        if (BOTH(1)) GRID_BAR(1);
    }

    if (IN(2)) {
        PHASE_VARS
        static_assert(attn_body::ATTN_LDS_BYTES <= RING_BYTES, "attention LDS");
#ifdef P2PROBE
        for (int pr_ = 0; pr_ < P2PROBE; ++pr_) {
            for (int u = vcu; u < 2 * (M / CHUNK); u += G)
                sgu_body::sgu_unit(u >> 1, u & 1, (const bf16*)(ws + WS_VG), UG, (bf16*)(ws + 232 * MiB), (const bf16*)(ws + WS_WSM), args.in[4], args.in[5], args.in[7], (char*)lds + RING_OFF);
#ifndef P2PROBE_SGU_ONLY
            const attn_body::AttnTensors ATp{(const attn_body::bf16*)Qb, (const attn_body::bf16*)(ws + WS_K), (const attn_body::bf16*)(ws + WS_V), (attn_body::bf16*)(ws + 216 * MiB), CL2};
            const attn_body::StaticOrder Sp(G, bx);
            attn_body::attn_phase<attn_body::StaticOrder>((char*)lds + RING_OFF, ATp, Sp);
#endif
            GRID_BAR(2);
        }
#endif
        constexpr int NCONVQ = (CONV_P0_FROM - CONV_SPLIT) / 64, NIL = NCONVQ < 512 ? NCONVQ : 512;
        for (;;) {
            __syncthreads();
            if (tid == 0) MISC[26] = __hip_atomic_fetch_add(ctl + CW_QUEUE, 1u, RLX_AGENT);
            __syncthreads();
            const int u = __builtin_amdgcn_readfirstlane((int)MISC[26]);
            if (u >= 768 + NCONVQ) break;
            int ua = -1, uc = -1, us = -1;
#if QORDER == 1
            if (u < NCONVQ) uc = u; else if (u < 512 + NCONVQ) ua = u - NCONVQ; else us = u - 512 - NCONVQ;
#elif QORDER == 2
            if (u < 512) ua = u; else if (u < 768) us = u - 512; else uc = u - 768;
#else
            if (u < 2 * NIL) { if (u & 1) uc = u >> 1; else ua = u >> 1; }
            else if (u < 512 + NCONVQ) { if (NCONVQ > 512) uc = u - 512; else ua = u - NCONVQ; }
            else us = u - 512 - NCONVQ;
#endif
            if (ua >= 0) { const int qb = 7 - (ua >> 6), bh = ua & 63;
                const int t0 = attn_body::attn_first_tile(CL2, bh, qb);
                attn_body::attn_unit<8>(bh / NH, bh % NH, qb, (const attn_body::bf16*)Qb, (const attn_body::bf16*)(ws + WS_K), (const attn_body::bf16*)(ws + WS_V), (attn_body::bf16*)Qb, CL2, (char*)lds + RING_OFF, t0); }
            else if (uc >= 0) convert_rows<8>(CONV_SPLIT + 64 * uc + 8 * wave, args.in[14], args.in[15], ws, lane);
            else sgu_body::sgu_unit(us >> 1, us & 1, (const bf16*)(ws + WS_VG), UG, UG, (const bf16*)(ws + WS_WSM), args.in[4], args.in[5], args.in[7], (char*)lds + RING_OFF);
        }
        if (BOTH(2)) GRID_BAR(2);
    }
    }

    for (int rp_ = 0; rp_ < RP3; ++rp_) if (IN(3)) {
        PHASE_VARS
        static_assert(WS_UG - WS_Q == (size_t)pg8::MERGE_DPM * 256 * AW * 2 && WS_WB - WS_WA == (size_t)4 * 256 * AW * 2, "merge passes: buffer offsets");
        { pg8::Gemm g{Qb, (const bf16*)(ws + WS_WA), M, D, AW}; pg8::MergeOrder S; S.init(M, D, G, bx);
          pg8::EpiMergeAB E{GATE, MERGED};
          pg8::gemm_phase<pg8::EpiMergeAB, pg8::MergeOrder, true, true>(L + RING_OFF, g, S, E); }
        if (BOTH(3)) GRID_BAR(3);
    }

    for (int rp_ = 0; rp_ < RP4; ++rp_) if (IN(4)) {
        PHASE_VARS
        pg8::Gemm g{MERGED, (const bf16*)(ws + WS_WOUT), M, D, D}; pg8::StaticOrder S; S.init(M, D, G, bx);
        pg8::EpiResid E{x, out, D, M};
        pg8::gemm_phase<pg8::EpiResid, pg8::StaticOrder, false, true>(L + RING_OFF, g, S, E);
        if (BOTH(4)) GRID_BAR(4);
    }

    for (int rp_ = 0; rp_ < RP5; ++rp_) if (IN(5)) {
        PHASE_VARS
        const float* g2 = args.in[11];
        f32x4 gv[4];
#pragma unroll
        for (int j = 0; j < 4; ++j) gv[j] = ((const GAS f32x4*)g2)[lane + 64 * j];
#pragma unroll 1
        for (int m0 = 4 * gw; m0 < M; m0 += 4 * NGW) {
            f32x4 vv[4][4];
#pragma unroll
            for (int rr = 0; rr < 4; ++rr)
#pragma unroll
                for (int j = 0; j < 4; ++j) vv[rr][j] = ((const GAS f32x4*)(out + (size_t)(m0 + rr) * D) + lane)[64 * j];
            asm volatile("" ::: "memory");
#pragma unroll
            for (int rr = 0; rr < 4; ++rr) {
                const int m = m0 + rr; f32x4 v[4]; float s = 0.f;
#pragma unroll
                for (int j = 0; j < 4; ++j) { v[j] = vv[rr][j]; s += (v[j].x * v[j].x + v[j].y * v[j].y) + (v[j].z * v[j].z + v[j].w * v[j].w); }
                const float r = 1.0f / sqrtf(wave_sum(s) * (1.f / D) + EPS);
                float am = 0.f;
#pragma unroll
                for (int j = 0; j < 4; ++j) { v[j] = v[j] * r * gv[j];
                    am = fmaxf(fmaxf(am, fmaxf(fabsf(v[j].x), fabsf(v[j].y))), fmaxf(fabsf(v[j].z), fabsf(v[j].w))); }
                am = wave_allmax(am);
                const float qs = am > 0.f ? 127.0f / am : 0.f;
#pragma unroll
                for (int j = 0; j < 4; ++j) { const unsigned q4 = peer_body::pack_i8x4(v[j].x * qs, v[j].y * qs, v[j].z * qs, v[j].w * qs);
                    *(GAS unsigned*)(ws + WS_H2Q + (size_t)(2 * j + (lane >> 5)) * ((size_t)M * 128) + (size_t)m * 128 + ((4 * lane) & 127)) = q4; ((GAS unsigned*)(ws + WS_XN + (size_t)m * D))[lane + 64 * j] = q4; }
                if (lane == 0) ((GAS float*)(ws + WS_ST))[m] = am * (1.0f / 127.0f);
            }
        }
        if (BOTH(5)) GRID_BAR(5);
    }

    for (int rp_ = 0; rp_ < RP6; ++rp_) if (IN(6)) {
        PHASE_VARS
        pg8::Gemm g{XN, (const bf16*)(ws + WS_WQ), M, QPW, D / 2}; pg8::StaticOrder S; S.init(M, QPW, G, bx);
        pg8::EpiBf16I8 E{QP, QPW, (const float*)(ws + WS_ST), (const float*)(ws + WS_SBWQ)};
        pg8::gemm_phase<pg8::EpiBf16I8, pg8::StaticOrder, true, true, true>(L + RING_OFF, g, S, E);
        if (BOTH(6)) GRID_BAR(6);
    }
    for (int rp_ = 0; rp_ < RP7; ++rp_) if (IN(7)) {
        PHASE_VARS
        for (int tk = vcu; tk < 8 * (M / 512); tk += G)
            peer_body::peer_retrieve(tk, QP, (const bf16*)(ws + WS_SK), (const float*)(ws + WS_SU), (const float*)(ws + WS_SV), (const float*)(ws + WS_ST),
                                     (bf16*)(ws + WS_PID), (float*)(ws + WS_G2), (float*)(ws + WS_PS2), (char*)lds + RING_OFF);
        if (BOTH(7)) GRID_BAR(7);
    }
    if (IN(8)) {
        PHASE_VARS
#ifdef TIMEPH
        const float oscale = 1.0f + sqrtf((float)(((__hip_atomic_load(ctl + 2048 + TIMEPH, RLX_AGENT) + TIMEOFF) / TIMEQ) * TIMEQ) * 1e-5f);
#else
        const float oscale = 1.0f;
#endif
        const int p = bx & 7, cntp = (G - p + 7) >> 3;
        peer_body::peer_fused(p, (bx >> 3) * NWAVES + wave, cntp * NWAVES, (const bf16*)(ws + WS_PID), (const float*)(ws + WS_G2), (const float*)(ws + WS_PS2), (const unsigned char*)(ws + WS_H2Q),
                              (const unsigned char*)(ws + WS_EU), (const unsigned char*)(ws + WS_EV), out, args.in[16], (char*)lds + RING_OFF, oscale);
    }
#undef IN
#undef BOTH
#undef GRID_BAR
}

extern "C" void kernel_launch(void* const* d_in, const int* in_sizes, int n_in, void* d_out, int out_size, void* d_ws, size_t ws_size, hipStream_t stream) {
    static int grid = 0;
    if (grid == 0) {
        int dev = 0, cus = 0;
        if (n_in != 17 || out_size != M * D || ws_size < WS_END) { fprintf(stderr, "kernel_launch: unexpected shapes (n_in %d out %d ws %zu)\n", n_in, out_size, ws_size); grid = -1; return; }
        if (hipGetDevice(&dev) != hipSuccess || hipDeviceGetAttribute(&cus, hipDeviceAttributeMultiprocessorCount, dev) != hipSuccess) { grid = -1; return; }
        if (hipFuncSetAttribute((const void*)skel_fwd, hipFuncAttributeMaxDynamicSharedMemorySize, LDS_BYTES) != hipSuccess) { fprintf(stderr, "kernel_launch: hipFuncSetAttribute failed\n"); grid = -1; return; }
        int per_cu = 0;
        if (hipOccupancyMaxActiveBlocksPerMultiprocessor(&per_cu, (const void*)skel_fwd, NWAVES * 64, LDS_BYTES) != hipSuccess || per_cu < 1) { fprintf(stderr, "kernel_launch: occupancy query says %d workgroups per CU\n", per_cu); grid = -1; return; }
        grid = cus;
    }
    if (grid < 0) return;
    unsigned char* ws = (unsigned char*)d_ws; float* out = (float*)d_out;
    (void)hipMemsetAsync(ws + WS_CTL, 0, CTL_ZERO_BYTES, stream);
    Args a{};
    for (int i = 0; i < 17; ++i) a.in[i] = (const float*)d_in[i];
    a.out = out; a.ws = ws;
#ifndef MULTI_LAUNCH
    {
        a.ph_lo = 0; a.ph_hi = N_PHASES; a.li = 0;
        void* kargs[] = {(void*)&a};
#ifdef PLAIN_LAUNCH
        hipLaunchKernelGGL(skel_fwd, dim3(grid), dim3(NWAVES * 64), LDS_BYTES, stream, a); const hipError_t e = hipPeekAtLastError(); (void)kargs;
#else
        const hipError_t e = hipLaunchCooperativeKernel((const void*)skel_fwd, dim3(grid), dim3(NWAVES * 64), kargs, LDS_BYTES, stream);
#endif
        if (e != hipSuccess) fprintf(stderr, "kernel_launch: cooperative launch failed: %s (grid %d)\n", hipGetErrorString(e), grid);
    }
#else
    for (int k = 0; k < N_PHASES; ++k) { a.ph_lo = k; a.ph_hi = k + 1; a.li = k; hipLaunchKernelGGL(skel_fwd, dim3(grid), dim3(NWAVES * 64), LDS_BYTES, stream, a); }
#endif
}
```

```cpp
#include <hip/hip_runtime.h>
#include <cstdio>
#include <cstdint>
#include <cmath>

constexpr int D = 1024, BATCH = 8, SEQ = 2048, M = BATCH * SEQ;
constexpr int NH = 8, HD = 64, AW = 512, SW = 512, CHUNK = 128, NG = 8, GD = 64;
constexpr int OFF_Q = 0, OFF_K = 512, OFF_V = 1024, OFF_F = 1536, OFF_UG = 1544, OFF_VG = 2056, OFF_GATE = 2568, IN_W = 4616;
constexpr int NPROJ = 4608;
constexpr int PH = 8, PKEYS = 128, PHALF = 128, PTOP = 16, NEXP = 16384, QPW = 2048, HK = 128;
constexpr float EPS = 1e-6f;
constexpr float LOG2E = 1.4426950408889634f;
constexpr float C2 = 0.125f * LOG2E;

constexpr size_t MiB = 1u << 20;
constexpr size_t WS_CTL = 0, CTL_ZERO_BYTES = 65536;
constexpr size_t WS_WIN = 1 * MiB;
constexpr size_t WS_WA = 10 * MiB;
constexpr size_t WS_WB = 11 * MiB;
constexpr size_t WS_WOUT = 12 * MiB;
constexpr size_t WS_WQ = 14 * MiB;
constexpr size_t WS_SK = 18 * MiB;
constexpr size_t WS_WSM = 18 * MiB + 512 * 1024;
constexpr size_t WS_EU = 20 * MiB;
constexpr size_t WS_EV = 52 * MiB;
constexpr size_t WS_XN = 84 * MiB;
constexpr size_t WS_Q = 116 * MiB;
constexpr size_t WS_K = 132 * MiB;
constexpr size_t WS_V = 148 * MiB;
constexpr size_t WS_UG = 164 * MiB;
constexpr size_t WS_VG = 180 * MiB;
constexpr size_t WS_LOGF = 196 * MiB;
constexpr size_t WS_CL2 = 197 * MiB;
constexpr size_t WS_STAT = 199 * MiB;
constexpr size_t WS_SU = 198 * MiB;
constexpr size_t WS_SV = 198 * MiB + 65536;
constexpr size_t WS_MERGED = WS_K;
constexpr size_t WS_QP = WS_Q;
constexpr size_t WS_PIDX = WS_VG;
constexpr size_t WS_PGATE = WS_VG + 8 * MiB;
constexpr size_t WS_H2Q = 200 * MiB;
constexpr size_t WS_ST = 198 * MiB + 131072;
constexpr size_t WS_SSQP = 198 * MiB + 262144;
constexpr size_t WS_SBQ = 198 * MiB + 524288;
constexpr size_t WS_PID = 180 * MiB;
constexpr size_t WS_G2 = 184 * MiB;
constexpr size_t WS_PS2 = 216 * MiB;
constexpr size_t WS_AP = 116 * MiB;
constexpr size_t WS_WP = 84 * MiB;
constexpr size_t WS_SW = 88 * MiB;
constexpr size_t WS_SSQ = 224 * MiB;
constexpr size_t WS_SBW = 198 * MiB + 786432;
constexpr size_t WS_SA = 198 * MiB + 851968;
constexpr size_t WS_SBWQ = 198 * MiB + 917504;
constexpr size_t WS_END = 256 * MiB;

template <int CTRL> __device__ __forceinline__ float wr_dppf(float v) { return __int_as_float(__builtin_amdgcn_update_dpp(0, __float_as_int(v), CTRL, 0xf, 0xf, false)); }
__device__ __forceinline__ float wave_allsum(float v) {
    v += wr_dppf<0xB1>(v); v += wr_dppf<0x4E>(v); v += wr_dppf<0x141>(v); v += wr_dppf<0x128>(v);
    { const auto s = __builtin_amdgcn_permlane16_swap(__float_as_uint(v), __float_as_uint(v), false, false); v = __uint_as_float(s[0]) + __uint_as_float(s[1]); }
    { const auto s = __builtin_amdgcn_permlane32_swap(__float_as_uint(v), __float_as_uint(v), false, false); v = __uint_as_float(s[0]) + __uint_as_float(s[1]); }
    return v;
}
__device__ __forceinline__ float wave_allmax(float v) {
    v = fmaxf(v, wr_dppf<0xB1>(v)); v = fmaxf(v, wr_dppf<0x4E>(v)); v = fmaxf(v, wr_dppf<0x141>(v)); v = fmaxf(v, wr_dppf<0x128>(v));
    { const auto s = __builtin_amdgcn_permlane16_swap(__float_as_uint(v), __float_as_uint(v), false, false); v = fmaxf(__uint_as_float(s[0]), __uint_as_float(s[1])); }
    { const auto s = __builtin_amdgcn_permlane32_swap(__float_as_uint(v), __float_as_uint(v), false, false); v = fmaxf(__uint_as_float(s[0]), __uint_as_float(s[1])); }
    return v;
}
namespace pg8 {
#define PG8_LAS __attribute__((address_space(3)))
typedef unsigned short bf16_t;
typedef short bf16x8 __attribute__((ext_vector_type(8)));
typedef float f32x4 __attribute__((ext_vector_type(4)));
typedef unsigned u32x4 __attribute__((ext_vector_type(4)));
constexpr int BM = 256, BK = 64, HALF = 128, HTB = HALF * BK * 2  , STAGE_BYTES = 8 * HTB, NXCD = 8, WGM = 8;

__host__ __device__ __forceinline__ int lds_byte(int r, int c) { const int st = (r >> 4) * 2 + (c >> 5), rr = r & 15, cc = c & 31, ob = rr * 64 + cc * 2; return st * 1024 + (ob ^ (((ob >> 9) & 1) << 5)); }
__host__ __device__ __forceinline__ void stage_rc(int b, int& R, int& C) { const int st = b / 1024, sb = b % 1024, swz = sb ^ (((sb >> 9) & 1) << 5); R = (st >> 1) * 16 + swz / 64; C = (st & 1) * 32 + (swz % 64) / 2; }
__host__ __device__ __forceinline__ int perm32(int rho) { const int n = rho >> 4, i = rho & 15; return 8 * (i >> 2) + 4 * n + (i & 3); }

struct Unit { int pm, pn; };
struct Gemm { const bf16_t* A; const bf16_t* Bt; int M, N, K; };

struct StaticOrder {
    int nM, nN, nwg, G, c;
    __host__ __device__ void init(int M, int N, int G_, int c_) { nM = M / BM; nN = N / BM; nwg = nM * nN; G = G_; c = c_; }
    __host__ __device__ bool next(int i, Unit& u) const {
        const long L = (long)i * G + c; if (L >= nwg) return false;
        int wgid = (int)L; { const int q = nwg / NXCD, r = nwg % NXCD, xcd = wgid % NXCD, off = wgid / NXCD; wgid = (xcd < r ? xcd * (q + 1) : r * (q + 1) + (xcd - r) * q) + off; }
        const int nig = WGM * nN, gid = wgid / nig, fm = gid * WGM, gsz = (nM - fm) < WGM ? (nM - fm) : WGM;
        u.pm = fm + ((wgid % nig) % gsz); u.pn = (wgid % nig) / gsz; return true;
    }
    __device__ __forceinline__ void a_ready(const Unit&) const {}
    __device__ __forceinline__ void done(const Unit&) const {}
};

typedef float cvt_f32x2_t __attribute__((ext_vector_type(2))); typedef __bf16 cvt_bf16x2_t __attribute__((ext_vector_type(2)));
__device__ __forceinline__ unsigned cvt_pk_bf16(float lo, float hi) { cvt_f32x2_t v = {lo, hi}; cvt_bf16x2_t b = __builtin_convertvector(v, cvt_bf16x2_t); return __builtin_bit_cast(unsigned, b); }
typedef float f32x2 __attribute__((ext_vector_type(2)));
__device__ __forceinline__ f32x2 gelu_pk(f32x2 v) {
    const f32x2 av = __builtin_elementwise_abs(v), d = av * 0.2316418882f + 1.0f;
    f32x2 t; t.x = __builtin_amdgcn_rcpf(d.x); t.y = __builtin_amdgcn_rcpf(d.y);
    f32x2 q = t * 0.5307027145f + (-0.7265760135f); q = q * t + 0.7107068705f; q = q * t + (-0.142248368f); q = q * t + 0.127414796f; q = q * t;
    const f32x2 s = (v * v) * (-0.72134752044f);
    f32x2 e; e.x = __builtin_amdgcn_exp2f(s.x); e.y = __builtin_amdgcn_exp2f(s.y);
    const f32x2 m = v * (q * e), r = v - m;
    f32x2 o; o.x = v.x < 0.f ? m.x : r.x; o.y = v.y < 0.f ? m.y : r.y; return o;
}

template <int ACT  > struct EpiBf16 {
    static constexpr bool PERM = true, AFTER_DRAIN = false; static_assert(ACT == 0 || ACT == 1, "EpiBf16: ACT is 0 (none) or 1 (gelu_pk)");
    bf16_t* O; int ldc; const float* bias; int split_cols; size_t split_stride; float scale0;
    __device__ __forceinline__ void operator()(const f32x4 (&acc)[2][2][4][2], const Unit& u, int wr, int wc, int fr, int fq) const {
        const int row0 = u.pm * BM + wr * 64 + fr; int colt = u.pn * BM; bf16_t* base = O;
        float sc = 1.f; if (split_cols) { const int t = colt / split_cols; base += (size_t)t * split_stride; colt -= t * split_cols; if (t == 0) sc = scale0; }
        const int col0 = colt + wc * 32 + 8 * fq, bcol0 = u.pn * BM + wc * 32 + 8 * fq;
        f32x4 bv[2][2];
#pragma unroll
        for (int bj = 0; bj < 2; ++bj)
#pragma unroll
            for (int n = 0; n < 2; ++n) bv[bj][n] = bias ? *(const f32x4*)(bias + bcol0 + bj * HALF + 4 * n) : (f32x4){0.f, 0.f, 0.f, 0.f};
#pragma unroll
        for (int ai = 0; ai < 2; ++ai)
#pragma unroll
            for (int m = 0; m < 4; ++m) { bf16_t* rowp = base + (size_t)(row0 + ai * HALF + m * 16) * ldc + col0;
#pragma unroll
                for (int bj = 0; bj < 2; ++bj) { f32x4 v0 = acc[ai][bj][m][0] + bv[bj][0], v1 = acc[ai][bj][m][1] + bv[bj][1];
                    if (ACT == 1) { f32x2 a = gelu_pk((f32x2){v0[0], v0[1]}), b = gelu_pk((f32x2){v0[2], v0[3]}), c = gelu_pk((f32x2){v1[0], v1[1]}), d = gelu_pk((f32x2){v1[2], v1[3]});
                        v0 = (f32x4){a.x, a.y, b.x, b.y}; v1 = (f32x4){c.x, c.y, d.x, d.y}; }
                    v0 = v0 * sc; v1 = v1 * sc; u32x4 w; w.x = cvt_pk_bf16(v0[0], v0[1]); w.y = cvt_pk_bf16(v0[2], v0[3]); w.z = cvt_pk_bf16(v1[0], v1[1]); w.w = cvt_pk_bf16(v1[2], v1[3]);
                    *(u32x4*)(rowp + bj * HALF) = w; } }
    }
};
__device__ __forceinline__ f32x2 sigmoid_pk(f32x2 v) {
#ifdef DBG_SIG
    f32x2 o; o.x = 1.0f / (1.0f + __expf(-v.x)); o.y = 1.0f / (1.0f + __expf(-v.y)); return o;
#else
    f32x2 e; e.x = __builtin_amdgcn_exp2f(v.x * -1.4426950408889634f); e.y = __builtin_amdgcn_exp2f(v.y * -1.4426950408889634f);
    f32x2 o; o.x = __builtin_amdgcn_rcpf(1.0f + e.x); o.y = __builtin_amdgcn_rcpf(1.0f + e.y); return o;
#endif
}
template <int ACT> __device__ __forceinline__ f32x4 act4(f32x4 v, float sc) {
    if (ACT == 0) return v * sc;
    f32x2 a, b;
    if (ACT == 2) { a = gelu_pk((f32x2){v[0], v[1]}); b = gelu_pk((f32x2){v[2], v[3]}); }
    else { a = sigmoid_pk((f32x2){v[0], v[1]}); b = sigmoid_pk((f32x2){v[2], v[3]}); }
    return (f32x4){a.x, a.y, b.x, b.y};
}
struct EpiProj {
    static constexpr bool PERM = true, AFTER_DRAIN = false;
    bf16_t* QKVUV; size_t tstride; bf16_t* GATE; float qscale;
    template <int ACT> __device__ __forceinline__ void body(const f32x4 (&acc)[2][2][4][2], bf16_t* base, int ldc, int row0, int col0, float sc) const {
#pragma unroll
        for (int ai = 0; ai < 2; ++ai)
#pragma unroll
            for (int m = 0; m < 4; ++m) { bf16_t* rowp = base + (size_t)(row0 + ai * HALF + m * 16) * ldc + col0;
#pragma unroll
                for (int bj = 0; bj < 2; ++bj) { const f32x4 v0 = act4<ACT>(acc[ai][bj][m][0], sc), v1 = act4<ACT>(acc[ai][bj][m][1], sc);
                    u32x4 w; w.x = cvt_pk_bf16(v0[0], v0[1]); w.y = cvt_pk_bf16(v0[2], v0[3]); w.z = cvt_pk_bf16(v1[0], v1[1]); w.w = cvt_pk_bf16(v1[2], v1[3]);
                    *(u32x4*)(rowp + bj * HALF) = w; } }
    }
    __device__ __forceinline__ void operator()(const f32x4 (&acc)[2][2][4][2], const Unit& u, int wr, int wc, int fr, int fq) const {
        const int row0 = u.pm * BM + wr * 64 + fr, pn = u.pn;
        if (pn < 10) { bf16_t* base = QKVUV + (size_t)(pn >> 1) * tstride; const int col0 = (pn & 1) * BM + wc * 32 + 8 * fq;
            if (pn < 6) body<0>(acc, base, 512, row0, col0, pn < 2 ? qscale : 1.0f); else body<2>(acc, base, 512, row0, col0, 1.0f); }
        else body<3>(acc, GATE, 2048, row0, (pn - 10) * BM + wc * 32 + 8 * fq, 1.0f);
    }
};
template <int PASS> struct EpiMerge {
    static constexpr bool PERM = true, AFTER_DRAIN = false;
    const bf16_t* GATE; bf16_t* MERGED;
    __device__ __forceinline__ void operator()(const f32x4 (&acc)[2][2][4][2], const Unit& u, int wr, int wc, int fr, int fq) const {
        const int row0 = u.pm * BM + wr * 64 + fr, col0 = u.pn * BM + wc * 32 + 8 * fq;
#pragma unroll
        for (int ai = 0; ai < 2; ++ai) {
            u32x4 gq[4][2], tq[4][2];
#pragma unroll
            for (int m = 0; m < 4; ++m) { const size_t r = (size_t)(row0 + ai * HALF + m * 16);
#pragma unroll
                for (int bj = 0; bj < 2; ++bj) { const int c = col0 + bj * HALF; gq[m][bj] = *(const u32x4*)(GATE + r * 2048 + PASS * 1024 + c);
                    if (PASS == 1) tq[m][bj] = *(const u32x4*)(MERGED + r * 1024 + c); } }
            asm volatile("" ::: "memory");
#pragma unroll
            for (int m = 0; m < 4; ++m) { const size_t r = (size_t)(row0 + ai * HALF + m * 16);
#pragma unroll
                for (int bj = 0; bj < 2; ++bj) { const int c = col0 + bj * HALF; const u32x4 g = gq[m][bj];
                    f32x4 v0 = acc[ai][bj][m][0], v1 = acc[ai][bj][m][1];
                    v0[0] *= __uint_as_float(g.x << 16); v0[1] *= __uint_as_float(g.x & 0xffff0000u); v0[2] *= __uint_as_float(g.y << 16); v0[3] *= __uint_as_float(g.y & 0xffff0000u);
                    v1[0] *= __uint_as_float(g.z << 16); v1[1] *= __uint_as_float(g.z & 0xffff0000u); v1[2] *= __uint_as_float(g.w << 16); v1[3] *= __uint_as_float(g.w & 0xffff0000u);
                    if (PASS == 1) { const u32x4 t = tq[m][bj];
                        v0[0] += __uint_as_float(t.x << 16); v0[1] += __uint_as_float(t.x & 0xffff0000u); v0[2] += __uint_as_float(t.y << 16); v0[3] += __uint_as_float(t.y & 0xffff0000u);
                        v1[0] += __uint_as_float(t.z << 16); v1[1] += __uint_as_float(t.z & 0xffff0000u); v1[2] += __uint_as_float(t.w << 16); v1[3] += __uint_as_float(t.w & 0xffff0000u); }
                    u32x4 w; w.x = cvt_pk_bf16(v0[0], v0[1]); w.y = cvt_pk_bf16(v0[2], v0[3]); w.z = cvt_pk_bf16(v1[0], v1[1]); w.w = cvt_pk_bf16(v1[2], v1[3]);
                    *(u32x4*)(MERGED + r * 1024 + c) = w; } }
            asm volatile("" ::: "memory");
        }
    }
};
struct EpiResid {
    static constexpr bool PERM = false, AFTER_DRAIN = false;
    const float* base; float* out; int ldc; int nrows;
    __device__ __forceinline__ void operator()(const f32x4 (&acc)[2][2][4][2], const Unit& u, int wr, int wc, int fr, int fq) const {
        const int col0 = u.pn * BM + wc * 32 + 4 * fq;
#pragma unroll
        for (int ai = 0; ai < 2; ++ai) {
            f32x4 pre[4][2][2];
#pragma unroll
            for (int m = 0; m < 4; ++m) { const size_t off = (size_t)(u.pm * BM + ai * HALF + wr * 64 + m * 16 + fr) * ldc + col0;
#pragma unroll
                for (int bj = 0; bj < 2; ++bj)
#pragma unroll
                    for (int n = 0; n < 2; ++n) pre[m][bj][n] = *(const f32x4*)(base + off + bj * HALF + n * 16); }
            asm volatile("" ::: "memory");
#pragma unroll
            for (int m = 0; m < 4; ++m) { const size_t off = (size_t)(u.pm * BM + ai * HALF + wr * 64 + m * 16 + fr) * ldc + col0;
#pragma unroll
                for (int bj = 0; bj < 2; ++bj)
#pragma unroll
                    for (int n = 0; n < 2; ++n) *(f32x4*)(out + off + bj * HALF + n * 16) = pre[m][bj][n] + acc[ai][bj][m][n]; }
            asm volatile("" ::: "memory");
        }
    }
};

constexpr int MERGE_DPM = 192;
struct MergeOrder : StaticOrder {
    __host__ __device__ bool next(int i, Unit& u) const {
        if (!StaticOrder::next(i >> 1, u)) return false;
        if (i & 1) { u.pm += MERGE_DPM; u.pn += 4; }
        return true;
    }
};
struct EpiMergeAB {
    static constexpr bool PERM = true, AFTER_DRAIN = false;
    const bf16_t* GATE; bf16_t* MERGED;
    __device__ __forceinline__ void operator()(const f32x4 (&acc)[2][2][4][2], const Unit& u, int wr, int wc, int fr, int fq) const {
        if (u.pn < 4) { EpiMerge<0> E{GATE, MERGED}; E(acc, u, wr, wc, fr, fq); }
        else { Unit v; v.pm = u.pm - MERGE_DPM; v.pn = u.pn - 4; EpiMerge<1> E{GATE, MERGED}; E(acc, v, wr, wc, fr, fq); }
    }
};
struct QueryOrder {
    int v, G, ntask;
    __host__ __device__ bool next(int i, Unit& u) const { const int tk = v + (i >> 1) * G; if (tk >= ntask) return false; u.pm = 2 * (tk >> 3) + (i & 1); u.pn = tk & 7; return true; }
    __device__ __forceinline__ void a_ready(const Unit&) const {}
    __device__ __forceinline__ void done(const Unit&) const {}
};

struct EpiProjI8 {
    static constexpr bool PERM = true, AFTER_DRAIN = false;
    bf16_t* QKVUV; size_t tstride; bf16_t* GATE; float qscale; const float* sA; const float* sB;
    template <int ACT> __device__ __forceinline__ void body(const f32x4 (&acc)[2][2][4][2], bf16_t* base, int ldc, int row0, int col0, int bcol0, float sc) const {
        f32x4 sb[2][2];
#pragma unroll
        for (int bj = 0; bj < 2; ++bj)
#pragma unroll
            for (int n = 0; n < 2; ++n) sb[bj][n] = *(const f32x4*)(sB + bcol0 + bj * HALF + 4 * n);
#pragma unroll
        for (int ai = 0; ai < 2; ++ai)
#pragma unroll
            for (int m = 0; m < 4; ++m) { const int row = row0 + ai * HALF + m * 16; bf16_t* rowp = base + (size_t)row * ldc + col0; const float sa = sA[row];
#pragma unroll
                for (int bj = 0; bj < 2; ++bj) {
                    typedef int i32x4_t __attribute__((ext_vector_type(4)));
                    const i32x4_t i0 = __builtin_bit_cast(i32x4_t, acc[ai][bj][m][0]), i1 = __builtin_bit_cast(i32x4_t, acc[ai][bj][m][1]);
                    const f32x4 f0 = (f32x4){(float)i0[0], (float)i0[1], (float)i0[2], (float)i0[3]} * sb[bj][0] * sa, f1 = (f32x4){(float)i1[0], (float)i1[1], (float)i1[2], (float)i1[3]} * sb[bj][1] * sa;
                    const f32x4 v0 = act4<ACT>(f0, sc), v1 = act4<ACT>(f1, sc);
                    u32x4 w; w.x = cvt_pk_bf16(v0[0], v0[1]); w.y = cvt_pk_bf16(v0[2], v0[3]); w.z = cvt_pk_bf16(v1[0], v1[1]); w.w = cvt_pk_bf16(v1[2], v1[3]);
                    *(u32x4*)(rowp + bj * HALF) = w; } }
    }
    __device__ __forceinline__ void operator()(const f32x4 (&acc)[2][2][4][2], const Unit& u, int wr, int wc, int fr, int fq) const {
        const int row0 = u.pm * BM + wr * 64 + fr, pn = u.pn, bcol0 = pn * BM + wc * 32 + 8 * fq;
        if (pn < 10) { bf16_t* base = QKVUV + (size_t)(pn >> 1) * tstride; const int col0 = (pn & 1) * BM + wc * 32 + 8 * fq;
            if (pn < 6) body<0>(acc, base, 512, row0, col0, bcol0, pn < 2 ? qscale : 1.0f); else body<2>(acc, base, 512, row0, col0, bcol0, 1.0f); }
        else body<3>(acc, GATE, 2048, row0, (pn - 10) * BM + wc * 32 + 8 * fq, bcol0, 1.0f);
    }
};

struct EpiBf16I8 {
    static constexpr bool PERM = true, AFTER_DRAIN = false;
    bf16_t* O; int ldc; const float* sA; const float* sB;
    __device__ __forceinline__ void operator()(const f32x4 (&acc)[2][2][4][2], const Unit& u, int wr, int wc, int fr, int fq) const {
        typedef int i32x4_t __attribute__((ext_vector_type(4)));
        const int row0 = u.pm * BM + wr * 64 + fr, col0 = u.pn * BM + wc * 32 + 8 * fq;
        f32x4 sb[2][2];
#pragma unroll
        for (int bj = 0; bj < 2; ++bj)
#pragma unroll
            for (int n = 0; n < 2; ++n) sb[bj][n] = *(const f32x4*)(sB + col0 + bj * HALF + 4 * n);
#pragma unroll
        for (int ai = 0; ai < 2; ++ai)
#pragma unroll
            for (int m = 0; m < 4; ++m) { const int row = row0 + ai * HALF + m * 16; bf16_t* rowp = O + (size_t)row * ldc + col0; const float sa = sA[row];
#pragma unroll
                for (int bj = 0; bj < 2; ++bj) {
                    const i32x4_t i0 = __builtin_bit_cast(i32x4_t, acc[ai][bj][m][0]), i1 = __builtin_bit_cast(i32x4_t, acc[ai][bj][m][1]);
                    const f32x4 v0 = (f32x4){(float)i0[0], (float)i0[1], (float)i0[2], (float)i0[3]} * sb[bj][0] * sa, v1 = (f32x4){(float)i1[0], (float)i1[1], (float)i1[2], (float)i1[3]} * sb[bj][1] * sa;
                    u32x4 w; w.x = cvt_pk_bf16(v0[0], v0[1]); w.y = cvt_pk_bf16(v0[2], v0[3]); w.z = cvt_pk_bf16(v1[0], v1[1]); w.w = cvt_pk_bf16(v1[2], v1[3]);
                    *(u32x4*)(rowp + bj * HALF) = w; } }
    }
};
template <class Epi, class Sched, bool ALIGN_EPI = false, bool SP2 = false, bool I8 = false>
__device__ __forceinline__ void gemm_phase(PG8_LAS unsigned char* lds, const Gemm g, const Sched& S, const Epi& E) {
    typedef int i32x4_t __attribute__((ext_vector_type(4)));
    int tid = threadIdx.x; asm volatile("" : "+v"(tid));
    const int wid = __builtin_amdgcn_readfirstlane(tid >> 6), lane = tid & 63, wr = wid >> 2, wc = wid & 3, fr = lane & 15, fq = lane >> 4;
    const int K = g.K, nt = K / BK;
    unsigned voffA[2], voffB[2];
#pragma unroll
    for (int i = 0; i < 2; ++i) { int R, C; stage_rc(tid * 16 + i * 8192, R, C); const int Rb = Epi::PERM ? ((R & ~31) + perm32(R & 31)) : R;
        voffA[i] = (unsigned)(R * K + C) * 2u; voffB[i] = (unsigned)(Rb * K + C) * 2u; }
    const size_t kstep = (size_t)(BK * 2);
    const size_t hstep = (size_t)HALF * K * 2;
    const size_t tstep = 2 * hstep;
    const unsigned ldsw = (unsigned)wid * 1024u;
    const int aoff = lds_byte(wr * 64 + fr, fq * 8), boff = lds_byte(wc * 32 + fr, fq * 8);
#define PG8_SA(b, h) (((b) * 2 + (h)) * HTB)
#define PG8_SB(b, h) ((4 + (b) * 2 + (h)) * HTB)
#define PG8_STAGE(bufoff, gbase, voff) do { _Pragma("unroll") for (int _i = 0; _i < 2; ++_i) \
        __builtin_amdgcn_global_load_lds((const unsigned*)((const char*)(gbase) + (voff)[_i]), (PG8_LAS unsigned*)(lds + (bufoff) + ldsw + _i * 8192), 16, 0, 0); } while (0)
#define PG8_LDA(dst, b, h) do { _Pragma("unroll") for (int m = 0; m < 4; ++m) _Pragma("unroll") for (int k = 0; k < 2; ++k) dst[m][k] = *(const PG8_LAS bf16x8*)(lds + PG8_SA(b, h) + aoff + m * 2048 + k * 1024); } while (0)
#define PG8_LDB(dst, b, h) do { _Pragma("unroll") for (int n = 0; n < 2; ++n) _Pragma("unroll") for (int k = 0; k < 2; ++k) dst[n][k] = *(const PG8_LAS bf16x8*)(lds + PG8_SB(b, h) + boff + n * 2048 + k * 1024); } while (0)
#define PG8_MMA(ai, bj, At, Bt) do { __builtin_amdgcn_s_setprio(1); _Pragma("unroll") for (int m = 0; m < 4; ++m) _Pragma("unroll") for (int n = 0; n < 2; ++n) _Pragma("unroll") for (int k = 0; k < 2; ++k) \
        { if constexpr (I8) acc[ai][bj][m][n] = __builtin_bit_cast(f32x4, __builtin_amdgcn_mfma_i32_16x16x64_i8(__builtin_bit_cast(i32x4_t, Bt[n][k]), __builtin_bit_cast(i32x4_t, At[m][k]), __builtin_bit_cast(i32x4_t, acc[ai][bj][m][n]), 0, 0, 0)); \
          else acc[ai][bj][m][n] = __builtin_amdgcn_mfma_f32_16x16x32_bf16(Bt[n][k], At[m][k], acc[ai][bj][m][n], 0, 0, 0); } __builtin_amdgcn_s_setprio(0); } while (0)
#define PG8_WAIT_V(n) asm volatile("s_waitcnt vmcnt(" #n ")" ::: "memory")
#define PG8_WAIT_L(n) asm volatile("s_waitcnt lgkmcnt(" #n ")" ::: "memory")
#define PG8_BAR __builtin_amdgcn_s_barrier()
#define PG8_SCHED __builtin_amdgcn_sched_barrier(0)
    Unit cur, nxt; int ui = 0;
    if (!S.next(0, cur)) return;
    f32x4 acc[2][2][4][2];
#pragma unroll
    for (int a = 0; a < 2; ++a)
#pragma unroll
        for (int b = 0; b < 2; ++b)
#pragma unroll
            for (int m = 0; m < 4; ++m)
#pragma unroll
                for (int n = 0; n < 2; ++n) acc[a][b][m][n] = (f32x4){0.f, 0.f, 0.f, 0.f};
    bf16x8 At[4][2], B0[2][2], B1[2][2];
    const char* cA = (const char*)g.A + (size_t)cur.pm * tstep; const char* cB = (const char*)g.Bt + (size_t)cur.pn * tstep;
    S.a_ready(cur);
    if constexpr (SP2) {
        PG8_STAGE(PG8_SB(0, 0), cB, voffB); PG8_STAGE(PG8_SB(0, 1), cB + hstep, voffB); PG8_STAGE(PG8_SA(0, 0), cA, voffA); PG8_STAGE(PG8_SA(0, 1), cA + hstep, voffA);
        if (wr == 1) PG8_BAR;
        PG8_WAIT_V(2); PG8_BAR;
        PG8_STAGE(PG8_SB(1, 0), cB + kstep, voffB); PG8_STAGE(PG8_SA(1, 0), cA + kstep, voffA); PG8_STAGE(PG8_SB(1, 1), cB + hstep + kstep, voffB);
        PG8_WAIT_V(6); PG8_BAR;
    } else {
        PG8_STAGE(PG8_SB(0, 0), cB, voffB); PG8_STAGE(PG8_SA(0, 0), cA, voffA); PG8_STAGE(PG8_SB(0, 1), cB + hstep, voffB); PG8_STAGE(PG8_SA(0, 1), cA + hstep, voffA);
        if (wr == 1) PG8_BAR;
        PG8_WAIT_V(4); PG8_BAR;
        PG8_STAGE(PG8_SB(1, 0), cB + kstep, voffB); PG8_STAGE(PG8_SA(1, 0), cA + kstep, voffA); PG8_STAGE(PG8_SB(1, 1), cB + hstep + kstep, voffB);
        PG8_WAIT_V(6); PG8_BAR;
    }
    for (;;) {
        const bool has_next = S.next(ui + 1, nxt);
        const char* nA = has_next ? (const char*)g.A + (size_t)nxt.pm * tstep : cA; const char* nB = has_next ? (const char*)g.Bt + (size_t)nxt.pn * tstep : cB;
        for (int t = 0; t < nt; t += 2) {
            const bool last = (t == nt - 2);
            const char* a1 = cA + (size_t)(t + 1) * kstep;
            const char* a2 = last ? nA : cA + (size_t)(t + 2) * kstep; const char* b2 = last ? nB : cB + (size_t)(t + 2) * kstep;
            const char* a3 = a2 + kstep; const char* b3 = b2 + kstep;
            if (last && has_next) S.a_ready(nxt);
            if constexpr (SP2) {
            PG8_LDB(B0, 0, 0); PG8_LDB(B1, 0, 1); PG8_SCHED; PG8_LDA(At, 0, 0); PG8_STAGE(PG8_SA(1, 1), a1 + hstep, voffA);
            PG8_WAIT_V(8); PG8_WAIT_L(0); PG8_BAR; PG8_MMA(0, 0, At, B0); PG8_MMA(0, 1, At, B1); PG8_BAR; PG8_SCHED;
            PG8_LDA(At, 0, 1); PG8_STAGE(PG8_SB(0, 0), b2, voffB); PG8_STAGE(PG8_SB(0, 1), b2 + hstep, voffB); PG8_STAGE(PG8_SA(0, 0), a2, voffA);
            PG8_WAIT_V(8); PG8_WAIT_L(0); PG8_BAR; PG8_MMA(1, 0, At, B0); PG8_MMA(1, 1, At, B1); PG8_BAR; PG8_SCHED;
            PG8_LDB(B0, 1, 0); PG8_LDB(B1, 1, 1); PG8_SCHED; PG8_LDA(At, 1, 0); PG8_STAGE(PG8_SA(0, 1), a2 + hstep, voffA);
            PG8_WAIT_V(8); PG8_WAIT_L(0); PG8_BAR; PG8_MMA(0, 0, At, B0); PG8_MMA(0, 1, At, B1); PG8_BAR; PG8_SCHED;
            PG8_LDA(At, 1, 1); PG8_STAGE(PG8_SB(1, 0), b3, voffB); PG8_STAGE(PG8_SB(1, 1), b3 + hstep, voffB); PG8_STAGE(PG8_SA(1, 0), a3, voffA);
            PG8_WAIT_V(8); PG8_WAIT_L(0); PG8_BAR; PG8_MMA(1, 0, At, B0); PG8_MMA(1, 1, At, B1); PG8_BAR; PG8_SCHED;
            } else {
            PG8_LDB(B0, 0, 0); PG8_SCHED; PG8_LDA(At, 0, 0); PG8_STAGE(PG8_SA(1, 1), a1 + hstep, voffA);
            PG8_WAIT_L(8); PG8_BAR; PG8_WAIT_L(0); PG8_MMA(0, 0, At, B0); PG8_BAR; PG8_SCHED;
            PG8_LDB(B1, 0, 1); PG8_STAGE(PG8_SB(0, 0), b2, voffB);
            PG8_BAR; PG8_WAIT_L(0); PG8_MMA(0, 1, At, B1); PG8_BAR;
            PG8_LDA(At, 0, 1); PG8_STAGE(PG8_SA(0, 0), a2, voffA);
            PG8_BAR; PG8_WAIT_L(0); PG8_MMA(1, 0, At, B0); PG8_BAR; PG8_SCHED;
            PG8_STAGE(PG8_SB(0, 1), b2 + hstep, voffB);
            PG8_WAIT_V(6); PG8_BAR; PG8_MMA(1, 1, At, B1); PG8_BAR;
            PG8_LDB(B0, 1, 0); PG8_SCHED; PG8_LDA(At, 1, 0); PG8_STAGE(PG8_SA(0, 1), a2 + hstep, voffA);
            PG8_WAIT_L(8); PG8_BAR; PG8_WAIT_L(0); PG8_MMA(0, 0, At, B0); PG8_BAR; PG8_SCHED;
            PG8_LDB(B1, 1, 1); PG8_STAGE(PG8_SB(1, 0), b3, voffB);
            PG8_BAR; PG8_WAIT_L(0); PG8_MMA(0, 1, At, B1); PG8_BAR;
            PG8_LDA(At, 1, 1); PG8_STAGE(PG8_SA(1, 0), a3, voffA);
            PG8_BAR; PG8_WAIT_L(0); PG8_MMA(1, 0, At, B0); PG8_BAR; PG8_SCHED;
            PG8_STAGE(PG8_SB(1, 1), b3 + hstep, voffB);
            PG8_WAIT_V(6); PG8_BAR; PG8_MMA(1, 1, At, B1); PG8_BAR;
            }
        }
        if constexpr (ALIGN_EPI) { if (wr == 0) PG8_BAR; }
        if constexpr (!Epi::AFTER_DRAIN) { E(acc, cur, wr, wc, fr, fq); S.done(cur); }
        if (!has_next) break;
#pragma unroll
        for (int a = 0; a < 2; ++a)
#pragma unroll
            for (int b = 0; b < 2; ++b)
#pragma unroll
                for (int m = 0; m < 4; ++m)
#pragma unroll
                    for (int n = 0; n < 2; ++n) acc[a][b][m][n] = (f32x4){0.f, 0.f, 0.f, 0.f};
        cur = nxt; cA = nA; cB = nB; ++ui;
        if constexpr (ALIGN_EPI) { if (wr == 1) PG8_BAR; }
    }
    PG8_WAIT_V(0);
    if constexpr (!ALIGN_EPI) { if (wr == 0) PG8_BAR; }
    PG8_BAR;
    if constexpr (Epi::AFTER_DRAIN) { E.fused(acc, cur, wr, wc, fr, fq, lds, wid, lane); S.done(cur); }
#undef PG8_SA
#undef PG8_SB
#undef PG8_STAGE
#undef PG8_LDA
#undef PG8_LDB
#undef PG8_MMA
#undef PG8_WAIT_V
#undef PG8_WAIT_L
#undef PG8_BAR
#undef PG8_SCHED
}
}
#include <hip/hip_bf16.h>
#include <cmath>
namespace attn_body {
using bf16=__hip_bfloat16;
using bf16x8=__attribute__((ext_vector_type(8)))short;
using s16x4=__attribute__((ext_vector_type(4)))short;
using f32x16=__attribute__((ext_vector_type(16)))float;
using u32x4=__attribute__((ext_vector_type(4)))unsigned;
constexpr int BATCH=8,NHEAD=8,SEQ=2048,D=64,DM=NHEAD*D;
constexpr int NW=8,QBLK=32,QB=QBLK*NW,KVBLK=64,NQB=SEQ/QB;
constexpr int ATTN_PITCH=DM, ATTN_UNIT_ROWS=QB;
__device__ __forceinline__ int crow(int r,int hi){return (r&3)+8*(r>>2)+4*hi;}
#define SBAR() __builtin_amdgcn_sched_barrier(0)
__device__ __forceinline__ void cmask(f32x16&p0,f32x16&p1,int jb,int qrel,int hi){
  const float NEG=-INFINITY; int kb=64*jb+4*hi;
  #pragma unroll
  for(int r=0;r<16;++r){int kv=kb+(r&3)+8*(r>>2); if(kv>qrel)p0[r]=NEG; if(kv+32>qrel)p1[r]=NEG;}
}

constexpr int NSLOT=3, SLOTB=8192;
constexpr int LDS_K=0, LDS_V=NSLOT*SLOTB, LDS_WS=2*NSLOT*SLOTB, LDS_OST=LDS_WS+NW*64*4, LDS_CS=LDS_OST+NW*4096, LDS_BYTES=LDS_CS+SEQ*4;
constexpr float C2=0.125f*1.4426950408889634f;
__device__ __forceinline__ void glds16(const void*gsrc,unsigned lds_dst){unsigned keep;
  asm volatile("s_mov_b32 %0, m0\n\ts_mov_b32 m0, %2\n\ts_nop 0\n\tglobal_load_lds_dwordx4 %1, off\n\ts_mov_b32 m0, %0":"=&s"(keep):"v"(gsrc),"s"(lds_dst):"memory");}
__device__ __forceinline__ float max3f(float a,float b,float c){float r;asm("v_max3_f32 %0, %1, %2, %3":"=v"(r):"v"(a),"v"(b),"v"(c));return r;}
__device__ __forceinline__ float max2f(float a,float b){float r;asm("v_max_f32_e32 %0, %1, %2":"=v"(r):"v"(a),"v"(b));return r;}
__device__ __forceinline__ float fadd_s(float a,float b){float r;asm("v_add_f32_e32 %0, %1, %2":"=v"(r):"v"(a),"v"(b));return r;}
__device__ __forceinline__ float fsub_s(float a,float b){float r;asm("v_sub_f32_e32 %0, %1, %2":"=v"(r):"v"(a),"v"(b));return r;}
typedef float f32x2_t __attribute__((ext_vector_type(2))); typedef __bf16 bf16x2_t __attribute__((ext_vector_type(2)));
__device__ __forceinline__ unsigned cvtpk_s(float lo,float hi){f32x2_t v={lo,hi};bf16x2_t b=__builtin_convertvector(v,bf16x2_t);return __builtin_bit_cast(unsigned,b);}
#define WAIT_BAR(N) asm volatile("s_waitcnt vmcnt(" #N ") lgkmcnt(0)\n\ts_barrier":::"memory")

__device__ __forceinline__ void qkt(f32x16&p0,f32x16&p1,const char*Kslot,const bf16x8*qr,int r32,int hi){
  const char*kb=Kslot+hi*1024+r32*16;
  #pragma unroll
  for(int d0=0;d0<4;++d0){
    const bf16x8 b0=*reinterpret_cast<const bf16x8*>(kb+d0*2048);
    const bf16x8 b1=*reinterpret_cast<const bf16x8*>(kb+d0*2048+512);
    p0=__builtin_amdgcn_mfma_f32_32x32x16_bf16(b0,qr[d0],p0,0,0,0);p1=__builtin_amdgcn_mfma_f32_32x32x16_bf16(b1,qr[d0],p1,0,0,0);}
}
typedef __attribute__((address_space(3))) const char* lds_cptr;
typedef short v4i16_t __attribute__((ext_vector_type(4)));
__device__ __forceinline__ void kload8(bf16x8*kf,lds_cptr kp){
  kf[0]=*(const __attribute__((address_space(3))) bf16x8*)(kp);      kf[1]=*(const __attribute__((address_space(3))) bf16x8*)(kp+512);
  kf[2]=*(const __attribute__((address_space(3))) bf16x8*)(kp+2048); kf[3]=*(const __attribute__((address_space(3))) bf16x8*)(kp+2560);
  kf[4]=*(const __attribute__((address_space(3))) bf16x8*)(kp+4096); kf[5]=*(const __attribute__((address_space(3))) bf16x8*)(kp+4608);
  kf[6]=*(const __attribute__((address_space(3))) bf16x8*)(kp+6144); kf[7]=*(const __attribute__((address_space(3))) bf16x8*)(kp+6656);
}
__device__ __forceinline__ void kload2(bf16x8*kf,lds_cptr kp,int j){ kf[2*j]=*(const __attribute__((address_space(3))) bf16x8*)(kp+j*2048); kf[2*j+1]=*(const __attribute__((address_space(3))) bf16x8*)(kp+j*2048+512); }
__device__ __forceinline__ s16x4 vtr(lds_cptr p){ return __builtin_bit_cast(s16x4,__builtin_amdgcn_ds_read_tr16_b64_v4i16((__attribute__((address_space(3))) v4i16_t*)p)); }
__device__ __forceinline__ float rowmax(const f32x16&p0,const f32x16&p1){
  float a=max3f(p0[0],p0[1],p1[0]),b=max3f(p0[2],p0[3],p1[1]);a=max3f(a,p1[2],p1[3]);
  #pragma unroll
  for(int r=4;r<16;r+=4){a=max3f(a,p0[r],p0[r+1]);b=max3f(b,p0[r+2],p0[r+3]);a=max3f(a,p1[r],p1[r+1]);b=max3f(b,p1[r+2],p1[r+3]);}
  const float m=max2f(a,b);
  auto rr=__builtin_amdgcn_permlane32_swap(__float_as_uint(m),__float_as_uint(m),false,false);
  return max2f(__uint_as_float(rr[0]),__uint_as_float(rr[1]));
}
__device__ __forceinline__ void pv(f32x16*o,int vb,bf16x8 pa0,bf16x8 pa1,bf16x8 pa2,bf16x8 pa3){
  #pragma unroll
  for(int d0=0;d0<2;++d0){s16x4 lo[4],hi[4];
    #pragma unroll
    for(int ks=0;ks<4;++ks){
      asm volatile("ds_read_b64_tr_b16 %0,%1 offset:%c2":"=&v"(lo[ks]):"v"(vb),"i"(d0*4096+ks*1024):"memory");
      asm volatile("ds_read_b64_tr_b16 %0,%1 offset:%c2":"=&v"(hi[ks]):"v"(vb),"i"(d0*4096+ks*1024+512):"memory");}
    asm volatile("s_waitcnt lgkmcnt(0)":::"memory");SBAR();
    #define PK(k) (bf16x8){lo[k][0],lo[k][1],lo[k][2],lo[k][3],hi[k][0],hi[k][1],hi[k][2],hi[k][3]}
    o[d0]=__builtin_amdgcn_mfma_f32_32x32x16_bf16(pa0,PK(0),o[d0],0,0,0);
    o[d0]=__builtin_amdgcn_mfma_f32_32x32x16_bf16(pa1,PK(1),o[d0],0,0,0);
    o[d0]=__builtin_amdgcn_mfma_f32_32x32x16_bf16(pa2,PK(2),o[d0],0,0,0);
    o[d0]=__builtin_amdgcn_mfma_f32_32x32x16_bf16(pa3,PK(3),o[d0],0,0,0);
    #undef PK
  }
}

#ifndef ATTN_STORE16
#define ATTN_STORE16(p,v) (*(u32x4*)(p)=(v))
#endif
template<int THRL> __device__ __forceinline__ void attn_unit(int b,int h,int qb,const bf16*Q,const bf16*__restrict__ K,const bf16*__restrict__ V,bf16*O,const float*__restrict__ CL2,char*shm,int t0=0){
  int tid=threadIdx.x; asm volatile("":"+v"(tid)); const int lane=tid&63,r32=lane&31,hi=lane>>5; const int wid=__builtin_amdgcn_readfirstlane(tid>>6);
  const long rowbase=(long)b*SEQ; const int q0=qb*QB;
  const bf16*Qw=Q+(rowbase+q0+wid*QBLK)*DM+h*D;
  const bf16*Kh=K+rowbase*DM+h*D,*Vh=V+rowbase*DM+h*D;
  const unsigned lds0=(unsigned)(uintptr_t)shm;
  float*wsf=(float*)(shm+LDS_WS)+wid*64;
  const bf16*ksrc=Kh+(long)(t0*KVBLK+lane)*DM+wid*8;
  const bf16*vsrc=Vh+(long)(t0*KVBLK+16*(wid&3)+(lane>>2))*DM+(wid>>2)*32+(lane&3)*8;
  const unsigned kdst=lds0+LDS_K+wid*1024, vdst=lds0+LDS_V+wid*1024;
  #define DMA_K(t,slot) glds16(ksrc+(long)(t)*KVBLK*DM,(unsigned)__builtin_amdgcn_readfirstlane(kdst+(slot)))
  #define DMA_V(t,slot) glds16(vsrc+(long)(t)*KVBLK*DM,(unsigned)__builtin_amdgcn_readfirstlane(vdst+(slot)))
  const int vb0=(int)(lds0+LDS_V)+((lane>>4)&1)*32+(lane&3)*8+(4*hi+((lane&15)>>2))*64;
  const char*Kbase=shm+LDS_K; bf16x8 kf[8];
  const lds_cptr shm3=(lds_cptr)shm; const lds_cptr kp0=shm3+LDS_K+hi*1024+r32*16; const lds_cptr vp0=shm3+LDS_V+((lane>>4)&1)*32+(lane&3)*8+(4*hi+((lane&15)>>2))*64;
  const int NT=(q0+QB)/KVBLK-t0;
  DMA_K(0,0);DMA_V(0,0);DMA_K(1,SLOTB);
  bf16x8 qr[4];
  #pragma unroll
  for(int d0=0;d0<4;++d0)qr[d0]=*reinterpret_cast<const bf16x8*>(&Qw[(long)r32*DM+d0*16+hi*8]);
  const float*cg=CL2+(long)(b*NHEAD+h)*SEQ;
  { float*csf=(float*)(shm+LDS_CS); for(int i=tid;i<q0+QB;i+=NW*64)csf[i]=cg[i]; }
  const lds_cptr cs3=(lds_cptr)shm+LDS_CS+hi*16+t0*256;
  float nm=cg[q0+wid*QBLK+r32],l_reg=0.f;f32x16 o[2];o[0]=f32x16{};o[1]=f32x16{};
  const int qrel=wid*QBLK+r32;
  #define CMASK(P0,P1,t) do{int jb_=(t)-(NT-4); if(jb_>=0)cmask(P0,P1,jb_,qrel,hi);}while(0)
  bool resc=false;
  typedef float f32x4_t __attribute__((ext_vector_type(4)));
  #define BIAS(C0,C1,t) do{ const lds_cptr cp_=cs3+(t)*256; \
    _Pragma("unroll") for(int g_=0;g_<4;++g_){ const f32x4_t a_=*(const __attribute__((address_space(3))) f32x4_t*)(cp_+g_*32), b_=*(const __attribute__((address_space(3))) f32x4_t*)(cp_+g_*32+128); \
      _Pragma("unroll") for(int i_=0;i_<4;++i_){ C0[4*g_+i_]=nm-a_[i_]; C1[4*g_+i_]=nm-b_[i_]; } } }while(0)
  #define START(P0,P1) do{ const float rm=rowmax(P0,P1); resc=false; \
    { const float dl=(rm>(float)THRL)?rm:0.f;     \
      nm=fsub_s(nm,dl); \
      _Pragma("unroll") for(int r=0;r<16;++r){P0[r]=fsub_s(P0[r],dl);P1[r]=fsub_s(P1[r],dl);} } \
    _Pragma("unroll") for(int r=0;r<16;++r)P0[r]=__builtin_amdgcn_exp2f(P0[r]); }while(0)
  #define RESC() do{ if(resc){ asm volatile("s_waitcnt lgkmcnt(0)":::"memory"); \
      _Pragma("unroll") for(int d_=0;d_<2;++d_) _Pragma("unroll") for(int r=0;r<16;++r)o[d_][r]*=wsf[crow(r,hi)]; } }while(0)
  f32x16 pA0,pA1,pB0,pB1;
  int sl_prev=0,sl_cur=0,sl_next=SLOTB;
  #define ROT() do{sl_prev=sl_cur;sl_cur=sl_next;sl_next=(sl_next==(NSLOT-1)*SLOTB)?0:sl_next+SLOTB;}while(0)
  DMA_K(2,2*SLOTB);
  WAIT_BAR(3);
  BIAS(pA0,pA1,0); qkt(pA0,pA1,Kbase,qr,r32,hi);asm volatile("s_nop 15\n\ts_nop 7":"+v"(pA0),"+v"(pA1));CMASK(pA0,pA1,0);
  START(pA0,pA1);
  _Pragma("unroll") for(int r=0;r<16;++r)pA1[r]=__builtin_amdgcn_exp2f(pA1[r]);
  WAIT_BAR(0);
  DMA_K(3,0);DMA_V(1,SLOTB);
  ROT();
  kload8(kf,kp0+sl_cur);
  WAIT_BAR(2);
  s16x4 vlo[8],vhi[8]; u32x4 pw0,pw1,pw2,pw3;
  #define PKW(P,B) cvtpk_s(P[B],P[B+1])
  #define PAF(k) __builtin_bit_cast(bf16x8,pw##k)
  #define VFR(i) (bf16x8){vlo[i][0],vlo[i][1],vlo[i][2],vlo[i][3],vhi[i][0],vhi[i][1],vhi[i][2],vhi[i][3]}
  #define PIN(x) asm volatile("":"+v"(x))
  #define MX3(a,b,c) __builtin_fmaxf(__builtin_fmaxf((a),(b)),(c))
  #define GAPA(MF,A0,A1,A2,A3,W0,W1,PW) do{ MF; sacc+=A0; sacc+=A1; sacc+=A2; sacc+=A3; PIN(sacc); W0; W1; PIN(PW); SBAR(); }while(0)
  #define EX(v) __builtin_amdgcn_exp2f(v)
  #define GAPB(MF,X,B) do{ MF; X[B]=EX(X[B]); X[B+1]=EX(X[B+1]); X[B+2]=EX(X[B+2]); X[B+3]=EX(X[B+3]); PIN(X); SBAR(); }while(0)
  #define VRD(i) do{ vlo[i]=vtr(vp_+(((i)>>2)*4096+((i)&3)*1024)); vhi[i]=vtr(vp_+(((i)>>2)*4096+((i)&3)*1024+512)); }while(0)
  #define KRD(G,j) do{ if(G){ kload2(kf,kp0+sl_next,j); SBAR(); } }while(0)
  #define STEP(C0,C1,P0,P1,t,GK,GV,GL) do{ SBAR(); BIAS(C0,C1,t); SBAR(); \
    const lds_cptr vp_=vp0+sl_prev; \
    VRD(0); SBAR(); float sacc=(P0[0]+P0[1]); \
    GAPA(C0=__builtin_amdgcn_mfma_f32_32x32x16_bf16(kf[0],qr[0],C0,0,0,0), P0[2],P0[3],P0[4],P0[5],     pw0[0]=PKW(P0,0), pw0[1]=PKW(P0,2), pw0); \
    VRD(4); SBAR(); GAPA(C1=__builtin_amdgcn_mfma_f32_32x32x16_bf16(kf[1],qr[0],C1,0,0,0), P0[6],P0[7],P0[8],P0[9],     pw0[2]=PKW(P0,4), pw0[3]=PKW(P0,6), pw0); \
    VRD(1); SBAR(); GAPA(C0=__builtin_amdgcn_mfma_f32_32x32x16_bf16(kf[2],qr[1],C0,0,0,0),   P0[10],P0[11],P0[12],P0[13], pw1[0]=PKW(P0,8), pw1[1]=PKW(P0,10), pw1); \
    VRD(5); SBAR(); GAPA(C1=__builtin_amdgcn_mfma_f32_32x32x16_bf16(kf[3],qr[1],C1,0,0,0),   P0[14],P0[15],P1[0],P1[1],   pw1[2]=PKW(P0,12),pw1[3]=PKW(P0,14), pw1); \
    VRD(2); SBAR(); GAPA(C0=__builtin_amdgcn_mfma_f32_32x32x16_bf16(kf[4],qr[2],C0,0,0,0),   P1[2],P1[3],P1[4],P1[5],     pw2[0]=PKW(P1,0), pw2[1]=PKW(P1,2), pw2); \
    VRD(6); SBAR(); GAPA(C1=__builtin_amdgcn_mfma_f32_32x32x16_bf16(kf[5],qr[2],C1,0,0,0),   P1[6],P1[7],P1[8],P1[9],     pw2[2]=PKW(P1,4), pw2[3]=PKW(P1,6), pw2); \
    VRD(3); SBAR(); GAPA(C0=__builtin_amdgcn_mfma_f32_32x32x16_bf16(kf[6],qr[3],C0,0,0,0),   P1[10],P1[11],P1[12],P1[13], pw3[0]=PKW(P1,8), pw3[1]=PKW(P1,10), pw3); \
    VRD(7); SBAR(); GAPA(C1=__builtin_amdgcn_mfma_f32_32x32x16_bf16(kf[7],qr[3],C1,0,0,0),   P1[14],P1[15],0.f,0.f,       pw3[2]=PKW(P1,12),pw3[3]=PKW(P1,14), pw3); \
    l_reg+=sacc; \
    if(GK){DMA_K((t)+3,sl_cur);} if(GV){DMA_V((t)+1,sl_next);} \
    CMASK(C0,C1,t); \
    { float a=MX3(C0[0],C0[1],C1[0]),b=MX3(C0[2],C0[3],C1[1]); a=MX3(a,C1[2],C1[3]); \
      _Pragma("unroll") for(int r=4;r<16;r+=4){a=MX3(a,C0[r],C0[r+1]);b=MX3(b,C0[r+2],C0[r+3]);a=MX3(a,C1[r],C1[r+1]);b=MX3(b,C1[r+2],C1[r+3]);} \
      float rm=__builtin_fmaxf(a,b); { auto rr=__builtin_amdgcn_permlane32_swap(__float_as_uint(rm),__float_as_uint(rm),false,false); rm=__builtin_fmaxf(__uint_as_float(rr[0]),__uint_as_float(rr[1])); } \
      resc=false; \
      if(__builtin_expect(__any(rm>(float)THRL),0)){ const float dl=__builtin_fmaxf(rm,0.f); nm-=dl; \
        _Pragma("unroll") for(int r=0;r<16;++r){C0[r]-=dl;C1[r]-=dl;} \
        const float f=__builtin_amdgcn_exp2f(-dl); l_reg*=f; if(hi==0)wsf[r32]=f; resc=true; } } \
    SBAR(); \
    GAPB(o[0]=__builtin_amdgcn_mfma_f32_32x32x16_bf16(PAF(0),VFR(0),o[0],0,0,0), C0,0); \
    GAPB(o[1]=__builtin_amdgcn_mfma_f32_32x32x16_bf16(PAF(0),VFR(4),o[1],0,0,0), C0,4); \
    KRD(GL,0); GAPB(o[0]=__builtin_amdgcn_mfma_f32_32x32x16_bf16(PAF(1),VFR(1),o[0],0,0,0), C0,8); \
    KRD(GL,1); GAPB(o[1]=__builtin_amdgcn_mfma_f32_32x32x16_bf16(PAF(1),VFR(5),o[1],0,0,0), C0,12); \
    KRD(GL,2); GAPB(o[0]=__builtin_amdgcn_mfma_f32_32x32x16_bf16(PAF(2),VFR(2),o[0],0,0,0), C1,0); \
    KRD(GL,3); GAPB(o[1]=__builtin_amdgcn_mfma_f32_32x32x16_bf16(PAF(2),VFR(6),o[1],0,0,0), C1,4); \
    GAPB(o[0]=__builtin_amdgcn_mfma_f32_32x32x16_bf16(PAF(3),VFR(3),o[0],0,0,0), C1,8); \
    GAPB(o[1]=__builtin_amdgcn_mfma_f32_32x32x16_bf16(PAF(3),VFR(7),o[1],0,0,0), C1,12); \
    }while(0)
  int t=1;
  #undef CMASK
  #define CMASK(P0,P1,t) do{}while(0)
  for(;t+5<NT;t+=2){
    STEP(pB0,pB1,pA0,pA1,t,true,true,true);     WAIT_BAR(2); RESC(); ROT();
    STEP(pA0,pA1,pB0,pB1,t+1,true,true,true);   WAIT_BAR(2); RESC(); ROT();
  }
  #undef CMASK
  #define CMASK(P0,P1,t) do{int jb_=(t)-(NT-4); if(jb_>=0)cmask(P0,P1,jb_,qrel,hi);}while(0)
  #define ENDW(tt) do{ if((tt)+3<NT){WAIT_BAR(2);} else if((tt)+2<NT){WAIT_BAR(1);} else {WAIT_BAR(0);} }while(0)
  for(;t+1<NT;t+=2){
    STEP(pB0,pB1,pA0,pA1,t,(t+3<NT),(t+1<NT),(t+1<NT));       ENDW(t);   RESC(); ROT();
    STEP(pA0,pA1,pB0,pB1,t+1,(t+4<NT),(t+2<NT),(t+2<NT));     ENDW(t+1); RESC(); ROT();
  }
  STEP(pB0,pB1,pA0,pA1,NT-1,false,false,false); RESC();
  { float sacc=pB0[0]+pB0[1]; _Pragma("unroll") for(int r=2;r<16;++r)sacc+=pB0[r]; _Pragma("unroll") for(int r=0;r<16;++r)sacc+=pB1[r]; l_reg+=sacc;
    pw0=(u32x4){PKW(pB0,0),PKW(pB0,2),PKW(pB0,4),PKW(pB0,6)};pw1=(u32x4){PKW(pB0,8),PKW(pB0,10),PKW(pB0,12),PKW(pB0,14)};pw2=(u32x4){PKW(pB1,0),PKW(pB1,2),PKW(pB1,4),PKW(pB1,6)};pw3=(u32x4){PKW(pB1,8),PKW(pB1,10),PKW(pB1,12),PKW(pB1,14)};
    SBAR(); pv(o,vb0+sl_cur,PAF(0),PAF(1),PAF(2),PAF(3)); }
  #undef PKW
  #undef PAF
  #undef VFR
  #undef PIN
  #undef MX3
  #undef GAPA
  #undef GAPB
  #undef EX
  #undef VRD
  #undef KRD
  #undef STEP
  #undef ENDW
  {auto rr=__builtin_amdgcn_permlane32_swap(__float_as_uint(l_reg),__float_as_uint(l_reg),false,false);l_reg=__uint_as_float(rr[0])+__uint_as_float(rr[1]);}
  if(hi==0)wsf[32+r32]=l_reg;asm volatile("s_waitcnt lgkmcnt(0)":::"memory");
  float rli[16];
  #pragma unroll
  for(int r=0;r<16;++r)rli[r]=__builtin_amdgcn_rcpf(wsf[32+crow(r,hi)]);
  bf16*Ow=O+(rowbase+q0+wid*QBLK)*DM+h*D;
  { bf16*stg=(bf16*)(shm+LDS_OST)+wid*2048;
    #pragma unroll
    for(int r=0;r<16;++r){const int orow=crow(r,hi);
      #pragma unroll
      for(int d0=0;d0<2;++d0)stg[orow*64+d0*32+r32]=__float2bfloat16(o[d0][r]*rli[r]);}
    asm volatile("s_waitcnt lgkmcnt(0)":::"memory");
    #pragma unroll
    for(int i=0;i<4;++i){const int row=i*8+(lane>>3),ch=lane&7; const u32x4 v=*(const u32x4*)(stg+row*64+ch*8); ATTN_STORE16(Ow+(long)row*DM+ch*8,v);} }
  asm volatile("s_waitcnt lgkmcnt(0)\n\ts_barrier":::"memory");
  #undef DMA_K
  #undef DMA_V
  #undef CMASK
  #undef START
  #undef RESC
  #undef ROT
  #undef BIAS
}
constexpr int ATTN_LDS_BYTES=LDS_BYTES;
constexpr float SKIP_THR=64.0f;
__device__ __forceinline__ int attn_first_tile(const float*__restrict__ CL2,int bh,int qb){
  const int lane=threadIdx.x&63; const float*c=CL2+(long)bh*SEQ; const int q0=qb*QB, nfar=4*qb;
  const float cq=c[q0]; const float cj=c[(lane<nfar?lane:0)*KVBLK+KVBLK-1];
  const unsigned long long keep=__ballot(lane<nfar && (cq-cj)>=-SKIP_THR) | (1ull<<nfar);
  const int t0=__builtin_ctzll(keep)&~1;
  return __builtin_amdgcn_readfirstlane(t0);
}
struct AttnTensors { const bf16* Q; const bf16* K; const bf16* V; bf16* O; const float* CL2; };
struct AttnUnit { int bh; int qb; };
struct StaticOrder {
  int vcu;
  __device__ __forceinline__ explicit StaticOrder(int grid,int block):vcu((block%8)*(grid/8)+block/8){}
  __device__ __forceinline__ bool next(int i,AttnUnit&u)const{ if(i>=2||vcu>=BATCH*NHEAD*4)return false; const int s=vcu&3; u.bh=vcu>>2; u.qb=(i==0)?s:7-s; return true; }
  __device__ __forceinline__ void a_ready(const AttnUnit&)const{}
  __device__ __forceinline__ void done(const AttnUnit&)const{}
};
template<class Sched,int THRL=8> __device__ __forceinline__ void attn_phase(char*lds,const AttnTensors&T,const Sched&S){
  AttnUnit u;
  for(int i=0;S.next(i,u);++i){ S.a_ready(u); attn_unit<THRL>(u.bh/NHEAD,u.bh%NHEAD,u.qb,T.Q,T.K,T.V,T.O,T.CL2,lds); S.done(u); }
}
#undef SBAR
#undef WAIT_BAR
}
namespace sgu_body {
using attn_body::bf16x8; using attn_body::s16x4; using attn_body::f32x16; using attn_body::u32x4; using attn_body::lds_cptr; using attn_body::vtr;
constexpr int SGU_LDS_BYTES = 65536;
__device__ __forceinline__ float bflo(unsigned w) { return __uint_as_float(w << 16); }
__device__ __forceinline__ float bfhi(unsigned w) { return __uint_as_float(w & 0xffff0000u); }
__device__ __forceinline__ void sgu_unit(int ck, int half, const unsigned short* __restrict__ VG, const unsigned short* UGI, unsigned short* UGY, const unsigned short* __restrict__ WSMP,
                                         const float* __restrict__ lng, const float* __restrict__ lnb, const float* __restrict__ bs, char* shm) {
    int tid = threadIdx.x; asm volatile("" : "+v"(tid)); const int lane = tid & 63, r32 = lane & 31, hi = lane >> 5; const int wid = __builtin_amdgcn_readfirstlane(tid >> 6);
    const size_t row0 = (size_t)ck * 128;
    u32x4 raw[16];
#pragma unroll
    for (int i = 0; i < 16; ++i) raw[i] = *(const u32x4*)(VG + (row0 + 16 * wid + i) * 512 + 8 * lane);
    float mu[16], rs[16];
#pragma unroll
    for (int i = 0; i < 16; ++i) {
        const float a0 = bflo(raw[i].x), a1 = bfhi(raw[i].x), a2 = bflo(raw[i].y), a3 = bfhi(raw[i].y), a4 = bflo(raw[i].z), a5 = bfhi(raw[i].z), a6 = bflo(raw[i].w), a7 = bfhi(raw[i].w);
        float s = ((a0 + a1) + (a2 + a3)) + ((a4 + a5) + (a6 + a7));
        float q = ((a0 * a0 + a1 * a1) + (a2 * a2 + a3 * a3)) + ((a4 * a4 + a5 * a5) + (a6 * a6 + a7 * a7));
        s = wave_allsum(s); q = wave_allsum(q);
        const float m = s * (1.0f / 512.0f); const float var = fmaxf(q * (1.0f / 512.0f) - m * m, 0.f);
        mu[i] = m; rs[i] = 1.0f / sqrtf(var + 1e-6f);
    }
    if ((lane >> 5) == half) {
        const int gl = (lane >> 3) & 3, cc = 8 * (lane & 7);
        float gv[8], bv[8];
#pragma unroll
        for (int j = 0; j < 8; ++j) { gv[j] = lng[8 * lane + j]; bv[j] = lnb[8 * lane + j]; }
        char* img = shm + gl * 16384 + (cc >> 5) * 4096 + (cc & 31) * 2;
#pragma unroll
        for (int i = 0; i < 16; ++i) {
            const int s = 16 * wid + i;
            const float m = mu[i], r = rs[i];
            const float v0 = (bflo(raw[i].x) - m) * r * gv[0] + bv[0], v1 = (bfhi(raw[i].x) - m) * r * gv[1] + bv[1], v2 = (bflo(raw[i].y) - m) * r * gv[2] + bv[2], v3 = (bfhi(raw[i].y) - m) * r * gv[3] + bv[3];
            const float v4 = (bflo(raw[i].z) - m) * r * gv[4] + bv[4], v5 = (bfhi(raw[i].z) - m) * r * gv[5] + bv[5], v6 = (bflo(raw[i].w) - m) * r * gv[6] + bv[6], v7 = (bfhi(raw[i].w) - m) * r * gv[7] + bv[7];
            u32x4 w; w.x = pg8::cvt_pk_bf16(v0, v1); w.y = pg8::cvt_pk_bf16(v2, v3); w.z = pg8::cvt_pk_bf16(v4, v5); w.w = pg8::cvt_pk_bf16(v6, v7);
            *(u32x4*)(img + (s >> 6) * 8192 + ((s & 63) >> 4) * 1024 + (s & 15) * 64) = w;
        }
    }
    typedef unsigned u32x2_t __attribute__((ext_vector_type(2)));
    const int gl4 = wid >> 1, cb4 = wid & 1, g4 = 4 * half + gl4;
    bf16x8 wf[20]; u32x2_t ugq[4][4]; float bsq[4];
#pragma unroll
    for (int tb = 0; tb < 4; ++tb) {
        const unsigned short* wrow = WSMP + ((size_t)(g4 * 128 + 32 * tb + r32)) * 128 + 8 * hi;
#pragma unroll
        for (int ks = 0; ks < 2 * (tb + 1); ++ks) wf[tb * (tb + 1) + ks] = *(const bf16x8*)(wrow + 16 * ks);
        const int t = 32 * tb + r32; bsq[tb] = bs[g4 * 128 + t];
        const unsigned short* urow = UGI + (row0 + t) * 512 + g4 * 64 + 32 * cb4 + 4 * hi;
#pragma unroll
        for (int q4 = 0; q4 < 4; ++q4) ugq[tb][q4] = *(const u32x2_t*)(urow + 8 * q4);
    }
    __syncthreads();
    {
        const int gl = gl4, cb = cb4, g = g4;
        const lds_cptr vp = (lds_cptr)shm + gl * 16384 + cb * 4096 + ((lane >> 4) & 1) * 32 + (lane & 3) * 8 + (4 * hi + ((lane & 15) >> 2)) * 64;
#pragma unroll
        for (int tb = 0; tb < 4; ++tb) {
            f32x16 acc = f32x16{};
#pragma unroll
            for (int ks = 0; ks < 2 * (tb + 1); ++ks) {
                const s16x4 lo = vtr(vp + (ks >> 2) * 8192 + (ks & 3) * 1024), hh = vtr(vp + (ks >> 2) * 8192 + (ks & 3) * 1024 + 512);
                const bf16x8 a = (bf16x8){lo[0], lo[1], lo[2], lo[3], hh[0], hh[1], hh[2], hh[3]};
                acc = __builtin_amdgcn_mfma_f32_32x32x16_bf16(a, wf[tb * (tb + 1) + ks], acc, 0, 0, 0);
            }
            const int t = 32 * tb + r32; const float bsv = bsq[tb];
            unsigned short* yrow = UGY + (row0 + t) * 512 + g * 64 + 32 * cb + 4 * hi;
#pragma unroll
            for (int q4 = 0; q4 < 4; ++q4) {
                const u32x2_t ug = ugq[tb][q4];
                const float y0 = bflo(ug.x) * (acc[4 * q4 + 0] + bsv), y1 = bfhi(ug.x) * (acc[4 * q4 + 1] + bsv), y2 = bflo(ug.y) * (acc[4 * q4 + 2] + bsv), y3 = bfhi(ug.y) * (acc[4 * q4 + 3] + bsv);
                u32x2_t w; w.x = pg8::cvt_pk_bf16(y0, y1); w.y = pg8::cvt_pk_bf16(y2, y3);
                *(u32x2_t*)(yrow + 8 * q4) = w;
            }
        }
    }
    __syncthreads();
}
}
namespace peer_body {
using attn_body::bf16x8; using attn_body::f32x16; using attn_body::u32x4;
typedef __bf16 bf16x2_t __attribute__((ext_vector_type(2)));
constexpr int PEER_TOK = 64;
constexpr int L_PI = 0, L_PG = 32768, L_PS = 65536, PEER_LDS_BYTES = 98304;
__device__ __forceinline__ int okey(int b) { return b ^ ((b >> 31) & 0x7fffffff); }
__device__ __forceinline__ void ce(int& a, int& b) { const int hi = a > b ? a : b, lo = a > b ? b : a; a = hi; b = lo; }
__device__ __forceinline__ void sort16(int (&v)[16]) {
#pragma unroll
    for (int k = 2; k <= 16; k <<= 1)
#pragma unroll
        for (int j = k >> 1; j > 0; j >>= 1)
#pragma unroll
            for (int i = 0; i < 16; ++i) { const int l = i ^ j; if (l > i) { if ((i & k) == 0) ce(v[i], v[l]); else ce(v[l], v[i]); } }
}
__device__ __forceinline__ void merge16(int (&a)[16], const int (&b)[16]) {
#pragma unroll
    for (int i = 0; i < 16; ++i) a[i] = a[i] > b[15 - i] ? a[i] : b[15 - i];
#pragma unroll
    for (int j = 8; j > 0; j >>= 1)
#pragma unroll
        for (int i = 0; i < 16; ++i) { const int l = i ^ j; if (l > i) ce(a[i], a[l]); }
}
__device__ __forceinline__ float dot2(unsigned w, unsigned x, float acc) { return __builtin_amdgcn_fdot2_f32_bf16(__builtin_bit_cast(bf16x2_t, w), __builtin_bit_cast(bf16x2_t, x), acc, false); }
__device__ __forceinline__ float gelu_erf(float v) { return 0.5f * v * (1.0f + erff(v * 0.70710678118654752f)); }

constexpr int SK_PITCH = 272;
__device__ __forceinline__ void top16_scores(int (&res)[16], const bf16x8 (&bq)[8], const char* SKl, int r32, int hi) {
    f32x16 acc[4];
#pragma unroll
    for (int nb = 0; nb < 4; ++nb) acc[nb] = f32x16{};
#pragma unroll
    for (int ks = 0; ks < 8; ++ks) {
#pragma unroll
        for (int nb = 0; nb < 4; ++nb) { const bf16x8 a = *(const bf16x8*)(SKl + (32 * nb + r32) * SK_PITCH + (16 * ks + 8 * hi) * 2);
            acc[nb] = __builtin_amdgcn_mfma_f32_32x32x16_bf16(a, bq[ks], acc[nb], 0, 0, 0); }
        if (ks & 1) __builtin_amdgcn_sched_barrier(0);
    }
    int k[4][16];
#pragma unroll
    for (int nb = 0; nb < 4; ++nb) {
#pragma unroll
        for (int r = 0; r < 16; ++r) { const int n = 32 * nb + (r & 3) + 8 * (r >> 2) + 4 * hi; k[nb][r] = okey((int)((__float_as_uint(acc[nb][r]) & ~0x7fu) | (unsigned)n)); }
        sort16(k[nb]);
    }
    merge16(k[0], k[1]); merge16(k[2], k[3]); merge16(k[0], k[2]);
    int lo[16], up[16];
#pragma unroll
    for (int i = 0; i < 16; ++i) { const auto rr = __builtin_amdgcn_permlane32_swap((unsigned)k[0][i], (unsigned)k[0][i], false, false); lo[i] = (int)rr[0]; up[i] = (int)rr[1]; }
    merge16(lo, up);
#pragma unroll
    for (int i = 0; i < 16; ++i) res[i] = lo[i];
}

__device__ __forceinline__ unsigned pack_i8x4(float a, float b, float c, float d) {
    const int ia = (int)__builtin_rintf(a), ib = (int)__builtin_rintf(b), ic = (int)__builtin_rintf(c), id = (int)__builtin_rintf(d);
    return (unsigned)(ia & 0xff) | ((unsigned)(ib & 0xff) << 8) | ((unsigned)(ic & 0xff) << 16) | ((unsigned)(id & 0xff) << 24);
}
typedef float f32x2_t __attribute__((ext_vector_type(2)));
typedef unsigned u32x2_t __attribute__((ext_vector_type(2)));
__device__ __forceinline__ void fma_fp8x4(f32x2_t& a01, f32x2_t& a23, unsigned v, f32x2_t w2) {
    const f32x2_t lo = __builtin_amdgcn_cvt_pk_f32_fp8((int)v, false), hi = __builtin_amdgcn_cvt_pk_f32_fp8((int)v, true);
    a01 = __builtin_elementwise_fma(lo, w2, a01); a23 = __builtin_elementwise_fma(hi, w2, a23);
}
template <int CTRL> __device__ __forceinline__ int dppi(int v) { return __builtin_amdgcn_update_dpp(0, v, CTRL, 0xf, 0xf, false); }
template <int CTRL> __device__ __forceinline__ float dppf(float v) { return __int_as_float(__builtin_amdgcn_update_dpp(0, __float_as_int(v), CTRL, 0xf, 0xf, false)); }
constexpr int DPP_HMIRROR = 0x141, DPP_XOR2 = 0x4E, DPP_XOR1 = 0xB1, DPP_ROR8 = 0x128;

__device__ __forceinline__ void peer_retrieve(int tk, const unsigned short* __restrict__ QP, const unsigned short* __restrict__ SK, const float* __restrict__ SU, const float* __restrict__ SV,
                                              const float* __restrict__ ST, unsigned short* __restrict__ PID, float* __restrict__ G2, float* __restrict__ PS2, char* shm) {
    int tid = threadIdx.x; asm volatile("" : "+v"(tid)); const int lane = tid & 63, r32 = lane & 31, hi = lane >> 5; const int wid = __builtin_amdgcn_readfirstlane(tid >> 6);
    const int h = tk & 7, T0 = (tk >> 3) * 512 + 64 * wid;
    {   const u32x4* src = (const u32x4*)(SK + (size_t)h * 2 * 128 * 128);
#pragma unroll
        for (int i = 0; i < 8; ++i) { const int c = tid + 512 * i, row = c >> 4, ch = c & 15; *(u32x4*)(shm + row * SK_PITCH + ch * 16) = src[c]; }
    }
    __syncthreads();
#pragma unroll 1
    for (int tb = 0; tb < 2; ++tb) {
        const unsigned short* QPt = QP + (size_t)(T0 + 32 * tb) * 2048 + h * 256;
        int A[16], B[16];
        bf16x8 bqa[8], bqb[8];
#pragma unroll
        for (int ks = 0; ks < 8; ++ks) { bqa[ks] = *(const bf16x8*)(QPt + (size_t)r32 * 2048 + 16 * ks + 8 * hi); bqb[ks] = *(const bf16x8*)(QPt + 128 + (size_t)r32 * 2048 + 16 * ks + 8 * hi); }
        top16_scores(A, bqa, shm, r32, hi);
        top16_scores(B, bqb, shm + 128 * SK_PITCH, r32, hi);
        float fa[16], fb[16]; int na[16], nb[16];
#pragma unroll
        for (int i = 0; i < 16; ++i) { const int ba = okey(A[i]), bb = okey(B[i]); fa[i] = __int_as_float(ba); fb[i] = __int_as_float(bb); na[i] = (ba & 0x7f) << 7; nb[i] = bb & 0x7f; }
#define CAND(i, j) okey((int)((__float_as_uint(fa[i] + fb[j]) & ~0x3fffu) | (unsigned)(na[i] | nb[j])))
        const int NEGK = (int)0x80000000;
        int L0[16], L1[16], L2[16], L3[16];
#pragma unroll
        for (int j = 0; j < 16; ++j) L0[j] = CAND(0, j);
#pragma unroll
        for (int j = 0; j < 8; ++j) L1[j] = CAND(1, j);
#pragma unroll
        for (int j = 0; j < 5; ++j) L1[8 + j] = CAND(2, j);
#pragma unroll
        for (int j = 0; j < 3; ++j) L1[13 + j] = CAND(3, j);
        L2[0] = CAND(3, 3);
#pragma unroll
        for (int j = 0; j < 3; ++j) L2[1 + j] = CAND(4, j);
#pragma unroll
        for (int j = 0; j < 2; ++j) { L2[4 + j] = CAND(5, j); L2[6 + j] = CAND(6, j); L2[8 + j] = CAND(7, j); }
#pragma unroll
        for (int i = 8; i < 14; ++i) L2[2 + i] = CAND(i, 0);
        L3[0] = CAND(14, 0); L3[1] = CAND(15, 0);
#pragma unroll
        for (int i = 2; i < 16; ++i) L3[i] = NEGK;
#undef CAND
        sort16(L1); sort16(L2); sort16(L3);
        merge16(L0, L1); merge16(L2, L3); merge16(L0, L2);
        float e[16]; int id[16]; float se = 0.f;
        const float s0 = __int_as_float((okey(L0[0]) & ~0x3fff) | 0x2000);
#pragma unroll
        for (int i = 0; i < 16; ++i) { const int b = okey(L0[i]); id[i] = b & 0x3fff; const float s = __int_as_float((b & ~0x3fff) | 0x2000); e[i] = __expf(s - s0); se += e[i]; }
        const float inv = 1.0f / se;
        if (hi == 0) {
            const size_t t = (size_t)(T0 + 32 * tb + r32); const float st = ST[t];
            unsigned short* pi = PID + t * 128 + h * 16; float* pg = G2 + t * 128 + h * 16; float* ps = PS2 + t * 128 + h * 16;
            u32x4 w0, w1;
            w0.x = (unsigned)id[0] | ((unsigned)id[1] << 16); w0.y = (unsigned)id[2] | ((unsigned)id[3] << 16); w0.z = (unsigned)id[4] | ((unsigned)id[5] << 16); w0.w = (unsigned)id[6] | ((unsigned)id[7] << 16);
            w1.x = (unsigned)id[8] | ((unsigned)id[9] << 16); w1.y = (unsigned)id[10] | ((unsigned)id[11] << 16); w1.z = (unsigned)id[12] | ((unsigned)id[13] << 16); w1.w = (unsigned)id[14] | ((unsigned)id[15] << 16);
            *(u32x4*)pi = w0; *(u32x4*)(pi + 8) = w1;
            float sv[16], su[16];
#pragma unroll
            for (int i = 0; i < 16; ++i) { sv[i] = SV[id[i]]; su[i] = SU[id[i]]; }
            asm volatile("" ::: "memory");
#pragma unroll
            for (int i = 0; i < 16; i += 4) {
                *(float4*)(pg + i) = make_float4(e[i] * inv * sv[i], e[i + 1] * inv * sv[i + 1], e[i + 2] * inv * sv[i + 2], e[i + 3] * inv * sv[i + 3]);
                *(float4*)(ps + i) = make_float4(su[i] * st, su[i + 1] * st, su[i + 2] * st, su[i + 3] * st); }
        }
    }
    __syncthreads();
}

constexpr int WL_STRIDE = 19712, WL_Y = 3328, PEER_FUSED_LDS = 8 * WL_STRIDE;
__device__ __forceinline__ void peer_fused(int p, int wq, int nwq, const unsigned short* __restrict__ PID, const float* __restrict__ G2, const float* __restrict__ PS2, const unsigned char* __restrict__ H2Q,
                                           const unsigned char* __restrict__ EU8, const unsigned char* __restrict__ EV8, float* X, const float* __restrict__ gfin, char* shm, float oscale) {
    int tid = threadIdx.x; asm volatile("" : "+v"(tid)); const int lane = tid & 63, g = lane >> 3, r = lane & 7; const int wid = __builtin_amdgcn_readfirstlane(tid >> 6);
    char* wl = shm + wid * WL_STRIDE;
    int2* aul = (int2*)(wl + WL_Y) + lane; unsigned* yl = (unsigned*)(wl + WL_Y) + lane; float* swl = (float*)(wl + 3072);
    const int k0 = 8 * (r >> 2) + 4 * ((r >> 1) & 1) + 2 * (r & 1);
    const int e0 = 8 * ((g >> 2) & 1) + 4 * ((g >> 1) & 1) + 2 * (g & 1);
    constexpr size_t SLICE = (size_t)16384 * 128;
#define FIDS(i, I0, I1) do { const u32x4* ip_ = (const u32x4*)(wl + (i) * 256 + 32 * g); I0 = ip_[0]; I1 = ip_[1]; } while (0)
#define FLOAD(R, base, I0, I1) do { _Pragma("unroll") for (int k_ = 0; k_ < 16; ++k_) { const unsigned w_ = (k_ < 8) ? I0[k_ >> 1] : I1[(k_ - 8) >> 1]; const unsigned e_ = (k_ & 1) ? (w_ >> 16) : (w_ & 0xffffu); \
        R[k_] = *(const u32x4*)((base) + (size_t)e_ * 128); } } while (0)
#define FUMATH(R, HQ, ACC) do { int s[16]; \
        _Pragma("unroll") for (int k_ = 0; k_ < 16; ++k_) { int d_ = __builtin_amdgcn_sdot4((int)R[k_].x, (int)HQ.x, 0, false); d_ = __builtin_amdgcn_sdot4((int)R[k_].y, (int)HQ.y, d_, false); \
            d_ = __builtin_amdgcn_sdot4((int)R[k_].z, (int)HQ.z, d_, false); d_ = __builtin_amdgcn_sdot4((int)R[k_].w, (int)HQ.w, d_, false); s[k_] = d_; } \
        _Pragma("unroll") for (int h_ = 0; h_ < 8; ++h_) { const int t1 = s[h_] + dppi<DPP_HMIRROR>(s[h_]), t2 = s[h_ + 8] + dppi<DPP_HMIRROR>(s[h_ + 8]); s[h_] = (r & 4) ? t2 : t1; } \
        _Pragma("unroll") for (int h_ = 0; h_ < 4; ++h_) { const int t1 = s[h_] + dppi<DPP_XOR2>(s[h_]), t2 = s[h_ + 4] + dppi<DPP_XOR2>(s[h_ + 4]); s[h_] = (r & 2) ? t2 : t1; } \
        _Pragma("unroll") for (int h_ = 0; h_ < 2; ++h_) { const int t1 = s[h_] + dppi<DPP_XOR1>(s[h_]), t2 = s[h_ + 2] + dppi<DPP_XOR1>(s[h_ + 2]); s[h_] = (r & 1) ? t2 : t1; } \
        { const int2 o_ = ACC; ACC = make_int2(o_.x + s[0], o_.y + s[1]); } } while (0)
#define FVMATH(R, W, XV, SWV, YP) do { int acc[16]; _Pragma("unroll") for (int i_ = 0; i_ < 16; ++i_) acc[i_] = 0; \
        _Pragma("unroll") for (int m_ = 0; m_ < 4; ++m_) { const int wm_ = (int)W[m_]; \
            _Pragma("unroll") for (int c_ = 0; c_ < 4; ++c_) { \
                const unsigned r0_ = R[4 * m_ + 0][c_], r1_ = R[4 * m_ + 1][c_], r2_ = R[4 * m_ + 2][c_], r3_ = R[4 * m_ + 3][c_]; \
                const unsigned t0_ = __builtin_amdgcn_perm(r1_, r0_, 0x05010400u), t1_ = __builtin_amdgcn_perm(r1_, r0_, 0x07030602u); \
                const unsigned t2_ = __builtin_amdgcn_perm(r3_, r2_, 0x05010400u), t3_ = __builtin_amdgcn_perm(r3_, r2_, 0x07030602u); \
                acc[4 * c_ + 0] = __builtin_amdgcn_sdot4((int)__builtin_amdgcn_perm(t2_, t0_, 0x05040100u), wm_, acc[4 * c_ + 0], false); \
                acc[4 * c_ + 1] = __builtin_amdgcn_sdot4((int)__builtin_amdgcn_perm(t2_, t0_, 0x07060302u), wm_, acc[4 * c_ + 1], false); \
                acc[4 * c_ + 2] = __builtin_amdgcn_sdot4((int)__builtin_amdgcn_perm(t3_, t1_, 0x05040100u), wm_, acc[4 * c_ + 2], false); \
                acc[4 * c_ + 3] = __builtin_amdgcn_sdot4((int)__builtin_amdgcn_perm(t3_, t1_, 0x07060302u), wm_, acc[4 * c_ + 3], false); } } \
          \
        _Pragma("unroll") for (int h_ = 0; h_ < 8; ++h_) { const auto sw_ = __builtin_amdgcn_permlane32_swap((unsigned)acc[h_], (unsigned)acc[h_ + 8], false, false); acc[h_] = (int)sw_[0] + (int)sw_[1]; } \
        _Pragma("unroll") for (int h_ = 0; h_ < 4; ++h_) { const auto sw_ = __builtin_amdgcn_permlane16_swap((unsigned)acc[h_], (unsigned)acc[h_ + 4], false, false); acc[h_] = (int)sw_[0] + (int)sw_[1]; } \
        _Pragma("unroll") for (int h_ = 0; h_ < 2; ++h_) { const int t1 = acc[h_] + dppi<DPP_ROR8>(acc[h_]), t2 = acc[h_ + 2] + dppi<DPP_ROR8>(acc[h_ + 2]); acc[h_] = (lane & 8) ? t2 : t1; } \
        const float2 xv = XV; *(YP) = pg8::cvt_pk_bf16(xv.x + SWV * (float)acc[0], xv.y + SWV * (float)acc[1]); } while (0)
    const int TEND = (p + 1) * (M / 8);
#pragma unroll 1
    for (int tb = p * (M / 8) + wq; tb < TEND; tb += 8 * nwq) {
#define TOK(i) ((tb + (i) * nwq) < TEND ? (tb + (i) * nwq) : tb)
#pragma unroll
        for (int i = 0; i < 8; ++i) ((unsigned*)(wl + i * 256))[lane] = ((const unsigned*)(PID + (size_t)TOK(i) * 128))[lane];
#pragma unroll
        for (int i = 0; i < 8; ++i) aul[64 * i] = make_int2(0, 0);
        {
            u32x4 RA[16], RB[16], i0, i1, hqa, hqb;
            { const int sl = p & 7; FIDS(0, i0, i1); hqa = *(const u32x4*)(H2Q + ((size_t)sl * M + TOK(0)) * 128 + r * 16); FLOAD(RA, EU8 + sl * SLICE + r * 16, i0, i1); }
#pragma unroll 1
            for (int st = 0; st < 8; ++st) {
                const int sl = (p + st) & 7, sln = (p + st + 1) & 7; const unsigned char* ub = EU8 + sl * SLICE + r * 16; const unsigned char* hb = H2Q + (size_t)sl * M * 128 + r * 16;
#pragma unroll 1
                for (int i = 0; i < 8; i += 2) {
                    FIDS(i + 1, i0, i1); hqb = *(const u32x4*)(hb + (size_t)TOK(i + 1) * 128); FLOAD(RB, ub, i0, i1);
                    FUMATH(RA, hqa, aul[64 * i]);
                    {
                        const bool last = (i == 6); const int in_ = last ? 0 : i + 2; const int sx = last ? sln : sl;
                        FIDS(in_, i0, i1); hqa = *(const u32x4*)(H2Q + ((size_t)sx * M + TOK(in_)) * 128 + r * 16); FLOAD(RA, EU8 + sx * SLICE + r * 16, i0, i1); }
                    FUMATH(RB, hqb, aul[64 * (i + 1)]);
                }
            }
        }
        float2 g2q[8], psq[8];
#pragma unroll
        for (int i = 0; i < 8; ++i) { const size_t o = (size_t)TOK(i) * 128 + 16 * g + k0; g2q[i] = *(const float2*)(G2 + o); psq[i] = *(const float2*)(PS2 + o); }
#pragma unroll
        for (int i = 0; i < 8; ++i) {
            const float2 g2 = g2q[i], ps = psq[i]; const int2 av = aul[64 * i];
            const float w0 = g2.x * gelu_erf((float)av.x * ps.x), w1 = g2.y * gelu_erf((float)av.y * ps.y);
            float am = fmaxf(fabsf(w0), fabsf(w1));
            am = wave_allmax(am);
            const float qs = am > 0.f ? 127.0f / am : 0.f; if (lane == 0) swl[i] = am * (1.0f / 127.0f);
            const int b0 = (int)__builtin_rintf(w0 * qs) & 0xff, b1 = (int)__builtin_rintf(w1 * qs) & 0xff;
            *(unsigned short*)(wl + 2048 + i * 128 + 16 * g + k0) = (unsigned short)(b0 | (b1 << 8));
        }
        {
            u32x4 RA[16], RB[16], i0, i1; float2 xva, xvb;
            { const int sl = p & 7; FIDS(0, i0, i1); xva = *(const float2*)(X + (size_t)TOK(0) * 1024 + sl * 128 + 16 * r + e0); FLOAD(RA, EV8 + sl * SLICE + r * 16, i0, i1); }
#pragma unroll 1
            for (int st = 0; st < 8; ++st) {
                const int sl = (p + st) & 7, sln = (p + st + 1) & 7; const unsigned char* vb = EV8 + sl * SLICE + r * 16; const float* xb = X + sl * 128 + 16 * r + e0; unsigned* yb = yl + sl * 64;
#pragma unroll 1
                for (int i = 0; i < 8; i += 2) {
                    FIDS(i + 1, i0, i1); xvb = *(const float2*)(xb + (size_t)TOK(i + 1) * 1024); FLOAD(RB, vb, i0, i1);
                    { const u32x4 wv = *(const u32x4*)(wl + 2048 + i * 128 + 16 * g); const float sw_ = swl[i]; FVMATH(RA, wv, xva, sw_, yb + i * 512); }
                    { const bool last = (i == 6); const int in_ = last ? 0 : i + 2; const int sx = last ? sln : sl; FIDS(in_, i0, i1); xva = *(const float2*)(X + (size_t)TOK(in_) * 1024 + sx * 128 + 16 * r + e0); FLOAD(RA, EV8 + sx * SLICE + r * 16, i0, i1); }
                    { const u32x4 wv = *(const u32x4*)(wl + 2048 + (i + 1) * 128 + 16 * g); const float sw_ = swl[i + 1]; FVMATH(RB, wv, xvb, sw_, yb + (i + 1) * 512); }
                }
            }
        }
        float2 gg[8];
#pragma unroll
        for (int sl = 0; sl < 8; ++sl) gg[sl] = *(const float2*)(gfin + sl * 128 + 16 * r + e0);
#pragma unroll 1
        for (int i = 0; i < 8; i += 2) {
            unsigned ya[8], yb[8]; float sa = 0.f, sb = 0.f;
#pragma unroll
            for (int sl = 0; sl < 8; ++sl) { ya[sl] = yl[(i * 8 + sl) * 64]; yb[sl] = yl[((i + 1) * 8 + sl) * 64]; }
#pragma unroll
            for (int sl = 0; sl < 8; ++sl) { const float a0 = __uint_as_float(ya[sl] << 16), a1 = __uint_as_float(ya[sl] & 0xffff0000u), b0 = __uint_as_float(yb[sl] << 16), b1 = __uint_as_float(yb[sl] & 0xffff0000u);
                sa += a0 * a0 + a1 * a1; sb += b0 * b0 + b1 * b1; }
            const float rr0 = oscale / sqrtf(wave_allsum(sa) * (1.0f / 1024.0f) + 1e-6f), rr1 = oscale / sqrtf(wave_allsum(sb) * (1.0f / 1024.0f) + 1e-6f);
            const bool v0 = (tb + i * nwq) < TEND, v1 = (tb + (i + 1) * nwq) < TEND;
            float* xr0 = X + (size_t)TOK(i) * 1024 + 16 * r + e0; float* xr1 = X + (size_t)TOK(i + 1) * 1024 + 16 * r + e0;
#pragma unroll
            for (int sl = 0; sl < 8; ++sl) {
                if (v0) *(float2*)(xr0 + sl * 128) = make_float2(__uint_as_float(ya[sl] << 16) * rr0 * gg[sl].x, __uint_as_float(ya[sl] & 0xffff0000u) * rr0 * gg[sl].y);
                if (v1) *(float2*)(xr1 + sl * 128) = make_float2(__uint_as_float(yb[sl] << 16) * rr1 * gg[sl].x, __uint_as_float(yb[sl] & 0xffff0000u) * rr1 * gg[sl].y); }
        }
#undef TOK
    }
#undef FIDS
#undef FLOAD
#undef FUMATH
#undef FVMATH
}
}
#define GAS __attribute__((address_space(1)))
#define LAS __attribute__((address_space(3)))
typedef unsigned short bf16;
typedef unsigned v4u __attribute__((ext_vector_type(4)));
typedef float f32x4 __attribute__((ext_vector_type(4)));
typedef short bf16x8 __attribute__((ext_vector_type(8)));
typedef GAS unsigned gu32;
typedef GAS unsigned long long gu64;
#define RLX_AGENT __ATOMIC_RELAXED, __HIP_MEMORY_SCOPE_AGENT
#define LDS_WAIT() asm volatile("s_waitcnt lgkmcnt(0)" ::: "memory")
#define VM_WAIT() asm volatile("s_waitcnt vmcnt(0)" ::: "memory")
__device__ __forceinline__ unsigned long long rt() { return __builtin_amdgcn_s_memrealtime(); }
__device__ __forceinline__ unsigned f2bf(float f) { unsigned u = __builtin_bit_cast(unsigned, f); return (u + 0x7fffu + ((u >> 16) & 1u)) >> 16; }
__device__ __forceinline__ unsigned pk2(float lo, float hi) { return f2bf(lo) | (f2bf(hi) << 16); }

#define XB_TMO      128
#define XB_XCNT(j)  (256  + 64 * (j))
#define XB_XSUB(j)  (1280 + 64 * (j))
#define XB_XGEN(j)  (2304 + 64 * (j))
#define XB_TOP      3328
#define XB_TOPGEN   3392
#define XCD_BAR_WORDS 3456
#define XB_SPIN_CAP (1u << 18)

__device__ __forceinline__ unsigned xb_ld(unsigned* p)              { return __hip_atomic_load(p, __ATOMIC_RELAXED, __HIP_MEMORY_SCOPE_AGENT); }
__device__ __forceinline__ unsigned xb_add(unsigned* p, unsigned v) { return __hip_atomic_fetch_add(p, v, __ATOMIC_RELAXED, __HIP_MEMORY_SCOPE_AGENT); }
__device__ __forceinline__ unsigned xb_xcc_id() { return (unsigned)__builtin_amdgcn_s_getreg((3 << 11) | 20) & 0xFu; }
#define XB_SPIN(cond, bar) do { unsigned _sp = 0; while (cond) { __builtin_amdgcn_s_sleep(1); \
    if ((++_sp & 255u) == 0u) { if (xb_ld(&(bar)[XB_TMO])) break; if (_sp > XB_SPIN_CAP) { atomicAdd(&(bar)[XB_TMO], 1u); break; } } } } while (0)

struct XcdBarrier {
    unsigned* bar; unsigned x;
    volatile LAS unsigned* st;
};

__device__ __forceinline__ XcdBarrier xcd_barrier_post(unsigned* bar, volatile LAS unsigned* st) {
    XcdBarrier b; b.bar = bar; b.x = xb_xcc_id(); b.st = st;
    if (threadIdx.x == 0) (void)xb_add(&bar[XB_XCNT(b.x)], 1u);
    return b;
}
__device__ __forceinline__ void xcd_barrier_complete(unsigned* bar, unsigned x, unsigned& nloc, unsigned& nx) {
    const unsigned G = gridDim.x * gridDim.y * gridDim.z;
    unsigned sum, cnt, mine, sp = 0u;
    for (;;) {
        sum = 0u; cnt = 0u; mine = 0u;
#pragma unroll
        for (unsigned j = 0; j < 16; ++j) { const unsigned c = xb_ld(&bar[XB_XCNT(j)]); sum += c; cnt += (c > 0u) ? 1u : 0u; mine = (j == x) ? c : mine; }
        if (sum == G) break;
        __builtin_amdgcn_s_sleep(1);
        if ((++sp & 255u) == 0u) { if (xb_ld(&bar[XB_TMO])) break; if (sp > XB_SPIN_CAP) { atomicAdd(&bar[XB_TMO], 1u); break; } }
    }
    nloc = mine > 0u ? mine : 1u; nx = cnt > 0u ? cnt : 1u;
}

__device__ __forceinline__ void xcd_barrier(const XcdBarrier& b) {
    asm volatile("s_waitcnt vmcnt(0)" ::: "memory");
    __syncthreads();
    if (threadIdx.x == 0) {
        unsigned* bar = b.bar;
        __builtin_amdgcn_s_waitcnt(0);
        unsigned nloc = b.st[0], nx = b.st[1];
        if (nloc == 0u) { xcd_barrier_complete(bar, b.x, nloc, nx); b.st[0] = nloc; b.st[1] = nx; }
        const unsigned old = xb_add(&bar[XB_XSUB(b.x)], 1u);
        const unsigned gen = old / nloc;
        if (old + 1u == (gen + 1u) * nloc) {
            __builtin_amdgcn_fence(__ATOMIC_RELEASE, "agent");
            asm volatile("s_waitcnt vmcnt(0)" ::: "memory");
            const unsigned og = xb_add(&bar[XB_TOP], 1u);
            const unsigned tg = og / nx;
            if (og + 1u == (tg + 1u) * nx) xb_add(&bar[XB_TOPGEN], 1u);
            else XB_SPIN(xb_ld(&bar[XB_TOPGEN]) == tg, bar);
            __builtin_amdgcn_fence(__ATOMIC_ACQUIRE, "agent");
            xb_add(&bar[XB_XGEN(b.x)], 1u);
            asm volatile("s_waitcnt vmcnt(0)" ::: "memory");
        } else {
            XB_SPIN(xb_ld(&bar[XB_XGEN(b.x)]) == gen, bar);
            __builtin_amdgcn_fence(__ATOMIC_ACQUIRE, "agent");
            asm volatile("s_waitcnt vmcnt(0)" ::: "memory");
        }
    }
    __syncthreads();
}

typedef unsigned short bf16_t;
__device__ __forceinline__ float bf2f(bf16_t v) { return __uint_as_float((unsigned)v << 16); }
__device__ __forceinline__ float gelu_exact(float v) { return 0.5f * v * (1.0f + erff(v * 0.70710678118654752f)); }
__device__ __forceinline__ float log_sigmoid(float z) { return z > 0.f ? -log1pf(expf(-z)) : z - log1pf(expf(z)); }
__device__ __forceinline__ float wave_sum(float v) {
    return wave_allsum(v);
}
__device__ __forceinline__ float wave_max(float v) {
    return wave_allmax(v);
}

#ifndef RP7
#define RP7 1
#endif
#ifndef RP8
#define RP8 1
#endif
#ifndef RP9
#define RP9 1
#endif
#ifndef RP0
#define RP0 1
#endif
#ifndef RP1
#define RP1 1
#endif
#ifndef RP12
#define RP12 1
#endif
#ifndef RP3
#define RP3 1
#endif
#ifndef RP4
#define RP4 1
#endif
#ifndef RP5
#define RP5 1
#endif
#ifndef RP6
#define RP6 1
#endif
#ifndef QORDER
#define QORDER 1
#endif
#ifndef CONV_P0_FROM
#define CONV_P0_FROM (2 * NEXP)
#endif
#ifndef CONV_SPLIT
#define CONV_SPLIT (NEXP / 2)
#endif
constexpr int NWAVES = 8;
constexpr int RING_OFF = 0, RING_BYTES = 157696;
constexpr int LDSCTL_OFF = RING_BYTES, MISC_OFF = LDSCTL_OFF + 320;
constexpr int LDS_BYTES = 158720;
constexpr int CW_BAR = 4096, CW_QUEUE = 3072, CW_CMAX = 8192, CMAX_WQ = 4864;
constexpr int N_PHASES = 9;

struct Args { const float* in[17]; float* out; unsigned char* ws; int ph_lo, ph_hi, li, pad; };

__device__ __forceinline__ void p0_transpose_item(const float* W, int ldw, int col0, int K, bf16* WT, int row0, LAS float* scr, int item, int nblk, int lane) {
    const int kb = item / nblk, nb = item % nblk, k0 = 64 * kb, n0 = 32 * nb;
    f32x4 v[8];
#pragma unroll
    for (int i = 0; i < 8; ++i) v[i] = *(const GAS f32x4*)(W + (size_t)(k0 + 8 * i + (lane >> 3)) * ldw + col0 + n0 + 4 * (lane & 7));
#pragma unroll
    for (int i = 0; i < 8; ++i) *(LAS f32x4*)(scr + (8 * i + (lane >> 3)) * 36 + 4 * (lane & 7)) = v[i];
    LDS_WAIT(); asm volatile("" ::: "memory");
    const int c = lane & 7;
#pragma unroll
    for (int j = 0; j < 4; ++j) { const int n = (lane >> 3) + 8 * j; const LAS float* s = scr + (8 * c) * 36 + n;
        v4u o; o.x = pg8::cvt_pk_bf16(s[0 * 36], s[1 * 36]); o.y = pg8::cvt_pk_bf16(s[2 * 36], s[3 * 36]); o.z = pg8::cvt_pk_bf16(s[4 * 36], s[5 * 36]); o.w = pg8::cvt_pk_bf16(s[6 * 36], s[7 * 36]);
        *(GAS v4u*)(WT + (size_t)(row0 + n0 + n) * K + k0 + 8 * c) = o; }
    LDS_WAIT(); asm volatile("" ::: "memory");
}
__device__ __forceinline__ void p0_transpose_item_i8(const float* W, int ldw, int col0, int K, unsigned char* WT8, float* sB, int row0, const unsigned* colmax, LAS float* scr, int item, int nblk, int lane) {
    const int kb = item / nblk, nb = item % nblk, k0 = 64 * kb, n0 = 32 * nb;
    f32x4 v[8];
#pragma unroll
    for (int i = 0; i < 8; ++i) v[i] = *(const GAS f32x4*)(W + (size_t)(k0 + 8 * i + (lane >> 3)) * ldw + col0 + n0 + 4 * (lane & 7));
#pragma unroll
    for (int i = 0; i < 8; ++i) *(LAS f32x4*)(scr + (8 * i + (lane >> 3)) * 36 + 4 * (lane & 7)) = v[i];
    LDS_WAIT(); asm volatile("" ::: "memory");
    const int c = lane & 3;
#pragma unroll
    for (int j = 0; j < 2; ++j) { const int n = (lane >> 2) + 16 * j; const LAS float* s = scr + (16 * c) * 36 + n;
        const float am = __uint_as_float(colmax[col0 + n0 + n]); const float qs = am > 0.f ? 127.0f / am : 0.f;
        v4u o;
        o.x = peer_body::pack_i8x4(s[0 * 36] * qs, s[1 * 36] * qs, s[2 * 36] * qs, s[3 * 36] * qs); o.y = peer_body::pack_i8x4(s[4 * 36] * qs, s[5 * 36] * qs, s[6 * 36] * qs, s[7 * 36] * qs);
        o.z = peer_body::pack_i8x4(s[8 * 36] * qs, s[9 * 36] * qs, s[10 * 36] * qs, s[11 * 36] * qs); o.w = peer_body::pack_i8x4(s[12 * 36] * qs, s[13 * 36] * qs, s[14 * 36] * qs, s[15 * 36] * qs);
        *(GAS v4u*)(WT8 + (size_t)(row0 + n0 + n) * K + k0 + 16 * c) = o;
        if (kb == 0 && c == 0) sB[row0 + n0 + n] = am * (1.0f / 127.0f); }
    LDS_WAIT(); asm volatile("" ::: "memory");
}
__device__ __forceinline__ void p0_colmax_task(const float* W, int ldw, int ncols, unsigned* colmax, int task, int lane) {
    const int ncb = (ncols + 255) / 256, cb = task % ncb, rb = task / ncb, c = 256 * cb + 4 * lane;
    if (c >= ncols) return;
    f32x4 m = (f32x4){0.f, 0.f, 0.f, 0.f};
#pragma unroll 8
    for (int i = 0; i < 32; ++i) { const f32x4 v = *(const GAS f32x4*)(W + (size_t)(32 * rb + i) * ldw + c);
        m.x = fmaxf(m.x, fabsf(v.x)); m.y = fmaxf(m.y, fabsf(v.y)); m.z = fmaxf(m.z, fabsf(v.z)); m.w = fmaxf(m.w, fabsf(v.w)); }
    atomicMax(colmax + c, __float_as_uint(m.x)); atomicMax(colmax + c + 1, __float_as_uint(m.y)); atomicMax(colmax + c + 2, __float_as_uint(m.z)); atomicMax(colmax + c + 3, __float_as_uint(m.w));
}
__device__ __forceinline__ void cvt_chunks(const float* src, bf16* dst, size_t nchunks, size_t gtid, size_t nthr) {
    for (size_t c = gtid; c < nchunks; c += nthr) { const f32x4 a = ((const GAS f32x4*)src)[2 * c], b = ((const GAS f32x4*)src)[2 * c + 1];
        v4u o; o.x = pg8::cvt_pk_bf16(a.x, a.y); o.y = pg8::cvt_pk_bf16(a.z, a.w); o.z = pg8::cvt_pk_bf16(b.x, b.y); o.w = pg8::cvt_pk_bf16(b.z, b.w);
        ((GAS v4u*)dst)[c] = o; }
}

template <int NR> __device__ __forceinline__ void convert_rows(int e0, const float* eu, const float* ev, unsigned char* ws, int lane) {
                const bool isV = e0 >= NEXP; const int row0 = isV ? e0 - NEXP : e0;
                const float* tab = isV ? ev : eu;
                f32x4 v[NR][4];
#pragma unroll
                for (int rr = 0; rr < NR; ++rr)
#pragma unroll
                    for (int i = 0; i < 4; ++i) v[rr][i] = __builtin_nontemporal_load((const GAS f32x4*)(tab + (size_t)(row0 + rr) * D + 16 * lane) + i);
#pragma unroll
                for (int rr = 0; rr < NR; ++rr) {
                    const int row = row0 + rr; float am = 0.f;
#pragma unroll
                    for (int i = 0; i < 4; ++i) am = fmaxf(fmaxf(am, fmaxf(fabsf(v[rr][i].x), fabsf(v[rr][i].y))), fmaxf(fabsf(v[rr][i].z), fabsf(v[rr][i].w)));
                    am = wave_allmax(am);
                    v4u q;
                    if (!isV) { const float inv = am > 0.f ? 127.0f / am : 0.f;
                        q.x = peer_body::pack_i8x4(v[rr][0].x * inv, v[rr][0].y * inv, v[rr][0].z * inv, v[rr][0].w * inv); q.y = peer_body::pack_i8x4(v[rr][1].x * inv, v[rr][1].y * inv, v[rr][1].z * inv, v[rr][1].w * inv);
                        q.z = peer_body::pack_i8x4(v[rr][2].x * inv, v[rr][2].y * inv, v[rr][2].z * inv, v[rr][2].w * inv); q.w = peer_body::pack_i8x4(v[rr][3].x * inv, v[rr][3].y * inv, v[rr][3].z * inv, v[rr][3].w * inv);
                        *(GAS v4u*)(ws + WS_EU + (size_t)(lane >> 3) * ((size_t)NEXP * 128) + (size_t)row * 128 + (lane & 7) * 16) = q; if (lane == 0) ((GAS float*)(ws + WS_SU))[row] = am * (1.0f / 127.0f); }
                    else { const float inv = am > 0.f ? 127.0f / am : 0.f;
                        q.x = peer_body::pack_i8x4(v[rr][0].x * inv, v[rr][0].y * inv, v[rr][0].z * inv, v[rr][0].w * inv); q.y = peer_body::pack_i8x4(v[rr][1].x * inv, v[rr][1].y * inv, v[rr][1].z * inv, v[rr][1].w * inv);
                        q.z = peer_body::pack_i8x4(v[rr][2].x * inv, v[rr][2].y * inv, v[rr][2].z * inv, v[rr][2].w * inv); q.w = peer_body::pack_i8x4(v[rr][3].x * inv, v[rr][3].y * inv, v[rr][3].z * inv, v[rr][3].w * inv);
                        *(GAS v4u*)(ws + WS_EV + (size_t)(lane >> 3) * ((size_t)NEXP * 128) + (size_t)row * 128 + (lane & 7) * 16) = q; if (lane == 0) ((GAS float*)(ws + WS_SV))[row] = am * (1.0f / 127.0f); }
                }
}

__global__ void __launch_bounds__(NWAVES * 64, 2) skel_fwd(Args args) {
    extern __shared__ __attribute__((aligned(16))) unsigned char lds[];
    LAS unsigned char* L = (LAS unsigned char*)lds;
    volatile LAS unsigned* MISC = (volatile LAS unsigned*)(L + MISC_OFF);
    const int G = gridDim.x; const int bx = blockIdx.x; const int vcu = (G % 8 == 0) ? (bx % 8) * (G / 8) + bx / 8 : bx;
    for (int u = threadIdx.x; u < (LDS_BYTES - LDSCTL_OFF) / 4; u += NWAVES * 64) ((LAS unsigned*)(L + LDSCTL_OFF))[u] = 0u;
    __syncthreads();
    (void)xcd_barrier_post((unsigned*)((gu32*)(args.ws + WS_CTL) + CW_BAR) + args.li * XCD_BAR_WORDS, MISC + 8);
#define PHASE_VARS \
    GAS unsigned char* wsg_ = (GAS unsigned char*)args.ws; asm volatile("" : "+s"(wsg_)); unsigned char* ws = (unsigned char*)wsg_; GAS float* outg_ = (GAS float*)args.out; asm volatile("" : "+s"(outg_)); float* out = (float*)outg_; \
    int tid = threadIdx.x; asm volatile("" : "+v"(tid)); const int lane = tid & 63, wave = __builtin_amdgcn_readfirstlane(tid >> 6); (void)lane; (void)wave; \
    gu32* ctl = (gu32*)(ws + WS_CTL); (void)ctl; const float* x = args.in[0]; (void)x; \
    bf16* XN = (bf16*)(ws + WS_XN); bf16* Qb = (bf16*)(ws + WS_Q); bf16* UG = (bf16*)(ws + WS_UG); (void)XN; (void)Qb; (void)UG; \
    bf16* GATE = (bf16*)out; bf16* MERGED = (bf16*)(ws + WS_MERGED); bf16* QP = (bf16*)(ws + WS_QP); (void)GATE; (void)MERGED; (void)QP; \
    float* LOGF = (float*)(ws + WS_LOGF); float* CL2 = (float*)(ws + WS_CL2); (void)LOGF; (void)CL2; \
    const int gw = vcu * NWAVES + wave, NGW = G * NWAVES; (void)gw; (void)NGW;
    const int lo = args.ph_lo, hi = args.ph_hi;
#ifndef PHMASK
#define PHMASK 0x1ff
#endif
#define IN(k) (((PHMASK >> (k)) & 1) && lo <= (k) && (k) < hi)
#define BOTH(k) (IN(k) && IN((k) + 1))
#ifdef TIMEPH
    if (bx == 0 && threadIdx.x == 0) { const unsigned long long t0_ = rt(); MISC[24] = (unsigned)t0_; }
#define GRID_BAR(k) do { XcdBarrier b_; b_.bar = (unsigned*)((gu32*)(args.ws + WS_CTL) + CW_BAR) + args.li * XCD_BAR_WORDS; b_.x = xb_xcc_id(); b_.st = MISC + 8; xcd_barrier(b_); if (bx == 0 && threadIdx.x == 0) { gu32* ctl = (gu32*)(args.ws + WS_CTL); const unsigned t_now = (unsigned)rt(); __hip_atomic_store(ctl + 2048 + (k), t_now - MISC[24], RLX_AGENT); MISC[24] = t_now; } } while (0)
#else
#define GRID_BAR(k) do { XcdBarrier b_; b_.bar = (unsigned*)((gu32*)(args.ws + WS_CTL) + CW_BAR) + args.li * XCD_BAR_WORDS; b_.x = xb_xcc_id(); b_.st = MISC + 8; xcd_barrier(b_); } while (0)
#endif

    for (int rp_ = 0; rp_ < RP0; ++rp_) if (IN(0)) {
        PHASE_VARS
        LAS float* scr = (LAS float*)(L + RING_OFF + wave * 16384);
        const float* w_in = args.in[2];
        unsigned* cmax_in = (unsigned*)(ctl + CW_CMAX);
        {
            constexpr int T_IN = ((IN_W + 255) / 256) * (D / 32);
            constexpr int T_WQ = (QPW / 256) * (D / 32);
            for (int it = gw; it < T_IN + T_WQ; it += NGW) { if (it < T_IN) p0_colmax_task(w_in, IN_W, IN_W, cmax_in, it, lane); else p0_colmax_task(args.in[12], QPW, QPW, cmax_in + CMAX_WQ, it - T_IN, lane); }
            GRID_BAR(0);
        }
        {
            constexpr int I_A = 16 * 48, I_B = 16 * 96, I_WA = 8 * 32, I_WB = 8 * 32, I_WO = 16 * 32, I_WQ = 16 * 64;
            constexpr int NITEMS = I_A + I_B + I_WA + I_WB + I_WO + I_WQ;
            for (int it = gw; it < NITEMS; it += NGW) {
                int r = it;
                if (r < I_A) { p0_transpose_item_i8(w_in, IN_W, 0, D, ws + WS_WIN, (float*)(ws + WS_SBW), 0, cmax_in, scr, r, 48, lane); continue; } r -= I_A;
                if (r < I_B) { p0_transpose_item_i8(w_in, IN_W, OFF_UG, D, ws + WS_WIN, (float*)(ws + WS_SBW), 1536, cmax_in, scr, r, 96, lane); continue; } r -= I_B;
                if (r < I_WA) { p0_transpose_item(args.in[8], D, 0, AW, (bf16*)(ws + WS_WA), 0, scr, r, 32, lane); continue; } r -= I_WA;
                if (r < I_WB) { p0_transpose_item(args.in[9], D, 0, SW, (bf16*)(ws + WS_WB), 0, scr, r, 32, lane); continue; } r -= I_WB;
                if (r < I_WO) { p0_transpose_item(args.in[10], D, 0, D, (bf16*)(ws + WS_WOUT), 0, scr, r, 32, lane); continue; } r -= I_WO;
                p0_transpose_item_i8(args.in[12], QPW, 0, D, ws + WS_WQ, (float*)(ws + WS_SBWQ), 0, cmax_in + CMAX_WQ, scr, r, 64, lane);
            }
        }
        {
            const size_t gtid = (size_t)gw * 64 + lane, nthr = (size_t)NGW * 64;
            cvt_chunks(args.in[13], (bf16*)(ws + WS_SK), (size_t)PH * 2 * PKEYS * PHALF / 8, gtid, nthr);
#pragma unroll 1
            for (int e0 = CONV_P0_FROM + 4 * gw; e0 < 2 * NEXP; e0 += 4 * NGW) convert_rows<4>(e0, args.in[14], args.in[15], ws, lane);
            const float* w_s = args.in[6]; bf16* wsm = (bf16*)(ws + WS_WSM);
            for (size_t c = gtid; c < (size_t)NG * CHUNK * CHUNK / 8; c += nthr) {
                const int pos = (int)((c * 8) & 127), t = (int)((c * 8) >> 7) & 127, ks = pos >> 4, hh = (pos >> 3) & 1, s0 = 16 * ks + 4 * hh, s1 = s0 + 8;
                const float* src = w_s + ((c * 8) & ~(size_t)127);
                const f32x4 a = *(const GAS f32x4*)(src + s0), b = *(const GAS f32x4*)(src + s1);
                v4u o; o.x = pg8::cvt_pk_bf16(s0 + 0 <= t ? a.x : 0.f, s0 + 1 <= t ? a.y : 0.f); o.y = pg8::cvt_pk_bf16(s0 + 2 <= t ? a.z : 0.f, s0 + 3 <= t ? a.w : 0.f);
                o.z = pg8::cvt_pk_bf16(s1 + 0 <= t ? b.x : 0.f, s1 + 1 <= t ? b.y : 0.f); o.w = pg8::cvt_pk_bf16(s1 + 2 <= t ? b.z : 0.f, s1 + 3 <= t ? b.w : 0.f);
                ((GAS v4u*)wsm)[c] = o; }
        }
        __syncthreads();
        {
            LAS float* wf = (LAS float*)(L + RING_OFF);
            for (int i = tid; i < 8 * D; i += NWAVES * 64) { const int k = i >> 3, c = i & 7; wf[c * D + k] = w_in[(size_t)k * IN_W + OFF_F + c]; }
            __syncthreads();
            const float* g1 = args.in[1]; const float* b_f = args.in[3];
            f32x4 gv[4];
#pragma unroll
            for (int j = 0; j < 4; ++j) gv[j] = ((const GAS f32x4*)g1)[lane + 64 * j];
#pragma unroll 1
            for (int m0 = 4 * gw; m0 < M; m0 += 4 * NGW) {
                f32x4 vv[4][4];
#pragma unroll
                for (int rr = 0; rr < 4; ++rr)
#pragma unroll
                    for (int j = 0; j < 4; ++j) vv[rr][j] = ((const GAS f32x4*)(x + (size_t)(m0 + rr) * D) + lane)[64 * j];
#pragma unroll
                for (int rr = 0; rr < 4; ++rr) {
                    const int m = m0 + rr; f32x4 v[4]; float s = 0.f;
#pragma unroll
                    for (int j = 0; j < 4; ++j) { v[j] = vv[rr][j]; s += (v[j].x * v[j].x + v[j].y * v[j].y) + (v[j].z * v[j].z + v[j].w * v[j].w); }
                    const float r = 1.0f / sqrtf(wave_sum(s) * (1.f / D) + EPS);
#pragma unroll
                    for (int j = 0; j < 4; ++j) v[j] = v[j] * r * gv[j];
                    {
                        float am = 0.f;
#pragma unroll
                        for (int j = 0; j < 4; ++j) am = fmaxf(fmaxf(am, fmaxf(fabsf(v[j].x), fabsf(v[j].y))), fmaxf(fabsf(v[j].z), fabsf(v[j].w)));
                        am = wave_allmax(am); const float qs = am > 0.f ? 127.0f / am : 0.f;
                        GAS unsigned* o4 = (GAS unsigned*)(ws + WS_XN + (size_t)m * D) + lane;
#pragma unroll
                        for (int j = 0; j < 4; ++j) o4[64 * j] = peer_body::pack_i8x4(v[j].x * qs, v[j].y * qs, v[j].z * qs, v[j].w * qs);
                        if (lane == 0) ((GAS float*)(ws + WS_SA))[m] = am * (1.0f / 127.0f); }
                    float fsum = 0.f;
#pragma unroll
                    for (int c = 0; c < 8; ++c) { float pp = 0.f;
#pragma unroll
                        for (int j = 0; j < 4; ++j) { const f32x4 w4 = *(const LAS f32x4*)(wf + c * D + 256 * j + 4 * lane); pp += (v[j].x * w4.x + v[j].y * w4.y) + (v[j].z * w4.z + v[j].w * w4.w); }
                        pp = wave_sum(pp); if (lane == c) fsum = pp; }
                    if (lane < 8) LOGF[(size_t)m * NH + lane] = log_sigmoid(fsum + b_f[lane]);
                }
            }
        }
        if (BOTH(0)) GRID_BAR(0);
    }

    for (int rp12_ = 0; rp12_ < RP12; ++rp12_) {
    for (int rp_ = 0; rp_ < RP1; ++rp_) if (IN(1)) {
        PHASE_VARS
        if (vcu < BATCH * NH) {
            const int b = vcu / NH, h = vcu % NH; LAS float* part = (LAS float*)(L + MISC_OFF + 64);
            float v[4];
#pragma unroll
            for (int i = 0; i < 4; ++i) v[i] = LOGF[(size_t)(b * SEQ + 4 * tid + i) * NH + h];
            v[1] += v[0]; v[2] += v[1]; v[3] += v[2];
            float tot = v[3];
#pragma unroll
            for (int o = 1; o < 64; o <<= 1) { const float u = __shfl_up(tot, o); if (lane >= o) tot += u; }
            if (lane == 63) part[wave] = tot;
            __syncthreads();
            float base = tot - v[3];
            for (int w = 0; w < wave; ++w) base += part[w];
#pragma unroll
            for (int i = 0; i < 4; ++i) CL2[(size_t)vcu * SEQ + 4 * tid + i] = (base + v[i]) * LOG2E;
            __syncthreads();
        }
        pg8::Gemm g{XN, (const bf16*)(ws + WS_WIN), M, NPROJ, D / 2}; pg8::StaticOrder S; S.init(M, NPROJ, G, bx);
        pg8::EpiProjI8 E{Qb, (size_t)M * 512, GATE, C2, (const float*)(ws + WS_SA), (const float*)(ws + WS_SBW)};
        pg8::gemm_phase<pg8::EpiProjI8, pg8::StaticOrder, true, true, true>(L + RING_OFF, g, S, E);
        {
            constexpr int NUN = (M / 256) * (NPROJ / 256);
            const int nmax = (NUN + G - 1) / G, nun = (NUN - bx + G - 1) / G;
            int ii_ = bx - (NUN - (nmax - 1) * G), nidle_ = G - (NUN - (nmax - 1) * G);
            if (nidle_ <= 0) { ii_ = bx; nidle_ = G; }
            if (nun < nmax || nidle_ == G) {
#pragma unroll 1
                for (int e0 = 4 * (ii_ * NWAVES + wave); e0 < CONV_SPLIT; e0 += 4 * nidle_ * NWAVES) convert_rows<4>(e0, args.in[14], args.in[15], ws, lane);
            }
        }
        if (BOTH(1)) GRID_BAR(1);
    }

    if (IN(2)) {
        PHASE_VARS
        static_assert(attn_body::ATTN_LDS_BYTES <= RING_BYTES && peer_body::PEER_FUSED_LDS <= RING_BYTES, "phase LDS");
#ifdef P2PROBE
        for (int pr_ = 0; pr_ < P2PROBE; ++pr_) {
            for (int u = vcu; u < 2 * (M / CHUNK); u += G)
                sgu_body::sgu_unit(u >> 1, u & 1, (const bf16*)(ws + WS_VG), UG, (bf16*)(ws + 232 * MiB), (const bf16*)(ws + WS_WSM), args.in[4], args.in[5], args.in[7], (char*)lds + RING_OFF);
#ifndef P2PROBE_SGU_ONLY
            const attn_body::AttnTensors ATp{(const attn_body::bf16*)Qb, (const attn_body::bf16*)(ws + WS_K), (const attn_body::bf16*)(ws + WS_V), (attn_body::bf16*)(ws + 216 * MiB), CL2};
            const attn_body::StaticOrder Sp(G, bx);
            attn_body::attn_phase<attn_body::StaticOrder>((char*)lds + RING_OFF, ATp, Sp);
#endif
            GRID_BAR(2);
        }
#endif
#ifndef CONVREP
#define CONVREP 1
#endif
        constexpr int NCONV1 = (CONV_P0_FROM - CONV_SPLIT) / 64, NCONVQ = CONVREP * NCONV1, NIL = NCONVQ < 512 ? NCONVQ : 512;
        for (;;) {
            __syncthreads();
            if (tid == 0) MISC[26] = __hip_atomic_fetch_add(ctl + CW_QUEUE, 1u, RLX_AGENT);
            __syncthreads();
            const int u = __builtin_amdgcn_readfirstlane((int)MISC[26]);
            if (u >= 768 + NCONVQ) break;
            int ua = -1, uc = -1, us = -1;
#if QORDER == 1
            if (u < NCONVQ) uc = u; else if (u < 512 + NCONVQ) ua = u - NCONVQ; else us = u - 512 - NCONVQ;
#elif QORDER == 3
            static_assert(NCONVQ == 384, "spread order: 2 attention : 3 conversion : 2 gating units per block of 7");
            if (u < 256) ua = u;
            else { const int v_ = u - 256, blk = v_ / 7, r_ = v_ - 7 * blk;
                if (r_ == 0 || r_ == 4) ua = 256 + 2 * blk + (r_ == 4); else if (r_ & 1) uc = 3 * blk + (r_ >> 1); else us = 2 * blk + (r_ == 6); }
#elif QORDER == 4
            static_assert(NCONVQ == 384, "spread order: 2 attention : 3 conversion per block of 5, gating units last");
            if (u < 256) ua = u;
            else if (u < 256 + 640) { const int v_ = u - 256, blk = v_ / 5, r_ = v_ - 5 * blk;
                if (r_ & 1) ua = 256 + 2 * blk + (r_ >> 1); else uc = 3 * blk + (r_ >> 1); }
            else us = u - 896;
#elif QORDER == 2
            if (u < 512) ua = u; else if (u < 768) us = u - 512; else uc = u - 768;
#else
            if (u < 2 * NIL) { if (u & 1) uc = u >> 1; else ua = u >> 1; }
            else if (u < 512 + NCONVQ) { if (NCONVQ > 512) uc = u - 512; else ua = u - NCONVQ; }
            else us = u - 512 - NCONVQ;
#endif
            if (ua >= 0) { const int qb = 7 - (ua >> 6), bh = ua & 63;
                const int t0 = attn_body::attn_first_tile(CL2, bh, qb);
                attn_body::attn_unit<8>(bh / NH, bh % NH, qb, (const attn_body::bf16*)Qb, (const attn_body::bf16*)(ws + WS_K), (const attn_body::bf16*)(ws + WS_V), (attn_body::bf16*)Qb, CL2, (char*)lds + RING_OFF, t0); }
            else if (uc >= 0) convert_rows<8>(CONV_SPLIT + 64 * (uc % NCONV1) + 8 * wave, args.in[14], args.in[15], ws, lane);
            else sgu_body::sgu_unit(us >> 1, us & 1, (const bf16*)(ws + WS_VG), UG, UG, (const bf16*)(ws + WS_WSM), args.in[4], args.in[5], args.in[7], (char*)lds + RING_OFF);
        }
        if (BOTH(2)) GRID_BAR(2);
    }
    }

    for (int rp_ = 0; rp_ < RP3; ++rp_) if (IN(3)) {
        PHASE_VARS
        static_assert(WS_UG - WS_Q == (size_t)pg8::MERGE_DPM * 256 * AW * 2 && WS_WB - WS_WA == (size_t)4 * 256 * AW * 2, "merge passes: buffer offsets");
        { pg8::Gemm g{Qb, (const bf16*)(ws + WS_WA), M, D, AW}; pg8::MergeOrder S; S.init(M, D, G, bx);
          pg8::EpiMergeAB E{GATE, MERGED};
          pg8::gemm_phase<pg8::EpiMergeAB, pg8::MergeOrder, true, true>(L + RING_OFF, g, S, E); }
        if (BOTH(3)) GRID_BAR(3);
    }

    for (int rp_ = 0; rp_ < RP4; ++rp_) if (IN(4)) {
        PHASE_VARS
        pg8::Gemm g{MERGED, (const bf16*)(ws + WS_WOUT), M, D, D}; pg8::StaticOrder S; S.init(M, D, G, bx);
        pg8::EpiResid E{x, out, D, M};
        pg8::gemm_phase<pg8::EpiResid, pg8::StaticOrder, false, true>(L + RING_OFF, g, S, E);
        if (BOTH(4)) GRID_BAR(4);
    }

    for (int rp_ = 0; rp_ < RP5; ++rp_) if (IN(5)) {
        PHASE_VARS
        const float* g2 = args.in[11];
        f32x4 gv[4];
#pragma unroll
        for (int j = 0; j < 4; ++j) gv[j] = ((const GAS f32x4*)g2)[lane + 64 * j];
#pragma unroll 1
        for (int m0 = 4 * gw; m0 < M; m0 += 4 * NGW) {
            f32x4 vv[4][4];
#pragma unroll
            for (int rr = 0; rr < 4; ++rr)
#pragma unroll
                for (int j = 0; j < 4; ++j) vv[rr][j] = ((const GAS f32x4*)(out + (size_t)(m0 + rr) * D) + lane)[64 * j];
            asm volatile("" ::: "memory");
#pragma unroll
            for (int rr = 0; rr < 4; ++rr) {
                const int m = m0 + rr; f32x4 v[4]; float s = 0.f;
#pragma unroll
                for (int j = 0; j < 4; ++j) { v[j] = vv[rr][j]; s += (v[j].x * v[j].x + v[j].y * v[j].y) + (v[j].z * v[j].z + v[j].w * v[j].w); }
                const float r = 1.0f / sqrtf(wave_sum(s) * (1.f / D) + EPS);
                float am = 0.f;
#pragma unroll
                for (int j = 0; j < 4; ++j) { v[j] = v[j] * r * gv[j];
                    am = fmaxf(fmaxf(am, fmaxf(fabsf(v[j].x), fabsf(v[j].y))), fmaxf(fabsf(v[j].z), fabsf(v[j].w))); }
                am = wave_allmax(am);
                const float qs = am > 0.f ? 127.0f / am : 0.f;
#pragma unroll
                for (int j = 0; j < 4; ++j) { const unsigned q4 = peer_body::pack_i8x4(v[j].x * qs, v[j].y * qs, v[j].z * qs, v[j].w * qs);
                    *(GAS unsigned*)(ws + WS_H2Q + (size_t)(2 * j + (lane >> 5)) * ((size_t)M * 128) + (size_t)m * 128 + ((4 * lane) & 127)) = q4; ((GAS unsigned*)(ws + WS_XN + (size_t)m * D))[lane + 64 * j] = q4; }
                if (lane == 0) ((GAS float*)(ws + WS_ST))[m] = am * (1.0f / 127.0f);
            }
        }
        if (BOTH(5)) GRID_BAR(5);
    }

    for (int rp_ = 0; rp_ < RP6; ++rp_) if (IN(6)) {
        PHASE_VARS
        pg8::Gemm g{XN, (const bf16*)(ws + WS_WQ), M, QPW, D / 2}; pg8::StaticOrder S; S.init(M, QPW, G, bx);
        pg8::EpiBf16I8 E{QP, QPW, (const float*)(ws + WS_ST), (const float*)(ws + WS_SBWQ)};
        pg8::gemm_phase<pg8::EpiBf16I8, pg8::StaticOrder, true, true, true>(L + RING_OFF, g, S, E);
        if (BOTH(6)) GRID_BAR(6);
    }
    for (int rp_ = 0; rp_ < RP7; ++rp_) if (IN(7)) {
        PHASE_VARS
        for (int tk = vcu; tk < 8 * (M / 512); tk += G)
            peer_body::peer_retrieve(tk, QP, (const bf16*)(ws + WS_SK), (const float*)(ws + WS_SU), (const float*)(ws + WS_SV), (const float*)(ws + WS_ST),
                                     (bf16*)(ws + WS_PID), (float*)(ws + WS_G2), (float*)(ws + WS_PS2), (char*)lds + RING_OFF);
        if (BOTH(7)) GRID_BAR(7);
    }
    if (IN(8)) {
        PHASE_VARS
#ifdef TIMEPH
        const float oscale = 1.0f + sqrtf((float)(((__hip_atomic_load(ctl + 2048 + TIMEPH, RLX_AGENT) + TIMEOFF) / TIMEQ) * TIMEQ) * 1e-5f);
#else
        const float oscale = 1.0f;
#endif
        const int p = bx & 7, cntp = (G - p + 7) >> 3;
        peer_body::peer_fused(p, (bx >> 3) * NWAVES + wave, cntp * NWAVES, (const bf16*)(ws + WS_PID), (const float*)(ws + WS_G2), (const float*)(ws + WS_PS2), (const unsigned char*)(ws + WS_H2Q),
                              (const unsigned char*)(ws + WS_EU), (const unsigned char*)(ws + WS_EV), out, args.in[16], (char*)lds + RING_OFF, oscale);
    }
#undef IN
#undef BOTH
#undef GRID_BAR
}

extern "C" void kernel_launch(void* const* d_in, const int* in_sizes, int n_in, void* d_out, int out_size, void* d_ws, size_t ws_size, hipStream_t stream) {
    static int grid = 0;
    if (grid == 0) {
        int dev = 0, cus = 0;
        if (n_in != 17 || out_size != M * D || ws_size < WS_END) { fprintf(stderr, "kernel_launch: unexpected shapes (n_in %d out %d ws %zu)\n", n_in, out_size, ws_size); grid = -1; return; }
        if (hipGetDevice(&dev) != hipSuccess || hipDeviceGetAttribute(&cus, hipDeviceAttributeMultiprocessorCount, dev) != hipSuccess) { grid = -1; return; }
        if (hipFuncSetAttribute((const void*)skel_fwd, hipFuncAttributeMaxDynamicSharedMemorySize, LDS_BYTES) != hipSuccess) { fprintf(stderr, "kernel_launch: hipFuncSetAttribute failed\n"); grid = -1; return; }
        int per_cu = 0;
        if (hipOccupancyMaxActiveBlocksPerMultiprocessor(&per_cu, (const void*)skel_fwd, NWAVES * 64, LDS_BYTES) != hipSuccess || per_cu < 1) { fprintf(stderr, "kernel_launch: occupancy query says %d workgroups per CU\n", per_cu); grid = -1; return; }
        grid = cus;
    }
    if (grid < 0) return;
    unsigned char* ws = (unsigned char*)d_ws; float* out = (float*)d_out;
    (void)hipMemsetAsync(ws + WS_CTL, 0, CTL_ZERO_BYTES, stream);
    Args a{};
    for (int i = 0; i < 17; ++i) a.in[i] = (const float*)d_in[i];
    a.out = out; a.ws = ws;
#ifndef MULTI_LAUNCH
    {
        a.ph_lo = 0; a.ph_hi = N_PHASES; a.li = 0;
        void* kargs[] = {(void*)&a};
#ifdef PLAIN_LAUNCH
        hipLaunchKernelGGL(skel_fwd, dim3(grid), dim3(NWAVES * 64), LDS_BYTES, stream, a); const hipError_t e = hipPeekAtLastError(); (void)kargs;
#else
        const hipError_t e = hipLaunchCooperativeKernel((const void*)skel_fwd, dim3(grid), dim3(NWAVES * 64), kargs, LDS_BYTES, stream);
#endif
        if (e != hipSuccess) fprintf(stderr, "kernel_launch: cooperative launch failed: %s (grid %d)\n", hipGetErrorString(e), grid);
    }
#else
    for (int k = 0; k < N_PHASES; ++k) { a.ph_lo = k; a.ph_hi = k + 1; a.li = k; hipLaunchKernelGGL(skel_fwd, dim3(grid), dim3(NWAVES * 64), LDS_BYTES, stream, a); }
#endif
}
```

```cpp
#include <hip/hip_runtime.h>
#include <cstdio>
#include <cstdint>
#include <cmath>

constexpr int D = 1024, BATCH = 8, SEQ = 2048, M = BATCH * SEQ;
constexpr int NH = 8, HD = 64, AW = 512, SW = 512, CHUNK = 128, NG = 8, GD = 64;
constexpr int OFF_Q = 0, OFF_K = 512, OFF_V = 1024, OFF_F = 1536, OFF_UG = 1544, OFF_VG = 2056, OFF_GATE = 2568, IN_W = 4616;
constexpr int NPROJ = 4608;
constexpr int PH = 8, PKEYS = 128, PHALF = 128, PTOP = 16, NEXP = 16384, QPW = 2048, HK = 128;
constexpr float EPS = 1e-6f;
constexpr float LOG2E = 1.4426950408889634f;
constexpr float C2 = 0.125f * LOG2E;

constexpr size_t MiB = 1u << 20;
constexpr size_t WS_CTL = 0, CTL_ZERO_BYTES = 65536;
constexpr size_t WS_WIN = 1 * MiB;
constexpr size_t WS_WA = 10 * MiB;
constexpr size_t WS_WB = 11 * MiB;
constexpr size_t WS_WOUT = 12 * MiB;
constexpr size_t WS_WQ = 14 * MiB;
constexpr size_t WS_SK = 18 * MiB;
constexpr size_t WS_WSM = 18 * MiB + 512 * 1024;
constexpr size_t WS_EU = 20 * MiB;
constexpr size_t WS_EV = 52 * MiB;
constexpr size_t WS_XN = 84 * MiB;
constexpr size_t WS_Q = 116 * MiB;
constexpr size_t WS_K = 132 * MiB;
constexpr size_t WS_V = 148 * MiB;
constexpr size_t WS_UG = 164 * MiB;
constexpr size_t WS_VG = 180 * MiB;
constexpr size_t WS_LOGF = 196 * MiB;
constexpr size_t WS_CL2 = 197 * MiB;
constexpr size_t WS_STAT = 199 * MiB;
constexpr size_t WS_SU = 198 * MiB;
constexpr size_t WS_SV = 198 * MiB + 65536;
constexpr size_t WS_MERGED = WS_K;
constexpr size_t WS_QP = WS_Q;
constexpr size_t WS_PIDX = WS_VG;
constexpr size_t WS_PGATE = WS_VG + 8 * MiB;
constexpr size_t WS_H2Q = 200 * MiB;
constexpr size_t WS_ST = 198 * MiB + 131072;
constexpr size_t WS_SSQP = 198 * MiB + 262144;
constexpr size_t WS_SBQ = 198 * MiB + 524288;
constexpr size_t WS_PID = 180 * MiB;
constexpr size_t WS_G2 = 184 * MiB;
constexpr size_t WS_PS2 = 216 * MiB;
constexpr size_t WS_AP = 116 * MiB;
constexpr size_t WS_WP = 84 * MiB;
constexpr size_t WS_SW = 88 * MiB;
constexpr size_t WS_SSQ = 224 * MiB;
constexpr size_t WS_SBW = 198 * MiB + 786432;
constexpr size_t WS_SA = 198 * MiB + 851968;
constexpr size_t WS_SBWQ = 198 * MiB + 917504;
constexpr size_t WS_END = 256 * MiB;

template <int CTRL> __device__ __forceinline__ float wr_dppf(float v) { return __int_as_float(__builtin_amdgcn_update_dpp(0, __float_as_int(v), CTRL, 0xf, 0xf, false)); }
__device__ __forceinline__ float wave_allsum(float v) {
    v += wr_dppf<0xB1>(v); v += wr_dppf<0x4E>(v); v += wr_dppf<0x141>(v); v += wr_dppf<0x128>(v);
    { const auto s = __builtin_amdgcn_permlane16_swap(__float_as_uint(v), __float_as_uint(v), false, false); v = __uint_as_float(s[0]) + __uint_as_float(s[1]); }
    { const auto s = __builtin_amdgcn_permlane32_swap(__float_as_uint(v), __float_as_uint(v), false, false); v = __uint_as_float(s[0]) + __uint_as_float(s[1]); }
    return v;
}
__device__ __forceinline__ float wave_allmax(float v) {
    v = fmaxf(v, wr_dppf<0xB1>(v)); v = fmaxf(v, wr_dppf<0x4E>(v)); v = fmaxf(v, wr_dppf<0x141>(v)); v = fmaxf(v, wr_dppf<0x128>(v));
    { const auto s = __builtin_amdgcn_permlane16_swap(__float_as_uint(v), __float_as_uint(v), false, false); v = fmaxf(__uint_as_float(s[0]), __uint_as_float(s[1])); }
    { const auto s = __builtin_amdgcn_permlane32_swap(__float_as_uint(v), __float_as_uint(v), false, false); v = fmaxf(__uint_as_float(s[0]), __uint_as_float(s[1])); }
    return v;
}
namespace pg8 {
#define PG8_LAS __attribute__((address_space(3)))
typedef unsigned short bf16_t;
typedef short bf16x8 __attribute__((ext_vector_type(8)));
typedef float f32x4 __attribute__((ext_vector_type(4)));
typedef unsigned u32x4 __attribute__((ext_vector_type(4)));
constexpr int BM = 256, BK = 64, HALF = 128, HTB = HALF * BK * 2  , STAGE_BYTES = 8 * HTB, NXCD = 8, WGM = 8;

__host__ __device__ __forceinline__ int lds_byte(int r, int c) { const int st = (r >> 4) * 2 + (c >> 5), rr = r & 15, cc = c & 31, ob = rr * 64 + cc * 2; return st * 1024 + (ob ^ (((ob >> 9) & 1) << 5)); }
__host__ __device__ __forceinline__ void stage_rc(int b, int& R, int& C) { const int st = b / 1024, sb = b % 1024, swz = sb ^ (((sb >> 9) & 1) << 5); R = (st >> 1) * 16 + swz / 64; C = (st & 1) * 32 + (swz % 64) / 2; }
__host__ __device__ __forceinline__ int perm32(int rho) { const int n = rho >> 4, i = rho & 15; return 8 * (i >> 2) + 4 * n + (i & 3); }

struct Unit { int pm, pn; };
struct Gemm { const bf16_t* A; const bf16_t* Bt; int M, N, K; };

struct StaticOrder {
    int nM, nN, nwg, G, c;
    __host__ __device__ void init(int M, int N, int G_, int c_) { nM = M / BM; nN = N / BM; nwg = nM * nN; G = G_; c = c_; }
    __host__ __device__ bool next(int i, Unit& u) const {
        const long L = (long)i * G + c; if (L >= nwg) return false;
        int wgid = (int)L; { const int q = nwg / NXCD, r = nwg % NXCD, xcd = wgid % NXCD, off = wgid / NXCD; wgid = (xcd < r ? xcd * (q + 1) : r * (q + 1) + (xcd - r) * q) + off; }
        const int nig = WGM * nN, gid = wgid / nig, fm = gid * WGM, gsz = (nM - fm) < WGM ? (nM - fm) : WGM;
        u.pm = fm + ((wgid % nig) % gsz); u.pn = (wgid % nig) / gsz; return true;
    }
    __device__ __forceinline__ void a_ready(const Unit&) const {}
    __device__ __forceinline__ void done(const Unit&) const {}
};

typedef float cvt_f32x2_t __attribute__((ext_vector_type(2))); typedef __bf16 cvt_bf16x2_t __attribute__((ext_vector_type(2)));
__device__ __forceinline__ unsigned cvt_pk_bf16(float lo, float hi) { cvt_f32x2_t v = {lo, hi}; cvt_bf16x2_t b = __builtin_convertvector(v, cvt_bf16x2_t); return __builtin_bit_cast(unsigned, b); }
typedef float f32x2 __attribute__((ext_vector_type(2)));
__device__ __forceinline__ f32x2 gelu_pk(f32x2 v) {
    const f32x2 av = __builtin_elementwise_abs(v), d = av * 0.2316418882f + 1.0f;
    f32x2 t; t.x = __builtin_amdgcn_rcpf(d.x); t.y = __builtin_amdgcn_rcpf(d.y);
    f32x2 q = t * 0.5307027145f + (-0.7265760135f); q = q * t + 0.7107068705f; q = q * t + (-0.142248368f); q = q * t + 0.127414796f; q = q * t;
    const f32x2 s = (v * v) * (-0.72134752044f);
    f32x2 e; e.x = __builtin_amdgcn_exp2f(s.x); e.y = __builtin_amdgcn_exp2f(s.y);
    const f32x2 m = v * (q * e), r = v - m;
    f32x2 o; o.x = v.x < 0.f ? m.x : r.x; o.y = v.y < 0.f ? m.y : r.y; return o;
}

template <int ACT  > struct EpiBf16 {
    static constexpr bool PERM = true, AFTER_DRAIN = false; static_assert(ACT == 0 || ACT == 1, "EpiBf16: ACT is 0 (none) or 1 (gelu_pk)");
    bf16_t* O; int ldc; const float* bias; int split_cols; size_t split_stride; float scale0;
    __device__ __forceinline__ void operator()(const f32x4 (&acc)[2][2][4][2], const Unit& u, int wr, int wc, int fr, int fq) const {
        const int row0 = u.pm * BM + wr * 64 + fr; int colt = u.pn * BM; bf16_t* base = O;
        float sc = 1.f; if (split_cols) { const int t = colt / split_cols; base += (size_t)t * split_stride; colt -= t * split_cols; if (t == 0) sc = scale0; }
        const int col0 = colt + wc * 32 + 8 * fq, bcol0 = u.pn * BM + wc * 32 + 8 * fq;
        f32x4 bv[2][2];
#pragma unroll
        for (int bj = 0; bj < 2; ++bj)
#pragma unroll
            for (int n = 0; n < 2; ++n) bv[bj][n] = bias ? *(const f32x4*)(bias + bcol0 + bj * HALF + 4 * n) : (f32x4){0.f, 0.f, 0.f, 0.f};
#pragma unroll
        for (int ai = 0; ai < 2; ++ai)
#pragma unroll
            for (int m = 0; m < 4; ++m) { bf16_t* rowp = base + (size_t)(row0 + ai * HALF + m * 16) * ldc + col0;
#pragma unroll
                for (int bj = 0; bj < 2; ++bj) { f32x4 v0 = acc[ai][bj][m][0] + bv[bj][0], v1 = acc[ai][bj][m][1] + bv[bj][1];
                    if (ACT == 1) { f32x2 a = gelu_pk((f32x2){v0[0], v0[1]}), b = gelu_pk((f32x2){v0[2], v0[3]}), c = gelu_pk((f32x2){v1[0], v1[1]}), d = gelu_pk((f32x2){v1[2], v1[3]});
                        v0 = (f32x4){a.x, a.y, b.x, b.y}; v1 = (f32x4){c.x, c.y, d.x, d.y}; }
                    v0 = v0 * sc; v1 = v1 * sc; u32x4 w; w.x = cvt_pk_bf16(v0[0], v0[1]); w.y = cvt_pk_bf16(v0[2], v0[3]); w.z = cvt_pk_bf16(v1[0], v1[1]); w.w = cvt_pk_bf16(v1[2], v1[3]);
                    *(u32x4*)(rowp + bj * HALF) = w; } }
    }
};
__device__ __forceinline__ f32x2 sigmoid_pk(f32x2 v) {
#ifdef DBG_SIG
    f32x2 o; o.x = 1.0f / (1.0f + __expf(-v.x)); o.y = 1.0f / (1.0f + __expf(-v.y)); return o;
#else
    f32x2 e; e.x = __builtin_amdgcn_exp2f(v.x * -1.4426950408889634f); e.y = __builtin_amdgcn_exp2f(v.y * -1.4426950408889634f);
    f32x2 o; o.x = __builtin_amdgcn_rcpf(1.0f + e.x); o.y = __builtin_amdgcn_rcpf(1.0f + e.y); return o;
#endif
}
typedef unsigned u32x2 __attribute__((ext_vector_type(2)));
__device__ __forceinline__ unsigned pack_u8x4(f32x4 v) {
    unsigned w = __builtin_amdgcn_cvt_pk_u8_f32(v[0], 0u, 0u); w = __builtin_amdgcn_cvt_pk_u8_f32(v[1], 1u, w); w = __builtin_amdgcn_cvt_pk_u8_f32(v[2], 2u, w); return __builtin_amdgcn_cvt_pk_u8_f32(v[3], 3u, w);
}
template <int ACT> __device__ __forceinline__ f32x4 act4(f32x4 v, float sc) {
    if (ACT == 0) return v * sc;
    f32x2 a, b;
    if (ACT == 2) { a = gelu_pk((f32x2){v[0], v[1]}); b = gelu_pk((f32x2){v[2], v[3]}); }
    else { a = sigmoid_pk((f32x2){v[0], v[1]}); b = sigmoid_pk((f32x2){v[2], v[3]}); }
    return (f32x4){a.x, a.y, b.x, b.y};
}
struct EpiProj {
    static constexpr bool PERM = true, AFTER_DRAIN = false;
    bf16_t* QKVUV; size_t tstride; bf16_t* GATE; float qscale;
    template <int ACT> __device__ __forceinline__ void body(const f32x4 (&acc)[2][2][4][2], bf16_t* base, int ldc, int row0, int col0, float sc) const {
#pragma unroll
        for (int ai = 0; ai < 2; ++ai)
#pragma unroll
            for (int m = 0; m < 4; ++m) { bf16_t* rowp = base + (size_t)(row0 + ai * HALF + m * 16) * ldc + col0;
#pragma unroll
                for (int bj = 0; bj < 2; ++bj) { const f32x4 v0 = act4<ACT>(acc[ai][bj][m][0], sc), v1 = act4<ACT>(acc[ai][bj][m][1], sc);
                    u32x4 w; w.x = cvt_pk_bf16(v0[0], v0[1]); w.y = cvt_pk_bf16(v0[2], v0[3]); w.z = cvt_pk_bf16(v1[0], v1[1]); w.w = cvt_pk_bf16(v1[2], v1[3]);
                    *(u32x4*)(rowp + bj * HALF) = w; } }
    }
    __device__ __forceinline__ void operator()(const f32x4 (&acc)[2][2][4][2], const Unit& u, int wr, int wc, int fr, int fq) const {
        const int row0 = u.pm * BM + wr * 64 + fr, pn = u.pn;
        if (pn < 10) { bf16_t* base = QKVUV + (size_t)(pn >> 1) * tstride; const int col0 = (pn & 1) * BM + wc * 32 + 8 * fq;
            if (pn < 6) body<0>(acc, base, 512, row0, col0, pn < 2 ? qscale : 1.0f); else body<2>(acc, base, 512, row0, col0, 1.0f); }
        else body<3>(acc, GATE, 2048, row0, (pn - 10) * BM + wc * 32 + 8 * fq, 1.0f);
    }
};
template <int PASS> struct EpiMerge {
    static constexpr bool PERM = true, AFTER_DRAIN = false;
    const bf16_t* GATE; bf16_t* MERGED;
    __device__ __forceinline__ void operator()(const f32x4 (&acc)[2][2][4][2], const Unit& u, int wr, int wc, int fr, int fq) const {
        const int row0 = u.pm * BM + wr * 64 + fr, col0 = u.pn * BM + wc * 32 + 8 * fq;
#pragma unroll
        for (int ai = 0; ai < 2; ++ai) {
            u32x2 gq[4][2]; u32x4 tq[4][2];
#pragma unroll
            for (int m = 0; m < 4; ++m) { const size_t r = (size_t)(row0 + ai * HALF + m * 16);
#pragma unroll
                for (int bj = 0; bj < 2; ++bj) { const int c = col0 + bj * HALF; gq[m][bj] = *(const u32x2*)((const unsigned char*)GATE + r * 2048 + PASS * 1024 + c);
                    if (PASS == 1) tq[m][bj] = *(const u32x4*)(MERGED + r * 1024 + c); } }
            asm volatile("" ::: "memory");
#pragma unroll
            for (int m = 0; m < 4; ++m) { const size_t r = (size_t)(row0 + ai * HALF + m * 16);
#pragma unroll
                for (int bj = 0; bj < 2; ++bj) { const int c = col0 + bj * HALF; const u32x2 g = gq[m][bj];
                    f32x4 v0 = acc[ai][bj][m][0], v1 = acc[ai][bj][m][1];
                    v0[0] *= (float)(g.x & 0xffu); v0[1] *= (float)((g.x >> 8) & 0xffu); v0[2] *= (float)((g.x >> 16) & 0xffu); v0[3] *= (float)(g.x >> 24);
                    v1[0] *= (float)(g.y & 0xffu); v1[1] *= (float)((g.y >> 8) & 0xffu); v1[2] *= (float)((g.y >> 16) & 0xffu); v1[3] *= (float)(g.y >> 24);
                    if (PASS == 1) { const u32x4 t = tq[m][bj];
                        v0[0] += __uint_as_float(t.x << 16); v0[1] += __uint_as_float(t.x & 0xffff0000u); v0[2] += __uint_as_float(t.y << 16); v0[3] += __uint_as_float(t.y & 0xffff0000u);
                        v1[0] += __uint_as_float(t.z << 16); v1[1] += __uint_as_float(t.z & 0xffff0000u); v1[2] += __uint_as_float(t.w << 16); v1[3] += __uint_as_float(t.w & 0xffff0000u); }
                    u32x4 w; w.x = cvt_pk_bf16(v0[0], v0[1]); w.y = cvt_pk_bf16(v0[2], v0[3]); w.z = cvt_pk_bf16(v1[0], v1[1]); w.w = cvt_pk_bf16(v1[2], v1[3]);
                    *(u32x4*)(MERGED + r * 1024 + c) = w; } }
            asm volatile("" ::: "memory");
        }
    }
};
struct EpiResid {
    static constexpr bool PERM = false, AFTER_DRAIN = false;
    const float* base; float* out; int ldc; int nrows;
    __device__ __forceinline__ void operator()(const f32x4 (&acc)[2][2][4][2], const Unit& u, int wr, int wc, int fr, int fq) const {
        const int col0 = u.pn * BM + wc * 32 + 4 * fq;
#pragma unroll
        for (int ai = 0; ai < 2; ++ai) {
            f32x4 pre[4][2][2];
#pragma unroll
            for (int m = 0; m < 4; ++m) { const size_t off = (size_t)(u.pm * BM + ai * HALF + wr * 64 + m * 16 + fr) * ldc + col0;
#pragma unroll
                for (int bj = 0; bj < 2; ++bj)
#pragma unroll
                    for (int n = 0; n < 2; ++n) pre[m][bj][n] = *(const f32x4*)(base + off + bj * HALF + n * 16); }
            asm volatile("" ::: "memory");
#pragma unroll
            for (int m = 0; m < 4; ++m) { const size_t off = (size_t)(u.pm * BM + ai * HALF + wr * 64 + m * 16 + fr) * ldc + col0;
#pragma unroll
                for (int bj = 0; bj < 2; ++bj)
#pragma unroll
                    for (int n = 0; n < 2; ++n) *(f32x4*)(out + off + bj * HALF + n * 16) = pre[m][bj][n] + acc[ai][bj][m][n]; }
            asm volatile("" ::: "memory");
        }
    }
};

constexpr int MERGE_DPM = 192;
struct MergeOrder : StaticOrder {
    __host__ __device__ bool next(int i, Unit& u) const {
        if (!StaticOrder::next(i >> 1, u)) return false;
        if (i & 1) { u.pm += MERGE_DPM; u.pn += 4; }
        return true;
    }
};
struct EpiMergeAB {
    static constexpr bool PERM = true, AFTER_DRAIN = false;
    const bf16_t* GATE; bf16_t* MERGED;
    __device__ __forceinline__ void operator()(const f32x4 (&acc)[2][2][4][2], const Unit& u, int wr, int wc, int fr, int fq) const {
        if (u.pn < 4) { EpiMerge<0> E{GATE, MERGED}; E(acc, u, wr, wc, fr, fq); }
        else { Unit v; v.pm = u.pm - MERGE_DPM; v.pn = u.pn - 4; EpiMerge<1> E{GATE, MERGED}; E(acc, v, wr, wc, fr, fq); }
    }
};
struct QueryOrder {
    int v, G, ntask;
    __host__ __device__ bool next(int i, Unit& u) const { const int tk = v + (i >> 1) * G; if (tk >= ntask) return false; u.pm = 2 * (tk >> 3) + (i & 1); u.pn = tk & 7; return true; }
    __device__ __forceinline__ void a_ready(const Unit&) const {}
    __device__ __forceinline__ void done(const Unit&) const {}
};

struct EpiProjI8 {
    static constexpr bool PERM = true, AFTER_DRAIN = false;
    bf16_t* QKVUV; size_t tstride; bf16_t* GATE; float qscale; const float* sA; const float* sB;
    template <int ACT> __device__ __forceinline__ void body(const f32x4 (&acc)[2][2][4][2], bf16_t* base, int ldc, int row0, int col0, int bcol0, float sc) const {
        f32x4 sb[2][2];
#pragma unroll
        for (int bj = 0; bj < 2; ++bj)
#pragma unroll
            for (int n = 0; n < 2; ++n) sb[bj][n] = *(const f32x4*)(sB + bcol0 + bj * HALF + 4 * n);
#pragma unroll
        for (int ai = 0; ai < 2; ++ai)
#pragma unroll
            for (int m = 0; m < 4; ++m) { const int row = row0 + ai * HALF + m * 16; bf16_t* rowp = base + (size_t)row * ldc + col0; const float sa = sA[row];
#pragma unroll
                for (int bj = 0; bj < 2; ++bj) {
                    typedef int i32x4_t __attribute__((ext_vector_type(4)));
                    const i32x4_t i0 = __builtin_bit_cast(i32x4_t, acc[ai][bj][m][0]), i1 = __builtin_bit_cast(i32x4_t, acc[ai][bj][m][1]);
                    const f32x4 f0 = (f32x4){(float)i0[0], (float)i0[1], (float)i0[2], (float)i0[3]} * sb[bj][0] * sa, f1 = (f32x4){(float)i1[0], (float)i1[1], (float)i1[2], (float)i1[3]} * sb[bj][1] * sa;
                    const f32x4 v0 = act4<ACT>(f0, sc), v1 = act4<ACT>(f1, sc);
                    if (ACT == 3) {
                        u32x2 w8; w8.x = pack_u8x4(v0 * 255.0f); w8.y = pack_u8x4(v1 * 255.0f);
                        *(u32x2*)((unsigned char*)base + (size_t)row * ldc + col0 + bj * HALF) = w8;
                    } else {
                    u32x4 w; w.x = cvt_pk_bf16(v0[0], v0[1]); w.y = cvt_pk_bf16(v0[2], v0[3]); w.z = cvt_pk_bf16(v1[0], v1[1]); w.w = cvt_pk_bf16(v1[2], v1[3]);
                    *(u32x4*)(rowp + bj * HALF) = w; } } }
    }
    __device__ __forceinline__ void operator()(const f32x4 (&acc)[2][2][4][2], const Unit& u, int wr, int wc, int fr, int fq) const {
        const int row0 = u.pm * BM + wr * 64 + fr, pn = u.pn, bcol0 = pn * BM + wc * 32 + 8 * fq;
        if (pn < 10) { bf16_t* base = QKVUV + (size_t)(pn >> 1) * tstride; const int col0 = (pn & 1) * BM + wc * 32 + 8 * fq;
            if (pn < 6) body<0>(acc, base, 512, row0, col0, bcol0, pn < 2 ? qscale : 1.0f); else body<2>(acc, base, 512, row0, col0, bcol0, 1.0f); }
        else body<3>(acc, GATE, 2048, row0, (pn - 10) * BM + wc * 32 + 8 * fq, bcol0, 1.0f);
    }
};

struct EpiBf16I8 {
    static constexpr bool PERM = true, AFTER_DRAIN = false;
    bf16_t* O; int ldc; const float* sA; const float* sB;
    __device__ __forceinline__ void operator()(const f32x4 (&acc)[2][2][4][2], const Unit& u, int wr, int wc, int fr, int fq) const {
        typedef int i32x4_t __attribute__((ext_vector_type(4)));
        const int row0 = u.pm * BM + wr * 64 + fr, col0 = u.pn * BM + wc * 32 + 8 * fq;
        f32x4 sb[2][2];
#pragma unroll
        for (int bj = 0; bj < 2; ++bj)
#pragma unroll
            for (int n = 0; n < 2; ++n) sb[bj][n] = *(const f32x4*)(sB + col0 + bj * HALF + 4 * n);
#pragma unroll
        for (int ai = 0; ai < 2; ++ai)
#pragma unroll
            for (int m = 0; m < 4; ++m) { const int row = row0 + ai * HALF + m * 16; bf16_t* rowp = O + (size_t)row * ldc + col0; const float sa = sA[row];
#pragma unroll
                for (int bj = 0; bj < 2; ++bj) {
                    const i32x4_t i0 = __builtin_bit_cast(i32x4_t, acc[ai][bj][m][0]), i1 = __builtin_bit_cast(i32x4_t, acc[ai][bj][m][1]);
                    const f32x4 v0 = (f32x4){(float)i0[0], (float)i0[1], (float)i0[2], (float)i0[3]} * sb[bj][0] * sa, v1 = (f32x4){(float)i1[0], (float)i1[1], (float)i1[2], (float)i1[3]} * sb[bj][1] * sa;
                    u32x4 w; w.x = cvt_pk_bf16(v0[0], v0[1]); w.y = cvt_pk_bf16(v0[2], v0[3]); w.z = cvt_pk_bf16(v1[0], v1[1]); w.w = cvt_pk_bf16(v1[2], v1[3]);
                    *(u32x4*)(rowp + bj * HALF) = w; } }
    }
};
template <class Epi, class Sched, bool ALIGN_EPI = false, bool SP2 = false, bool I8 = false>
__device__ __forceinline__ void gemm_phase(PG8_LAS unsigned char* lds, const Gemm g, const Sched& S, const Epi& E) {
    typedef int i32x4_t __attribute__((ext_vector_type(4)));
    int tid = threadIdx.x; asm volatile("" : "+v"(tid));
    const int wid = __builtin_amdgcn_readfirstlane(tid >> 6), lane = tid & 63, wr = wid >> 2, wc = wid & 3, fr = lane & 15, fq = lane >> 4;
    const int K = g.K, nt = K / BK;
    unsigned voffA[2], voffB[2];
#pragma unroll
    for (int i = 0; i < 2; ++i) { int R, C; stage_rc(tid * 16 + i * 8192, R, C); const int Rb = Epi::PERM ? ((R & ~31) + perm32(R & 31)) : R;
        voffA[i] = (unsigned)(R * K + C) * 2u; voffB[i] = (unsigned)(Rb * K + C) * 2u; }
    const size_t kstep = (size_t)(BK * 2);
    const size_t hstep = (size_t)HALF * K * 2;
    const size_t tstep = 2 * hstep;
    const unsigned ldsw = (unsigned)wid * 1024u;
    const int aoff = lds_byte(wr * 64 + fr, fq * 8), boff = lds_byte(wc * 32 + fr, fq * 8);
#define PG8_SA(b, h) (((b) * 2 + (h)) * HTB)
#define PG8_SB(b, h) ((4 + (b) * 2 + (h)) * HTB)
#define PG8_STAGE(bufoff, gbase, voff) do { _Pragma("unroll") for (int _i = 0; _i < 2; ++_i) \
        __builtin_amdgcn_global_load_lds((const unsigned*)((const char*)(gbase) + (voff)[_i]), (PG8_LAS unsigned*)(lds + (bufoff) + ldsw + _i * 8192), 16, 0, 0); } while (0)
#define PG8_LDA(dst, b, h) do { _Pragma("unroll") for (int m = 0; m < 4; ++m) _Pragma("unroll") for (int k = 0; k < 2; ++k) dst[m][k] = *(const PG8_LAS bf16x8*)(lds + PG8_SA(b, h) + aoff + m * 2048 + k * 1024); } while (0)
#define PG8_LDB(dst, b, h) do { _Pragma("unroll") for (int n = 0; n < 2; ++n) _Pragma("unroll") for (int k = 0; k < 2; ++k) dst[n][k] = *(const PG8_LAS bf16x8*)(lds + PG8_SB(b, h) + boff + n * 2048 + k * 1024); } while (0)
#define PG8_MMA(ai, bj, At, Bt) do { __builtin_amdgcn_s_setprio(1); _Pragma("unroll") for (int m = 0; m < 4; ++m) _Pragma("unroll") for (int n = 0; n < 2; ++n) _Pragma("unroll") for (int k = 0; k < 2; ++k) \
        { if constexpr (I8) acc[ai][bj][m][n] = __builtin_bit_cast(f32x4, __builtin_amdgcn_mfma_i32_16x16x64_i8(__builtin_bit_cast(i32x4_t, Bt[n][k]), __builtin_bit_cast(i32x4_t, At[m][k]), __builtin_bit_cast(i32x4_t, acc[ai][bj][m][n]), 0, 0, 0)); \
          else acc[ai][bj][m][n] = __builtin_amdgcn_mfma_f32_16x16x32_bf16(Bt[n][k], At[m][k], acc[ai][bj][m][n], 0, 0, 0); } __builtin_amdgcn_s_setprio(0); } while (0)
#define PG8_WAIT_V(n) asm volatile("s_waitcnt vmcnt(" #n ")" ::: "memory")
#define PG8_WAIT_L(n) asm volatile("s_waitcnt lgkmcnt(" #n ")" ::: "memory")
#define PG8_BAR __builtin_amdgcn_s_barrier()
#define PG8_SCHED __builtin_amdgcn_sched_barrier(0)
    Unit cur, nxt; int ui = 0;
    if (!S.next(0, cur)) return;
    f32x4 acc[2][2][4][2];
#pragma unroll
    for (int a = 0; a < 2; ++a)
#pragma unroll
        for (int b = 0; b < 2; ++b)
#pragma unroll
            for (int m = 0; m < 4; ++m)
#pragma unroll
                for (int n = 0; n < 2; ++n) acc[a][b][m][n] = (f32x4){0.f, 0.f, 0.f, 0.f};
    bf16x8 At[4][2], B0[2][2], B1[2][2];
    const char* cA = (const char*)g.A + (size_t)cur.pm * tstep; const char* cB = (const char*)g.Bt + (size_t)cur.pn * tstep;
    S.a_ready(cur);
    if constexpr (SP2) {
        PG8_STAGE(PG8_SB(0, 0), cB, voffB); PG8_STAGE(PG8_SB(0, 1), cB + hstep, voffB); PG8_STAGE(PG8_SA(0, 0), cA, voffA); PG8_STAGE(PG8_SA(0, 1), cA + hstep, voffA);
        if (wr == 1) PG8_BAR;
        PG8_WAIT_V(2); PG8_BAR;
        PG8_STAGE(PG8_SB(1, 0), cB + kstep, voffB); PG8_STAGE(PG8_SA(1, 0), cA + kstep, voffA); PG8_STAGE(PG8_SB(1, 1), cB + hstep + kstep, voffB);
        PG8_WAIT_V(6); PG8_BAR;
    } else {
        PG8_STAGE(PG8_SB(0, 0), cB, voffB); PG8_STAGE(PG8_SA(0, 0), cA, voffA); PG8_STAGE(PG8_SB(0, 1), cB + hstep, voffB); PG8_STAGE(PG8_SA(0, 1), cA + hstep, voffA);
        if (wr == 1) PG8_BAR;
        PG8_WAIT_V(4); PG8_BAR;
        PG8_STAGE(PG8_SB(1, 0), cB + kstep, voffB); PG8_STAGE(PG8_SA(1, 0), cA + kstep, voffA); PG8_STAGE(PG8_SB(1, 1), cB + hstep + kstep, voffB);
        PG8_WAIT_V(6); PG8_BAR;
    }
    for (;;) {
        const bool has_next = S.next(ui + 1, nxt);
        const char* nA = has_next ? (const char*)g.A + (size_t)nxt.pm * tstep : cA; const char* nB = has_next ? (const char*)g.Bt + (size_t)nxt.pn * tstep : cB;
        for (int t = 0; t < nt; t += 2) {
            const bool last = (t == nt - 2);
            const char* a1 = cA + (size_t)(t + 1) * kstep;
            const char* a2 = last ? nA : cA + (size_t)(t + 2) * kstep; const char* b2 = last ? nB : cB + (size_t)(t + 2) * kstep;
            const char* a3 = a2 + kstep; const char* b3 = b2 + kstep;
            if (last && has_next) S.a_ready(nxt);
            if constexpr (SP2) {
            PG8_LDB(B0, 0, 0); PG8_LDB(B1, 0, 1); PG8_SCHED; PG8_LDA(At, 0, 0); PG8_STAGE(PG8_SA(1, 1), a1 + hstep, voffA);
            PG8_WAIT_V(8); PG8_WAIT_L(0); PG8_BAR; PG8_MMA(0, 0, At, B0); PG8_MMA(0, 1, At, B1); PG8_BAR; PG8_SCHED;
            PG8_LDA(At, 0, 1); PG8_STAGE(PG8_SB(0, 0), b2, voffB); PG8_STAGE(PG8_SB(0, 1), b2 + hstep, voffB); PG8_STAGE(PG8_SA(0, 0), a2, voffA);
            PG8_WAIT_V(8); PG8_WAIT_L(0); PG8_BAR; PG8_MMA(1, 0, At, B0); PG8_MMA(1, 1, At, B1); PG8_BAR; PG8_SCHED;
            PG8_LDB(B0, 1, 0); PG8_LDB(B1, 1, 1); PG8_SCHED; PG8_LDA(At, 1, 0); PG8_STAGE(PG8_SA(0, 1), a2 + hstep, voffA);
            PG8_WAIT_V(8); PG8_WAIT_L(0); PG8_BAR; PG8_MMA(0, 0, At, B0); PG8_MMA(0, 1, At, B1); PG8_BAR; PG8_SCHED;
            PG8_LDA(At, 1, 1); PG8_STAGE(PG8_SB(1, 0), b3, voffB); PG8_STAGE(PG8_SB(1, 1), b3 + hstep, voffB); PG8_STAGE(PG8_SA(1, 0), a3, voffA);
            PG8_WAIT_V(8); PG8_WAIT_L(0); PG8_BAR; PG8_MMA(1, 0, At, B0); PG8_MMA(1, 1, At, B1); PG8_BAR; PG8_SCHED;
            } else {
            PG8_LDB(B0, 0, 0); PG8_SCHED; PG8_LDA(At, 0, 0); PG8_STAGE(PG8_SA(1, 1), a1 + hstep, voffA);
            PG8_WAIT_L(8); PG8_BAR; PG8_WAIT_L(0); PG8_MMA(0, 0, At, B0); PG8_BAR; PG8_SCHED;
            PG8_LDB(B1, 0, 1); PG8_STAGE(PG8_SB(0, 0), b2, voffB);
            PG8_BAR; PG8_WAIT_L(0); PG8_MMA(0, 1, At, B1); PG8_BAR;
            PG8_LDA(At, 0, 1); PG8_STAGE(PG8_SA(0, 0), a2, voffA);
            PG8_BAR; PG8_WAIT_L(0); PG8_MMA(1, 0, At, B0); PG8_BAR; PG8_SCHED;
            PG8_STAGE(PG8_SB(0, 1), b2 + hstep, voffB);
            PG8_WAIT_V(6); PG8_BAR; PG8_MMA(1, 1, At, B1); PG8_BAR;
            PG8_LDB(B0, 1, 0); PG8_SCHED; PG8_LDA(At, 1, 0); PG8_STAGE(PG8_SA(0, 1), a2 + hstep, voffA);
            PG8_WAIT_L(8); PG8_BAR; PG8_WAIT_L(0); PG8_MMA(0, 0, At, B0); PG8_BAR; PG8_SCHED;
            PG8_LDB(B1, 1, 1); PG8_STAGE(PG8_SB(1, 0), b3, voffB);
            PG8_BAR; PG8_WAIT_L(0); PG8_MMA(0, 1, At, B1); PG8_BAR;
            PG8_LDA(At, 1, 1); PG8_STAGE(PG8_SA(1, 0), a3, voffA);
            PG8_BAR; PG8_WAIT_L(0); PG8_MMA(1, 0, At, B0); PG8_BAR; PG8_SCHED;
            PG8_STAGE(PG8_SB(1, 1), b3 + hstep, voffB);
            PG8_WAIT_V(6); PG8_BAR; PG8_MMA(1, 1, At, B1); PG8_BAR;
            }
        }
        if constexpr (ALIGN_EPI) { if (wr == 0) PG8_BAR; }
        if constexpr (!Epi::AFTER_DRAIN) { E(acc, cur, wr, wc, fr, fq); S.done(cur); }
        if (!has_next) break;
#pragma unroll
        for (int a = 0; a < 2; ++a)
#pragma unroll
            for (int b = 0; b < 2; ++b)
#pragma unroll
                for (int m = 0; m < 4; ++m)
#pragma unroll
                    for (int n = 0; n < 2; ++n) acc[a][b][m][n] = (f32x4){0.f, 0.f, 0.f, 0.f};
        cur = nxt; cA = nA; cB = nB; ++ui;
        if constexpr (ALIGN_EPI) { if (wr == 1) PG8_BAR; }
    }
    PG8_WAIT_V(0);
    if constexpr (!ALIGN_EPI) { if (wr == 0) PG8_BAR; }
    PG8_BAR;
    if constexpr (Epi::AFTER_DRAIN) { E.fused(acc, cur, wr, wc, fr, fq, lds, wid, lane); S.done(cur); }
#undef PG8_SA
#undef PG8_SB
#undef PG8_STAGE
#undef PG8_LDA
#undef PG8_LDB
#undef PG8_MMA
#undef PG8_WAIT_V
#undef PG8_WAIT_L
#undef PG8_BAR
#undef PG8_SCHED
}
}
#include <hip/hip_bf16.h>
#include <cmath>
namespace attn_body {
using bf16=__hip_bfloat16;
using bf16x8=__attribute__((ext_vector_type(8)))short;
using s16x4=__attribute__((ext_vector_type(4)))short;
using f32x16=__attribute__((ext_vector_type(16)))float;
using u32x4=__attribute__((ext_vector_type(4)))unsigned;
constexpr int BATCH=8,NHEAD=8,SEQ=2048,D=64,DM=NHEAD*D;
constexpr int NW=8,QBLK=32,QB=QBLK*NW,KVBLK=64,NQB=SEQ/QB;
constexpr int ATTN_PITCH=DM, ATTN_UNIT_ROWS=QB;
__device__ __forceinline__ int crow(int r,int hi){return (r&3)+8*(r>>2)+4*hi;}
#define SBAR() __builtin_amdgcn_sched_barrier(0)
__device__ __forceinline__ void cmask(f32x16&p0,f32x16&p1,int jb,int qrel,int hi){
  const float NEG=-INFINITY; int kb=64*jb+4*hi;
  #pragma unroll
  for(int r=0;r<16;++r){int kv=kb+(r&3)+8*(r>>2); if(kv>qrel)p0[r]=NEG; if(kv+32>qrel)p1[r]=NEG;}
}

constexpr int NSLOT=3, SLOTB=8192;
constexpr int LDS_K=0, LDS_V=NSLOT*SLOTB, LDS_WS=2*NSLOT*SLOTB, LDS_OST=LDS_WS+NW*64*4, LDS_CS=LDS_OST+NW*4096, LDS_BYTES=LDS_CS+SEQ*4;
constexpr float C2=0.125f*1.4426950408889634f;
__device__ __forceinline__ void glds16(const void*gsrc,unsigned lds_dst){unsigned keep;
  asm volatile("s_mov_b32 %0, m0\n\ts_mov_b32 m0, %2\n\ts_nop 0\n\tglobal_load_lds_dwordx4 %1, off\n\ts_mov_b32 m0, %0":"=&s"(keep):"v"(gsrc),"s"(lds_dst):"memory");}
__device__ __forceinline__ float max3f(float a,float b,float c){float r;asm("v_max3_f32 %0, %1, %2, %3":"=v"(r):"v"(a),"v"(b),"v"(c));return r;}
__device__ __forceinline__ float max2f(float a,float b){float r;asm("v_max_f32_e32 %0, %1, %2":"=v"(r):"v"(a),"v"(b));return r;}
__device__ __forceinline__ float fadd_s(float a,float b){float r;asm("v_add_f32_e32 %0, %1, %2":"=v"(r):"v"(a),"v"(b));return r;}
__device__ __forceinline__ float fsub_s(float a,float b){float r;asm("v_sub_f32_e32 %0, %1, %2":"=v"(r):"v"(a),"v"(b));return r;}
typedef float f32x2_t __attribute__((ext_vector_type(2))); typedef __bf16 bf16x2_t __attribute__((ext_vector_type(2)));
__device__ __forceinline__ unsigned cvtpk_s(float lo,float hi){f32x2_t v={lo,hi};bf16x2_t b=__builtin_convertvector(v,bf16x2_t);return __builtin_bit_cast(unsigned,b);}
#define WAIT_BAR(N) asm volatile("s_waitcnt vmcnt(" #N ") lgkmcnt(0)\n\ts_barrier":::"memory")

__device__ __forceinline__ void qkt(f32x16&p0,f32x16&p1,const char*Kslot,const bf16x8*qr,int r32,int hi){
  const char*kb=Kslot+hi*1024+r32*16;
  #pragma unroll
  for(int d0=0;d0<4;++d0){
    const bf16x8 b0=*reinterpret_cast<const bf16x8*>(kb+d0*2048);
    const bf16x8 b1=*reinterpret_cast<const bf16x8*>(kb+d0*2048+512);
    p0=__builtin_amdgcn_mfma_f32_32x32x16_bf16(b0,qr[d0],p0,0,0,0);p1=__builtin_amdgcn_mfma_f32_32x32x16_bf16(b1,qr[d0],p1,0,0,0);}
}
typedef __attribute__((address_space(3))) const char* lds_cptr;
typedef short v4i16_t __attribute__((ext_vector_type(4)));
__device__ __forceinline__ void kload8(bf16x8*kf,lds_cptr kp){
  kf[0]=*(const __attribute__((address_space(3))) bf16x8*)(kp);      kf[1]=*(const __attribute__((address_space(3))) bf16x8*)(kp+512);
  kf[2]=*(const __attribute__((address_space(3))) bf16x8*)(kp+2048); kf[3]=*(const __attribute__((address_space(3))) bf16x8*)(kp+2560);
  kf[4]=*(const __attribute__((address_space(3))) bf16x8*)(kp+4096); kf[5]=*(const __attribute__((address_space(3))) bf16x8*)(kp+4608);
  kf[6]=*(const __attribute__((address_space(3))) bf16x8*)(kp+6144); kf[7]=*(const __attribute__((address_space(3))) bf16x8*)(kp+6656);
}
__device__ __forceinline__ void kload2(bf16x8*kf,lds_cptr kp,int j){ kf[2*j]=*(const __attribute__((address_space(3))) bf16x8*)(kp+j*2048); kf[2*j+1]=*(const __attribute__((address_space(3))) bf16x8*)(kp+j*2048+512); }
__device__ __forceinline__ s16x4 vtr(lds_cptr p){ return __builtin_bit_cast(s16x4,__builtin_amdgcn_ds_read_tr16_b64_v4i16((__attribute__((address_space(3))) v4i16_t*)p)); }
__device__ __forceinline__ float rowmax(const f32x16&p0,const f32x16&p1){
  float a=max3f(p0[0],p0[1],p1[0]),b=max3f(p0[2],p0[3],p1[1]);a=max3f(a,p1[2],p1[3]);
  #pragma unroll
  for(int r=4;r<16;r+=4){a=max3f(a,p0[r],p0[r+1]);b=max3f(b,p0[r+2],p0[r+3]);a=max3f(a,p1[r],p1[r+1]);b=max3f(b,p1[r+2],p1[r+3]);}
  const float m=max2f(a,b);
  auto rr=__builtin_amdgcn_permlane32_swap(__float_as_uint(m),__float_as_uint(m),false,false);
  return max2f(__uint_as_float(rr[0]),__uint_as_float(rr[1]));
}
__device__ __forceinline__ void pv(f32x16*o,int vb,bf16x8 pa0,bf16x8 pa1,bf16x8 pa2,bf16x8 pa3){
  #pragma unroll
  for(int d0=0;d0<2;++d0){s16x4 lo[4],hi[4];
    #pragma unroll
    for(int ks=0;ks<4;++ks){
      asm volatile("ds_read_b64_tr_b16 %0,%1 offset:%c2":"=&v"(lo[ks]):"v"(vb),"i"(d0*4096+ks*1024):"memory");
      asm volatile("ds_read_b64_tr_b16 %0,%1 offset:%c2":"=&v"(hi[ks]):"v"(vb),"i"(d0*4096+ks*1024+512):"memory");}
    asm volatile("s_waitcnt lgkmcnt(0)":::"memory");SBAR();
    #define PK(k) (bf16x8){lo[k][0],lo[k][1],lo[k][2],lo[k][3],hi[k][0],hi[k][1],hi[k][2],hi[k][3]}
    o[d0]=__builtin_amdgcn_mfma_f32_32x32x16_bf16(pa0,PK(0),o[d0],0,0,0);
    o[d0]=__builtin_amdgcn_mfma_f32_32x32x16_bf16(pa1,PK(1),o[d0],0,0,0);
    o[d0]=__builtin_amdgcn_mfma_f32_32x32x16_bf16(pa2,PK(2),o[d0],0,0,0);
    o[d0]=__builtin_amdgcn_mfma_f32_32x32x16_bf16(pa3,PK(3),o[d0],0,0,0);
    #undef PK
  }
}

#ifndef ATTN_STORE16
#define ATTN_STORE16(p,v) (*(u32x4*)(p)=(v))
#endif
template<int THRL> __device__ __forceinline__ void attn_unit(int b,int h,int qb,const bf16*Q,const bf16*__restrict__ K,const bf16*__restrict__ V,bf16*O,const float*__restrict__ CL2,char*shm,int t0=0){
  int tid=threadIdx.x; asm volatile("":"+v"(tid)); const int lane=tid&63,r32=lane&31,hi=lane>>5; const int wid=__builtin_amdgcn_readfirstlane(tid>>6);
  const long rowbase=(long)b*SEQ; const int q0=qb*QB;
  const bf16*Qw=Q+(rowbase+q0+wid*QBLK)*DM+h*D;
  const bf16*Kh=K+rowbase*DM+h*D,*Vh=V+rowbase*DM+h*D;
  const unsigned lds0=(unsigned)(uintptr_t)shm;
  float*wsf=(float*)(shm+LDS_WS)+wid*64;
  const bf16*ksrc=Kh+(long)(t0*KVBLK+lane)*DM+wid*8;
  const bf16*vsrc=Vh+(long)(t0*KVBLK+16*(wid&3)+(lane>>2))*DM+(wid>>2)*32+(lane&3)*8;
  const unsigned kdst=lds0+LDS_K+wid*1024, vdst=lds0+LDS_V+wid*1024;
  #define DMA_K(t,slot) glds16(ksrc+(long)(t)*KVBLK*DM,(unsigned)__builtin_amdgcn_readfirstlane(kdst+(slot)))
  #define DMA_V(t,slot) glds16(vsrc+(long)(t)*KVBLK*DM,(unsigned)__builtin_amdgcn_readfirstlane(vdst+(slot)))
  const int vb0=(int)(lds0+LDS_V)+((lane>>4)&1)*32+(lane&3)*8+(4*hi+((lane&15)>>2))*64;
  const char*Kbase=shm+LDS_K; bf16x8 kf[8];
  const lds_cptr shm3=(lds_cptr)shm; const lds_cptr kp0=shm3+LDS_K+hi*1024+r32*16; const lds_cptr vp0=shm3+LDS_V+((lane>>4)&1)*32+(lane&3)*8+(4*hi+((lane&15)>>2))*64;
  const int NT=(q0+QB)/KVBLK-t0;
  DMA_K(0,0);DMA_V(0,0);DMA_K(1,SLOTB);
  bf16x8 qr[4];
  #pragma unroll
  for(int d0=0;d0<4;++d0)qr[d0]=*reinterpret_cast<const bf16x8*>(&Qw[(long)r32*DM+d0*16+hi*8]);
  const float*cg=CL2+(long)(b*NHEAD+h)*SEQ;
  { float*csf=(float*)(shm+LDS_CS); for(int i=tid;i<q0+QB;i+=NW*64)csf[i]=cg[i]; }
  const lds_cptr cs3=(lds_cptr)shm+LDS_CS+hi*16+t0*256;
  float nm=cg[q0+wid*QBLK+r32],l_reg=0.f;f32x16 o[2];o[0]=f32x16{};o[1]=f32x16{};
  const int qrel=wid*QBLK+r32;
  #define CMASK(P0,P1,t) do{int jb_=(t)-(NT-4); if(jb_>=0)cmask(P0,P1,jb_,qrel,hi);}while(0)
  bool resc=false;
  typedef float f32x4_t __attribute__((ext_vector_type(4)));
  #define BIAS(C0,C1,t) do{ const lds_cptr cp_=cs3+(t)*256; \
    _Pragma("unroll") for(int g_=0;g_<4;++g_){ const f32x4_t a_=*(const __attribute__((address_space(3))) f32x4_t*)(cp_+g_*32), b_=*(const __attribute__((address_space(3))) f32x4_t*)(cp_+g_*32+128); \
      _Pragma("unroll") for(int i_=0;i_<4;++i_){ C0[4*g_+i_]=nm-a_[i_]; C1[4*g_+i_]=nm-b_[i_]; } } }while(0)
  #define START(P0,P1) do{ const float rm=rowmax(P0,P1); resc=false; \
    { const float dl=(rm>(float)THRL)?rm:0.f;     \
      nm=fsub_s(nm,dl); \
      _Pragma("unroll") for(int r=0;r<16;++r){P0[r]=fsub_s(P0[r],dl);P1[r]=fsub_s(P1[r],dl);} } \
    _Pragma("unroll") for(int r=0;r<16;++r)P0[r]=__builtin_amdgcn_exp2f(P0[r]); }while(0)
  #define RESC() do{ if(resc){ asm volatile("s_waitcnt lgkmcnt(0)":::"memory"); \
      _Pragma("unroll") for(int d_=0;d_<2;++d_) _Pragma("unroll") for(int r=0;r<16;++r)o[d_][r]*=wsf[crow(r,hi)]; } }while(0)
  f32x16 pA0,pA1,pB0,pB1;
  int sl_prev=0,sl_cur=0,sl_next=SLOTB;
  #define ROT() do{sl_prev=sl_cur;sl_cur=sl_next;sl_next=(sl_next==(NSLOT-1)*SLOTB)?0:sl_next+SLOTB;}while(0)
  DMA_K(2,2*SLOTB);
  WAIT_BAR(3);
  BIAS(pA0,pA1,0); qkt(pA0,pA1,Kbase,qr,r32,hi);asm volatile("s_nop 15\n\ts_nop 7":"+v"(pA0),"+v"(pA1));CMASK(pA0,pA1,0);
  START(pA0,pA1);
  _Pragma("unroll") for(int r=0;r<16;++r)pA1[r]=__builtin_amdgcn_exp2f(pA1[r]);
  WAIT_BAR(0);
  DMA_K(3,0);DMA_V(1,SLOTB);
  ROT();
  kload8(kf,kp0+sl_cur);
  WAIT_BAR(2);
  s16x4 vlo[8],vhi[8]; u32x4 pw0,pw1,pw2,pw3;
  #define PKW(P,B) cvtpk_s(P[B],P[B+1])
  #define PAF(k) __builtin_bit_cast(bf16x8,pw##k)
  #define VFR(i) (bf16x8){vlo[i][0],vlo[i][1],vlo[i][2],vlo[i][3],vhi[i][0],vhi[i][1],vhi[i][2],vhi[i][3]}
  #define PIN(x) asm volatile("":"+v"(x))
  #define MX3(a,b,c) __builtin_fmaxf(__builtin_fmaxf((a),(b)),(c))
  #define GAPA(MF,A0,A1,A2,A3,W0,W1,PW) do{ MF; sacc+=A0; sacc+=A1; sacc+=A2; sacc+=A3; PIN(sacc); W0; W1; PIN(PW); SBAR(); }while(0)
  #define EX(v) __builtin_amdgcn_exp2f(v)
  #define GAPB(MF,X,B) do{ MF; X[B]=EX(X[B]); X[B+1]=EX(X[B+1]); X[B+2]=EX(X[B+2]); X[B+3]=EX(X[B+3]); PIN(X); SBAR(); }while(0)
  #define VRD(i) do{ vlo[i]=vtr(vp_+(((i)>>2)*4096+((i)&3)*1024)); vhi[i]=vtr(vp_+(((i)>>2)*4096+((i)&3)*1024+512)); }while(0)
  #define KRD(G,j) do{ if(G){ kload2(kf,kp0+sl_next,j); SBAR(); } }while(0)
  #define STEP(C0,C1,P0,P1,t,GK,GV,GL) do{ SBAR(); BIAS(C0,C1,t); SBAR(); \
    const lds_cptr vp_=vp0+sl_prev; \
    VRD(0); SBAR(); float sacc=(P0[0]+P0[1]); \
    GAPA(C0=__builtin_amdgcn_mfma_f32_32x32x16_bf16(kf[0],qr[0],C0,0,0,0), P0[2],P0[3],P0[4],P0[5],     pw0[0]=PKW(P0,0), pw0[1]=PKW(P0,2), pw0); \
    VRD(4); SBAR(); GAPA(C1=__builtin_amdgcn_mfma_f32_32x32x16_bf16(kf[1],qr[0],C1,0,0,0), P0[6],P0[7],P0[8],P0[9],     pw0[2]=PKW(P0,4), pw0[3]=PKW(P0,6), pw0); \
    VRD(1); SBAR(); GAPA(C0=__builtin_amdgcn_mfma_f32_32x32x16_bf16(kf[2],qr[1],C0,0,0,0),   P0[10],P0[11],P0[12],P0[13], pw1[0]=PKW(P0,8), pw1[1]=PKW(P0,10), pw1); \
    VRD(5); SBAR(); GAPA(C1=__builtin_amdgcn_mfma_f32_32x32x16_bf16(kf[3],qr[1],C1,0,0,0),   P0[14],P0[15],P1[0],P1[1],   pw1[2]=PKW(P0,12),pw1[3]=PKW(P0,14), pw1); \
    VRD(2); SBAR(); GAPA(C0=__builtin_amdgcn_mfma_f32_32x32x16_bf16(kf[4],qr[2],C0,0,0,0),   P1[2],P1[3],P1[4],P1[5],     pw2[0]=PKW(P1,0), pw2[1]=PKW(P1,2), pw2); \
    VRD(6); SBAR(); GAPA(C1=__builtin_amdgcn_mfma_f32_32x32x16_bf16(kf[5],qr[2],C1,0,0,0),   P1[6],P1[7],P1[8],P1[9],     pw2[2]=PKW(P1,4), pw2[3]=PKW(P1,6), pw2); \
    VRD(3); SBAR(); GAPA(C0=__builtin_amdgcn_mfma_f32_32x32x16_bf16(kf[6],qr[3],C0,0,0,0),   P1[10],P1[11],P1[12],P1[13], pw3[0]=PKW(P1,8), pw3[1]=PKW(P1,10), pw3); \
    VRD(7); SBAR(); GAPA(C1=__builtin_amdgcn_mfma_f32_32x32x16_bf16(kf[7],qr[3],C1,0,0,0),   P1[14],P1[15],0.f,0.f,       pw3[2]=PKW(P1,12),pw3[3]=PKW(P1,14), pw3); \
    l_reg+=sacc; \
    if(GK){DMA_K((t)+3,sl_cur);} if(GV){DMA_V((t)+1,sl_next);} \
    CMASK(C0,C1,t); \
    { float a=MX3(C0[0],C0[1],C1[0]),b=MX3(C0[2],C0[3],C1[1]); a=MX3(a,C1[2],C1[3]); \
      _Pragma("unroll") for(int r=4;r<16;r+=4){a=MX3(a,C0[r],C0[r+1]);b=MX3(b,C0[r+2],C0[r+3]);a=MX3(a,C1[r],C1[r+1]);b=MX3(b,C1[r+2],C1[r+3]);} \
      float rm=__builtin_fmaxf(a,b); { auto rr=__builtin_amdgcn_permlane32_swap(__float_as_uint(rm),__float_as_uint(rm),false,false); rm=__builtin_fmaxf(__uint_as_float(rr[0]),__uint_as_float(rr[1])); } \
      resc=false; \
      if(__builtin_expect(__any(rm>(float)THRL),0)){ const float dl=__builtin_fmaxf(rm,0.f); nm-=dl; \
        _Pragma("unroll") for(int r=0;r<16;++r){C0[r]-=dl;C1[r]-=dl;} \
        const float f=__builtin_amdgcn_exp2f(-dl); l_reg*=f; if(hi==0)wsf[r32]=f; resc=true; } } \
    SBAR(); \
    GAPB(o[0]=__builtin_amdgcn_mfma_f32_32x32x16_bf16(PAF(0),VFR(0),o[0],0,0,0), C0,0); \
    GAPB(o[1]=__builtin_amdgcn_mfma_f32_32x32x16_bf16(PAF(0),VFR(4),o[1],0,0,0), C0,4); \
    KRD(GL,0); GAPB(o[0]=__builtin_amdgcn_mfma_f32_32x32x16_bf16(PAF(1),VFR(1),o[0],0,0,0), C0,8); \
    KRD(GL,1); GAPB(o[1]=__builtin_amdgcn_mfma_f32_32x32x16_bf16(PAF(1),VFR(5),o[1],0,0,0), C0,12); \
    KRD(GL,2); GAPB(o[0]=__builtin_amdgcn_mfma_f32_32x32x16_bf16(PAF(2),VFR(2),o[0],0,0,0), C1,0); \
    KRD(GL,3); GAPB(o[1]=__builtin_amdgcn_mfma_f32_32x32x16_bf16(PAF(2),VFR(6),o[1],0,0,0), C1,4); \
    GAPB(o[0]=__builtin_amdgcn_mfma_f32_32x32x16_bf16(PAF(3),VFR(3),o[0],0,0,0), C1,8); \
    GAPB(o[1]=__builtin_amdgcn_mfma_f32_32x32x16_bf16(PAF(3),VFR(7),o[1],0,0,0), C1,12); \
    }while(0)
  int t=1;
  #undef CMASK
  #define CMASK(P0,P1,t) do{}while(0)
  for(;t+5<NT;t+=2){
    STEP(pB0,pB1,pA0,pA1,t,true,true,true);     WAIT_BAR(2); RESC(); ROT();
    STEP(pA0,pA1,pB0,pB1,t+1,true,true,true);   WAIT_BAR(2); RESC(); ROT();
  }
  #undef CMASK
  #define CMASK(P0,P1,t) do{int jb_=(t)-(NT-4); if(jb_>=0)cmask(P0,P1,jb_,qrel,hi);}while(0)
  #define ENDW(tt) do{ if((tt)+3<NT){WAIT_BAR(2);} else if((tt)+2<NT){WAIT_BAR(1);} else {WAIT_BAR(0);} }while(0)
  for(;t+1<NT;t+=2){
    STEP(pB0,pB1,pA0,pA1,t,(t+3<NT),(t+1<NT),(t+1<NT));       ENDW(t);   RESC(); ROT();
    STEP(pA0,pA1,pB0,pB1,t+1,(t+4<NT),(t+2<NT),(t+2<NT));     ENDW(t+1); RESC(); ROT();
  }
  STEP(pB0,pB1,pA0,pA1,NT-1,false,false,false); RESC();
  { float sacc=pB0[0]+pB0[1]; _Pragma("unroll") for(int r=2;r<16;++r)sacc+=pB0[r]; _Pragma("unroll") for(int r=0;r<16;++r)sacc+=pB1[r]; l_reg+=sacc;
    pw0=(u32x4){PKW(pB0,0),PKW(pB0,2),PKW(pB0,4),PKW(pB0,6)};pw1=(u32x4){PKW(pB0,8),PKW(pB0,10),PKW(pB0,12),PKW(pB0,14)};pw2=(u32x4){PKW(pB1,0),PKW(pB1,2),PKW(pB1,4),PKW(pB1,6)};pw3=(u32x4){PKW(pB1,8),PKW(pB1,10),PKW(pB1,12),PKW(pB1,14)};
    SBAR(); pv(o,vb0+sl_cur,PAF(0),PAF(1),PAF(2),PAF(3)); }
  #undef PKW
  #undef PAF
  #undef VFR
  #undef PIN
  #undef MX3
  #undef GAPA
  #undef GAPB
  #undef EX
  #undef VRD
  #undef KRD
  #undef STEP
  #undef ENDW
  {auto rr=__builtin_amdgcn_permlane32_swap(__float_as_uint(l_reg),__float_as_uint(l_reg),false,false);l_reg=__uint_as_float(rr[0])+__uint_as_float(rr[1]);}
  if(hi==0)wsf[32+r32]=l_reg;asm volatile("s_waitcnt lgkmcnt(0)":::"memory");
  float rli[16];
  #pragma unroll
  for(int r=0;r<16;++r)rli[r]=__builtin_amdgcn_rcpf(wsf[32+crow(r,hi)]);
  bf16*Ow=O+(rowbase+q0+wid*QBLK)*DM+h*D;
  { bf16*stg=(bf16*)(shm+LDS_OST)+wid*2048;
    #pragma unroll
    for(int r=0;r<16;++r){const int orow=crow(r,hi);
      #pragma unroll
      for(int d0=0;d0<2;++d0)stg[orow*64+d0*32+r32]=__float2bfloat16(o[d0][r]*rli[r]);}
    asm volatile("s_waitcnt lgkmcnt(0)":::"memory");
    #pragma unroll
    for(int i=0;i<4;++i){const int row=i*8+(lane>>3),ch=lane&7; const u32x4 v=*(const u32x4*)(stg+row*64+ch*8); ATTN_STORE16(Ow+(long)row*DM+ch*8,v);} }
  asm volatile("s_waitcnt lgkmcnt(0)\n\ts_barrier":::"memory");
  #undef DMA_K
  #undef DMA_V
  #undef CMASK
  #undef START
  #undef RESC
  #undef ROT
  #undef BIAS
}
constexpr int ATTN_LDS_BYTES=LDS_BYTES;
constexpr float SKIP_THR=64.0f;
__device__ __forceinline__ int attn_first_tile(const float*__restrict__ CL2,int bh,int qb){
  const int lane=threadIdx.x&63; const float*c=CL2+(long)bh*SEQ; const int q0=qb*QB, nfar=4*qb;
  const float cq=c[q0]; const float cj=c[(lane<nfar?lane:0)*KVBLK+KVBLK-1];
  const unsigned long long keep=__ballot(lane<nfar && (cq-cj)>=-SKIP_THR) | (1ull<<nfar);
  const int t0=__builtin_ctzll(keep)&~1;
  return __builtin_amdgcn_readfirstlane(t0);
}
struct AttnTensors { const bf16* Q; const bf16* K; const bf16* V; bf16* O; const float* CL2; };
struct AttnUnit { int bh; int qb; };
struct StaticOrder {
  int vcu;
  __device__ __forceinline__ explicit StaticOrder(int grid,int block):vcu((block%8)*(grid/8)+block/8){}
  __device__ __forceinline__ bool next(int i,AttnUnit&u)const{ if(i>=2||vcu>=BATCH*NHEAD*4)return false; const int s=vcu&3; u.bh=vcu>>2; u.qb=(i==0)?s:7-s; return true; }
  __device__ __forceinline__ void a_ready(const AttnUnit&)const{}
  __device__ __forceinline__ void done(const AttnUnit&)const{}
};
template<class Sched,int THRL=8> __device__ __forceinline__ void attn_phase(char*lds,const AttnTensors&T,const Sched&S){
  AttnUnit u;
  for(int i=0;S.next(i,u);++i){ S.a_ready(u); attn_unit<THRL>(u.bh/NHEAD,u.bh%NHEAD,u.qb,T.Q,T.K,T.V,T.O,T.CL2,lds); S.done(u); }
}
#undef SBAR
#undef WAIT_BAR
}
namespace sgu_body {
using attn_body::bf16x8; using attn_body::s16x4; using attn_body::f32x16; using attn_body::u32x4; using attn_body::lds_cptr; using attn_body::vtr;
constexpr int SGU_LDS_BYTES = 65536;
__device__ __forceinline__ float bflo(unsigned w) { return __uint_as_float(w << 16); }
__device__ __forceinline__ float bfhi(unsigned w) { return __uint_as_float(w & 0xffff0000u); }
__device__ __forceinline__ void sgu_unit(int ck, int half, const unsigned short* __restrict__ VG, const unsigned short* UGI, unsigned short* UGY, const unsigned short* __restrict__ WSMP,
                                         const float* __restrict__ lng, const float* __restrict__ lnb, const float* __restrict__ bs, char* shm) {
    int tid = threadIdx.x; asm volatile("" : "+v"(tid)); const int lane = tid & 63, r32 = lane & 31, hi = lane >> 5; const int wid = __builtin_amdgcn_readfirstlane(tid >> 6);
    const size_t row0 = (size_t)ck * 128;
    u32x4 raw[16];
#pragma unroll
    for (int i = 0; i < 16; ++i) raw[i] = *(const u32x4*)(VG + (row0 + 16 * wid + i) * 512 + 8 * lane);
    float mu[16], rs[16];
#pragma unroll
    for (int i = 0; i < 16; ++i) {
        const float a0 = bflo(raw[i].x), a1 = bfhi(raw[i].x), a2 = bflo(raw[i].y), a3 = bfhi(raw[i].y), a4 = bflo(raw[i].z), a5 = bfhi(raw[i].z), a6 = bflo(raw[i].w), a7 = bfhi(raw[i].w);
        float s = ((a0 + a1) + (a2 + a3)) + ((a4 + a5) + (a6 + a7));
        float q = ((a0 * a0 + a1 * a1) + (a2 * a2 + a3 * a3)) + ((a4 * a4 + a5 * a5) + (a6 * a6 + a7 * a7));
        s = wave_allsum(s); q = wave_allsum(q);
        const float m = s * (1.0f / 512.0f); const float var = fmaxf(q * (1.0f / 512.0f) - m * m, 0.f);
        mu[i] = m; rs[i] = 1.0f / sqrtf(var + 1e-6f);
    }
    if ((lane >> 5) == half) {
        const int gl = (lane >> 3) & 3, cc = 8 * (lane & 7);
        float gv[8], bv[8];
#pragma unroll
        for (int j = 0; j < 8; ++j) { gv[j] = lng[8 * lane + j]; bv[j] = lnb[8 * lane + j]; }
        char* img = shm + gl * 16384 + (cc >> 5) * 4096 + (cc & 31) * 2;
#pragma unroll
        for (int i = 0; i < 16; ++i) {
            const int s = 16 * wid + i;
            const float m = mu[i], r = rs[i];
            const float v0 = (bflo(raw[i].x) - m) * r * gv[0] + bv[0], v1 = (bfhi(raw[i].x) - m) * r * gv[1] + bv[1], v2 = (bflo(raw[i].y) - m) * r * gv[2] + bv[2], v3 = (bfhi(raw[i].y) - m) * r * gv[3] + bv[3];
            const float v4 = (bflo(raw[i].z) - m) * r * gv[4] + bv[4], v5 = (bfhi(raw[i].z) - m) * r * gv[5] + bv[5], v6 = (bflo(raw[i].w) - m) * r * gv[6] + bv[6], v7 = (bfhi(raw[i].w) - m) * r * gv[7] + bv[7];
            u32x4 w; w.x = pg8::cvt_pk_bf16(v0, v1); w.y = pg8::cvt_pk_bf16(v2, v3); w.z = pg8::cvt_pk_bf16(v4, v5); w.w = pg8::cvt_pk_bf16(v6, v7);
            *(u32x4*)(img + (s >> 6) * 8192 + ((s & 63) >> 4) * 1024 + (s & 15) * 64) = w;
        }
    }
    typedef unsigned u32x2_t __attribute__((ext_vector_type(2)));
    const int gl4 = wid >> 1, cb4 = wid & 1, g4 = 4 * half + gl4;
    bf16x8 wf[20]; u32x2_t ugq[4][4]; float bsq[4];
#pragma unroll
    for (int tb = 0; tb < 4; ++tb) {
        const unsigned short* wrow = WSMP + ((size_t)(g4 * 128 + 32 * tb + r32)) * 128 + 8 * hi;
#pragma unroll
        for (int ks = 0; ks < 2 * (tb + 1); ++ks) wf[tb * (tb + 1) + ks] = *(const bf16x8*)(wrow + 16 * ks);
        const int t = 32 * tb + r32; bsq[tb] = bs[g4 * 128 + t];
        const unsigned short* urow = UGI + (row0 + t) * 512 + g4 * 64 + 32 * cb4 + 4 * hi;
#pragma unroll
        for (int q4 = 0; q4 < 4; ++q4) ugq[tb][q4] = *(const u32x2_t*)(urow + 8 * q4);
    }
    __syncthreads();
    {
        const int gl = gl4, cb = cb4, g = g4;
        const lds_cptr vp = (lds_cptr)shm + gl * 16384 + cb * 4096 + ((lane >> 4) & 1) * 32 + (lane & 3) * 8 + (4 * hi + ((lane & 15) >> 2)) * 64;
#pragma unroll
        for (int tb = 0; tb < 4; ++tb) {
            f32x16 acc = f32x16{};
#pragma unroll
            for (int ks = 0; ks < 2 * (tb + 1); ++ks) {
                const s16x4 lo = vtr(vp + (ks >> 2) * 8192 + (ks & 3) * 1024), hh = vtr(vp + (ks >> 2) * 8192 + (ks & 3) * 1024 + 512);
                const bf16x8 a = (bf16x8){lo[0], lo[1], lo[2], lo[3], hh[0], hh[1], hh[2], hh[3]};
                acc = __builtin_amdgcn_mfma_f32_32x32x16_bf16(a, wf[tb * (tb + 1) + ks], acc, 0, 0, 0);
            }
            const int t = 32 * tb + r32; const float bsv = bsq[tb];
            unsigned short* yrow = UGY + (row0 + t) * 512 + g * 64 + 32 * cb + 4 * hi;
#pragma unroll
            for (int q4 = 0; q4 < 4; ++q4) {
                const u32x2_t ug = ugq[tb][q4];
                const float y0 = bflo(ug.x) * (acc[4 * q4 + 0] + bsv), y1 = bfhi(ug.x) * (acc[4 * q4 + 1] + bsv), y2 = bflo(ug.y) * (acc[4 * q4 + 2] + bsv), y3 = bfhi(ug.y) * (acc[4 * q4 + 3] + bsv);
                u32x2_t w; w.x = pg8::cvt_pk_bf16(y0, y1); w.y = pg8::cvt_pk_bf16(y2, y3);
                *(u32x2_t*)(yrow + 8 * q4) = w;
            }
        }
    }
    __syncthreads();
}
}
namespace peer_body {
using attn_body::bf16x8; using attn_body::f32x16; using attn_body::u32x4;
typedef __bf16 bf16x2_t __attribute__((ext_vector_type(2)));
constexpr int PEER_TOK = 64;
constexpr int L_PI = 0, L_PG = 32768, L_PS = 65536, PEER_LDS_BYTES = 98304;
__device__ __forceinline__ int okey(int b) { return b ^ ((b >> 31) & 0x7fffffff); }
__device__ __forceinline__ void ce(int& a, int& b) { const int hi = a > b ? a : b, lo = a > b ? b : a; a = hi; b = lo; }
__device__ __forceinline__ void sort16(int (&v)[16]) {
#pragma unroll
    for (int k = 2; k <= 16; k <<= 1)
#pragma unroll
        for (int j = k >> 1; j > 0; j >>= 1)
#pragma unroll
            for (int i = 0; i < 16; ++i) { const int l = i ^ j; if (l > i) { if ((i & k) == 0) ce(v[i], v[l]); else ce(v[l], v[i]); } }
}
__device__ __forceinline__ void merge16(int (&a)[16], const int (&b)[16]) {
#pragma unroll
    for (int i = 0; i < 16; ++i) a[i] = a[i] > b[15 - i] ? a[i] : b[15 - i];
#pragma unroll
    for (int j = 8; j > 0; j >>= 1)
#pragma unroll
        for (int i = 0; i < 16; ++i) { const int l = i ^ j; if (l > i) ce(a[i], a[l]); }
}
__device__ __forceinline__ float dot2(unsigned w, unsigned x, float acc) { return __builtin_amdgcn_fdot2_f32_bf16(__builtin_bit_cast(bf16x2_t, w), __builtin_bit_cast(bf16x2_t, x), acc, false); }
__device__ __forceinline__ float gelu_erf(float v) { return 0.5f * v * (1.0f + erff(v * 0.70710678118654752f)); }

constexpr int SK_PITCH = 272;
__device__ __forceinline__ void top16_scores(int (&res)[16], const bf16x8 (&bq)[8], const char* SKl, int r32, int hi) {
    f32x16 acc[4];
#pragma unroll
    for (int nb = 0; nb < 4; ++nb) acc[nb] = f32x16{};
#pragma unroll
    for (int ks = 0; ks < 8; ++ks) {
#pragma unroll
        for (int nb = 0; nb < 4; ++nb) { const bf16x8 a = *(const bf16x8*)(SKl + (32 * nb + r32) * SK_PITCH + (16 * ks + 8 * hi) * 2);
            acc[nb] = __builtin_amdgcn_mfma_f32_32x32x16_bf16(a, bq[ks], acc[nb], 0, 0, 0); }
        if (ks & 1) __builtin_amdgcn_sched_barrier(0);
    }
    int k[4][16];
#pragma unroll
    for (int nb = 0; nb < 4; ++nb) {
#pragma unroll
        for (int r = 0; r < 16; ++r) { const int n = 32 * nb + (r & 3) + 8 * (r >> 2) + 4 * hi; k[nb][r] = okey((int)((__float_as_uint(acc[nb][r]) & ~0x7fu) | (unsigned)n)); }
        sort16(k[nb]);
    }
    merge16(k[0], k[1]); merge16(k[2], k[3]); merge16(k[0], k[2]);
    int lo[16], up[16];
#pragma unroll
    for (int i = 0; i < 16; ++i) { const auto rr = __builtin_amdgcn_permlane32_swap((unsigned)k[0][i], (unsigned)k[0][i], false, false); lo[i] = (int)rr[0]; up[i] = (int)rr[1]; }
    merge16(lo, up);
#pragma unroll
    for (int i = 0; i < 16; ++i) res[i] = lo[i];
}

__device__ __forceinline__ unsigned pack_i8x4(float a, float b, float c, float d) {
    const int ia = (int)__builtin_rintf(a), ib = (int)__builtin_rintf(b), ic = (int)__builtin_rintf(c), id = (int)__builtin_rintf(d);
    return (unsigned)(ia & 0xff) | ((unsigned)(ib & 0xff) << 8) | ((unsigned)(ic & 0xff) << 16) | ((unsigned)(id & 0xff) << 24);
}
typedef float f32x2_t __attribute__((ext_vector_type(2)));
typedef unsigned u32x2_t __attribute__((ext_vector_type(2)));
__device__ __forceinline__ void fma_fp8x4(f32x2_t& a01, f32x2_t& a23, unsigned v, f32x2_t w2) {
    const f32x2_t lo = __builtin_amdgcn_cvt_pk_f32_fp8((int)v, false), hi = __builtin_amdgcn_cvt_pk_f32_fp8((int)v, true);
    a01 = __builtin_elementwise_fma(lo, w2, a01); a23 = __builtin_elementwise_fma(hi, w2, a23);
}
template <int CTRL> __device__ __forceinline__ int dppi(int v) { return __builtin_amdgcn_update_dpp(0, v, CTRL, 0xf, 0xf, false); }
template <int CTRL> __device__ __forceinline__ float dppf(float v) { return __int_as_float(__builtin_amdgcn_update_dpp(0, __float_as_int(v), CTRL, 0xf, 0xf, false)); }
constexpr int DPP_HMIRROR = 0x141, DPP_XOR2 = 0x4E, DPP_XOR1 = 0xB1, DPP_ROR8 = 0x128;

__device__ __forceinline__ void peer_retrieve(int tk, const unsigned short* __restrict__ QP, const unsigned short* __restrict__ SK, const float* __restrict__ SU, const float* __restrict__ SV,
                                              const float* __restrict__ ST, unsigned short* __restrict__ PID, float* __restrict__ G2, float* __restrict__ PS2, char* shm) {
    int tid = threadIdx.x; asm volatile("" : "+v"(tid)); const int lane = tid & 63, r32 = lane & 31, hi = lane >> 5; const int wid = __builtin_amdgcn_readfirstlane(tid >> 6);
    const int h = tk & 7, T0 = (tk >> 3) * 512 + 64 * wid;
    {   const u32x4* src = (const u32x4*)(SK + (size_t)h * 2 * 128 * 128);
#pragma unroll
        for (int i = 0; i < 8; ++i) { const int c = tid + 512 * i, row = c >> 4, ch = c & 15; *(u32x4*)(shm + row * SK_PITCH + ch * 16) = src[c]; }
    }
    __syncthreads();
#pragma unroll 1
    for (int tb = 0; tb < 2; ++tb) {
        const unsigned short* QPt = QP + (size_t)(T0 + 32 * tb) * 2048 + h * 256;
        int A[16], B[16];
        bf16x8 bqa[8], bqb[8];
#pragma unroll
        for (int ks = 0; ks < 8; ++ks) { bqa[ks] = *(const bf16x8*)(QPt + (size_t)r32 * 2048 + 16 * ks + 8 * hi); bqb[ks] = *(const bf16x8*)(QPt + 128 + (size_t)r32 * 2048 + 16 * ks + 8 * hi); }
        top16_scores(A, bqa, shm, r32, hi);
        top16_scores(B, bqb, shm + 128 * SK_PITCH, r32, hi);
        float fa[16], fb[16]; int na[16], nb[16];
#pragma unroll
        for (int i = 0; i < 16; ++i) { const int ba = okey(A[i]), bb = okey(B[i]); fa[i] = __int_as_float(ba); fb[i] = __int_as_float(bb); na[i] = (ba & 0x7f) << 7; nb[i] = bb & 0x7f; }
#define CAND(i, j) okey((int)((__float_as_uint(fa[i] + fb[j]) & ~0x3fffu) | (unsigned)(na[i] | nb[j])))
        const int NEGK = (int)0x80000000;
        int L0[16], L1[16], L2[16], L3[16];
#pragma unroll
        for (int j = 0; j < 16; ++j) L0[j] = CAND(0, j);
#pragma unroll
        for (int j = 0; j < 8; ++j) L1[j] = CAND(1, j);
#pragma unroll
        for (int j = 0; j < 5; ++j) L1[8 + j] = CAND(2, j);
#pragma unroll
        for (int j = 0; j < 3; ++j) L1[13 + j] = CAND(3, j);
        L2[0] = CAND(3, 3);
#pragma unroll
        for (int j = 0; j < 3; ++j) L2[1 + j] = CAND(4, j);
#pragma unroll
        for (int j = 0; j < 2; ++j) { L2[4 + j] = CAND(5, j); L2[6 + j] = CAND(6, j); L2[8 + j] = CAND(7, j); }
#pragma unroll
        for (int i = 8; i < 14; ++i) L2[2 + i] = CAND(i, 0);
        L3[0] = CAND(14, 0); L3[1] = CAND(15, 0);
#pragma unroll
        for (int i = 2; i < 16; ++i) L3[i] = NEGK;
#undef CAND
        sort16(L1); sort16(L2); sort16(L3);
        merge16(L0, L1); merge16(L2, L3); merge16(L0, L2);
        float e[16]; int id[16]; float se = 0.f;
        const float s0 = __int_as_float((okey(L0[0]) & ~0x3fff) | 0x2000);
#pragma unroll
        for (int i = 0; i < 16; ++i) { const int b = okey(L0[i]); id[i] = b & 0x3fff; const float s = __int_as_float((b & ~0x3fff) | 0x2000); e[i] = __expf(s - s0); se += e[i]; }
        const float inv = 1.0f / se;
        if (hi == 0) {
            const size_t t = (size_t)(T0 + 32 * tb + r32); const float st = ST[t];
            unsigned short* pi = PID + t * 128 + h * 16; float* pg = G2 + t * 128 + h * 16; float* ps = PS2 + t * 128 + h * 16;
            u32x4 w0, w1;
            w0.x = (unsigned)id[0] | ((unsigned)id[1] << 16); w0.y = (unsigned)id[2] | ((unsigned)id[3] << 16); w0.z = (unsigned)id[4] | ((unsigned)id[5] << 16); w0.w = (unsigned)id[6] | ((unsigned)id[7] << 16);
            w1.x = (unsigned)id[8] | ((unsigned)id[9] << 16); w1.y = (unsigned)id[10] | ((unsigned)id[11] << 16); w1.z = (unsigned)id[12] | ((unsigned)id[13] << 16); w1.w = (unsigned)id[14] | ((unsigned)id[15] << 16);
            *(u32x4*)pi = w0; *(u32x4*)(pi + 8) = w1;
            float sv[16], su[16];
#pragma unroll
            for (int i = 0; i < 16; ++i) { sv[i] = SV[id[i]]; su[i] = SU[id[i]]; }
            asm volatile("" ::: "memory");
#pragma unroll
            for (int i = 0; i < 16; i += 4) {
                *(float4*)(pg + i) = make_float4(e[i] * inv * sv[i], e[i + 1] * inv * sv[i + 1], e[i + 2] * inv * sv[i + 2], e[i + 3] * inv * sv[i + 3]);
                *(float4*)(ps + i) = make_float4(su[i] * st, su[i + 1] * st, su[i + 2] * st, su[i + 3] * st); }
        }
    }
    __syncthreads();
}

constexpr int WL_STRIDE = 19712, WL_Y = 3328, PEER_FUSED_LDS = 8 * WL_STRIDE;
__device__ __forceinline__ void peer_fused(int p, int wq, int nwq, const unsigned short* __restrict__ PID, const float* __restrict__ G2, const float* __restrict__ PS2, const unsigned char* __restrict__ H2Q,
                                           const unsigned char* __restrict__ EU8, const unsigned char* __restrict__ EV8, float* X, const float* __restrict__ gfin, char* shm, float oscale) {
    int tid = threadIdx.x; asm volatile("" : "+v"(tid)); const int lane = tid & 63, g = lane >> 3, r = lane & 7; const int wid = __builtin_amdgcn_readfirstlane(tid >> 6);
    char* wl = shm + wid * WL_STRIDE;
    int2* aul = (int2*)(wl + WL_Y) + lane; unsigned* yl = (unsigned*)(wl + WL_Y) + lane; float* swl = (float*)(wl + 3072);
    const int k0 = 8 * (r >> 2) + 4 * ((r >> 1) & 1) + 2 * (r & 1);
    const int e0 = 8 * ((g >> 2) & 1) + 4 * ((g >> 1) & 1) + 2 * (g & 1);
    constexpr size_t SLICE = (size_t)16384 * 128;
#define FIDS(i, I0, I1) do { const u32x4* ip_ = (const u32x4*)(wl + (i) * 256 + 32 * g); I0 = ip_[0]; I1 = ip_[1]; } while (0)
#define FLOAD(R, base, I0, I1) do { _Pragma("unroll") for (int k_ = 0; k_ < 16; ++k_) { const unsigned w_ = (k_ < 8) ? I0[k_ >> 1] : I1[(k_ - 8) >> 1]; const unsigned e_ = (k_ & 1) ? (w_ >> 16) : (w_ & 0xffffu); \
        R[k_] = *(const u32x4*)((base) + (size_t)e_ * 128); } } while (0)
#define FUMATH(R, HQ, ACC) do { int s[16]; \
        _Pragma("unroll") for (int k_ = 0; k_ < 16; ++k_) { int d_ = __builtin_amdgcn_sdot4((int)R[k_].x, (int)HQ.x, 0, false); d_ = __builtin_amdgcn_sdot4((int)R[k_].y, (int)HQ.y, d_, false); \
            d_ = __builtin_amdgcn_sdot4((int)R[k_].z, (int)HQ.z, d_, false); d_ = __builtin_amdgcn_sdot4((int)R[k_].w, (int)HQ.w, d_, false); s[k_] = d_; } \
        _Pragma("unroll") for (int h_ = 0; h_ < 8; ++h_) { const int t1 = s[h_] + dppi<DPP_HMIRROR>(s[h_]), t2 = s[h_ + 8] + dppi<DPP_HMIRROR>(s[h_ + 8]); s[h_] = (r & 4) ? t2 : t1; } \
        _Pragma("unroll") for (int h_ = 0; h_ < 4; ++h_) { const int t1 = s[h_] + dppi<DPP_XOR2>(s[h_]), t2 = s[h_ + 4] + dppi<DPP_XOR2>(s[h_ + 4]); s[h_] = (r & 2) ? t2 : t1; } \
        _Pragma("unroll") for (int h_ = 0; h_ < 2; ++h_) { const int t1 = s[h_] + dppi<DPP_XOR1>(s[h_]), t2 = s[h_ + 2] + dppi<DPP_XOR1>(s[h_ + 2]); s[h_] = (r & 1) ? t2 : t1; } \
        { const int2 o_ = ACC; ACC = make_int2(o_.x + s[0], o_.y + s[1]); } } while (0)
#define FVMATH(R, W, XV, SWV, YP) do { int acc[16]; _Pragma("unroll") for (int i_ = 0; i_ < 16; ++i_) acc[i_] = 0; \
        _Pragma("unroll") for (int m_ = 0; m_ < 4; ++m_) { const int wm_ = (int)W[m_]; \
            _Pragma("unroll") for (int c_ = 0; c_ < 4; ++c_) { \
                const unsigned r0_ = R[4 * m_ + 0][c_], r1_ = R[4 * m_ + 1][c_], r2_ = R[4 * m_ + 2][c_], r3_ = R[4 * m_ + 3][c_]; \
                const unsigned t0_ = __builtin_amdgcn_perm(r1_, r0_, 0x05010400u), t1_ = __builtin_amdgcn_perm(r1_, r0_, 0x07030602u); \
                const unsigned t2_ = __builtin_amdgcn_perm(r3_, r2_, 0x05010400u), t3_ = __builtin_amdgcn_perm(r3_, r2_, 0x07030602u); \
                acc[4 * c_ + 0] = __builtin_amdgcn_sdot4((int)__builtin_amdgcn_perm(t2_, t0_, 0x05040100u), wm_, acc[4 * c_ + 0], false); \
                acc[4 * c_ + 1] = __builtin_amdgcn_sdot4((int)__builtin_amdgcn_perm(t2_, t0_, 0x07060302u), wm_, acc[4 * c_ + 1], false); \
                acc[4 * c_ + 2] = __builtin_amdgcn_sdot4((int)__builtin_amdgcn_perm(t3_, t1_, 0x05040100u), wm_, acc[4 * c_ + 2], false); \
                acc[4 * c_ + 3] = __builtin_amdgcn_sdot4((int)__builtin_amdgcn_perm(t3_, t1_, 0x07060302u), wm_, acc[4 * c_ + 3], false); } } \
          \
        _Pragma("unroll") for (int h_ = 0; h_ < 8; ++h_) { const auto sw_ = __builtin_amdgcn_permlane32_swap((unsigned)acc[h_], (unsigned)acc[h_ + 8], false, false); acc[h_] = (int)sw_[0] + (int)sw_[1]; } \
        _Pragma("unroll") for (int h_ = 0; h_ < 4; ++h_) { const auto sw_ = __builtin_amdgcn_permlane16_swap((unsigned)acc[h_], (unsigned)acc[h_ + 4], false, false); acc[h_] = (int)sw_[0] + (int)sw_[1]; } \
        _Pragma("unroll") for (int h_ = 0; h_ < 2; ++h_) { const int t1 = acc[h_] + dppi<DPP_ROR8>(acc[h_]), t2 = acc[h_ + 2] + dppi<DPP_ROR8>(acc[h_ + 2]); acc[h_] = (lane & 8) ? t2 : t1; } \
        const float2 xv = XV; *(YP) = pg8::cvt_pk_bf16(xv.x + SWV * (float)acc[0], xv.y + SWV * (float)acc[1]); } while (0)
    const int TEND = (p + 1) * (M / 8);
#pragma unroll 1
    for (int tb = p * (M / 8) + wq; tb < TEND; tb += 8 * nwq) {
#define TOK(i) ((tb + (i) * nwq) < TEND ? (tb + (i) * nwq) : tb)
#pragma unroll
        for (int i = 0; i < 8; ++i) ((unsigned*)(wl + i * 256))[lane] = ((const unsigned*)(PID + (size_t)TOK(i) * 128))[lane];
#pragma unroll
        for (int i = 0; i < 8; ++i) aul[64 * i] = make_int2(0, 0);
        {
            u32x4 RA[16], RB[16], i0, i1, hqa, hqb;
            { const int sl = p & 7; FIDS(0, i0, i1); hqa = *(const u32x4*)(H2Q + ((size_t)sl * M + TOK(0)) * 128 + r * 16); FLOAD(RA, EU8 + sl * SLICE + r * 16, i0, i1); }
#pragma unroll 1
            for (int st = 0; st < 8; ++st) {
                const int sl = (p + st) & 7, sln = (p + st + 1) & 7; const unsigned char* ub = EU8 + sl * SLICE + r * 16; const unsigned char* hb = H2Q + (size_t)sl * M * 128 + r * 16;
#pragma unroll 1
                for (int i = 0; i < 8; i += 2) {
                    FIDS(i + 1, i0, i1); hqb = *(const u32x4*)(hb + (size_t)TOK(i + 1) * 128); FLOAD(RB, ub, i0, i1);
                    FUMATH(RA, hqa, aul[64 * i]);
                    {
                        const bool last = (i == 6); const int in_ = last ? 0 : i + 2; const int sx = last ? sln : sl;
                        FIDS(in_, i0, i1); hqa = *(const u32x4*)(H2Q + ((size_t)sx * M + TOK(in_)) * 128 + r * 16); FLOAD(RA, EU8 + sx * SLICE + r * 16, i0, i1); }
                    FUMATH(RB, hqb, aul[64 * (i + 1)]);
                }
            }
        }
        float2 g2q[8], psq[8];
#pragma unroll
        for (int i = 0; i < 8; ++i) { const size_t o = (size_t)TOK(i) * 128 + 16 * g + k0; g2q[i] = *(const float2*)(G2 + o); psq[i] = *(const float2*)(PS2 + o); }
#pragma unroll
        for (int i = 0; i < 8; ++i) {
            const float2 g2 = g2q[i], ps = psq[i]; const int2 av = aul[64 * i];
            const float w0 = g2.x * gelu_erf((float)av.x * ps.x), w1 = g2.y * gelu_erf((float)av.y * ps.y);
            float am = fmaxf(fabsf(w0), fabsf(w1));
            am = wave_allmax(am);
            const float qs = am > 0.f ? 127.0f / am : 0.f; if (lane == 0) swl[i] = am * (1.0f / 127.0f);
            const int b0 = (int)__builtin_rintf(w0 * qs) & 0xff, b1 = (int)__builtin_rintf(w1 * qs) & 0xff;
            *(unsigned short*)(wl + 2048 + i * 128 + 16 * g + k0) = (unsigned short)(b0 | (b1 << 8));
        }
        {
            u32x4 RA[16], RB[16], i0, i1; float2 xva, xvb;
            { const int sl = p & 7; FIDS(0, i0, i1); xva = *(const float2*)(X + (size_t)TOK(0) * 1024 + sl * 128 + 16 * r + e0); FLOAD(RA, EV8 + sl * SLICE + r * 16, i0, i1); }
#pragma unroll 1
            for (int st = 0; st < 8; ++st) {
                const int sl = (p + st) & 7, sln = (p + st + 1) & 7; const unsigned char* vb = EV8 + sl * SLICE + r * 16; const float* xb = X + sl * 128 + 16 * r + e0; unsigned* yb = yl + sl * 64;
#pragma unroll 1
                for (int i = 0; i < 8; i += 2) {
                    FIDS(i + 1, i0, i1); xvb = *(const float2*)(xb + (size_t)TOK(i + 1) * 1024); FLOAD(RB, vb, i0, i1);
                    { const u32x4 wv = *(const u32x4*)(wl + 2048 + i * 128 + 16 * g); const float sw_ = swl[i]; FVMATH(RA, wv, xva, sw_, yb + i * 512); }
                    { const bool last = (i == 6); const int in_ = last ? 0 : i + 2; const int sx = last ? sln : sl; FIDS(in_, i0, i1); xva = *(const float2*)(X + (size_t)TOK(in_) * 1024 + sx * 128 + 16 * r + e0); FLOAD(RA, EV8 + sx * SLICE + r * 16, i0, i1); }
                    { const u32x4 wv = *(const u32x4*)(wl + 2048 + (i + 1) * 128 + 16 * g); const float sw_ = swl[i + 1]; FVMATH(RB, wv, xvb, sw_, yb + (i + 1) * 512); }
                }
            }
        }
        float2 gg[8];
#pragma unroll
        for (int sl = 0; sl < 8; ++sl) gg[sl] = *(const float2*)(gfin + sl * 128 + 16 * r + e0);
#pragma unroll 1
        for (int i = 0; i < 8; i += 2) {
            unsigned ya[8], yb[8]; float sa = 0.f, sb = 0.f;
#pragma unroll
            for (int sl = 0; sl < 8; ++sl) { ya[sl] = yl[(i * 8 + sl) * 64]; yb[sl] = yl[((i + 1) * 8 + sl) * 64]; }
#pragma unroll
            for (int sl = 0; sl < 8; ++sl) { const float a0 = __uint_as_float(ya[sl] << 16), a1 = __uint_as_float(ya[sl] & 0xffff0000u), b0 = __uint_as_float(yb[sl] << 16), b1 = __uint_as_float(yb[sl] & 0xffff0000u);
                sa += a0 * a0 + a1 * a1; sb += b0 * b0 + b1 * b1; }
            const float rr0 = oscale / sqrtf(wave_allsum(sa) * (1.0f / 1024.0f) + 1e-6f), rr1 = oscale / sqrtf(wave_allsum(sb) * (1.0f / 1024.0f) + 1e-6f);
            const bool v0 = (tb + i * nwq) < TEND, v1 = (tb + (i + 1) * nwq) < TEND;
            float* xr0 = X + (size_t)TOK(i) * 1024 + 16 * r + e0; float* xr1 = X + (size_t)TOK(i + 1) * 1024 + 16 * r + e0;
#pragma unroll
            for (int sl = 0; sl < 8; ++sl) {
                if (v0) *(float2*)(xr0 + sl * 128) = make_float2(__uint_as_float(ya[sl] << 16) * rr0 * gg[sl].x, __uint_as_float(ya[sl] & 0xffff0000u) * rr0 * gg[sl].y);
                if (v1) *(float2*)(xr1 + sl * 128) = make_float2(__uint_as_float(yb[sl] << 16) * rr1 * gg[sl].x, __uint_as_float(yb[sl] & 0xffff0000u) * rr1 * gg[sl].y); }
        }
#undef TOK
    }
#undef FIDS
#undef FLOAD
#undef FUMATH
#undef FVMATH
}
}
#define GAS __attribute__((address_space(1)))
#define LAS __attribute__((address_space(3)))
typedef unsigned short bf16;
typedef unsigned v4u __attribute__((ext_vector_type(4)));
typedef float f32x4 __attribute__((ext_vector_type(4)));
typedef short bf16x8 __attribute__((ext_vector_type(8)));
typedef GAS unsigned gu32;
typedef GAS unsigned long long gu64;
#define RLX_AGENT __ATOMIC_RELAXED, __HIP_MEMORY_SCOPE_AGENT
#define LDS_WAIT() asm volatile("s_waitcnt lgkmcnt(0)" ::: "memory")
#define VM_WAIT() asm volatile("s_waitcnt vmcnt(0)" ::: "memory")
__device__ __forceinline__ unsigned long long rt() { return __builtin_amdgcn_s_memrealtime(); }
__device__ __forceinline__ unsigned f2bf(float f) { unsigned u = __builtin_bit_cast(unsigned, f); return (u + 0x7fffu + ((u >> 16) & 1u)) >> 16; }
__device__ __forceinline__ unsigned pk2(float lo, float hi) { return f2bf(lo) | (f2bf(hi) << 16); }

#define XB_TMO      128
#define XB_XCNT(j)  (256  + 64 * (j))
#define XB_XSUB(j)  (1280 + 64 * (j))
#define XB_XGEN(j)  (2304 + 64 * (j))
#define XB_TOP      3328
#define XB_TOPGEN   3392
#define XCD_BAR_WORDS 3456
#define XB_SPIN_CAP (1u << 18)

__device__ __forceinline__ unsigned xb_ld(unsigned* p)              { return __hip_atomic_load(p, __ATOMIC_RELAXED, __HIP_MEMORY_SCOPE_AGENT); }
__device__ __forceinline__ unsigned xb_add(unsigned* p, unsigned v) { return __hip_atomic_fetch_add(p, v, __ATOMIC_RELAXED, __HIP_MEMORY_SCOPE_AGENT); }
__device__ __forceinline__ unsigned xb_xcc_id() { return (unsigned)__builtin_amdgcn_s_getreg((3 << 11) | 20) & 0xFu; }
#define XB_SPIN(cond, bar) do { unsigned _sp = 0; while (cond) { __builtin_amdgcn_s_sleep(1); \
    if ((++_sp & 255u) == 0u) { if (xb_ld(&(bar)[XB_TMO])) break; if (_sp > XB_SPIN_CAP) { atomicAdd(&(bar)[XB_TMO], 1u); break; } } } } while (0)

struct XcdBarrier {
    unsigned* bar; unsigned x;
    volatile LAS unsigned* st;
};

__device__ __forceinline__ XcdBarrier xcd_barrier_post(unsigned* bar, volatile LAS unsigned* st) {
    XcdBarrier b; b.bar = bar; b.x = xb_xcc_id(); b.st = st;
    if (threadIdx.x == 0) (void)xb_add(&bar[XB_XCNT(b.x)], 1u);
    return b;
}
__device__ __forceinline__ void xcd_barrier_complete(unsigned* bar, unsigned x, unsigned& nloc, unsigned& nx) {
    const unsigned G = gridDim.x * gridDim.y * gridDim.z;
    unsigned sum, cnt, mine, sp = 0u;
    for (;;) {
        sum = 0u; cnt = 0u; mine = 0u;
#pragma unroll
        for (unsigned j = 0; j < 16; ++j) { const unsigned c = xb_ld(&bar[XB_XCNT(j)]); sum += c; cnt += (c > 0u) ? 1u : 0u; mine = (j == x) ? c : mine; }
        if (sum == G) break;
        __builtin_amdgcn_s_sleep(1);
        if ((++sp & 255u) == 0u) { if (xb_ld(&bar[XB_TMO])) break; if (sp > XB_SPIN_CAP) { atomicAdd(&bar[XB_TMO], 1u); break; } }
    }
    nloc = mine > 0u ? mine : 1u; nx = cnt > 0u ? cnt : 1u;
}

__device__ __forceinline__ void xcd_barrier(const XcdBarrier& b) {
    asm volatile("s_waitcnt vmcnt(0)" ::: "memory");
    __syncthreads();
    if (threadIdx.x == 0) {
        unsigned* bar = b.bar;
        __builtin_amdgcn_s_waitcnt(0);
        unsigned nloc = b.st[0], nx = b.st[1];
        if (nloc == 0u) { xcd_barrier_complete(bar, b.x, nloc, nx); b.st[0] = nloc; b.st[1] = nx; }
        const unsigned old = xb_add(&bar[XB_XSUB(b.x)], 1u);
        const unsigned gen = old / nloc;
        if (old + 1u == (gen + 1u) * nloc) {
            __builtin_amdgcn_fence(__ATOMIC_RELEASE, "agent");
            asm volatile("s_waitcnt vmcnt(0)" ::: "memory");
            const unsigned og = xb_add(&bar[XB_TOP], 1u);
            const unsigned tg = og / nx;
            if (og + 1u == (tg + 1u) * nx) xb_add(&bar[XB_TOPGEN], 1u);
            else XB_SPIN(xb_ld(&bar[XB_TOPGEN]) == tg, bar);
            __builtin_amdgcn_fence(__ATOMIC_ACQUIRE, "agent");
            xb_add(&bar[XB_XGEN(b.x)], 1u);
            asm volatile("s_waitcnt vmcnt(0)" ::: "memory");
        } else {
            XB_SPIN(xb_ld(&bar[XB_XGEN(b.x)]) == gen, bar);
            __builtin_amdgcn_fence(__ATOMIC_ACQUIRE, "agent");
            asm volatile("s_waitcnt vmcnt(0)" ::: "memory");
        }
    }
    __syncthreads();
}

typedef unsigned short bf16_t;
__device__ __forceinline__ float bf2f(bf16_t v) { return __uint_as_float((unsigned)v << 16); }
__device__ __forceinline__ float gelu_exact(float v) { return 0.5f * v * (1.0f + erff(v * 0.70710678118654752f)); }
__device__ __forceinline__ float log_sigmoid(float z) { return z > 0.f ? -log1pf(expf(-z)) : z - log1pf(expf(z)); }
__device__ __forceinline__ float wave_sum(float v) {
    return wave_allsum(v);
}
__device__ __forceinline__ float wave_max(float v) {
    return wave_allmax(v);
}

#ifndef RP7
#define RP7 1
#endif
#ifndef RP8
#define RP8 1
#endif
#ifndef RP9
#define RP9 1
#endif
#ifndef RP0
#define RP0 1
#endif
#ifndef RP1
#define RP1 1
#endif
#ifndef RP12
#define RP12 1
#endif
#ifndef RP3
#define RP3 1
#endif
#ifndef RP4
#define RP4 1
#endif
#ifndef RP5
#define RP5 1
#endif
#ifndef RP6
#define RP6 1
#endif
#ifndef QORDER
#define QORDER 1
#endif
#ifndef CONV_P0_FROM
#define CONV_P0_FROM (2 * NEXP)
#endif
#ifndef CONV_SPLIT
#define CONV_SPLIT (NEXP / 2)
#endif
constexpr int NWAVES = 8;
constexpr int RING_OFF = 0, RING_BYTES = 157696;
constexpr int LDSCTL_OFF = RING_BYTES, MISC_OFF = LDSCTL_OFF + 320;
constexpr int LDS_BYTES = 158720;
constexpr int CW_BAR = 4096, CW_QUEUE = 3072, CW_CMAX = 8192, CMAX_WQ = 4864;
constexpr int N_PHASES = 9;

struct Args { const float* in[17]; float* out; unsigned char* ws; int ph_lo, ph_hi, li, pad; };

__device__ __forceinline__ void p0_transpose_item(const float* W, int ldw, int col0, int K, bf16* WT, int row0, LAS float* scr, int item, int nblk, int lane, float sc = 1.0f) {
    const int kb = item / nblk, nb = item % nblk, k0 = 64 * kb, n0 = 32 * nb;
    f32x4 v[8];
#pragma unroll
    for (int i = 0; i < 8; ++i) v[i] = *(const GAS f32x4*)(W + (size_t)(k0 + 8 * i + (lane >> 3)) * ldw + col0 + n0 + 4 * (lane & 7));
#pragma unroll
    for (int i = 0; i < 8; ++i) *(LAS f32x4*)(scr + (8 * i + (lane >> 3)) * 36 + 4 * (lane & 7)) = v[i];
    LDS_WAIT(); asm volatile("" ::: "memory");
    const int c = lane & 7;
#pragma unroll
    for (int j = 0; j < 4; ++j) { const int n = (lane >> 3) + 8 * j; const LAS float* s = scr + (8 * c) * 36 + n;
        v4u o; o.x = pg8::cvt_pk_bf16(s[0 * 36] * sc, s[1 * 36] * sc); o.y = pg8::cvt_pk_bf16(s[2 * 36] * sc, s[3 * 36] * sc); o.z = pg8::cvt_pk_bf16(s[4 * 36] * sc, s[5 * 36] * sc); o.w = pg8::cvt_pk_bf16(s[6 * 36] * sc, s[7 * 36] * sc);
        *(GAS v4u*)(WT + (size_t)(row0 + n0 + n) * K + k0 + 8 * c) = o; }
    LDS_WAIT(); asm volatile("" ::: "memory");
}
__device__ __forceinline__ void p0_transpose_item_i8(const float* W, int ldw, int col0, int K, unsigned char* WT8, float* sB, int row0, const unsigned* colmax, LAS float* scr, int item, int nblk, int lane) {
    const int kb = item / nblk, nb = item % nblk, k0 = 64 * kb, n0 = 32 * nb;
    f32x4 v[8];
#pragma unroll
    for (int i = 0; i < 8; ++i) v[i] = *(const GAS f32x4*)(W + (size_t)(k0 + 8 * i + (lane >> 3)) * ldw + col0 + n0 + 4 * (lane & 7));
#pragma unroll
    for (int i = 0; i < 8; ++i) *(LAS f32x4*)(scr + (8 * i + (lane >> 3)) * 36 + 4 * (lane & 7)) = v[i];
    LDS_WAIT(); asm volatile("" ::: "memory");
    const int c = lane & 3;
#pragma unroll
    for (int j = 0; j < 2; ++j) { const int n = (lane >> 2) + 16 * j; const LAS float* s = scr + (16 * c) * 36 + n;
        const float am = __uint_as_float(colmax[col0 + n0 + n]); const float qs = am > 0.f ? 127.0f / am : 0.f;
        v4u o;
        o.x = peer_body::pack_i8x4(s[0 * 36] * qs, s[1 * 36] * qs, s[2 * 36] * qs, s[3 * 36] * qs); o.y = peer_body::pack_i8x4(s[4 * 36] * qs, s[5 * 36] * qs, s[6 * 36] * qs, s[7 * 36] * qs);
        o.z = peer_body::pack_i8x4(s[8 * 36] * qs, s[9 * 36] * qs, s[10 * 36] * qs, s[11 * 36] * qs); o.w = peer_body::pack_i8x4(s[12 * 36] * qs, s[13 * 36] * qs, s[14 * 36] * qs, s[15 * 36] * qs);
        *(GAS v4u*)(WT8 + (size_t)(row0 + n0 + n) * K + k0 + 16 * c) = o;
        if (kb == 0 && c == 0) sB[row0 + n0 + n] = am * (1.0f / 127.0f); }
    LDS_WAIT(); asm volatile("" ::: "memory");
}
__device__ __forceinline__ void p0_colmax_task(const float* W, int ldw, int ncols, unsigned* colmax, int task, int lane) {
    const int ncb = (ncols + 255) / 256, cb = task % ncb, rb = task / ncb, c = 256 * cb + 4 * lane;
    if (c >= ncols) return;
    f32x4 m = (f32x4){0.f, 0.f, 0.f, 0.f};
#pragma unroll 8
    for (int i = 0; i < 32; ++i) { const f32x4 v = *(const GAS f32x4*)(W + (size_t)(32 * rb + i) * ldw + c);
        m.x = fmaxf(m.x, fabsf(v.x)); m.y = fmaxf(m.y, fabsf(v.y)); m.z = fmaxf(m.z, fabsf(v.z)); m.w = fmaxf(m.w, fabsf(v.w)); }
    atomicMax(colmax + c, __float_as_uint(m.x)); atomicMax(colmax + c + 1, __float_as_uint(m.y)); atomicMax(colmax + c + 2, __float_as_uint(m.z)); atomicMax(colmax + c + 3, __float_as_uint(m.w));
}
__device__ __forceinline__ void cvt_chunks(const float* src, bf16* dst, size_t nchunks, size_t gtid, size_t nthr) {
    for (size_t c = gtid; c < nchunks; c += nthr) { const f32x4 a = ((const GAS f32x4*)src)[2 * c], b = ((const GAS f32x4*)src)[2 * c + 1];
        v4u o; o.x = pg8::cvt_pk_bf16(a.x, a.y); o.y = pg8::cvt_pk_bf16(a.z, a.w); o.z = pg8::cvt_pk_bf16(b.x, b.y); o.w = pg8::cvt_pk_bf16(b.z, b.w);
        ((GAS v4u*)dst)[c] = o; }
}

template <int NR> __device__ __forceinline__ void convert_rows(int e0, const float* eu, const float* ev, unsigned char* ws, int lane) {
                const bool isV = e0 >= NEXP; const int row0 = isV ? e0 - NEXP : e0;
                const float* tab = isV ? ev : eu;
                f32x4 v[NR][4];
#pragma unroll
                for (int rr = 0; rr < NR; ++rr)
#pragma unroll
                    for (int i = 0; i < 4; ++i) v[rr][i] = __builtin_nontemporal_load((const GAS f32x4*)(tab + (size_t)(row0 + rr) * D + 16 * lane) + i);
#pragma unroll
                for (int rr = 0; rr < NR; ++rr) {
                    const int row = row0 + rr; float am = 0.f;
#pragma unroll
                    for (int i = 0; i < 4; ++i) am = fmaxf(fmaxf(am, fmaxf(fabsf(v[rr][i].x), fabsf(v[rr][i].y))), fmaxf(fabsf(v[rr][i].z), fabsf(v[rr][i].w)));
                    am = wave_allmax(am);
                    v4u q;
                    if (!isV) { const float inv = am > 0.f ? 127.0f / am : 0.f;
                        q.x = peer_body::pack_i8x4(v[rr][0].x * inv, v[rr][0].y * inv, v[rr][0].z * inv, v[rr][0].w * inv); q.y = peer_body::pack_i8x4(v[rr][1].x * inv, v[rr][1].y * inv, v[rr][1].z * inv, v[rr][1].w * inv);
                        q.z = peer_body::pack_i8x4(v[rr][2].x * inv, v[rr][2].y * inv, v[rr][2].z * inv, v[rr][2].w * inv); q.w = peer_body::pack_i8x4(v[rr][3].x * inv, v[rr][3].y * inv, v[rr][3].z * inv, v[rr][3].w * inv);
                        *(GAS v4u*)(ws + WS_EU + (size_t)(lane >> 3) * ((size_t)NEXP * 128) + (size_t)row * 128 + (lane & 7) * 16) = q; if (lane == 0) ((GAS float*)(ws + WS_SU))[row] = am * (1.0f / 127.0f); }
                    else { const float inv = am > 0.f ? 127.0f / am : 0.f;
                        q.x = peer_body::pack_i8x4(v[rr][0].x * inv, v[rr][0].y * inv, v[rr][0].z * inv, v[rr][0].w * inv); q.y = peer_body::pack_i8x4(v[rr][1].x * inv, v[rr][1].y * inv, v[rr][1].z * inv, v[rr][1].w * inv);
                        q.z = peer_body::pack_i8x4(v[rr][2].x * inv, v[rr][2].y * inv, v[rr][2].z * inv, v[rr][2].w * inv); q.w = peer_body::pack_i8x4(v[rr][3].x * inv, v[rr][3].y * inv, v[rr][3].z * inv, v[rr][3].w * inv);
                        *(GAS v4u*)(ws + WS_EV + (size_t)(lane >> 3) * ((size_t)NEXP * 128) + (size_t)row * 128 + (lane & 7) * 16) = q; if (lane == 0) ((GAS float*)(ws + WS_SV))[row] = am * (1.0f / 127.0f); }
                }
}

__global__ void __launch_bounds__(NWAVES * 64, 2) skel_fwd(Args args) {
    extern __shared__ __attribute__((aligned(16))) unsigned char lds[];
    LAS unsigned char* L = (LAS unsigned char*)lds;
    volatile LAS unsigned* MISC = (volatile LAS unsigned*)(L + MISC_OFF);
    const int G = gridDim.x; const int bx = blockIdx.x; const int vcu = (G % 8 == 0) ? (bx % 8) * (G / 8) + bx / 8 : bx;
    for (int u = threadIdx.x; u < (LDS_BYTES - LDSCTL_OFF) / 4; u += NWAVES * 64) ((LAS unsigned*)(L + LDSCTL_OFF))[u] = 0u;
    __syncthreads();
    (void)xcd_barrier_post((unsigned*)((gu32*)(args.ws + WS_CTL) + CW_BAR) + args.li * XCD_BAR_WORDS, MISC + 8);
#define PHASE_VARS \
    GAS unsigned char* wsg_ = (GAS unsigned char*)args.ws; asm volatile("" : "+s"(wsg_)); unsigned char* ws = (unsigned char*)wsg_; GAS float* outg_ = (GAS float*)args.out; asm volatile("" : "+s"(outg_)); float* out = (float*)outg_; \
    int tid = threadIdx.x; asm volatile("" : "+v"(tid)); const int lane = tid & 63, wave = __builtin_amdgcn_readfirstlane(tid >> 6); (void)lane; (void)wave; \
    gu32* ctl = (gu32*)(ws + WS_CTL); (void)ctl; const float* x = args.in[0]; (void)x; \
    bf16* XN = (bf16*)(ws + WS_XN); bf16* Qb = (bf16*)(ws + WS_Q); bf16* UG = (bf16*)(ws + WS_UG); (void)XN; (void)Qb; (void)UG; \
    bf16* GATE = (bf16*)out; bf16* MERGED = (bf16*)(ws + WS_MERGED); bf16* QP = (bf16*)(ws + WS_QP); (void)GATE; (void)MERGED; (void)QP; \
    float* LOGF = (float*)(ws + WS_LOGF); float* CL2 = (float*)(ws + WS_CL2); (void)LOGF; (void)CL2; \
    const int gw = vcu * NWAVES + wave, NGW = G * NWAVES; (void)gw; (void)NGW;
    const int lo = args.ph_lo, hi = args.ph_hi;
#ifndef PHMASK
#define PHMASK 0x1ff
#endif
#define IN(k) (((PHMASK >> (k)) & 1) && lo <= (k) && (k) < hi)
#define BOTH(k) (IN(k) && IN((k) + 1))
#ifdef TIMEPH
    if (bx == 0 && threadIdx.x == 0) { const unsigned long long t0_ = rt(); MISC[24] = (unsigned)t0_; }
#define GRID_BAR(k) do { XcdBarrier b_; b_.bar = (unsigned*)((gu32*)(args.ws + WS_CTL) + CW_BAR) + args.li * XCD_BAR_WORDS; b_.x = xb_xcc_id(); b_.st = MISC + 8; xcd_barrier(b_); if (bx == 0 && threadIdx.x == 0) { gu32* ctl = (gu32*)(args.ws + WS_CTL); const unsigned t_now = (unsigned)rt(); __hip_atomic_store(ctl + 2048 + (k), t_now - MISC[24], RLX_AGENT); MISC[24] = t_now; } } while (0)
#else
#define GRID_BAR(k) do { XcdBarrier b_; b_.bar = (unsigned*)((gu32*)(args.ws + WS_CTL) + CW_BAR) + args.li * XCD_BAR_WORDS; b_.x = xb_xcc_id(); b_.st = MISC + 8; xcd_barrier(b_); } while (0)
#endif

    for (int rp_ = 0; rp_ < RP0; ++rp_) if (IN(0)) {
        PHASE_VARS
        LAS float* scr = (LAS float*)(L + RING_OFF + wave * 16384);
        const float* w_in = args.in[2];
        unsigned* cmax_in = (unsigned*)(ctl + CW_CMAX);
        {
            constexpr int T_IN = ((IN_W + 255) / 256) * (D / 32);
            constexpr int T_WQ = (QPW / 256) * (D / 32);
            for (int it = gw; it < T_IN + T_WQ; it += NGW) { if (it < T_IN) p0_colmax_task(w_in, IN_W, IN_W, cmax_in, it, lane); else p0_colmax_task(args.in[12], QPW, QPW, cmax_in + CMAX_WQ, it - T_IN, lane); }
            GRID_BAR(0);
        }
        {
            constexpr int I_A = 16 * 48, I_B = 16 * 96, I_WA = 8 * 32, I_WB = 8 * 32, I_WO = 16 * 32, I_WQ = 16 * 64;
            constexpr int NITEMS = I_A + I_B + I_WA + I_WB + I_WO + I_WQ;
            for (int it = gw; it < NITEMS; it += NGW) {
                int r = it;
                if (r < I_A) { p0_transpose_item_i8(w_in, IN_W, 0, D, ws + WS_WIN, (float*)(ws + WS_SBW), 0, cmax_in, scr, r, 48, lane); continue; } r -= I_A;
                if (r < I_B) { p0_transpose_item_i8(w_in, IN_W, OFF_UG, D, ws + WS_WIN, (float*)(ws + WS_SBW), 1536, cmax_in, scr, r, 96, lane); continue; } r -= I_B;
                if (r < I_WA) { p0_transpose_item(args.in[8], D, 0, AW, (bf16*)(ws + WS_WA), 0, scr, r, 32, lane, 1.0f / 255.0f); continue; } r -= I_WA;
                if (r < I_WB) { p0_transpose_item(args.in[9], D, 0, SW, (bf16*)(ws + WS_WB), 0, scr, r, 32, lane, 1.0f / 255.0f); continue; } r -= I_WB;
                if (r < I_WO) { p0_transpose_item(args.in[10], D, 0, D, (bf16*)(ws + WS_WOUT), 0, scr, r, 32, lane); continue; } r -= I_WO;
                p0_transpose_item_i8(args.in[12], QPW, 0, D, ws + WS_WQ, (float*)(ws + WS_SBWQ), 0, cmax_in + CMAX_WQ, scr, r, 64, lane);
            }
        }
        {
            const size_t gtid = (size_t)gw * 64 + lane, nthr = (size_t)NGW * 64;
            cvt_chunks(args.in[13], (bf16*)(ws + WS_SK), (size_t)PH * 2 * PKEYS * PHALF / 8, gtid, nthr);
#pragma unroll 1
            for (int e0 = CONV_P0_FROM + 4 * gw; e0 < 2 * NEXP; e0 += 4 * NGW) convert_rows<4>(e0, args.in[14], args.in[15], ws, lane);
            const float* w_s = args.in[6]; bf16* wsm = (bf16*)(ws + WS_WSM);
            for (size_t c = gtid; c < (size_t)NG * CHUNK * CHUNK / 8; c += nthr) {
                const int pos = (int)((c * 8) & 127), t = (int)((c * 8) >> 7) & 127, ks = pos >> 4, hh = (pos >> 3) & 1, s0 = 16 * ks + 4 * hh, s1 = s0 + 8;
                const float* src = w_s + ((c * 8) & ~(size_t)127);
                const f32x4 a = *(const GAS f32x4*)(src + s0), b = *(const GAS f32x4*)(src + s1);
                v4u o; o.x = pg8::cvt_pk_bf16(s0 + 0 <= t ? a.x : 0.f, s0 + 1 <= t ? a.y : 0.f); o.y = pg8::cvt_pk_bf16(s0 + 2 <= t ? a.z : 0.f, s0 + 3 <= t ? a.w : 0.f);
                o.z = pg8::cvt_pk_bf16(s1 + 0 <= t ? b.x : 0.f, s1 + 1 <= t ? b.y : 0.f); o.w = pg8::cvt_pk_bf16(s1 + 2 <= t ? b.z : 0.f, s1 + 3 <= t ? b.w : 0.f);
                ((GAS v4u*)wsm)[c] = o; }
        }
        __syncthreads();
        {
            LAS float* wf = (LAS float*)(L + RING_OFF);
            for (int i = tid; i < 8 * D; i += NWAVES * 64) { const int k = i >> 3, c = i & 7; wf[c * D + k] = w_in[(size_t)k * IN_W + OFF_F + c]; }
            __syncthreads();
            const float* g1 = args.in[1]; const float* b_f = args.in[3];
            f32x4 gv[4];
#pragma unroll
            for (int j = 0; j < 4; ++j) gv[j] = ((const GAS f32x4*)g1)[lane + 64 * j];
#pragma unroll 1
            for (int m0 = 4 * gw; m0 < M; m0 += 4 * NGW) {
                f32x4 vv[4][4];
#pragma unroll
                for (int rr = 0; rr < 4; ++rr)
#pragma unroll
                    for (int j = 0; j < 4; ++j) vv[rr][j] = ((const GAS f32x4*)(x + (size_t)(m0 + rr) * D) + lane)[64 * j];
#pragma unroll
                for (int rr = 0; rr < 4; ++rr) {
                    const int m = m0 + rr; f32x4 v[4]; float s = 0.f;
#pragma unroll
                    for (int j = 0; j < 4; ++j) { v[j] = vv[rr][j]; s += (v[j].x * v[j].x + v[j].y * v[j].y) + (v[j].z * v[j].z + v[j].w * v[j].w); }
                    const float r = 1.0f / sqrtf(wave_sum(s) * (1.f / D) + EPS);
#pragma unroll
                    for (int j = 0; j < 4; ++j) v[j] = v[j] * r * gv[j];
                    {
                        float am = 0.f;
#pragma unroll
                        for (int j = 0; j < 4; ++j) am = fmaxf(fmaxf(am, fmaxf(fabsf(v[j].x), fabsf(v[j].y))), fmaxf(fabsf(v[j].z), fabsf(v[j].w)));
                        am = wave_allmax(am); const float qs = am > 0.f ? 127.0f / am : 0.f;
                        GAS unsigned* o4 = (GAS unsigned*)(ws + WS_XN + (size_t)m * D) + lane;
#pragma unroll
                        for (int j = 0; j < 4; ++j) o4[64 * j] = peer_body::pack_i8x4(v[j].x * qs, v[j].y * qs, v[j].z * qs, v[j].w * qs);
                        if (lane == 0) ((GAS float*)(ws + WS_SA))[m] = am * (1.0f / 127.0f); }
                    float fsum = 0.f;
#pragma unroll
                    for (int c = 0; c < 8; ++c) { float pp = 0.f;
#pragma unroll
                        for (int j = 0; j < 4; ++j) { const f32x4 w4 = *(const LAS f32x4*)(wf + c * D + 256 * j + 4 * lane); pp += (v[j].x * w4.x + v[j].y * w4.y) + (v[j].z * w4.z + v[j].w * w4.w); }
                        pp = wave_sum(pp); if (lane == c) fsum = pp; }
                    if (lane < 8) LOGF[(size_t)m * NH + lane] = log_sigmoid(fsum + b_f[lane]);
                }
            }
        }
        if (BOTH(0)) GRID_BAR(0);
    }

    for (int rp12_ = 0; rp12_ < RP12; ++rp12_) {
    for (int rp_ = 0; rp_ < RP1; ++rp_) if (IN(1)) {
        PHASE_VARS
        if (vcu < BATCH * NH) {
            const int b = vcu / NH, h = vcu % NH; LAS float* part = (LAS float*)(L + MISC_OFF + 64);
            float v[4];
#pragma unroll
            for (int i = 0; i < 4; ++i) v[i] = LOGF[(size_t)(b * SEQ + 4 * tid + i) * NH + h];
            v[1] += v[0]; v[2] += v[1]; v[3] += v[2];
            float tot = v[3];
#pragma unroll
            for (int o = 1; o < 64; o <<= 1) { const float u = __shfl_up(tot, o); if (lane >= o) tot += u; }
            if (lane == 63) part[wave] = tot;
            __syncthreads();
            float base = tot - v[3];
            for (int w = 0; w < wave; ++w) base += part[w];
#pragma unroll
            for (int i = 0; i < 4; ++i) CL2[(size_t)vcu * SEQ + 4 * tid + i] = (base + v[i]) * LOG2E;
            __syncthreads();
        }
        pg8::Gemm g{XN, (const bf16*)(ws + WS_WIN), M, NPROJ, D / 2}; pg8::StaticOrder S; S.init(M, NPROJ, G, bx);
        pg8::EpiProjI8 E{Qb, (size_t)M * 512, GATE, C2, (const float*)(ws + WS_SA), (const float*)(ws + WS_SBW)};
        pg8::gemm_phase<pg8::EpiProjI8, pg8::StaticOrder, true, true, true>(L + RING_OFF, g, S, E);
        {
            constexpr int NUN = (M / 256) * (NPROJ / 256);
            const int nmax = (NUN + G - 1) / G, nun = (NUN - bx + G - 1) / G;
            int ii_ = bx - (NUN - (nmax - 1) * G), nidle_ = G - (NUN - (nmax - 1) * G);
            if (nidle_ <= 0) { ii_ = bx; nidle_ = G; }
            if (nun < nmax || nidle_ == G) {
#pragma unroll 1
                for (int e0 = 4 * (ii_ * NWAVES + wave); e0 < CONV_SPLIT; e0 += 4 * nidle_ * NWAVES) convert_rows<4>(e0, args.in[14], args.in[15], ws, lane);
            }
        }
        if (BOTH(1)) GRID_BAR(1);
    }

    if (IN(2)) {
        PHASE_VARS
        static_assert(attn_body::ATTN_LDS_BYTES <= RING_BYTES && peer_body::PEER_FUSED_LDS <= RING_BYTES, "phase LDS");
#ifdef P2PROBE
        for (int pr_ = 0; pr_ < P2PROBE; ++pr_) {
            for (int u = vcu; u < 2 * (M / CHUNK); u += G)
                sgu_body::sgu_unit(u >> 1, u & 1, (const bf16*)(ws + WS_VG), UG, (bf16*)(ws + 232 * MiB), (const bf16*)(ws + WS_WSM), args.in[4], args.in[5], args.in[7], (char*)lds + RING_OFF);
#ifndef P2PROBE_SGU_ONLY
            const attn_body::AttnTensors ATp{(const attn_body::bf16*)Qb, (const attn_body::bf16*)(ws + WS_K), (const attn_body::bf16*)(ws + WS_V), (attn_body::bf16*)(ws + 216 * MiB), CL2};
            const attn_body::StaticOrder Sp(G, bx);
            attn_body::attn_phase<attn_body::StaticOrder>((char*)lds + RING_OFF, ATp, Sp);
#endif
            GRID_BAR(2);
        }
#endif
#ifndef CONVREP
#define CONVREP 1
#endif
        constexpr int NCONV1 = (CONV_P0_FROM - CONV_SPLIT) / 64, NCONVQ = CONVREP * NCONV1, NIL = NCONVQ < 512 ? NCONVQ : 512;
        for (;;) {
            __syncthreads();
            if (tid == 0) MISC[26] = __hip_atomic_fetch_add(ctl + CW_QUEUE, 1u, RLX_AGENT);
            __syncthreads();
            const int u = __builtin_amdgcn_readfirstlane((int)MISC[26]);
            if (u >= 768 + NCONVQ) break;
            int ua = -1, uc = -1, us = -1;
#if QORDER == 1
            if (u < NCONVQ) uc = u; else if (u < 512 + NCONVQ) ua = u - NCONVQ; else us = u - 512 - NCONVQ;
#elif QORDER == 3
            static_assert(NCONVQ == 384, "spread order: 2 attention : 3 conversion : 2 gating units per block of 7");
            if (u < 256) ua = u;
            else { const int v_ = u - 256, blk = v_ / 7, r_ = v_ - 7 * blk;
                if (r_ == 0 || r_ == 4) ua = 256 + 2 * blk + (r_ == 4); else if (r_ & 1) uc = 3 * blk + (r_ >> 1); else us = 2 * blk + (r_ == 6); }
#elif QORDER == 4
            static_assert(NCONVQ == 384, "spread order: 2 attention : 3 conversion per block of 5, gating units last");
            if (u < 256) ua = u;
            else if (u < 256 + 640) { const int v_ = u - 256, blk = v_ / 5, r_ = v_ - 5 * blk;
                if (r_ & 1) ua = 256 + 2 * blk + (r_ >> 1); else uc = 3 * blk + (r_ >> 1); }
            else us = u - 896;
#elif QORDER == 2
            if (u < 512) ua = u; else if (u < 768) us = u - 512; else uc = u - 768;
#else
            if (u < 2 * NIL) { if (u & 1) uc = u >> 1; else ua = u >> 1; }
            else if (u < 512 + NCONVQ) { if (NCONVQ > 512) uc = u - 512; else ua = u - NCONVQ; }
            else us = u - 512 - NCONVQ;
#endif
            if (ua >= 0) { const int qb = 7 - (ua >> 6), bh = ua & 63;
                const int t0 = attn_body::attn_first_tile(CL2, bh, qb);
                attn_body::attn_unit<8>(bh / NH, bh % NH, qb, (const attn_body::bf16*)Qb, (const attn_body::bf16*)(ws + WS_K), (const attn_body::bf16*)(ws + WS_V), (attn_body::bf16*)Qb, CL2, (char*)lds + RING_OFF, t0); }
            else if (uc >= 0) convert_rows<8>(CONV_SPLIT + 64 * (uc % NCONV1) + 8 * wave, args.in[14], args.in[15], ws, lane);
            else sgu_body::sgu_unit(us >> 1, us & 1, (const bf16*)(ws + WS_VG), UG, UG, (const bf16*)(ws + WS_WSM), args.in[4], args.in[5], args.in[7], (char*)lds + RING_OFF);
        }
        if (BOTH(2)) GRID_BAR(2);
    }
    }

    for (int rp_ = 0; rp_ < RP3; ++rp_) if (IN(3)) {
        PHASE_VARS
        static_assert(WS_UG - WS_Q == (size_t)pg8::MERGE_DPM * 256 * AW * 2 && WS_WB - WS_WA == (size_t)4 * 256 * AW * 2, "merge passes: buffer offsets");
        { pg8::Gemm g{Qb, (const bf16*)(ws + WS_WA), M, D, AW}; pg8::MergeOrder S; S.init(M, D, G, bx);
          pg8::EpiMergeAB E{GATE, MERGED};
          pg8::gemm_phase<pg8::EpiMergeAB, pg8::MergeOrder, true, true>(L + RING_OFF, g, S, E); }
        if (BOTH(3)) GRID_BAR(3);
    }

    for (int rp_ = 0; rp_ < RP4; ++rp_) if (IN(4)) {
        PHASE_VARS
        pg8::Gemm g{MERGED, (const bf16*)(ws + WS_WOUT), M, D, D}; pg8::StaticOrder S; S.init(M, D, G, bx);
        pg8::EpiResid E{x, out, D, M};
        pg8::gemm_phase<pg8::EpiResid, pg8::StaticOrder, false, true>(L + RING_OFF, g, S, E);
        if (BOTH(4)) GRID_BAR(4);
    }

    for (int rp_ = 0; rp_ < RP5; ++rp_) if (IN(5)) {
        PHASE_VARS
        const float* g2 = args.in[11];
        f32x4 gv[4];
#pragma unroll
        for (int j = 0; j < 4; ++j) gv[j] = ((const GAS f32x4*)g2)[lane + 64 * j];
#pragma unroll 1
        for (int m0 = 4 * gw; m0 < M; m0 += 4 * NGW) {
            f32x4 vv[4][4];
#pragma unroll
            for (int rr = 0; rr < 4; ++rr)
#pragma unroll
                for (int j = 0; j < 4; ++j) vv[rr][j] = ((const GAS f32x4*)(out + (size_t)(m0 + rr) * D) + lane)[64 * j];
            asm volatile("" ::: "memory");
#pragma unroll
            for (int rr = 0; rr < 4; ++rr) {
                const int m = m0 + rr; f32x4 v[4]; float s = 0.f;
#pragma unroll
                for (int j = 0; j < 4; ++j) { v[j] = vv[rr][j]; s += (v[j].x * v[j].x + v[j].y * v[j].y) + (v[j].z * v[j].z + v[j].w * v[j].w); }
                const float r = 1.0f / sqrtf(wave_sum(s) * (1.f / D) + EPS);
                float am = 0.f;
#pragma unroll
                for (int j = 0; j < 4; ++j) { v[j] = v[j] * r * gv[j];
                    am = fmaxf(fmaxf(am, fmaxf(fabsf(v[j].x), fabsf(v[j].y))), fmaxf(fabsf(v[j].z), fabsf(v[j].w))); }
                am = wave_allmax(am);
                const float qs = am > 0.f ? 127.0f / am : 0.f;
#pragma unroll
                for (int j = 0; j < 4; ++j) { const unsigned q4 = peer_body::pack_i8x4(v[j].x * qs, v[j].y * qs, v[j].z * qs, v[j].w * qs);
                    *(GAS unsigned*)(ws + WS_H2Q + (size_t)(2 * j + (lane >> 5)) * ((size_t)M * 128) + (size_t)m * 128 + ((4 * lane) & 127)) = q4; ((GAS unsigned*)(ws + WS_XN + (size_t)m * D))[lane + 64 * j] = q4; }
                if (lane == 0) ((GAS float*)(ws + WS_ST))[m] = am * (1.0f / 127.0f);
            }
        }
        if (BOTH(5)) GRID_BAR(5);
    }

    for (int rp_ = 0; rp_ < RP6; ++rp_) if (IN(6)) {
        PHASE_VARS
        pg8::Gemm g{XN, (const bf16*)(ws + WS_WQ), M, QPW, D / 2}; pg8::StaticOrder S; S.init(M, QPW, G, bx);
        pg8::EpiBf16I8 E{QP, QPW, (const float*)(ws + WS_ST), (const float*)(ws + WS_SBWQ)};
        pg8::gemm_phase<pg8::EpiBf16I8, pg8::StaticOrder, true, true, true>(L + RING_OFF, g, S, E);
        if (BOTH(6)) GRID_BAR(6);
    }
    for (int rp_ = 0; rp_ < RP7; ++rp_) if (IN(7)) {
        PHASE_VARS
        for (int tk = vcu; tk < 8 * (M / 512); tk += G)
            peer_body::peer_retrieve(tk, QP, (const bf16*)(ws + WS_SK), (const float*)(ws + WS_SU), (const float*)(ws + WS_SV), (const float*)(ws + WS_ST),
                                     (bf16*)(ws + WS_PID), (float*)(ws + WS_G2), (float*)(ws + WS_PS2), (char*)lds + RING_OFF);
        if (BOTH(7)) GRID_BAR(7);
    }
    if (IN(8)) {
        PHASE_VARS
#ifdef TIMEPH
        const float oscale = 1.0f + sqrtf((float)(((__hip_atomic_load(ctl + 2048 + TIMEPH, RLX_AGENT) + TIMEOFF) / TIMEQ) * TIMEQ) * 1e-5f);
#else
        const float oscale = 1.0f;
#endif
        const int p = bx & 7, cntp = (G - p + 7) >> 3;
        peer_body::peer_fused(p, (bx >> 3) * NWAVES + wave, cntp * NWAVES, (const bf16*)(ws + WS_PID), (const float*)(ws + WS_G2), (const float*)(ws + WS_PS2), (const unsigned char*)(ws + WS_H2Q),
                              (const unsigned char*)(ws + WS_EU), (const unsigned char*)(ws + WS_EV), out, args.in[16], (char*)lds + RING_OFF, oscale);
    }
#undef IN
#undef BOTH
#undef GRID_BAR
}

extern "C" void kernel_launch(void* const* d_in, const int* in_sizes, int n_in, void* d_out, int out_size, void* d_ws, size_t ws_size, hipStream_t stream) {
    static int grid = 0;
    if (grid == 0) {
        int dev = 0, cus = 0;
        if (n_in != 17 || out_size != M * D || ws_size < WS_END) { fprintf(stderr, "kernel_launch: unexpected shapes (n_in %d out %d ws %zu)\n", n_in, out_size, ws_size); grid = -1; return; }
        if (hipGetDevice(&dev) != hipSuccess || hipDeviceGetAttribute(&cus, hipDeviceAttributeMultiprocessorCount, dev) != hipSuccess) { grid = -1; return; }
        if (hipFuncSetAttribute((const void*)skel_fwd, hipFuncAttributeMaxDynamicSharedMemorySize, LDS_BYTES) != hipSuccess) { fprintf(stderr, "kernel_launch: hipFuncSetAttribute failed\n"); grid = -1; return; }
        int per_cu = 0;
        if (hipOccupancyMaxActiveBlocksPerMultiprocessor(&per_cu, (const void*)skel_fwd, NWAVES * 64, LDS_BYTES) != hipSuccess || per_cu < 1) { fprintf(stderr, "kernel_launch: occupancy query says %d workgroups per CU\n", per_cu); grid = -1; return; }
        grid = cus;
    }
    if (grid < 0) return;
    unsigned char* ws = (unsigned char*)d_ws; float* out = (float*)d_out;
    (void)hipMemsetAsync(ws + WS_CTL, 0, CTL_ZERO_BYTES, stream);
    Args a{};
    for (int i = 0; i < 17; ++i) a.in[i] = (const float*)d_in[i];
    a.out = out; a.ws = ws;
#ifndef MULTI_LAUNCH
    {
        a.ph_lo = 0; a.ph_hi = N_PHASES; a.li = 0;
        void* kargs[] = {(void*)&a};
#ifdef PLAIN_LAUNCH
        hipLaunchKernelGGL(skel_fwd, dim3(grid), dim3(NWAVES * 64), LDS_BYTES, stream, a); const hipError_t e = hipPeekAtLastError(); (void)kargs;
#else
        const hipError_t e = hipLaunchCooperativeKernel((const void*)skel_fwd, dim3(grid), dim3(NWAVES * 64), kargs, LDS_BYTES, stream);
#endif
        if (e != hipSuccess) fprintf(stderr, "kernel_launch: cooperative launch failed: %s (grid %d)\n", hipGetErrorString(e), grid);
    }
#else
    for (int k = 0; k < N_PHASES; ++k) { a.ph_lo = k; a.ph_hi = k + 1; a.li = k; hipLaunchKernelGGL(skel_fwd, dim3(grid), dim3(NWAVES * 64), LDS_BYTES, stream, a); }
#endif
}
```

```cpp
#include <hip/hip_runtime.h>
#include <cstdio>
#include <cstdint>
#include <cmath>

constexpr int D = 1024, BATCH = 8, SEQ = 2048, M = BATCH * SEQ;
constexpr int NH = 8, HD = 64, AW = 512, SW = 512, CHUNK = 128, NG = 8, GD = 64;
constexpr int OFF_Q = 0, OFF_K = 512, OFF_V = 1024, OFF_F = 1536, OFF_UG = 1544, OFF_VG = 2056, OFF_GATE = 2568, IN_W = 4616;
constexpr int NPROJ = 4608;
constexpr int PH = 8, PKEYS = 128, PHALF = 128, PTOP = 16, NEXP = 16384, QPW = 2048, HK = 128;
constexpr float EPS = 1e-6f;
constexpr float LOG2E = 1.4426950408889634f;
constexpr float C2 = 0.125f * LOG2E;

constexpr size_t MiB = 1u << 20;
constexpr size_t WS_CTL = 0, CTL_ZERO_BYTES = 65536;
constexpr size_t WS_WIN = 1 * MiB;
constexpr size_t WS_WA = 10 * MiB;
constexpr size_t WS_WB = 11 * MiB;
constexpr size_t WS_WOUT = 12 * MiB;
constexpr size_t WS_WQ = 14 * MiB;
constexpr size_t WS_SK = 18 * MiB;
constexpr size_t WS_WSM = 18 * MiB + 512 * 1024;
constexpr size_t WS_EU = 20 * MiB;
constexpr size_t WS_EV = 52 * MiB;
constexpr size_t WS_XN = 84 * MiB;
constexpr size_t WS_Q = 116 * MiB;
constexpr size_t WS_K = 132 * MiB;
constexpr size_t WS_V = 148 * MiB;
constexpr size_t WS_UG = 164 * MiB;
constexpr size_t WS_VG = 180 * MiB;
constexpr size_t WS_LOGF = 196 * MiB;
constexpr size_t WS_CL2 = 197 * MiB;
constexpr size_t WS_SU = 198 * MiB;
constexpr size_t WS_SV = 198 * MiB + 65536;
constexpr size_t WS_MERGED = WS_K;
constexpr size_t WS_QP = WS_Q;
constexpr size_t WS_H2Q = 200 * MiB;
constexpr size_t WS_ST = 198 * MiB + 131072;
constexpr size_t WS_PID = 180 * MiB;
constexpr size_t WS_G2 = 184 * MiB;
constexpr size_t WS_PS2 = 216 * MiB;
constexpr size_t WS_SBW = 198 * MiB + 786432;
constexpr size_t WS_SA = 198 * MiB + 851968;
constexpr size_t WS_SBWQ = 198 * MiB + 917504;
constexpr size_t WS_X1B = 224 * MiB;
constexpr size_t WS_END = 256 * MiB;

template <int CTRL> __device__ __forceinline__ float wr_dppf(float v) { return __int_as_float(__builtin_amdgcn_update_dpp(0, __float_as_int(v), CTRL, 0xf, 0xf, false)); }
__device__ __forceinline__ float wave_allsum(float v) {
    v += wr_dppf<0xB1>(v); v += wr_dppf<0x4E>(v); v += wr_dppf<0x141>(v); v += wr_dppf<0x128>(v);
    { const auto s = __builtin_amdgcn_permlane16_swap(__float_as_uint(v), __float_as_uint(v), false, false); v = __uint_as_float(s[0]) + __uint_as_float(s[1]); }
    { const auto s = __builtin_amdgcn_permlane32_swap(__float_as_uint(v), __float_as_uint(v), false, false); v = __uint_as_float(s[0]) + __uint_as_float(s[1]); }
    return v;
}
__device__ __forceinline__ float wave_allmax(float v) {
    v = fmaxf(v, wr_dppf<0xB1>(v)); v = fmaxf(v, wr_dppf<0x4E>(v)); v = fmaxf(v, wr_dppf<0x141>(v)); v = fmaxf(v, wr_dppf<0x128>(v));
    { const auto s = __builtin_amdgcn_permlane16_swap(__float_as_uint(v), __float_as_uint(v), false, false); v = fmaxf(__uint_as_float(s[0]), __uint_as_float(s[1])); }
    { const auto s = __builtin_amdgcn_permlane32_swap(__float_as_uint(v), __float_as_uint(v), false, false); v = fmaxf(__uint_as_float(s[0]), __uint_as_float(s[1])); }
    return v;
}
namespace pg8 {
#define PG8_LAS __attribute__((address_space(3)))
typedef unsigned short bf16_t;
typedef short bf16x8 __attribute__((ext_vector_type(8)));
typedef float f32x4 __attribute__((ext_vector_type(4)));
typedef unsigned u32x4 __attribute__((ext_vector_type(4)));
constexpr int BM = 256, BK = 64, HALF = 128, HTB = HALF * BK * 2  , STAGE_BYTES = 8 * HTB, NXCD = 8, WGM = 8;

__host__ __device__ __forceinline__ int lds_byte(int r, int c) { const int st = (r >> 4) * 2 + (c >> 5), rr = r & 15, cc = c & 31, ob = rr * 64 + cc * 2; return st * 1024 + (ob ^ (((ob >> 9) & 1) << 5)); }
__host__ __device__ __forceinline__ void stage_rc(int b, int& R, int& C) { const int st = b / 1024, sb = b % 1024, swz = sb ^ (((sb >> 9) & 1) << 5); R = (st >> 1) * 16 + swz / 64; C = (st & 1) * 32 + (swz % 64) / 2; }
__host__ __device__ __forceinline__ int perm32(int rho) { const int n = rho >> 4, i = rho & 15; return 8 * (i >> 2) + 4 * n + (i & 3); }

struct Unit { int pm, pn; };
struct Gemm { const bf16_t* A; const bf16_t* Bt; int M, N, K; };

struct StaticOrder {
    int nM, nN, nwg, G, c;
    __host__ __device__ void init(int M, int N, int G_, int c_) { nM = M / BM; nN = N / BM; nwg = nM * nN; G = G_; c = c_; }
    __host__ __device__ bool next(int i, Unit& u) const {
        const long L = (long)i * G + c; if (L >= nwg) return false;
        int wgid = (int)L; { const int q = nwg / NXCD, r = nwg % NXCD, xcd = wgid % NXCD, off = wgid / NXCD; wgid = (xcd < r ? xcd * (q + 1) : r * (q + 1) + (xcd - r) * q) + off; }
        const int nig = WGM * nN, gid = wgid / nig, fm = gid * WGM, gsz = (nM - fm) < WGM ? (nM - fm) : WGM;
        u.pm = fm + ((wgid % nig) % gsz); u.pn = (wgid % nig) / gsz; return true;
    }
    __device__ __forceinline__ void a_ready(const Unit&) const {}
    __device__ __forceinline__ void done(const Unit&) const {}
};

typedef float cvt_f32x2_t __attribute__((ext_vector_type(2))); typedef __bf16 cvt_bf16x2_t __attribute__((ext_vector_type(2)));
__device__ __forceinline__ unsigned cvt_pk_bf16(float lo, float hi) { cvt_f32x2_t v = {lo, hi}; cvt_bf16x2_t b = __builtin_convertvector(v, cvt_bf16x2_t); return __builtin_bit_cast(unsigned, b); }
typedef float f32x2 __attribute__((ext_vector_type(2)));
__device__ __forceinline__ f32x2 gelu_pk(f32x2 v) {
    const f32x2 av = __builtin_elementwise_abs(v), d = av * 0.2316418882f + 1.0f;
    f32x2 t; t.x = __builtin_amdgcn_rcpf(d.x); t.y = __builtin_amdgcn_rcpf(d.y);
    f32x2 q = t * 0.5307027145f + (-0.7265760135f); q = q * t + 0.7107068705f; q = q * t + (-0.142248368f); q = q * t + 0.127414796f; q = q * t;
    const f32x2 s = (v * v) * (-0.72134752044f);
    f32x2 e; e.x = __builtin_amdgcn_exp2f(s.x); e.y = __builtin_amdgcn_exp2f(s.y);
    const f32x2 m = v * (q * e), r = v - m;
    f32x2 o; o.x = v.x < 0.f ? m.x : r.x; o.y = v.y < 0.f ? m.y : r.y; return o;
}

template <int ACT  > struct EpiBf16 {
    static constexpr bool PERM = true, AFTER_DRAIN = false; static_assert(ACT == 0 || ACT == 1, "EpiBf16: ACT is 0 (none) or 1 (gelu_pk)");
    bf16_t* O; int ldc; const float* bias; int split_cols; size_t split_stride; float scale0;
    __device__ __forceinline__ void operator()(const f32x4 (&acc)[2][2][4][2], const Unit& u, int wr, int wc, int fr, int fq) const {
        const int row0 = u.pm * BM + wr * 64 + fr; int colt = u.pn * BM; bf16_t* base = O;
        float sc = 1.f; if (split_cols) { const int t = colt / split_cols; base += (size_t)t * split_stride; colt -= t * split_cols; if (t == 0) sc = scale0; }
        const int col0 = colt + wc * 32 + 8 * fq, bcol0 = u.pn * BM + wc * 32 + 8 * fq;
        f32x4 bv[2][2];
#pragma unroll
        for (int bj = 0; bj < 2; ++bj)
#pragma unroll
            for (int n = 0; n < 2; ++n) bv[bj][n] = bias ? *(const f32x4*)(bias + bcol0 + bj * HALF + 4 * n) : (f32x4){0.f, 0.f, 0.f, 0.f};
#pragma unroll
        for (int ai = 0; ai < 2; ++ai)
#pragma unroll
            for (int m = 0; m < 4; ++m) { bf16_t* rowp = base + (size_t)(row0 + ai * HALF + m * 16) * ldc + col0;
#pragma unroll
                for (int bj = 0; bj < 2; ++bj) { f32x4 v0 = acc[ai][bj][m][0] + bv[bj][0], v1 = acc[ai][bj][m][1] + bv[bj][1];
                    if (ACT == 1) { f32x2 a = gelu_pk((f32x2){v0[0], v0[1]}), b = gelu_pk((f32x2){v0[2], v0[3]}), c = gelu_pk((f32x2){v1[0], v1[1]}), d = gelu_pk((f32x2){v1[2], v1[3]});
                        v0 = (f32x4){a.x, a.y, b.x, b.y}; v1 = (f32x4){c.x, c.y, d.x, d.y}; }
                    v0 = v0 * sc; v1 = v1 * sc; u32x4 w; w.x = cvt_pk_bf16(v0[0], v0[1]); w.y = cvt_pk_bf16(v0[2], v0[3]); w.z = cvt_pk_bf16(v1[0], v1[1]); w.w = cvt_pk_bf16(v1[2], v1[3]);
                    *(u32x4*)(rowp + bj * HALF) = w; } }
    }
};
__device__ __forceinline__ f32x2 sigmoid_pk(f32x2 v) {
#ifdef DBG_SIG
    f32x2 o; o.x = 1.0f / (1.0f + __expf(-v.x)); o.y = 1.0f / (1.0f + __expf(-v.y)); return o;
#else
    f32x2 e; e.x = __builtin_amdgcn_exp2f(v.x * -1.4426950408889634f); e.y = __builtin_amdgcn_exp2f(v.y * -1.4426950408889634f);
    f32x2 o; o.x = __builtin_amdgcn_rcpf(1.0f + e.x); o.y = __builtin_amdgcn_rcpf(1.0f + e.y); return o;
#endif
}
typedef unsigned u32x2 __attribute__((ext_vector_type(2)));
__device__ __forceinline__ unsigned pack_u8x4(f32x4 v) {
    unsigned w = __builtin_amdgcn_cvt_pk_u8_f32(v[0], 0u, 0u); w = __builtin_amdgcn_cvt_pk_u8_f32(v[1], 1u, w); w = __builtin_amdgcn_cvt_pk_u8_f32(v[2], 2u, w); return __builtin_amdgcn_cvt_pk_u8_f32(v[3], 3u, w);
}
template <int ACT> __device__ __forceinline__ f32x4 act4(f32x4 v, float sc) {
    if (ACT == 0) return v * sc;
    f32x2 a, b;
    if (ACT == 2) { a = gelu_pk((f32x2){v[0], v[1]}); b = gelu_pk((f32x2){v[2], v[3]}); }
    else { a = sigmoid_pk((f32x2){v[0], v[1]}); b = sigmoid_pk((f32x2){v[2], v[3]}); }
    return (f32x4){a.x, a.y, b.x, b.y};
}
struct EpiProj {
    static constexpr bool PERM = true, AFTER_DRAIN = false;
    bf16_t* QKVUV; size_t tstride; bf16_t* GATE; float qscale;
    template <int ACT> __device__ __forceinline__ void body(const f32x4 (&acc)[2][2][4][2], bf16_t* base, int ldc, int row0, int col0, float sc) const {
#pragma unroll
        for (int ai = 0; ai < 2; ++ai)
#pragma unroll
            for (int m = 0; m < 4; ++m) { bf16_t* rowp = base + (size_t)(row0 + ai * HALF + m * 16) * ldc + col0;
#pragma unroll
                for (int bj = 0; bj < 2; ++bj) { const f32x4 v0 = act4<ACT>(acc[ai][bj][m][0], sc), v1 = act4<ACT>(acc[ai][bj][m][1], sc);
                    u32x4 w; w.x = cvt_pk_bf16(v0[0], v0[1]); w.y = cvt_pk_bf16(v0[2], v0[3]); w.z = cvt_pk_bf16(v1[0], v1[1]); w.w = cvt_pk_bf16(v1[2], v1[3]);
                    *(u32x4*)(rowp + bj * HALF) = w; } }
    }
    __device__ __forceinline__ void operator()(const f32x4 (&acc)[2][2][4][2], const Unit& u, int wr, int wc, int fr, int fq) const {
        const int row0 = u.pm * BM + wr * 64 + fr, pn = u.pn;
        if (pn < 10) { bf16_t* base = QKVUV + (size_t)(pn >> 1) * tstride; const int col0 = (pn & 1) * BM + wc * 32 + 8 * fq;
            if (pn < 6) body<0>(acc, base, 512, row0, col0, pn < 2 ? qscale : 1.0f); else body<2>(acc, base, 512, row0, col0, 1.0f); }
        else body<3>(acc, GATE, 2048, row0, (pn - 10) * BM + wc * 32 + 8 * fq, 1.0f);
    }
};
template <int PASS> struct EpiMerge {
    static constexpr bool PERM = true, AFTER_DRAIN = false;
    const bf16_t* GATE; bf16_t* MERGED;
    __device__ __forceinline__ void operator()(const f32x4 (&acc)[2][2][4][2], const Unit& u, int wr, int wc, int fr, int fq) const {
        const int row0 = u.pm * BM + wr * 64 + fr, col0 = u.pn * BM + wc * 32 + 8 * fq;
#pragma unroll
        for (int ai = 0; ai < 2; ++ai) {
            u32x2 gq[4][2]; u32x4 tq[4][2];
#pragma unroll
            for (int m = 0; m < 4; ++m) { const size_t r = (size_t)(row0 + ai * HALF + m * 16);
#pragma unroll
                for (int bj = 0; bj < 2; ++bj) { const int c = col0 + bj * HALF; gq[m][bj] = *(const u32x2*)((const unsigned char*)GATE + r * 2048 + PASS * 1024 + c);
                    if (PASS == 1) tq[m][bj] = *(const u32x4*)(MERGED + r * 1024 + c); } }
            asm volatile("" ::: "memory");
#pragma unroll
            for (int m = 0; m < 4; ++m) { const size_t r = (size_t)(row0 + ai * HALF + m * 16);
#pragma unroll
                for (int bj = 0; bj < 2; ++bj) { const int c = col0 + bj * HALF; const u32x2 g = gq[m][bj];
                    f32x4 v0 = acc[ai][bj][m][0], v1 = acc[ai][bj][m][1];
                    v0[0] *= (float)(g.x & 0xffu); v0[1] *= (float)((g.x >> 8) & 0xffu); v0[2] *= (float)((g.x >> 16) & 0xffu); v0[3] *= (float)(g.x >> 24);
                    v1[0] *= (float)(g.y & 0xffu); v1[1] *= (float)((g.y >> 8) & 0xffu); v1[2] *= (float)((g.y >> 16) & 0xffu); v1[3] *= (float)(g.y >> 24);
                    if (PASS == 1) { const u32x4 t = tq[m][bj];
                        v0[0] += __uint_as_float(t.x << 16); v0[1] += __uint_as_float(t.x & 0xffff0000u); v0[2] += __uint_as_float(t.y << 16); v0[3] += __uint_as_float(t.y & 0xffff0000u);
                        v1[0] += __uint_as_float(t.z << 16); v1[1] += __uint_as_float(t.z & 0xffff0000u); v1[2] += __uint_as_float(t.w << 16); v1[3] += __uint_as_float(t.w & 0xffff0000u); }
                    u32x4 w; w.x = cvt_pk_bf16(v0[0], v0[1]); w.y = cvt_pk_bf16(v0[2], v0[3]); w.z = cvt_pk_bf16(v1[0], v1[1]); w.w = cvt_pk_bf16(v1[2], v1[3]);
                    *(u32x4*)(MERGED + r * 1024 + c) = w; } }
            asm volatile("" ::: "memory");
        }
    }
};
struct EpiResid {
    static constexpr bool PERM = false, AFTER_DRAIN = false;
    const float* base; float* out; int ldc; int nrows;
    __device__ __forceinline__ void operator()(const f32x4 (&acc)[2][2][4][2], const Unit& u, int wr, int wc, int fr, int fq) const {
        const int col0 = u.pn * BM + wc * 32 + 4 * fq;
#pragma unroll
        for (int ai = 0; ai < 2; ++ai) {
            f32x4 pre[4][2][2];
#pragma unroll
            for (int m = 0; m < 4; ++m) { const size_t off = (size_t)(u.pm * BM + ai * HALF + wr * 64 + m * 16 + fr) * ldc + col0;
#pragma unroll
                for (int bj = 0; bj < 2; ++bj)
#pragma unroll
                    for (int n = 0; n < 2; ++n) pre[m][bj][n] = *(const f32x4*)(base + off + bj * HALF + n * 16); }
            asm volatile("" ::: "memory");
#pragma unroll
            for (int m = 0; m < 4; ++m) { const size_t off = (size_t)(u.pm * BM + ai * HALF + wr * 64 + m * 16 + fr) * ldc + col0;
#pragma unroll
                for (int bj = 0; bj < 2; ++bj)
#pragma unroll
                    for (int n = 0; n < 2; ++n) *(f32x4*)(out + off + bj * HALF + n * 16) = pre[m][bj][n] + acc[ai][bj][m][n]; }
            asm volatile("" ::: "memory");
        }
    }
};

struct EpiResidB {
    static constexpr bool PERM = true, AFTER_DRAIN = false;
    const float* base; bf16_t* out; int ldc;
    __device__ __forceinline__ void operator()(const f32x4 (&acc)[2][2][4][2], const Unit& u, int wr, int wc, int fr, int fq) const {
        const int row0 = u.pm * BM + wr * 64 + fr, col0 = u.pn * BM + wc * 32 + 8 * fq;
#pragma unroll
        for (int ai = 0; ai < 2; ++ai) {
            f32x4 pre[4][2][2];
#pragma unroll
            for (int m = 0; m < 4; ++m) { const size_t off = (size_t)(row0 + ai * HALF + m * 16) * ldc + col0;
#pragma unroll
                for (int bj = 0; bj < 2; ++bj)
#pragma unroll
                    for (int n = 0; n < 2; ++n) pre[m][bj][n] = *(const f32x4*)(base + off + bj * HALF + 4 * n); }
            asm volatile("" ::: "memory");
#pragma unroll
            for (int m = 0; m < 4; ++m) { const size_t off = (size_t)(row0 + ai * HALF + m * 16) * ldc + col0;
#pragma unroll
                for (int bj = 0; bj < 2; ++bj) { const f32x4 v0 = pre[m][bj][0] + acc[ai][bj][m][0], v1 = pre[m][bj][1] + acc[ai][bj][m][1];
                    u32x4 w; w.x = cvt_pk_bf16(v0[0], v0[1]); w.y = cvt_pk_bf16(v0[2], v0[3]); w.z = cvt_pk_bf16(v1[0], v1[1]); w.w = cvt_pk_bf16(v1[2], v1[3]);
                    *(u32x4*)(out + off + bj * HALF) = w; } }
            asm volatile("" ::: "memory");
        }
    }
};

constexpr int MERGE_DPM = 192;
struct MergeOrder : StaticOrder {
    __host__ __device__ bool next(int i, Unit& u) const {
        if (!StaticOrder::next(i >> 1, u)) return false;
        if (i & 1) { u.pm += MERGE_DPM; u.pn += 4; }
        return true;
    }
};
struct EpiMergeAB {
    static constexpr bool PERM = true, AFTER_DRAIN = false;
    const bf16_t* GATE; bf16_t* MERGED;
    __device__ __forceinline__ void operator()(const f32x4 (&acc)[2][2][4][2], const Unit& u, int wr, int wc, int fr, int fq) const {
        if (u.pn < 4) { EpiMerge<0> E{GATE, MERGED}; E(acc, u, wr, wc, fr, fq); }
        else { Unit v; v.pm = u.pm - MERGE_DPM; v.pn = u.pn - 4; EpiMerge<1> E{GATE, MERGED}; E(acc, v, wr, wc, fr, fq); }
    }
};
struct QueryOrder {
    int v, G, ntask;
    __host__ __device__ bool next(int i, Unit& u) const { const int tk = v + (i >> 1) * G; if (tk >= ntask) return false; u.pm = 2 * (tk >> 3) + (i & 1); u.pn = tk & 7; return true; }
    __device__ __forceinline__ void a_ready(const Unit&) const {}
    __device__ __forceinline__ void done(const Unit&) const {}
};

struct EpiProjI8 {
    static constexpr bool PERM = true, AFTER_DRAIN = false;
    bf16_t* QKVUV; size_t tstride; bf16_t* GATE; float qscale; const float* sA; const float* sB;
    template <int ACT> __device__ __forceinline__ void body(const f32x4 (&acc)[2][2][4][2], bf16_t* base, int ldc, int row0, int col0, int bcol0, float sc) const {
        f32x4 sb[2][2];
#pragma unroll
        for (int bj = 0; bj < 2; ++bj)
#pragma unroll
            for (int n = 0; n < 2; ++n) sb[bj][n] = *(const f32x4*)(sB + bcol0 + bj * HALF + 4 * n);
#pragma unroll
        for (int ai = 0; ai < 2; ++ai)
#pragma unroll
            for (int m = 0; m < 4; ++m) { const int row = row0 + ai * HALF + m * 16; bf16_t* rowp = base + (size_t)row * ldc + col0; const float sa = sA[row];
#pragma unroll
                for (int bj = 0; bj < 2; ++bj) {
                    typedef int i32x4_t __attribute__((ext_vector_type(4)));
                    const i32x4_t i0 = __builtin_bit_cast(i32x4_t, acc[ai][bj][m][0]), i1 = __builtin_bit_cast(i32x4_t, acc[ai][bj][m][1]);
                    const f32x4 f0 = (f32x4){(float)i0[0], (float)i0[1], (float)i0[2], (float)i0[3]} * sb[bj][0] * sa, f1 = (f32x4){(float)i1[0], (float)i1[1], (float)i1[2], (float)i1[3]} * sb[bj][1] * sa;
                    const f32x4 v0 = act4<ACT>(f0, sc), v1 = act4<ACT>(f1, sc);
                    if (ACT == 3) {
                        u32x2 w8; w8.x = pack_u8x4(v0 * 255.0f); w8.y = pack_u8x4(v1 * 255.0f);
                        *(u32x2*)((unsigned char*)base + (size_t)row * ldc + col0 + bj * HALF) = w8;
                    } else {
                    u32x4 w; w.x = cvt_pk_bf16(v0[0], v0[1]); w.y = cvt_pk_bf16(v0[2], v0[3]); w.z = cvt_pk_bf16(v1[0], v1[1]); w.w = cvt_pk_bf16(v1[2], v1[3]);
                    *(u32x4*)(rowp + bj * HALF) = w; } } }
    }
    __device__ __forceinline__ void operator()(const f32x4 (&acc)[2][2][4][2], const Unit& u, int wr, int wc, int fr, int fq) const {
        const int row0 = u.pm * BM + wr * 64 + fr, pn = u.pn, bcol0 = pn * BM + wc * 32 + 8 * fq;
        if (pn < 10) { bf16_t* base = QKVUV + (size_t)(pn >> 1) * tstride; const int col0 = (pn & 1) * BM + wc * 32 + 8 * fq;
            if (pn < 6) body<0>(acc, base, 512, row0, col0, bcol0, pn < 2 ? qscale : 1.0f); else body<2>(acc, base, 512, row0, col0, bcol0, 1.0f); }
        else body<3>(acc, GATE, 2048, row0, (pn - 10) * BM + wc * 32 + 8 * fq, bcol0, 1.0f);
    }
};

struct EpiBf16I8 {
    static constexpr bool PERM = true, AFTER_DRAIN = false;
    bf16_t* O; int ldc; const float* sA; const float* sB;
    __device__ __forceinline__ void operator()(const f32x4 (&acc)[2][2][4][2], const Unit& u, int wr, int wc, int fr, int fq) const {
        typedef int i32x4_t __attribute__((ext_vector_type(4)));
        const int row0 = u.pm * BM + wr * 64 + fr, col0 = u.pn * BM + wc * 32 + 8 * fq;
        f32x4 sb[2][2];
#pragma unroll
        for (int bj = 0; bj < 2; ++bj)
#pragma unroll
            for (int n = 0; n < 2; ++n) sb[bj][n] = *(const f32x4*)(sB + col0 + bj * HALF + 4 * n);
#pragma unroll
        for (int ai = 0; ai < 2; ++ai)
#pragma unroll
            for (int m = 0; m < 4; ++m) { const int row = row0 + ai * HALF + m * 16; bf16_t* rowp = O + (size_t)row * ldc + col0; const float sa = sA[row];
#pragma unroll
                for (int bj = 0; bj < 2; ++bj) {
                    const i32x4_t i0 = __builtin_bit_cast(i32x4_t, acc[ai][bj][m][0]), i1 = __builtin_bit_cast(i32x4_t, acc[ai][bj][m][1]);
                    const f32x4 v0 = (f32x4){(float)i0[0], (float)i0[1], (float)i0[2], (float)i0[3]} * sb[bj][0] * sa, v1 = (f32x4){(float)i1[0], (float)i1[1], (float)i1[2], (float)i1[3]} * sb[bj][1] * sa;
                    u32x4 w; w.x = cvt_pk_bf16(v0[0], v0[1]); w.y = cvt_pk_bf16(v0[2], v0[3]); w.z = cvt_pk_bf16(v1[0], v1[1]); w.w = cvt_pk_bf16(v1[2], v1[3]);
                    *(u32x4*)(rowp + bj * HALF) = w; } }
    }
};
template <class Epi, class Sched, bool ALIGN_EPI = false, bool SP2 = false, bool I8 = false>
__device__ __forceinline__ void gemm_phase(PG8_LAS unsigned char* lds, const Gemm g, const Sched& S, const Epi& E) {
    typedef int i32x4_t __attribute__((ext_vector_type(4)));
    int tid = threadIdx.x; asm volatile("" : "+v"(tid));
    const int wid = __builtin_amdgcn_readfirstlane(tid >> 6), lane = tid & 63, wr = wid >> 2, wc = wid & 3, fr = lane & 15, fq = lane >> 4;
    const int K = g.K, nt = K / BK;
    unsigned voffA[2], voffB[2];
#pragma unroll
    for (int i = 0; i < 2; ++i) { int R, C; stage_rc(tid * 16 + i * 8192, R, C); const int Rb = Epi::PERM ? ((R & ~31) + perm32(R & 31)) : R;
        voffA[i] = (unsigned)(R * K + C) * 2u; voffB[i] = (unsigned)(Rb * K + C) * 2u; }
    const size_t kstep = (size_t)(BK * 2);
    const size_t hstep = (size_t)HALF * K * 2;
    const size_t tstep = 2 * hstep;
    const unsigned ldsw = (unsigned)wid * 1024u;
    const int aoff = lds_byte(wr * 64 + fr, fq * 8), boff = lds_byte(wc * 32 + fr, fq * 8);
#define PG8_SA(b, h) (((b) * 2 + (h)) * HTB)
#define PG8_SB(b, h) ((4 + (b) * 2 + (h)) * HTB)
#define PG8_STAGE(bufoff, gbase, voff) do { _Pragma("unroll") for (int _i = 0; _i < 2; ++_i) \
        __builtin_amdgcn_global_load_lds((const unsigned*)((const char*)(gbase) + (voff)[_i]), (PG8_LAS unsigned*)(lds + (bufoff) + ldsw + _i * 8192), 16, 0, 0); } while (0)
#define PG8_LDA(dst, b, h) do { _Pragma("unroll") for (int m = 0; m < 4; ++m) _Pragma("unroll") for (int k = 0; k < 2; ++k) dst[m][k] = *(const PG8_LAS bf16x8*)(lds + PG8_SA(b, h) + aoff + m * 2048 + k * 1024); } while (0)
#define PG8_LDB(dst, b, h) do { _Pragma("unroll") for (int n = 0; n < 2; ++n) _Pragma("unroll") for (int k = 0; k < 2; ++k) dst[n][k] = *(const PG8_LAS bf16x8*)(lds + PG8_SB(b, h) + boff + n * 2048 + k * 1024); } while (0)
#define PG8_MMA(ai, bj, At, Bt) do { __builtin_amdgcn_s_setprio(1); _Pragma("unroll") for (int m = 0; m < 4; ++m) _Pragma("unroll") for (int n = 0; n < 2; ++n) _Pragma("unroll") for (int k = 0; k < 2; ++k) \
        { if constexpr (I8) acc[ai][bj][m][n] = __builtin_bit_cast(f32x4, __builtin_amdgcn_mfma_i32_16x16x64_i8(__builtin_bit_cast(i32x4_t, Bt[n][k]), __builtin_bit_cast(i32x4_t, At[m][k]), __builtin_bit_cast(i32x4_t, acc[ai][bj][m][n]), 0, 0, 0)); \
          else acc[ai][bj][m][n] = __builtin_amdgcn_mfma_f32_16x16x32_bf16(Bt[n][k], At[m][k], acc[ai][bj][m][n], 0, 0, 0); } __builtin_amdgcn_s_setprio(0); } while (0)
#define PG8_WAIT_V(n) asm volatile("s_waitcnt vmcnt(" #n ")" ::: "memory")
#define PG8_WAIT_L(n) asm volatile("s_waitcnt lgkmcnt(" #n ")" ::: "memory")
#define PG8_BAR __builtin_amdgcn_s_barrier()
#define PG8_SCHED __builtin_amdgcn_sched_barrier(0)
    Unit cur, nxt; int ui = 0;
    if (!S.next(0, cur)) return;
    f32x4 acc[2][2][4][2];
#pragma unroll
    for (int a = 0; a < 2; ++a)
#pragma unroll
        for (int b = 0; b < 2; ++b)
#pragma unroll
            for (int m = 0; m < 4; ++m)
#pragma unroll
                for (int n = 0; n < 2; ++n) acc[a][b][m][n] = (f32x4){0.f, 0.f, 0.f, 0.f};
    bf16x8 At[4][2], B0[2][2], B1[2][2];
    const char* cA = (const char*)g.A + (size_t)cur.pm * tstep; const char* cB = (const char*)g.Bt + (size_t)cur.pn * tstep;
    S.a_ready(cur);
    if constexpr (SP2) {
        PG8_STAGE(PG8_SB(0, 0), cB, voffB); PG8_STAGE(PG8_SB(0, 1), cB + hstep, voffB); PG8_STAGE(PG8_SA(0, 0), cA, voffA); PG8_STAGE(PG8_SA(0, 1), cA + hstep, voffA);
        if (wr == 1) PG8_BAR;
        PG8_WAIT_V(2); PG8_BAR;
        PG8_STAGE(PG8_SB(1, 0), cB + kstep, voffB); PG8_STAGE(PG8_SA(1, 0), cA + kstep, voffA); PG8_STAGE(PG8_SB(1, 1), cB + hstep + kstep, voffB);
        PG8_WAIT_V(6); PG8_BAR;
    } else {
        PG8_STAGE(PG8_SB(0, 0), cB, voffB); PG8_STAGE(PG8_SA(0, 0), cA, voffA); PG8_STAGE(PG8_SB(0, 1), cB + hstep, voffB); PG8_STAGE(PG8_SA(0, 1), cA + hstep, voffA);
        if (wr == 1) PG8_BAR;
        PG8_WAIT_V(4); PG8_BAR;
        PG8_STAGE(PG8_SB(1, 0), cB + kstep, voffB); PG8_STAGE(PG8_SA(1, 0), cA + kstep, voffA); PG8_STAGE(PG8_SB(1, 1), cB + hstep + kstep, voffB);
        PG8_WAIT_V(6); PG8_BAR;
    }
    for (;;) {
        const bool has_next = S.next(ui + 1, nxt);
        const char* nA = has_next ? (const char*)g.A + (size_t)nxt.pm * tstep : cA; const char* nB = has_next ? (const char*)g.Bt + (size_t)nxt.pn * tstep : cB;
        for (int t = 0; t < nt; t += 2) {
            const bool last = (t == nt - 2);
            const char* a1 = cA + (size_t)(t + 1) * kstep;
            const char* a2 = last ? nA : cA + (size_t)(t + 2) * kstep; const char* b2 = last ? nB : cB + (size_t)(t + 2) * kstep;
            const char* a3 = a2 + kstep; const char* b3 = b2 + kstep;
            if (last && has_next) S.a_ready(nxt);
            if constexpr (SP2) {
            PG8_LDB(B0, 0, 0); PG8_LDB(B1, 0, 1); PG8_SCHED; PG8_LDA(At, 0, 0); PG8_STAGE(PG8_SA(1, 1), a1 + hstep, voffA);
            PG8_WAIT_V(8); PG8_WAIT_L(0); PG8_BAR; PG8_MMA(0, 0, At, B0); PG8_MMA(0, 1, At, B1); PG8_BAR; PG8_SCHED;
            PG8_LDA(At, 0, 1); PG8_STAGE(PG8_SB(0, 0), b2, voffB); PG8_STAGE(PG8_SB(0, 1), b2 + hstep, voffB); PG8_STAGE(PG8_SA(0, 0), a2, voffA);
            PG8_WAIT_V(8); PG8_WAIT_L(0); PG8_BAR; PG8_MMA(1, 0, At, B0); PG8_MMA(1, 1, At, B1); PG8_BAR; PG8_SCHED;
            PG8_LDB(B0, 1, 0); PG8_LDB(B1, 1, 1); PG8_SCHED; PG8_LDA(At, 1, 0); PG8_STAGE(PG8_SA(0, 1), a2 + hstep, voffA);
            PG8_WAIT_V(8); PG8_WAIT_L(0); PG8_BAR; PG8_MMA(0, 0, At, B0); PG8_MMA(0, 1, At, B1); PG8_BAR; PG8_SCHED;
            PG8_LDA(At, 1, 1); PG8_STAGE(PG8_SB(1, 0), b3, voffB); PG8_STAGE(PG8_SB(1, 1), b3 + hstep, voffB); PG8_STAGE(PG8_SA(1, 0), a3, voffA);
            PG8_WAIT_V(8); PG8_WAIT_L(0); PG8_BAR; PG8_MMA(1, 0, At, B0); PG8_MMA(1, 1, At, B1); PG8_BAR; PG8_SCHED;
            } else {
            PG8_LDB(B0, 0, 0); PG8_SCHED; PG8_LDA(At, 0, 0); PG8_STAGE(PG8_SA(1, 1), a1 + hstep, voffA);
            PG8_WAIT_L(8); PG8_BAR; PG8_WAIT_L(0); PG8_MMA(0, 0, At, B0); PG8_BAR; PG8_SCHED;
            PG8_LDB(B1, 0, 1); PG8_STAGE(PG8_SB(0, 0), b2, voffB);
            PG8_BAR; PG8_WAIT_L(0); PG8_MMA(0, 1, At, B1); PG8_BAR;
            PG8_LDA(At, 0, 1); PG8_STAGE(PG8_SA(0, 0), a2, voffA);
            PG8_BAR; PG8_WAIT_L(0); PG8_MMA(1, 0, At, B0); PG8_BAR; PG8_SCHED;
            PG8_STAGE(PG8_SB(0, 1), b2 + hstep, voffB);
            PG8_WAIT_V(6); PG8_BAR; PG8_MMA(1, 1, At, B1); PG8_BAR;
            PG8_LDB(B0, 1, 0); PG8_SCHED; PG8_LDA(At, 1, 0); PG8_STAGE(PG8_SA(0, 1), a2 + hstep, voffA);
            PG8_WAIT_L(8); PG8_BAR; PG8_WAIT_L(0); PG8_MMA(0, 0, At, B0); PG8_BAR; PG8_SCHED;
            PG8_LDB(B1, 1, 1); PG8_STAGE(PG8_SB(1, 0), b3, voffB);
            PG8_BAR; PG8_WAIT_L(0); PG8_MMA(0, 1, At, B1); PG8_BAR;
            PG8_LDA(At, 1, 1); PG8_STAGE(PG8_SA(1, 0), a3, voffA);
            PG8_BAR; PG8_WAIT_L(0); PG8_MMA(1, 0, At, B0); PG8_BAR; PG8_SCHED;
            PG8_STAGE(PG8_SB(1, 1), b3 + hstep, voffB);
            PG8_WAIT_V(6); PG8_BAR; PG8_MMA(1, 1, At, B1); PG8_BAR;
            }
        }
        if constexpr (ALIGN_EPI) { if (wr == 0) PG8_BAR; }
        if constexpr (!Epi::AFTER_DRAIN) { E(acc, cur, wr, wc, fr, fq); S.done(cur); }
        if (!has_next) break;
#pragma unroll
        for (int a = 0; a < 2; ++a)
#pragma unroll
            for (int b = 0; b < 2; ++b)
#pragma unroll
                for (int m = 0; m < 4; ++m)
#pragma unroll
                    for (int n = 0; n < 2; ++n) acc[a][b][m][n] = (f32x4){0.f, 0.f, 0.f, 0.f};
        cur = nxt; cA = nA; cB = nB; ++ui;
        if constexpr (ALIGN_EPI) { if (wr == 1) PG8_BAR; }
    }
    PG8_WAIT_V(0);
    if constexpr (!ALIGN_EPI) { if (wr == 0) PG8_BAR; }
    PG8_BAR;
    if constexpr (Epi::AFTER_DRAIN) { E.fused(acc, cur, wr, wc, fr, fq, lds, wid, lane); S.done(cur); }
#undef PG8_SA
#undef PG8_SB
#undef PG8_STAGE
#undef PG8_LDA
#undef PG8_LDB
#undef PG8_MMA
#undef PG8_WAIT_V
#undef PG8_WAIT_L
#undef PG8_BAR
#undef PG8_SCHED
}
}
#include <hip/hip_bf16.h>
#include <cmath>
namespace attn_body {
using bf16=__hip_bfloat16;
using bf16x8=__attribute__((ext_vector_type(8)))short;
using s16x4=__attribute__((ext_vector_type(4)))short;
using f32x16=__attribute__((ext_vector_type(16)))float;
using u32x4=__attribute__((ext_vector_type(4)))unsigned;
constexpr int BATCH=8,NHEAD=8,SEQ=2048,D=64,DM=NHEAD*D;
constexpr int NW=8,QBLK=32,QB=QBLK*NW,KVBLK=64,NQB=SEQ/QB;
constexpr int ATTN_PITCH=DM, ATTN_UNIT_ROWS=QB;
__device__ __forceinline__ int crow(int r,int hi){return (r&3)+8*(r>>2)+4*hi;}
#define SBAR() __builtin_amdgcn_sched_barrier(0)
__device__ __forceinline__ void cmask(f32x16&p0,f32x16&p1,int jb,int qrel,int hi){
  const float NEG=-INFINITY; int kb=64*jb+4*hi;
  #pragma unroll
  for(int r=0;r<16;++r){int kv=kb+(r&3)+8*(r>>2); if(kv>qrel)p0[r]=NEG; if(kv+32>qrel)p1[r]=NEG;}
}

constexpr int NSLOT=3, SLOTB=8192;
constexpr int LDS_K=0, LDS_V=NSLOT*SLOTB, LDS_WS=2*NSLOT*SLOTB, LDS_OST=LDS_WS+NW*64*4, LDS_CS=LDS_OST+NW*4096, LDS_BYTES=LDS_CS+SEQ*4;
constexpr float C2=0.125f*1.4426950408889634f;
__device__ __forceinline__ void glds16(const void*gsrc,unsigned lds_dst){unsigned keep;
  asm volatile("s_mov_b32 %0, m0\n\ts_mov_b32 m0, %2\n\ts_nop 0\n\tglobal_load_lds_dwordx4 %1, off\n\ts_mov_b32 m0, %0":"=&s"(keep):"v"(gsrc),"s"(lds_dst):"memory");}
__device__ __forceinline__ float max3f(float a,float b,float c){float r;asm("v_max3_f32 %0, %1, %2, %3":"=v"(r):"v"(a),"v"(b),"v"(c));return r;}
__device__ __forceinline__ float max2f(float a,float b){float r;asm("v_max_f32_e32 %0, %1, %2":"=v"(r):"v"(a),"v"(b));return r;}
__device__ __forceinline__ float fadd_s(float a,float b){float r;asm("v_add_f32_e32 %0, %1, %2":"=v"(r):"v"(a),"v"(b));return r;}
__device__ __forceinline__ float fsub_s(float a,float b){float r;asm("v_sub_f32_e32 %0, %1, %2":"=v"(r):"v"(a),"v"(b));return r;}
typedef float f32x2_t __attribute__((ext_vector_type(2))); typedef __bf16 bf16x2_t __attribute__((ext_vector_type(2)));
__device__ __forceinline__ unsigned cvtpk_s(float lo,float hi){f32x2_t v={lo,hi};bf16x2_t b=__builtin_convertvector(v,bf16x2_t);return __builtin_bit_cast(unsigned,b);}
#define WAIT_BAR(N) asm volatile("s_waitcnt vmcnt(" #N ") lgkmcnt(0)\n\ts_barrier":::"memory")

__device__ __forceinline__ void qkt(f32x16&p0,f32x16&p1,const char*Kslot,const bf16x8*qr,int r32,int hi){
  const char*kb=Kslot+hi*1024+r32*16;
  #pragma unroll
  for(int d0=0;d0<4;++d0){
    const bf16x8 b0=*reinterpret_cast<const bf16x8*>(kb+d0*2048);
    const bf16x8 b1=*reinterpret_cast<const bf16x8*>(kb+d0*2048+512);
    p0=__builtin_amdgcn_mfma_f32_32x32x16_bf16(b0,qr[d0],p0,0,0,0);p1=__builtin_amdgcn_mfma_f32_32x32x16_bf16(b1,qr[d0],p1,0,0,0);}
}
typedef __attribute__((address_space(3))) const char* lds_cptr;
typedef short v4i16_t __attribute__((ext_vector_type(4)));
__device__ __forceinline__ void kload8(bf16x8*kf,lds_cptr kp){
  kf[0]=*(const __attribute__((address_space(3))) bf16x8*)(kp);      kf[1]=*(const __attribute__((address_space(3))) bf16x8*)(kp+512);
  kf[2]=*(const __attribute__((address_space(3))) bf16x8*)(kp+2048); kf[3]=*(const __attribute__((address_space(3))) bf16x8*)(kp+2560);
  kf[4]=*(const __attribute__((address_space(3))) bf16x8*)(kp+4096); kf[5]=*(const __attribute__((address_space(3))) bf16x8*)(kp+4608);
  kf[6]=*(const __attribute__((address_space(3))) bf16x8*)(kp+6144); kf[7]=*(const __attribute__((address_space(3))) bf16x8*)(kp+6656);
}
__device__ __forceinline__ void kload2(bf16x8*kf,lds_cptr kp,int j){ kf[2*j]=*(const __attribute__((address_space(3))) bf16x8*)(kp+j*2048); kf[2*j+1]=*(const __attribute__((address_space(3))) bf16x8*)(kp+j*2048+512); }
__device__ __forceinline__ s16x4 vtr(lds_cptr p){ return __builtin_bit_cast(s16x4,__builtin_amdgcn_ds_read_tr16_b64_v4i16((__attribute__((address_space(3))) v4i16_t*)p)); }
__device__ __forceinline__ float rowmax(const f32x16&p0,const f32x16&p1){
  float a=max3f(p0[0],p0[1],p1[0]),b=max3f(p0[2],p0[3],p1[1]);a=max3f(a,p1[2],p1[3]);
  #pragma unroll
  for(int r=4;r<16;r+=4){a=max3f(a,p0[r],p0[r+1]);b=max3f(b,p0[r+2],p0[r+3]);a=max3f(a,p1[r],p1[r+1]);b=max3f(b,p1[r+2],p1[r+3]);}
  const float m=max2f(a,b);
  auto rr=__builtin_amdgcn_permlane32_swap(__float_as_uint(m),__float_as_uint(m),false,false);
  return max2f(__uint_as_float(rr[0]),__uint_as_float(rr[1]));
}
__device__ __forceinline__ void pv(f32x16*o,int vb,bf16x8 pa0,bf16x8 pa1,bf16x8 pa2,bf16x8 pa3){
  #pragma unroll
  for(int d0=0;d0<2;++d0){s16x4 lo[4],hi[4];
    #pragma unroll
    for(int ks=0;ks<4;++ks){
      asm volatile("ds_read_b64_tr_b16 %0,%1 offset:%c2":"=&v"(lo[ks]):"v"(vb),"i"(d0*4096+ks*1024):"memory");
      asm volatile("ds_read_b64_tr_b16 %0,%1 offset:%c2":"=&v"(hi[ks]):"v"(vb),"i"(d0*4096+ks*1024+512):"memory");}
    asm volatile("s_waitcnt lgkmcnt(0)":::"memory");SBAR();
    #define PK(k) (bf16x8){lo[k][0],lo[k][1],lo[k][2],lo[k][3],hi[k][0],hi[k][1],hi[k][2],hi[k][3]}
    o[d0]=__builtin_amdgcn_mfma_f32_32x32x16_bf16(pa0,PK(0),o[d0],0,0,0);
    o[d0]=__builtin_amdgcn_mfma_f32_32x32x16_bf16(pa1,PK(1),o[d0],0,0,0);
    o[d0]=__builtin_amdgcn_mfma_f32_32x32x16_bf16(pa2,PK(2),o[d0],0,0,0);
    o[d0]=__builtin_amdgcn_mfma_f32_32x32x16_bf16(pa3,PK(3),o[d0],0,0,0);
    #undef PK
  }
}

#ifndef ATTN_STORE16
#define ATTN_STORE16(p,v) (*(u32x4*)(p)=(v))
#endif
template<int THRL> __device__ __forceinline__ void attn_unit(int b,int h,int qb,const bf16*Q,const bf16*__restrict__ K,const bf16*__restrict__ V,bf16*O,const float*__restrict__ CL2,char*shm,int t0=0){
  int tid=threadIdx.x; asm volatile("":"+v"(tid)); const int lane=tid&63,r32=lane&31,hi=lane>>5; const int wid=__builtin_amdgcn_readfirstlane(tid>>6);
  const long rowbase=(long)b*SEQ; const int q0=qb*QB;
  const bf16*Qw=Q+(rowbase+q0+wid*QBLK)*DM+h*D;
  const bf16*Kh=K+rowbase*DM+h*D,*Vh=V+rowbase*DM+h*D;
  const unsigned lds0=(unsigned)(uintptr_t)shm;
  float*wsf=(float*)(shm+LDS_WS)+wid*64;
  const bf16*ksrc=Kh+(long)(t0*KVBLK+lane)*DM+wid*8;
  const bf16*vsrc=Vh+(long)(t0*KVBLK+16*(wid&3)+(lane>>2))*DM+(wid>>2)*32+(lane&3)*8;
  const unsigned kdst=lds0+LDS_K+wid*1024, vdst=lds0+LDS_V+wid*1024;
  #define DMA_K(t,slot) glds16(ksrc+(long)(t)*KVBLK*DM,(unsigned)__builtin_amdgcn_readfirstlane(kdst+(slot)))
  #define DMA_V(t,slot) glds16(vsrc+(long)(t)*KVBLK*DM,(unsigned)__builtin_amdgcn_readfirstlane(vdst+(slot)))
  const int vb0=(int)(lds0+LDS_V)+((lane>>4)&1)*32+(lane&3)*8+(4*hi+((lane&15)>>2))*64;
  const char*Kbase=shm+LDS_K; bf16x8 kf[8];
  const lds_cptr shm3=(lds_cptr)shm; const lds_cptr kp0=shm3+LDS_K+hi*1024+r32*16; const lds_cptr vp0=shm3+LDS_V+((lane>>4)&1)*32+(lane&3)*8+(4*hi+((lane&15)>>2))*64;
  const int NT=(q0+QB)/KVBLK-t0;
  DMA_K(0,0);DMA_V(0,0);DMA_K(1,SLOTB);
  bf16x8 qr[4];
  #pragma unroll
  for(int d0=0;d0<4;++d0)qr[d0]=*reinterpret_cast<const bf16x8*>(&Qw[(long)r32*DM+d0*16+hi*8]);
  const float*cg=CL2+(long)(b*NHEAD+h)*SEQ;
  { float*csf=(float*)(shm+LDS_CS); for(int i=tid;i<q0+QB;i+=NW*64)csf[i]=cg[i]; }
  const lds_cptr cs3=(lds_cptr)shm+LDS_CS+hi*16+t0*256;
  float nm=cg[q0+wid*QBLK+r32],l_reg=0.f;f32x16 o[2];o[0]=f32x16{};o[1]=f32x16{};
  const int qrel=wid*QBLK+r32;
  #define CMASK(P0,P1,t) do{int jb_=(t)-(NT-4); if(jb_>=0)cmask(P0,P1,jb_,qrel,hi);}while(0)
  bool resc=false;
  typedef float f32x4_t __attribute__((ext_vector_type(4)));
  #define BIAS(C0,C1,t) do{ const lds_cptr cp_=cs3+(t)*256; \
    _Pragma("unroll") for(int g_=0;g_<4;++g_){ const f32x4_t a_=*(const __attribute__((address_space(3))) f32x4_t*)(cp_+g_*32), b_=*(const __attribute__((address_space(3))) f32x4_t*)(cp_+g_*32+128); \
      _Pragma("unroll") for(int i_=0;i_<4;++i_){ C0[4*g_+i_]=nm-a_[i_]; C1[4*g_+i_]=nm-b_[i_]; } } }while(0)
  #define START(P0,P1) do{ const float rm=rowmax(P0,P1); resc=false; \
    { const float dl=(rm>(float)THRL)?rm:0.f;     \
      nm=fsub_s(nm,dl); \
      _Pragma("unroll") for(int r=0;r<16;++r){P0[r]=fsub_s(P0[r],dl);P1[r]=fsub_s(P1[r],dl);} } \
    _Pragma("unroll") for(int r=0;r<16;++r)P0[r]=__builtin_amdgcn_exp2f(P0[r]); }while(0)
  #define RESC() do{ if(resc){ asm volatile("s_waitcnt lgkmcnt(0)":::"memory"); \
      _Pragma("unroll") for(int d_=0;d_<2;++d_) _Pragma("unroll") for(int r=0;r<16;++r)o[d_][r]*=wsf[crow(r,hi)]; } }while(0)
  f32x16 pA0,pA1,pB0,pB1;
  int sl_prev=0,sl_cur=0,sl_next=SLOTB;
  #define ROT() do{sl_prev=sl_cur;sl_cur=sl_next;sl_next=(sl_next==(NSLOT-1)*SLOTB)?0:sl_next+SLOTB;}while(0)
  DMA_K(2,2*SLOTB);
  WAIT_BAR(3);
  BIAS(pA0,pA1,0); qkt(pA0,pA1,Kbase,qr,r32,hi);asm volatile("s_nop 15\n\ts_nop 7":"+v"(pA0),"+v"(pA1));CMASK(pA0,pA1,0);
  START(pA0,pA1);
  _Pragma("unroll") for(int r=0;r<16;++r)pA1[r]=__builtin_amdgcn_exp2f(pA1[r]);
  WAIT_BAR(0);
  DMA_K(3,0);DMA_V(1,SLOTB);
  ROT();
  kload8(kf,kp0+sl_cur);
  WAIT_BAR(2);
  s16x4 vlo[8],vhi[8]; u32x4 pw0,pw1,pw2,pw3;
  #define PKW(P,B) cvtpk_s(P[B],P[B+1])
  #define PAF(k) __builtin_bit_cast(bf16x8,pw##k)
  #define VFR(i) (bf16x8){vlo[i][0],vlo[i][1],vlo[i][2],vlo[i][3],vhi[i][0],vhi[i][1],vhi[i][2],vhi[i][3]}
  #define PIN(x) asm volatile("":"+v"(x))
  #define MX3(a,b,c) __builtin_fmaxf(__builtin_fmaxf((a),(b)),(c))
  #define GAPA(MF,A0,A1,A2,A3,W0,W1,PW) do{ MF; sacc+=A0; sacc+=A1; sacc+=A2; sacc+=A3; PIN(sacc); W0; W1; PIN(PW); SBAR(); }while(0)
  #define EX(v) __builtin_amdgcn_exp2f(v)
  #define GAPB(MF,X,B) do{ MF; X[B]=EX(X[B]); X[B+1]=EX(X[B+1]); X[B+2]=EX(X[B+2]); X[B+3]=EX(X[B+3]); PIN(X); SBAR(); }while(0)
  #define VRD(i) do{ vlo[i]=vtr(vp_+(((i)>>2)*4096+((i)&3)*1024)); vhi[i]=vtr(vp_+(((i)>>2)*4096+((i)&3)*1024+512)); }while(0)
  #define KRD(G,j) do{ if(G){ kload2(kf,kp0+sl_next,j); SBAR(); } }while(0)
  #define STEP(C0,C1,P0,P1,t,GK,GV,GL) do{ SBAR(); BIAS(C0,C1,t); SBAR(); \
    const lds_cptr vp_=vp0+sl_prev; \
    VRD(0); SBAR(); float sacc=(P0[0]+P0[1]); \
    GAPA(C0=__builtin_amdgcn_mfma_f32_32x32x16_bf16(kf[0],qr[0],C0,0,0,0), P0[2],P0[3],P0[4],P0[5],     pw0[0]=PKW(P0,0), pw0[1]=PKW(P0,2), pw0); \
    VRD(4); SBAR(); GAPA(C1=__builtin_amdgcn_mfma_f32_32x32x16_bf16(kf[1],qr[0],C1,0,0,0), P0[6],P0[7],P0[8],P0[9],     pw0[2]=PKW(P0,4), pw0[3]=PKW(P0,6), pw0); \
    VRD(1); SBAR(); GAPA(C0=__builtin_amdgcn_mfma_f32_32x32x16_bf16(kf[2],qr[1],C0,0,0,0),   P0[10],P0[11],P0[12],P0[13], pw1[0]=PKW(P0,8), pw1[1]=PKW(P0,10), pw1); \
    VRD(5); SBAR(); GAPA(C1=__builtin_amdgcn_mfma_f32_32x32x16_bf16(kf[3],qr[1],C1,0,0,0),   P0[14],P0[15],P1[0],P1[1],   pw1[2]=PKW(P0,12),pw1[3]=PKW(P0,14), pw1); \
    VRD(2); SBAR(); GAPA(C0=__builtin_amdgcn_mfma_f32_32x32x16_bf16(kf[4],qr[2],C0,0,0,0),   P1[2],P1[3],P1[4],P1[5],     pw2[0]=PKW(P1,0), pw2[1]=PKW(P1,2), pw2); \
    VRD(6); SBAR(); GAPA(C1=__builtin_amdgcn_mfma_f32_32x32x16_bf16(kf[5],qr[2],C1,0,0,0),   P1[6],P1[7],P1[8],P1[9],     pw2[2]=PKW(P1,4), pw2[3]=PKW(P1,6), pw2); \
    VRD(3); SBAR(); GAPA(C0=__builtin_amdgcn_mfma_f32_32x32x16_bf16(kf[6],qr[3],C0,0,0,0),   P1[10],P1[11],P1[12],P1[13], pw3[0]=PKW(P1,8), pw3[1]=PKW(P1,10), pw3); \
    VRD(7); SBAR(); GAPA(C1=__builtin_amdgcn_mfma_f32_32x32x16_bf16(kf[7],qr[3],C1,0,0,0),   P1[14],P1[15],0.f,0.f,       pw3[2]=PKW(P1,12),pw3[3]=PKW(P1,14), pw3); \
    l_reg+=sacc; \
    if(GK){DMA_K((t)+3,sl_cur);} if(GV){DMA_V((t)+1,sl_next);} \
    CMASK(C0,C1,t); \
    { float a=MX3(C0[0],C0[1],C1[0]),b=MX3(C0[2],C0[3],C1[1]); a=MX3(a,C1[2],C1[3]); \
      _Pragma("unroll") for(int r=4;r<16;r+=4){a=MX3(a,C0[r],C0[r+1]);b=MX3(b,C0[r+2],C0[r+3]);a=MX3(a,C1[r],C1[r+1]);b=MX3(b,C1[r+2],C1[r+3]);} \
      float rm=__builtin_fmaxf(a,b); { auto rr=__builtin_amdgcn_permlane32_swap(__float_as_uint(rm),__float_as_uint(rm),false,false); rm=__builtin_fmaxf(__uint_as_float(rr[0]),__uint_as_float(rr[1])); } \
      resc=false; \
      if(__builtin_expect(__any(rm>(float)THRL),0)){ const float dl=__builtin_fmaxf(rm,0.f); nm-=dl; \
        _Pragma("unroll") for(int r=0;r<16;++r){C0[r]-=dl;C1[r]-=dl;} \
        const float f=__builtin_amdgcn_exp2f(-dl); l_reg*=f; if(hi==0)wsf[r32]=f; resc=true; } } \
    SBAR(); \
    GAPB(o[0]=__builtin_amdgcn_mfma_f32_32x32x16_bf16(PAF(0),VFR(0),o[0],0,0,0), C0,0); \
    GAPB(o[1]=__builtin_amdgcn_mfma_f32_32x32x16_bf16(PAF(0),VFR(4),o[1],0,0,0), C0,4); \
    KRD(GL,0); GAPB(o[0]=__builtin_amdgcn_mfma_f32_32x32x16_bf16(PAF(1),VFR(1),o[0],0,0,0), C0,8); \
    KRD(GL,1); GAPB(o[1]=__builtin_amdgcn_mfma_f32_32x32x16_bf16(PAF(1),VFR(5),o[1],0,0,0), C0,12); \
    KRD(GL,2); GAPB(o[0]=__builtin_amdgcn_mfma_f32_32x32x16_bf16(PAF(2),VFR(2),o[0],0,0,0), C1,0); \
    KRD(GL,3); GAPB(o[1]=__builtin_amdgcn_mfma_f32_32x32x16_bf16(PAF(2),VFR(6),o[1],0,0,0), C1,4); \
    GAPB(o[0]=__builtin_amdgcn_mfma_f32_32x32x16_bf16(PAF(3),VFR(3),o[0],0,0,0), C1,8); \
    GAPB(o[1]=__builtin_amdgcn_mfma_f32_32x32x16_bf16(PAF(3),VFR(7),o[1],0,0,0), C1,12); \
    }while(0)
  int t=1;
  #undef CMASK
  #define CMASK(P0,P1,t) do{}while(0)
  for(;t+5<NT;t+=2){
    STEP(pB0,pB1,pA0,pA1,t,true,true,true);     WAIT_BAR(2); RESC(); ROT();
    STEP(pA0,pA1,pB0,pB1,t+1,true,true,true);   WAIT_BAR(2); RESC(); ROT();
  }
  #undef CMASK
  #define CMASK(P0,P1,t) do{int jb_=(t)-(NT-4); if(jb_>=0)cmask(P0,P1,jb_,qrel,hi);}while(0)
  #define ENDW(tt) do{ if((tt)+3<NT){WAIT_BAR(2);} else if((tt)+2<NT){WAIT_BAR(1);} else {WAIT_BAR(0);} }while(0)
  for(;t+1<NT;t+=2){
    STEP(pB0,pB1,pA0,pA1,t,(t+3<NT),(t+1<NT),(t+1<NT));       ENDW(t);   RESC(); ROT();
    STEP(pA0,pA1,pB0,pB1,t+1,(t+4<NT),(t+2<NT),(t+2<NT));     ENDW(t+1); RESC(); ROT();
  }
  STEP(pB0,pB1,pA0,pA1,NT-1,false,false,false); RESC();
  { float sacc=pB0[0]+pB0[1]; _Pragma("unroll") for(int r=2;r<16;++r)sacc+=pB0[r]; _Pragma("unroll") for(int r=0;r<16;++r)sacc+=pB1[r]; l_reg+=sacc;
    pw0=(u32x4){PKW(pB0,0),PKW(pB0,2),PKW(pB0,4),PKW(pB0,6)};pw1=(u32x4){PKW(pB0,8),PKW(pB0,10),PKW(pB0,12),PKW(pB0,14)};pw2=(u32x4){PKW(pB1,0),PKW(pB1,2),PKW(pB1,4),PKW(pB1,6)};pw3=(u32x4){PKW(pB1,8),PKW(pB1,10),PKW(pB1,12),PKW(pB1,14)};
    SBAR(); pv(o,vb0+sl_cur,PAF(0),PAF(1),PAF(2),PAF(3)); }
  #undef PKW
  #undef PAF
  #undef VFR
  #undef PIN
  #undef MX3
  #undef GAPA
  #undef GAPB
  #undef EX
  #undef VRD
  #undef KRD
  #undef STEP
  #undef ENDW
  {auto rr=__builtin_amdgcn_permlane32_swap(__float_as_uint(l_reg),__float_as_uint(l_reg),false,false);l_reg=__uint_as_float(rr[0])+__uint_as_float(rr[1]);}
  if(hi==0)wsf[32+r32]=l_reg;asm volatile("s_waitcnt lgkmcnt(0)":::"memory");
  float rli[16];
  #pragma unroll
  for(int r=0;r<16;++r)rli[r]=__builtin_amdgcn_rcpf(wsf[32+crow(r,hi)]);
  bf16*Ow=O+(rowbase+q0+wid*QBLK)*DM+h*D;
  { bf16*stg=(bf16*)(shm+LDS_OST)+wid*2048;
    #pragma unroll
    for(int r=0;r<16;++r){const int orow=crow(r,hi);
      #pragma unroll
      for(int d0=0;d0<2;++d0)stg[orow*64+d0*32+r32]=__float2bfloat16(o[d0][r]*rli[r]);}
    asm volatile("s_waitcnt lgkmcnt(0)":::"memory");
    #pragma unroll
    for(int i=0;i<4;++i){const int row=i*8+(lane>>3),ch=lane&7; const u32x4 v=*(const u32x4*)(stg+row*64+ch*8); ATTN_STORE16(Ow+(long)row*DM+ch*8,v);} }
  asm volatile("s_waitcnt lgkmcnt(0)\n\ts_barrier":::"memory");
  #undef DMA_K
  #undef DMA_V
  #undef CMASK
  #undef START
  #undef RESC
  #undef ROT
  #undef BIAS
}
constexpr int ATTN_LDS_BYTES=LDS_BYTES;
constexpr float SKIP_THR=64.0f;
__device__ __forceinline__ int attn_first_tile(const float*__restrict__ CL2,int bh,int qb){
  const int lane=threadIdx.x&63; const float*c=CL2+(long)bh*SEQ; const int q0=qb*QB, nfar=4*qb;
  const float cq=c[q0]; const float cj=c[(lane<nfar?lane:0)*KVBLK+KVBLK-1];
  const unsigned long long keep=__ballot(lane<nfar && (cq-cj)>=-SKIP_THR) | (1ull<<nfar);
  const int t0=__builtin_ctzll(keep)&~1;
  return __builtin_amdgcn_readfirstlane(t0);
}
struct AttnTensors { const bf16* Q; const bf16* K; const bf16* V; bf16* O; const float* CL2; };
struct AttnUnit { int bh; int qb; };
struct StaticOrder {
  int vcu;
  __device__ __forceinline__ explicit StaticOrder(int grid,int block):vcu((block%8)*(grid/8)+block/8){}
  __device__ __forceinline__ bool next(int i,AttnUnit&u)const{ if(i>=2||vcu>=BATCH*NHEAD*4)return false; const int s=vcu&3; u.bh=vcu>>2; u.qb=(i==0)?s:7-s; return true; }
  __device__ __forceinline__ void a_ready(const AttnUnit&)const{}
  __device__ __forceinline__ void done(const AttnUnit&)const{}
};
template<class Sched,int THRL=8> __device__ __forceinline__ void attn_phase(char*lds,const AttnTensors&T,const Sched&S){
  AttnUnit u;
  for(int i=0;S.next(i,u);++i){ S.a_ready(u); attn_unit<THRL>(u.bh/NHEAD,u.bh%NHEAD,u.qb,T.Q,T.K,T.V,T.O,T.CL2,lds); S.done(u); }
}
#undef SBAR
#undef WAIT_BAR
}
namespace sgu_body {
using attn_body::bf16x8; using attn_body::s16x4; using attn_body::f32x16; using attn_body::u32x4; using attn_body::lds_cptr; using attn_body::vtr;
constexpr int SGU_LDS_BYTES = 65536;
__device__ __forceinline__ float bflo(unsigned w) { return __uint_as_float(w << 16); }
__device__ __forceinline__ float bfhi(unsigned w) { return __uint_as_float(w & 0xffff0000u); }
__device__ __forceinline__ void sgu_unit(int ck, int half, const unsigned short* __restrict__ VG, const unsigned short* UGI, unsigned short* UGY, const unsigned short* __restrict__ WSMP,
                                         const float* __restrict__ lng, const float* __restrict__ lnb, const float* __restrict__ bs, char* shm) {
    int tid = threadIdx.x; asm volatile("" : "+v"(tid)); const int lane = tid & 63, r32 = lane & 31, hi = lane >> 5; const int wid = __builtin_amdgcn_readfirstlane(tid >> 6);
    const size_t row0 = (size_t)ck * 128;
    u32x4 raw[16];
#pragma unroll
    for (int i = 0; i < 16; ++i) raw[i] = *(const u32x4*)(VG + (row0 + 16 * wid + i) * 512 + 8 * lane);
    float mu[16], rs[16];
#pragma unroll
    for (int i = 0; i < 16; ++i) {
        const float a0 = bflo(raw[i].x), a1 = bfhi(raw[i].x), a2 = bflo(raw[i].y), a3 = bfhi(raw[i].y), a4 = bflo(raw[i].z), a5 = bfhi(raw[i].z), a6 = bflo(raw[i].w), a7 = bfhi(raw[i].w);
        float s = ((a0 + a1) + (a2 + a3)) + ((a4 + a5) + (a6 + a7));
        float q = ((a0 * a0 + a1 * a1) + (a2 * a2 + a3 * a3)) + ((a4 * a4 + a5 * a5) + (a6 * a6 + a7 * a7));
        s = wave_allsum(s); q = wave_allsum(q);
        const float m = s * (1.0f / 512.0f); const float var = fmaxf(q * (1.0f / 512.0f) - m * m, 0.f);
        mu[i] = m; rs[i] = 1.0f / sqrtf(var + 1e-6f);
    }
    if ((lane >> 5) == half) {
        const int gl = (lane >> 3) & 3, cc = 8 * (lane & 7);
        float gv[8], bv[8];
#pragma unroll
        for (int j = 0; j < 8; ++j) { gv[j] = lng[8 * lane + j]; bv[j] = lnb[8 * lane + j]; }
        char* img = shm + gl * 16384 + (cc >> 5) * 4096 + (cc & 31) * 2;
#pragma unroll
        for (int i = 0; i < 16; ++i) {
            const int s = 16 * wid + i;
            const float m = mu[i], r = rs[i];
            const float v0 = (bflo(raw[i].x) - m) * r * gv[0] + bv[0], v1 = (bfhi(raw[i].x) - m) * r * gv[1] + bv[1], v2 = (bflo(raw[i].y) - m) * r * gv[2] + bv[2], v3 = (bfhi(raw[i].y) - m) * r * gv[3] + bv[3];
            const float v4 = (bflo(raw[i].z) - m) * r * gv[4] + bv[4], v5 = (bfhi(raw[i].z) - m) * r * gv[5] + bv[5], v6 = (bflo(raw[i].w) - m) * r * gv[6] + bv[6], v7 = (bfhi(raw[i].w) - m) * r * gv[7] + bv[7];
            u32x4 w; w.x = pg8::cvt_pk_bf16(v0, v1); w.y = pg8::cvt_pk_bf16(v2, v3); w.z = pg8::cvt_pk_bf16(v4, v5); w.w = pg8::cvt_pk_bf16(v6, v7);
            *(u32x4*)(img + (s >> 6) * 8192 + ((s & 63) >> 4) * 1024 + (s & 15) * 64) = w;
        }
    }
    typedef unsigned u32x2_t __attribute__((ext_vector_type(2)));
    const int gl4 = wid >> 1, cb4 = wid & 1, g4 = 4 * half + gl4;
    bf16x8 wf[20]; u32x2_t ugq[4][4]; float bsq[4];
#pragma unroll
    for (int tb = 0; tb < 4; ++tb) {
        const unsigned short* wrow = WSMP + ((size_t)(g4 * 128 + 32 * tb + r32)) * 128 + 8 * hi;
#pragma unroll
        for (int ks = 0; ks < 2 * (tb + 1); ++ks) wf[tb * (tb + 1) + ks] = *(const bf16x8*)(wrow + 16 * ks);
        const int t = 32 * tb + r32; bsq[tb] = bs[g4 * 128 + t];
        const unsigned short* urow = UGI + (row0 + t) * 512 + g4 * 64 + 32 * cb4 + 4 * hi;
#pragma unroll
        for (int q4 = 0; q4 < 4; ++q4) ugq[tb][q4] = *(const u32x2_t*)(urow + 8 * q4);
    }
    __syncthreads();
    {
        const int gl = gl4, cb = cb4, g = g4;
        const lds_cptr vp = (lds_cptr)shm + gl * 16384 + cb * 4096 + ((lane >> 4) & 1) * 32 + (lane & 3) * 8 + (4 * hi + ((lane & 15) >> 2)) * 64;
#pragma unroll
        for (int tb = 0; tb < 4; ++tb) {
            f32x16 acc = f32x16{};
#pragma unroll
            for (int ks = 0; ks < 2 * (tb + 1); ++ks) {
                const s16x4 lo = vtr(vp + (ks >> 2) * 8192 + (ks & 3) * 1024), hh = vtr(vp + (ks >> 2) * 8192 + (ks & 3) * 1024 + 512);
                const bf16x8 a = (bf16x8){lo[0], lo[1], lo[2], lo[3], hh[0], hh[1], hh[2], hh[3]};
                acc = __builtin_amdgcn_mfma_f32_32x32x16_bf16(a, wf[tb * (tb + 1) + ks], acc, 0, 0, 0);
            }
            const int t = 32 * tb + r32; const float bsv = bsq[tb];
            unsigned short* yrow = UGY + (row0 + t) * 512 + g * 64 + 32 * cb + 4 * hi;
#pragma unroll
            for (int q4 = 0; q4 < 4; ++q4) {
                const u32x2_t ug = ugq[tb][q4];
                const float y0 = bflo(ug.x) * (acc[4 * q4 + 0] + bsv), y1 = bfhi(ug.x) * (acc[4 * q4 + 1] + bsv), y2 = bflo(ug.y) * (acc[4 * q4 + 2] + bsv), y3 = bfhi(ug.y) * (acc[4 * q4 + 3] + bsv);
                u32x2_t w; w.x = pg8::cvt_pk_bf16(y0, y1); w.y = pg8::cvt_pk_bf16(y2, y3);
                *(u32x2_t*)(yrow + 8 * q4) = w;
            }
        }
    }
    __syncthreads();
}
}
namespace peer_body {
using attn_body::bf16x8; using attn_body::f32x16; using attn_body::u32x4;
typedef __bf16 bf16x2_t __attribute__((ext_vector_type(2)));
constexpr int PEER_TOK = 64;
constexpr int L_PI = 0, L_PG = 32768, L_PS = 65536, PEER_LDS_BYTES = 98304;
__device__ __forceinline__ int okey(int b) { return b ^ ((b >> 31) & 0x7fffffff); }
__device__ __forceinline__ void ce(int& a, int& b) { const int hi = a > b ? a : b, lo = a > b ? b : a; a = hi; b = lo; }
__device__ __forceinline__ void sort16(int (&v)[16]) {
#pragma unroll
    for (int k = 2; k <= 16; k <<= 1)
#pragma unroll
        for (int j = k >> 1; j > 0; j >>= 1)
#pragma unroll
            for (int i = 0; i < 16; ++i) { const int l = i ^ j; if (l > i) { if ((i & k) == 0) ce(v[i], v[l]); else ce(v[l], v[i]); } }
}
__device__ __forceinline__ void merge16(int (&a)[16], const int (&b)[16]) {
#pragma unroll
    for (int i = 0; i < 16; ++i) a[i] = a[i] > b[15 - i] ? a[i] : b[15 - i];
#pragma unroll
    for (int j = 8; j > 0; j >>= 1)
#pragma unroll
        for (int i = 0; i < 16; ++i) { const int l = i ^ j; if (l > i) ce(a[i], a[l]); }
}
__device__ __forceinline__ float dot2(unsigned w, unsigned x, float acc) { return __builtin_amdgcn_fdot2_f32_bf16(__builtin_bit_cast(bf16x2_t, w), __builtin_bit_cast(bf16x2_t, x), acc, false); }
__device__ __forceinline__ float gelu_erf(float v) { return 0.5f * v * (1.0f + erff(v * 0.70710678118654752f)); }

constexpr int SK_PITCH = 272;
__device__ __forceinline__ void top16_scores(int (&res)[16], const bf16x8 (&bq)[8], const char* SKl, int r32, int hi) {
    f32x16 acc[4];
#pragma unroll
    for (int nb = 0; nb < 4; ++nb) acc[nb] = f32x16{};
#pragma unroll
    for (int ks = 0; ks < 8; ++ks) {
#pragma unroll
        for (int nb = 0; nb < 4; ++nb) { const bf16x8 a = *(const bf16x8*)(SKl + (32 * nb + r32) * SK_PITCH + (16 * ks + 8 * hi) * 2);
            acc[nb] = __builtin_amdgcn_mfma_f32_32x32x16_bf16(a, bq[ks], acc[nb], 0, 0, 0); }
        if (ks & 1) __builtin_amdgcn_sched_barrier(0);
    }
    int k[4][16];
#pragma unroll
    for (int nb = 0; nb < 4; ++nb) {
#pragma unroll
        for (int r = 0; r < 16; ++r) { const int n = 32 * nb + (r & 3) + 8 * (r >> 2) + 4 * hi; k[nb][r] = okey((int)((__float_as_uint(acc[nb][r]) & ~0x7fu) | (unsigned)n)); }
        sort16(k[nb]);
    }
    merge16(k[0], k[1]); merge16(k[2], k[3]); merge16(k[0], k[2]);
    int lo[16], up[16];
#pragma unroll
    for (int i = 0; i < 16; ++i) { const auto rr = __builtin_amdgcn_permlane32_swap((unsigned)k[0][i], (unsigned)k[0][i], false, false); lo[i] = (int)rr[0]; up[i] = (int)rr[1]; }
    merge16(lo, up);
#pragma unroll
    for (int i = 0; i < 16; ++i) res[i] = lo[i];
}

__device__ __forceinline__ unsigned pack_i8x4(float a, float b, float c, float d) {
    const int ia = (int)__builtin_rintf(a), ib = (int)__builtin_rintf(b), ic = (int)__builtin_rintf(c), id = (int)__builtin_rintf(d);
    return (unsigned)(ia & 0xff) | ((unsigned)(ib & 0xff) << 8) | ((unsigned)(ic & 0xff) << 16) | ((unsigned)(id & 0xff) << 24);
}
typedef float f32x2_t __attribute__((ext_vector_type(2)));
typedef unsigned u32x2_t __attribute__((ext_vector_type(2)));
__device__ __forceinline__ void fma_fp8x4(f32x2_t& a01, f32x2_t& a23, unsigned v, f32x2_t w2) {
    const f32x2_t lo = __builtin_amdgcn_cvt_pk_f32_fp8((int)v, false), hi = __builtin_amdgcn_cvt_pk_f32_fp8((int)v, true);
    a01 = __builtin_elementwise_fma(lo, w2, a01); a23 = __builtin_elementwise_fma(hi, w2, a23);
}
template <int CTRL> __device__ __forceinline__ int dppi(int v) { return __builtin_amdgcn_update_dpp(0, v, CTRL, 0xf, 0xf, false); }
template <int CTRL> __device__ __forceinline__ float dppf(float v) { return __int_as_float(__builtin_amdgcn_update_dpp(0, __float_as_int(v), CTRL, 0xf, 0xf, false)); }
constexpr int DPP_HMIRROR = 0x141, DPP_XOR2 = 0x4E, DPP_XOR1 = 0xB1, DPP_ROR8 = 0x128;

__device__ __forceinline__ void peer_retrieve(int tk, const unsigned short* __restrict__ QP, const unsigned short* __restrict__ SK, const float* __restrict__ SU, const float* __restrict__ SV,
                                              const float* __restrict__ ST, unsigned short* __restrict__ PID, float* __restrict__ G2, float* __restrict__ PS2, char* shm) {
    int tid = threadIdx.x; asm volatile("" : "+v"(tid)); const int lane = tid & 63, r32 = lane & 31, hi = lane >> 5; const int wid = __builtin_amdgcn_readfirstlane(tid >> 6);
    const int h = tk & 7, T0 = (tk >> 3) * 512 + 64 * wid;
    {   const u32x4* src = (const u32x4*)(SK + (size_t)h * 2 * 128 * 128);
#pragma unroll
        for (int i = 0; i < 8; ++i) { const int c = tid + 512 * i, row = c >> 4, ch = c & 15; *(u32x4*)(shm + row * SK_PITCH + ch * 16) = src[c]; }
    }
    __syncthreads();
#pragma unroll 1
    for (int tb = 0; tb < 2; ++tb) {
        const unsigned short* QPt = QP + (size_t)(T0 + 32 * tb) * 2048 + h * 256;
        int A[16], B[16];
        bf16x8 bqa[8], bqb[8];
#pragma unroll
        for (int ks = 0; ks < 8; ++ks) { bqa[ks] = *(const bf16x8*)(QPt + (size_t)r32 * 2048 + 16 * ks + 8 * hi); bqb[ks] = *(const bf16x8*)(QPt + 128 + (size_t)r32 * 2048 + 16 * ks + 8 * hi); }
        top16_scores(A, bqa, shm, r32, hi);
        top16_scores(B, bqb, shm + 128 * SK_PITCH, r32, hi);
        float fa[16], fb[16]; int na[16], nb[16];
#pragma unroll
        for (int i = 0; i < 16; ++i) { const int ba = okey(A[i]), bb = okey(B[i]); fa[i] = __int_as_float(ba); fb[i] = __int_as_float(bb); na[i] = (ba & 0x7f) << 7; nb[i] = bb & 0x7f; }
#define CAND(i, j) okey((int)((__float_as_uint(fa[i] + fb[j]) & ~0x3fffu) | (unsigned)(na[i] | nb[j])))
        const int NEGK = (int)0x80000000;
        int L0[16], L1[16], L2[16], L3[16];
#pragma unroll
        for (int j = 0; j < 16; ++j) L0[j] = CAND(0, j);
#pragma unroll
        for (int j = 0; j < 8; ++j) L1[j] = CAND(1, j);
#pragma unroll
        for (int j = 0; j < 5; ++j) L1[8 + j] = CAND(2, j);
#pragma unroll
        for (int j = 0; j < 3; ++j) L1[13 + j] = CAND(3, j);
        L2[0] = CAND(3, 3);
#pragma unroll
        for (int j = 0; j < 3; ++j) L2[1 + j] = CAND(4, j);
#pragma unroll
        for (int j = 0; j < 2; ++j) { L2[4 + j] = CAND(5, j); L2[6 + j] = CAND(6, j); L2[8 + j] = CAND(7, j); }
#pragma unroll
        for (int i = 8; i < 14; ++i) L2[2 + i] = CAND(i, 0);
        L3[0] = CAND(14, 0); L3[1] = CAND(15, 0);
#pragma unroll
        for (int i = 2; i < 16; ++i) L3[i] = NEGK;
#undef CAND
        sort16(L1); sort16(L2); sort16(L3);
        merge16(L0, L1); merge16(L2, L3); merge16(L0, L2);
        float e[16]; int id[16]; float se = 0.f;
        const float s0 = __int_as_float((okey(L0[0]) & ~0x3fff) | 0x2000);
#pragma unroll
        for (int i = 0; i < 16; ++i) { const int b = okey(L0[i]); id[i] = b & 0x3fff; const float s = __int_as_float((b & ~0x3fff) | 0x2000); e[i] = __expf(s - s0); se += e[i]; }
        const float inv = 1.0f / se;
        if (hi == 0) {
            const size_t t = (size_t)(T0 + 32 * tb + r32); const float st = ST[t];
            unsigned short* pi = PID + t * 128 + h * 16; float* pg = G2 + t * 128 + h * 16; float* ps = PS2 + t * 128 + h * 16;
            u32x4 w0, w1;
            w0.x = (unsigned)id[0] | ((unsigned)id[1] << 16); w0.y = (unsigned)id[2] | ((unsigned)id[3] << 16); w0.z = (unsigned)id[4] | ((unsigned)id[5] << 16); w0.w = (unsigned)id[6] | ((unsigned)id[7] << 16);
            w1.x = (unsigned)id[8] | ((unsigned)id[9] << 16); w1.y = (unsigned)id[10] | ((unsigned)id[11] << 16); w1.z = (unsigned)id[12] | ((unsigned)id[13] << 16); w1.w = (unsigned)id[14] | ((unsigned)id[15] << 16);
            *(u32x4*)pi = w0; *(u32x4*)(pi + 8) = w1;
            float sv[16], su[16];
#pragma unroll
            for (int i = 0; i < 16; ++i) { sv[i] = SV[id[i]]; su[i] = SU[id[i]]; }
            asm volatile("" ::: "memory");
#pragma unroll
            for (int i = 0; i < 16; i += 4) {
                *(float4*)(pg + i) = make_float4(e[i] * inv * sv[i], e[i + 1] * inv * sv[i + 1], e[i + 2] * inv * sv[i + 2], e[i + 3] * inv * sv[i + 3]);
                *(float4*)(ps + i) = make_float4(su[i] * st, su[i + 1] * st, su[i + 2] * st, su[i + 3] * st); }
        }
    }
    __syncthreads();
}

constexpr int WL_STRIDE = 19712, WL_Y = 3328, PEER_FUSED_LDS = 8 * WL_STRIDE;
__device__ __forceinline__ void peer_fused(int p, int wq, int nwq, const unsigned short* __restrict__ PID, const float* __restrict__ G2, const float* __restrict__ PS2, const unsigned char* __restrict__ H2Q,
                                           const unsigned char* __restrict__ EU8, const unsigned char* __restrict__ EV8, const unsigned short* __restrict__ X1, float* X, const float* __restrict__ gfin, char* shm, float oscale) {
    int tid = threadIdx.x; asm volatile("" : "+v"(tid)); const int lane = tid & 63, g = lane >> 3, r = lane & 7; const int wid = __builtin_amdgcn_readfirstlane(tid >> 6);
    char* wl = shm + wid * WL_STRIDE;
    int2* aul = (int2*)(wl + WL_Y) + lane; unsigned* yl = (unsigned*)(wl + WL_Y) + lane; float* swl = (float*)(wl + 3072);
    const int k0 = 8 * (r >> 2) + 4 * ((r >> 1) & 1) + 2 * (r & 1);
    const int e0 = 8 * ((g >> 2) & 1) + 4 * ((g >> 1) & 1) + 2 * (g & 1);
    constexpr size_t SLICE = (size_t)16384 * 128;
#define FIDS(i, I0, I1) do { const u32x4* ip_ = (const u32x4*)(wl + (i) * 256 + 32 * g); I0 = ip_[0]; I1 = ip_[1]; } while (0)
#define FLOAD(R, base, I0, I1) do { _Pragma("unroll") for (int k_ = 0; k_ < 16; ++k_) { const unsigned w_ = (k_ < 8) ? I0[k_ >> 1] : I1[(k_ - 8) >> 1]; const unsigned e_ = (k_ & 1) ? (w_ >> 16) : (w_ & 0xffffu); \
        R[k_] = *(const u32x4*)((base) + (size_t)e_ * 128); } } while (0)
#define FUMATH(R, HQ, ACC) do { int s[16]; \
        _Pragma("unroll") for (int k_ = 0; k_ < 16; ++k_) { int d_ = __builtin_amdgcn_sdot4((int)R[k_].x, (int)HQ.x, 0, false); d_ = __builtin_amdgcn_sdot4((int)R[k_].y, (int)HQ.y, d_, false); \
            d_ = __builtin_amdgcn_sdot4((int)R[k_].z, (int)HQ.z, d_, false); d_ = __builtin_amdgcn_sdot4((int)R[k_].w, (int)HQ.w, d_, false); s[k_] = d_; } \
        _Pragma("unroll") for (int h_ = 0; h_ < 8; ++h_) { const int t1 = s[h_] + dppi<DPP_HMIRROR>(s[h_]), t2 = s[h_ + 8] + dppi<DPP_HMIRROR>(s[h_ + 8]); s[h_] = (r & 4) ? t2 : t1; } \
        _Pragma("unroll") for (int h_ = 0; h_ < 4; ++h_) { const int t1 = s[h_] + dppi<DPP_XOR2>(s[h_]), t2 = s[h_ + 4] + dppi<DPP_XOR2>(s[h_ + 4]); s[h_] = (r & 2) ? t2 : t1; } \
        _Pragma("unroll") for (int h_ = 0; h_ < 2; ++h_) { const int t1 = s[h_] + dppi<DPP_XOR1>(s[h_]), t2 = s[h_ + 2] + dppi<DPP_XOR1>(s[h_ + 2]); s[h_] = (r & 1) ? t2 : t1; } \
        { const int2 o_ = ACC; ACC = make_int2(o_.x + s[0], o_.y + s[1]); } } while (0)
#define FVMATH(R, W, XV, SWV, YP) do { int acc[16]; _Pragma("unroll") for (int i_ = 0; i_ < 16; ++i_) acc[i_] = 0; \
        _Pragma("unroll") for (int m_ = 0; m_ < 4; ++m_) { const int wm_ = (int)W[m_]; \
            _Pragma("unroll") for (int c_ = 0; c_ < 4; ++c_) { \
                const unsigned r0_ = R[4 * m_ + 0][c_], r1_ = R[4 * m_ + 1][c_], r2_ = R[4 * m_ + 2][c_], r3_ = R[4 * m_ + 3][c_]; \
                const unsigned t0_ = __builtin_amdgcn_perm(r1_, r0_, 0x05010400u), t1_ = __builtin_amdgcn_perm(r1_, r0_, 0x07030602u); \
                const unsigned t2_ = __builtin_amdgcn_perm(r3_, r2_, 0x05010400u), t3_ = __builtin_amdgcn_perm(r3_, r2_, 0x07030602u); \
                acc[4 * c_ + 0] = __builtin_amdgcn_sdot4((int)__builtin_amdgcn_perm(t2_, t0_, 0x05040100u), wm_, acc[4 * c_ + 0], false); \
                acc[4 * c_ + 1] = __builtin_amdgcn_sdot4((int)__builtin_amdgcn_perm(t2_, t0_, 0x07060302u), wm_, acc[4 * c_ + 1], false); \
                acc[4 * c_ + 2] = __builtin_amdgcn_sdot4((int)__builtin_amdgcn_perm(t3_, t1_, 0x05040100u), wm_, acc[4 * c_ + 2], false); \
                acc[4 * c_ + 3] = __builtin_amdgcn_sdot4((int)__builtin_amdgcn_perm(t3_, t1_, 0x07060302u), wm_, acc[4 * c_ + 3], false); } } \
          \
        _Pragma("unroll") for (int h_ = 0; h_ < 8; ++h_) { const auto sw_ = __builtin_amdgcn_permlane32_swap((unsigned)acc[h_], (unsigned)acc[h_ + 8], false, false); acc[h_] = (int)sw_[0] + (int)sw_[1]; } \
        _Pragma("unroll") for (int h_ = 0; h_ < 4; ++h_) { const auto sw_ = __builtin_amdgcn_permlane16_swap((unsigned)acc[h_], (unsigned)acc[h_ + 4], false, false); acc[h_] = (int)sw_[0] + (int)sw_[1]; } \
        _Pragma("unroll") for (int h_ = 0; h_ < 2; ++h_) { const int t1 = acc[h_] + dppi<DPP_ROR8>(acc[h_]), t2 = acc[h_ + 2] + dppi<DPP_ROR8>(acc[h_ + 2]); acc[h_] = (lane & 8) ? t2 : t1; } \
        const unsigned xv = XV; *(YP) = pg8::cvt_pk_bf16(__uint_as_float(xv << 16) + SWV * (float)acc[0], __uint_as_float(xv & 0xffff0000u) + SWV * (float)acc[1]); } while (0)
    const int TEND = (p + 1) * (M / 8);
#pragma unroll 1
    for (int tb = p * (M / 8) + wq; tb < TEND; tb += 8 * nwq) {
#define TOK(i) ((tb + (i) * nwq) < TEND ? (tb + (i) * nwq) : tb)
#pragma unroll
        for (int i = 0; i < 8; ++i) ((unsigned*)(wl + i * 256))[lane] = ((const unsigned*)(PID + (size_t)TOK(i) * 128))[lane];
#pragma unroll
        for (int i = 0; i < 8; ++i) aul[64 * i] = make_int2(0, 0);
        {
            u32x4 RA[16], RB[16], i0, i1, hqa, hqb;
            { const int sl = p & 7; FIDS(0, i0, i1); hqa = *(const u32x4*)(H2Q + ((size_t)sl * M + TOK(0)) * 128 + r * 16); FLOAD(RA, EU8 + sl * SLICE + r * 16, i0, i1); }
#pragma unroll 1
            for (int st = 0; st < 8; ++st) {
                const int sl = (p + st) & 7, sln = (p + st + 1) & 7; const unsigned char* ub = EU8 + sl * SLICE + r * 16; const unsigned char* hb = H2Q + (size_t)sl * M * 128 + r * 16;
#pragma unroll 1
                for (int i = 0; i < 8; i += 2) {
                    FIDS(i + 1, i0, i1); hqb = *(const u32x4*)(hb + (size_t)TOK(i + 1) * 128); FLOAD(RB, ub, i0, i1);
                    FUMATH(RA, hqa, aul[64 * i]);
                    {
                        const bool last = (i == 6); const int in_ = last ? 0 : i + 2; const int sx = last ? sln : sl;
                        FIDS(in_, i0, i1); hqa = *(const u32x4*)(H2Q + ((size_t)sx * M + TOK(in_)) * 128 + r * 16); FLOAD(RA, EU8 + sx * SLICE + r * 16, i0, i1); }
                    FUMATH(RB, hqb, aul[64 * (i + 1)]);
                }
            }
        }
        float2 g2q[8], psq[8];
#pragma unroll
        for (int i = 0; i < 8; ++i) { const size_t o = (size_t)TOK(i) * 128 + 16 * g + k0; g2q[i] = *(const float2*)(G2 + o); psq[i] = *(const float2*)(PS2 + o); }
#pragma unroll
        for (int i = 0; i < 8; ++i) {
            const float2 g2 = g2q[i], ps = psq[i]; const int2 av = aul[64 * i];
            const float w0 = g2.x * gelu_erf((float)av.x * ps.x), w1 = g2.y * gelu_erf((float)av.y * ps.y);
            float am = fmaxf(fabsf(w0), fabsf(w1));
            am = wave_allmax(am);
            const float qs = am > 0.f ? 127.0f / am : 0.f; if (lane == 0) swl[i] = am * (1.0f / 127.0f);
            const int b0 = (int)__builtin_rintf(w0 * qs) & 0xff, b1 = (int)__builtin_rintf(w1 * qs) & 0xff;
            *(unsigned short*)(wl + 2048 + i * 128 + 16 * g + k0) = (unsigned short)(b0 | (b1 << 8));
        }
        {
            u32x4 RA[16], RB[16], i0, i1; unsigned xva, xvb;
            { const int sl = p & 7; FIDS(0, i0, i1); xva = *(const unsigned*)(X1 + (size_t)TOK(0) * 1024 + sl * 128 + 16 * r + e0); FLOAD(RA, EV8 + sl * SLICE + r * 16, i0, i1); }
#pragma unroll 1
            for (int st = 0; st < 8; ++st) {
                const int sl = (p + st) & 7, sln = (p + st + 1) & 7; const unsigned char* vb = EV8 + sl * SLICE + r * 16; const unsigned short* xb = X1 + sl * 128 + 16 * r + e0; unsigned* yb = yl + sl * 64;
#pragma unroll 1
                for (int i = 0; i < 8; i += 2) {
                    FIDS(i + 1, i0, i1); xvb = *(const unsigned*)(xb + (size_t)TOK(i + 1) * 1024); FLOAD(RB, vb, i0, i1);
                    { const u32x4 wv = *(const u32x4*)(wl + 2048 + i * 128 + 16 * g); const float sw_ = swl[i]; FVMATH(RA, wv, xva, sw_, yb + i * 512); }
                    { const bool last = (i == 6); const int in_ = last ? 0 : i + 2; const int sx = last ? sln : sl; FIDS(in_, i0, i1); xva = *(const unsigned*)(X1 + (size_t)TOK(in_) * 1024 + sx * 128 + 16 * r + e0); FLOAD(RA, EV8 + sx * SLICE + r * 16, i0, i1); }
                    { const u32x4 wv = *(const u32x4*)(wl + 2048 + (i + 1) * 128 + 16 * g); const float sw_ = swl[i + 1]; FVMATH(RB, wv, xvb, sw_, yb + (i + 1) * 512); }
                }
            }
        }
        float2 gg[8];
#pragma unroll
        for (int sl = 0; sl < 8; ++sl) gg[sl] = *(const float2*)(gfin + sl * 128 + 16 * r + e0);
#pragma unroll 1
        for (int i = 0; i < 8; i += 2) {
            unsigned ya[8], yb[8]; float sa = 0.f, sb = 0.f;
#pragma unroll
            for (int sl = 0; sl < 8; ++sl) { ya[sl] = yl[(i * 8 + sl) * 64]; yb[sl] = yl[((i + 1) * 8 + sl) * 64]; }
#pragma unroll
            for (int sl = 0; sl < 8; ++sl) { const float a0 = __uint_as_float(ya[sl] << 16), a1 = __uint_as_float(ya[sl] & 0xffff0000u), b0 = __uint_as_float(yb[sl] << 16), b1 = __uint_as_float(yb[sl] & 0xffff0000u);
                sa += a0 * a0 + a1 * a1; sb += b0 * b0 + b1 * b1; }
            const float rr0 = oscale / sqrtf(wave_allsum(sa) * (1.0f / 1024.0f) + 1e-6f), rr1 = oscale / sqrtf(wave_allsum(sb) * (1.0f / 1024.0f) + 1e-6f);
            const bool v0 = (tb + i * nwq) < TEND, v1 = (tb + (i + 1) * nwq) < TEND;
            float* xr0 = X + (size_t)TOK(i) * 1024 + 16 * r + e0; float* xr1 = X + (size_t)TOK(i + 1) * 1024 + 16 * r + e0;
#pragma unroll
            for (int sl = 0; sl < 8; ++sl) {
                if (v0) *(float2*)(xr0 + sl * 128) = make_float2(__uint_as_float(ya[sl] << 16) * rr0 * gg[sl].x, __uint_as_float(ya[sl] & 0xffff0000u) * rr0 * gg[sl].y);
                if (v1) *(float2*)(xr1 + sl * 128) = make_float2(__uint_as_float(yb[sl] << 16) * rr1 * gg[sl].x, __uint_as_float(yb[sl] & 0xffff0000u) * rr1 * gg[sl].y); }
        }
#undef TOK
    }
#undef FIDS
#undef FLOAD
#undef FUMATH
#undef FVMATH
}
}
#define GAS __attribute__((address_space(1)))
#define LAS __attribute__((address_space(3)))
typedef unsigned short bf16;
typedef unsigned v4u __attribute__((ext_vector_type(4)));
typedef unsigned v2u __attribute__((ext_vector_type(2)));
typedef float f32x4 __attribute__((ext_vector_type(4)));
typedef short bf16x8 __attribute__((ext_vector_type(8)));
typedef GAS unsigned gu32;
typedef GAS unsigned long long gu64;
#define RLX_AGENT __ATOMIC_RELAXED, __HIP_MEMORY_SCOPE_AGENT
#define LDS_WAIT() asm volatile("s_waitcnt lgkmcnt(0)" ::: "memory")
#define VM_WAIT() asm volatile("s_waitcnt vmcnt(0)" ::: "memory")
__device__ __forceinline__ unsigned long long rt() { return __builtin_amdgcn_s_memrealtime(); }
__device__ __forceinline__ unsigned f2bf(float f) { unsigned u = __builtin_bit_cast(unsigned, f); return (u + 0x7fffu + ((u >> 16) & 1u)) >> 16; }
__device__ __forceinline__ unsigned pk2(float lo, float hi) { return f2bf(lo) | (f2bf(hi) << 16); }

#define XB_TMO      128
#define XB_XCNT(j)  (256  + 64 * (j))
#define XB_XSUB(j)  (1280 + 64 * (j))
#define XB_XGEN(j)  (2304 + 64 * (j))
#define XB_TOP      3328
#define XB_TOPGEN   3392
#define XCD_BAR_WORDS 3456
#define XB_SPIN_CAP (1u << 18)

__device__ __forceinline__ unsigned xb_ld(unsigned* p)              { return __hip_atomic_load(p, __ATOMIC_RELAXED, __HIP_MEMORY_SCOPE_AGENT); }
__device__ __forceinline__ unsigned xb_add(unsigned* p, unsigned v) { return __hip_atomic_fetch_add(p, v, __ATOMIC_RELAXED, __HIP_MEMORY_SCOPE_AGENT); }
__device__ __forceinline__ unsigned xb_xcc_id() { return (unsigned)__builtin_amdgcn_s_getreg((3 << 11) | 20) & 0xFu; }
#define XB_SPIN(cond, bar) do { unsigned _sp = 0; while (cond) { __builtin_amdgcn_s_sleep(1); \
    if ((++_sp & 255u) == 0u) { if (xb_ld(&(bar)[XB_TMO])) break; if (_sp > XB_SPIN_CAP) { atomicAdd(&(bar)[XB_TMO], 1u); break; } } } } while (0)

struct XcdBarrier {
    unsigned* bar; unsigned x;
    volatile LAS unsigned* st;
};

__device__ __forceinline__ XcdBarrier xcd_barrier_post(unsigned* bar, volatile LAS unsigned* st) {
    XcdBarrier b; b.bar = bar; b.x = xb_xcc_id(); b.st = st;
    if (threadIdx.x == 0) (void)xb_add(&bar[XB_XCNT(b.x)], 1u);
    return b;
}
__device__ __forceinline__ void xcd_barrier_complete(unsigned* bar, unsigned x, unsigned& nloc, unsigned& nx) {
    const unsigned G = gridDim.x * gridDim.y * gridDim.z;
    unsigned sum, cnt, mine, sp = 0u;
    for (;;) {
        sum = 0u; cnt = 0u; mine = 0u;
#pragma unroll
        for (unsigned j = 0; j < 16; ++j) { const unsigned c = xb_ld(&bar[XB_XCNT(j)]); sum += c; cnt += (c > 0u) ? 1u : 0u; mine = (j == x) ? c : mine; }
        if (sum == G) break;
        __builtin_amdgcn_s_sleep(1);
        if ((++sp & 255u) == 0u) { if (xb_ld(&bar[XB_TMO])) break; if (sp > XB_SPIN_CAP) { atomicAdd(&bar[XB_TMO], 1u); break; } }
    }
    nloc = mine > 0u ? mine : 1u; nx = cnt > 0u ? cnt : 1u;
}

__device__ __forceinline__ void xcd_barrier(const XcdBarrier& b) {
    asm volatile("s_waitcnt vmcnt(0)" ::: "memory");
    __syncthreads();
    if (threadIdx.x == 0) {
        unsigned* bar = b.bar;
        __builtin_amdgcn_s_waitcnt(0);
        unsigned nloc = b.st[0], nx = b.st[1];
        if (nloc == 0u) { xcd_barrier_complete(bar, b.x, nloc, nx); b.st[0] = nloc; b.st[1] = nx; }
        const unsigned old = xb_add(&bar[XB_XSUB(b.x)], 1u);
        const unsigned gen = old / nloc;
        if (old + 1u == (gen + 1u) * nloc) {
            __builtin_amdgcn_fence(__ATOMIC_RELEASE, "agent");
            asm volatile("s_waitcnt vmcnt(0)" ::: "memory");
            const unsigned og = xb_add(&bar[XB_TOP], 1u);
            const unsigned tg = og / nx;
            if (og + 1u == (tg + 1u) * nx) xb_add(&bar[XB_TOPGEN], 1u);
            else XB_SPIN(xb_ld(&bar[XB_TOPGEN]) == tg, bar);
            __builtin_amdgcn_fence(__ATOMIC_ACQUIRE, "agent");
            xb_add(&bar[XB_XGEN(b.x)], 1u);
            asm volatile("s_waitcnt vmcnt(0)" ::: "memory");
        } else {
            XB_SPIN(xb_ld(&bar[XB_XGEN(b.x)]) == gen, bar);
            __builtin_amdgcn_fence(__ATOMIC_ACQUIRE, "agent");
            asm volatile("s_waitcnt vmcnt(0)" ::: "memory");
        }
    }
    __syncthreads();
}

typedef unsigned short bf16_t;
__device__ __forceinline__ float bf2f(bf16_t v) { return __uint_as_float((unsigned)v << 16); }
__device__ __forceinline__ float gelu_exact(float v) { return 0.5f * v * (1.0f + erff(v * 0.70710678118654752f)); }
__device__ __forceinline__ float log_sigmoid(float z) { return z > 0.f ? -log1pf(expf(-z)) : z - log1pf(expf(z)); }
__device__ __forceinline__ float wave_sum(float v) {
    return wave_allsum(v);
}
__device__ __forceinline__ float wave_max(float v) {
    return wave_allmax(v);
}

#ifndef RP7
#define RP7 1
#endif
#ifndef RP8
#define RP8 1
#endif
#ifndef RP9
#define RP9 1
#endif
#ifndef RP0
#define RP0 1
#endif
#ifndef RP1
#define RP1 1
#endif
#ifndef RP12
#define RP12 1
#endif
#ifndef RP3
#define RP3 1
#endif
#ifndef RP4
#define RP4 1
#endif
#ifndef RP5
#define RP5 1
#endif
#ifndef RP6
#define RP6 1
#endif
#ifndef QORDER
#define QORDER 1
#endif
#ifndef CONV_P0_FROM
#define CONV_P0_FROM (2 * NEXP)
#endif
#ifndef CONV_SPLIT
#define CONV_SPLIT (NEXP / 2)
#endif
constexpr int NWAVES = 8;
constexpr int RING_OFF = 0, RING_BYTES = 157696;
constexpr int LDSCTL_OFF = RING_BYTES, MISC_OFF = LDSCTL_OFF + 320;
constexpr int LDS_BYTES = 158720;
constexpr int CW_BAR = 4096, CW_QUEUE = 3072, CW_CMAX = 8192, CMAX_WQ = 4864;
constexpr int N_PHASES = 9;

struct Args { const float* in[17]; float* out; unsigned char* ws; int ph_lo, ph_hi, li, pad; };

__device__ __forceinline__ void p0_transpose_item(const float* W, int ldw, int col0, int K, bf16* WT, int row0, LAS float* scr, int item, int nblk, int lane, float sc = 1.0f) {
    const int kb = item / nblk, nb = item % nblk, k0 = 64 * kb, n0 = 32 * nb;
    f32x4 v[8];
#pragma unroll
    for (int i = 0; i < 8; ++i) v[i] = *(const GAS f32x4*)(W + (size_t)(k0 + 8 * i + (lane >> 3)) * ldw + col0 + n0 + 4 * (lane & 7));
#pragma unroll
    for (int i = 0; i < 8; ++i) *(LAS f32x4*)(scr + (8 * i + (lane >> 3)) * 36 + 4 * (lane & 7)) = v[i];
    LDS_WAIT(); asm volatile("" ::: "memory");
    const int c = lane & 7;
#pragma unroll
    for (int j = 0; j < 4; ++j) { const int n = (lane >> 3) + 8 * j; const LAS float* s = scr + (8 * c) * 36 + n;
        v4u o; o.x = pg8::cvt_pk_bf16(s[0 * 36] * sc, s[1 * 36] * sc); o.y = pg8::cvt_pk_bf16(s[2 * 36] * sc, s[3 * 36] * sc); o.z = pg8::cvt_pk_bf16(s[4 * 36] * sc, s[5 * 36] * sc); o.w = pg8::cvt_pk_bf16(s[6 * 36] * sc, s[7 * 36] * sc);
        *(GAS v4u*)(WT + (size_t)(row0 + n0 + n) * K + k0 + 8 * c) = o; }
    LDS_WAIT(); asm volatile("" ::: "memory");
}
__device__ __forceinline__ void p0_transpose_item_i8(const float* W, int ldw, int col0, int K, unsigned char* WT8, float* sB, int row0, const unsigned* colmax, LAS float* scr, int item, int nblk, int lane) {
    const int kb = item / nblk, nb = item % nblk, k0 = 64 * kb, n0 = 32 * nb;
    f32x4 v[8];
#pragma unroll
    for (int i = 0; i < 8; ++i) v[i] = *(const GAS f32x4*)(W + (size_t)(k0 + 8 * i + (lane >> 3)) * ldw + col0 + n0 + 4 * (lane & 7));
#pragma unroll
    for (int i = 0; i < 8; ++i) *(LAS f32x4*)(scr + (8 * i + (lane >> 3)) * 36 + 4 * (lane & 7)) = v[i];
    LDS_WAIT(); asm volatile("" ::: "memory");
    const int c = lane & 3;
#pragma unroll
    for (int j = 0; j < 2; ++j) { const int n = (lane >> 2) + 16 * j; const LAS float* s = scr + (16 * c) * 36 + n;
        const float am = __uint_as_float(colmax[col0 + n0 + n]); const float qs = am > 0.f ? 127.0f / am : 0.f;
        v4u o;
        o.x = peer_body::pack_i8x4(s[0 * 36] * qs, s[1 * 36] * qs, s[2 * 36] * qs, s[3 * 36] * qs); o.y = peer_body::pack_i8x4(s[4 * 36] * qs, s[5 * 36] * qs, s[6 * 36] * qs, s[7 * 36] * qs);
        o.z = peer_body::pack_i8x4(s[8 * 36] * qs, s[9 * 36] * qs, s[10 * 36] * qs, s[11 * 36] * qs); o.w = peer_body::pack_i8x4(s[12 * 36] * qs, s[13 * 36] * qs, s[14 * 36] * qs, s[15 * 36] * qs);
        *(GAS v4u*)(WT8 + (size_t)(row0 + n0 + n) * K + k0 + 16 * c) = o;
        if (kb == 0 && c == 0) sB[row0 + n0 + n] = am * (1.0f / 127.0f); }
    LDS_WAIT(); asm volatile("" ::: "memory");
}
__device__ __forceinline__ void p0_colmax_task(const float* W, int ldw, int ncols, unsigned* colmax, int task, int lane) {
    const int ncb = (ncols + 255) / 256, cb = task % ncb, rb = task / ncb, c = 256 * cb + 4 * lane;
    if (c >= ncols) return;
    f32x4 m = (f32x4){0.f, 0.f, 0.f, 0.f};
#pragma unroll 8
    for (int i = 0; i < 32; ++i) { const f32x4 v = *(const GAS f32x4*)(W + (size_t)(32 * rb + i) * ldw + c);
        m.x = fmaxf(m.x, fabsf(v.x)); m.y = fmaxf(m.y, fabsf(v.y)); m.z = fmaxf(m.z, fabsf(v.z)); m.w = fmaxf(m.w, fabsf(v.w)); }
    atomicMax(colmax + c, __float_as_uint(m.x)); atomicMax(colmax + c + 1, __float_as_uint(m.y)); atomicMax(colmax + c + 2, __float_as_uint(m.z)); atomicMax(colmax + c + 3, __float_as_uint(m.w));
}
__device__ __forceinline__ void cvt_chunks(const float* src, bf16* dst, size_t nchunks, size_t gtid, size_t nthr) {
    for (size_t c = gtid; c < nchunks; c += nthr) { const f32x4 a = ((const GAS f32x4*)src)[2 * c], b = ((const GAS f32x4*)src)[2 * c + 1];
        v4u o; o.x = pg8::cvt_pk_bf16(a.x, a.y); o.y = pg8::cvt_pk_bf16(a.z, a.w); o.z = pg8::cvt_pk_bf16(b.x, b.y); o.w = pg8::cvt_pk_bf16(b.z, b.w);
        ((GAS v4u*)dst)[c] = o; }
}

template <int NR> __device__ __forceinline__ void convert_rows(int e0, const float* eu, const float* ev, unsigned char* ws, int lane) {
                const bool isV = e0 >= NEXP; const int row0 = isV ? e0 - NEXP : e0;
                const float* tab = isV ? ev : eu;
                f32x4 v[NR][4];
#pragma unroll
                for (int rr = 0; rr < NR; ++rr)
#pragma unroll
                    for (int i = 0; i < 4; ++i) v[rr][i] = __builtin_nontemporal_load((const GAS f32x4*)(tab + (size_t)(row0 + rr) * D + 16 * lane) + i);
#pragma unroll
                for (int rr = 0; rr < NR; ++rr) {
                    const int row = row0 + rr; float am = 0.f;
#pragma unroll
                    for (int i = 0; i < 4; ++i) am = fmaxf(fmaxf(am, fmaxf(fabsf(v[rr][i].x), fabsf(v[rr][i].y))), fmaxf(fabsf(v[rr][i].z), fabsf(v[rr][i].w)));
                    am = wave_allmax(am);
                    v4u q;
                    if (!isV) { const float inv = am > 0.f ? 127.0f / am : 0.f;
                        q.x = peer_body::pack_i8x4(v[rr][0].x * inv, v[rr][0].y * inv, v[rr][0].z * inv, v[rr][0].w * inv); q.y = peer_body::pack_i8x4(v[rr][1].x * inv, v[rr][1].y * inv, v[rr][1].z * inv, v[rr][1].w * inv);
                        q.z = peer_body::pack_i8x4(v[rr][2].x * inv, v[rr][2].y * inv, v[rr][2].z * inv, v[rr][2].w * inv); q.w = peer_body::pack_i8x4(v[rr][3].x * inv, v[rr][3].y * inv, v[rr][3].z * inv, v[rr][3].w * inv);
                        *(GAS v4u*)(ws + WS_EU + (size_t)(lane >> 3) * ((size_t)NEXP * 128) + (size_t)row * 128 + (lane & 7) * 16) = q; if (lane == 0) ((GAS float*)(ws + WS_SU))[row] = am * (1.0f / 127.0f); }
                    else { const float inv = am > 0.f ? 127.0f / am : 0.f;
                        q.x = peer_body::pack_i8x4(v[rr][0].x * inv, v[rr][0].y * inv, v[rr][0].z * inv, v[rr][0].w * inv); q.y = peer_body::pack_i8x4(v[rr][1].x * inv, v[rr][1].y * inv, v[rr][1].z * inv, v[rr][1].w * inv);
                        q.z = peer_body::pack_i8x4(v[rr][2].x * inv, v[rr][2].y * inv, v[rr][2].z * inv, v[rr][2].w * inv); q.w = peer_body::pack_i8x4(v[rr][3].x * inv, v[rr][3].y * inv, v[rr][3].z * inv, v[rr][3].w * inv);
                        *(GAS v4u*)(ws + WS_EV + (size_t)(lane >> 3) * ((size_t)NEXP * 128) + (size_t)row * 128 + (lane & 7) * 16) = q; if (lane == 0) ((GAS float*)(ws + WS_SV))[row] = am * (1.0f / 127.0f); }
                }
}

__global__ void __launch_bounds__(NWAVES * 64, 2) skel_fwd(Args args) {
    extern __shared__ __attribute__((aligned(16))) unsigned char lds[];
    LAS unsigned char* L = (LAS unsigned char*)lds;
    volatile LAS unsigned* MISC = (volatile LAS unsigned*)(L + MISC_OFF);
    const int G = gridDim.x; const int bx = blockIdx.x; const int vcu = (G % 8 == 0) ? (bx % 8) * (G / 8) + bx / 8 : bx;
    for (int u = threadIdx.x; u < (LDS_BYTES - LDSCTL_OFF) / 4; u += NWAVES * 64) ((LAS unsigned*)(L + LDSCTL_OFF))[u] = 0u;
    __syncthreads();
    (void)xcd_barrier_post((unsigned*)((gu32*)(args.ws + WS_CTL) + CW_BAR) + args.li * XCD_BAR_WORDS, MISC + 8);
#define PHASE_VARS \
    GAS unsigned char* wsg_ = (GAS unsigned char*)args.ws; asm volatile("" : "+s"(wsg_)); unsigned char* ws = (unsigned char*)wsg_; GAS float* outg_ = (GAS float*)args.out; asm volatile("" : "+s"(outg_)); float* out = (float*)outg_; \
    int tid = threadIdx.x; asm volatile("" : "+v"(tid)); const int lane = tid & 63, wave = __builtin_amdgcn_readfirstlane(tid >> 6); (void)lane; (void)wave; \
    gu32* ctl = (gu32*)(ws + WS_CTL); (void)ctl; const float* x = args.in[0]; (void)x; \
    bf16* XN = (bf16*)(ws + WS_XN); bf16* Qb = (bf16*)(ws + WS_Q); bf16* UG = (bf16*)(ws + WS_UG); (void)XN; (void)Qb; (void)UG; \
    bf16* GATE = (bf16*)out; bf16* MERGED = (bf16*)(ws + WS_MERGED); bf16* QP = (bf16*)(ws + WS_QP); (void)GATE; (void)MERGED; (void)QP; \
    float* LOGF = (float*)(ws + WS_LOGF); float* CL2 = (float*)(ws + WS_CL2); (void)LOGF; (void)CL2; \
    const int gw = vcu * NWAVES + wave, NGW = G * NWAVES; (void)gw; (void)NGW;
    const int lo = args.ph_lo, hi = args.ph_hi;
#ifndef PHMASK
#define PHMASK 0x1ff
#endif
#define IN(k) (((PHMASK >> (k)) & 1) && lo <= (k) && (k) < hi)
#define BOTH(k) (IN(k) && IN((k) + 1))
#ifdef TIMEPH
    if (bx == 0 && threadIdx.x == 0) { const unsigned long long t0_ = rt(); MISC[24] = (unsigned)t0_; }
#define GRID_BAR(k) do { XcdBarrier b_; b_.bar = (unsigned*)((gu32*)(args.ws + WS_CTL) + CW_BAR) + args.li * XCD_BAR_WORDS; b_.x = xb_xcc_id(); b_.st = MISC + 8; xcd_barrier(b_); if (bx == 0 && threadIdx.x == 0) { gu32* ctl = (gu32*)(args.ws + WS_CTL); const unsigned t_now = (unsigned)rt(); __hip_atomic_store(ctl + 2048 + (k), t_now - MISC[24], RLX_AGENT); MISC[24] = t_now; } } while (0)
#else
#define GRID_BAR(k) do { XcdBarrier b_; b_.bar = (unsigned*)((gu32*)(args.ws + WS_CTL) + CW_BAR) + args.li * XCD_BAR_WORDS; b_.x = xb_xcc_id(); b_.st = MISC + 8; xcd_barrier(b_); } while (0)
#endif

    for (int rp_ = 0; rp_ < RP0; ++rp_) if (IN(0)) {
        PHASE_VARS
        LAS float* scr = (LAS float*)(L + RING_OFF + wave * 16384);
        const float* w_in = args.in[2];
        unsigned* cmax_in = (unsigned*)(ctl + CW_CMAX);
        {
            constexpr int T_IN = ((IN_W + 255) / 256) * (D / 32);
            constexpr int T_WQ = (QPW / 256) * (D / 32);
            for (int it = gw; it < T_IN + T_WQ; it += NGW) { if (it < T_IN) p0_colmax_task(w_in, IN_W, IN_W, cmax_in, it, lane); else p0_colmax_task(args.in[12], QPW, QPW, cmax_in + CMAX_WQ, it - T_IN, lane); }
            GRID_BAR(0);
        }
        {
            constexpr int I_A = 16 * 48, I_B = 16 * 96, I_WA = 8 * 32, I_WB = 8 * 32, I_WO = 16 * 32, I_WQ = 16 * 64;
            constexpr int NITEMS = I_A + I_B + I_WA + I_WB + I_WO + I_WQ;
            for (int it = gw; it < NITEMS; it += NGW) {
                int r = it;
                if (r < I_A) { p0_transpose_item_i8(w_in, IN_W, 0, D, ws + WS_WIN, (float*)(ws + WS_SBW), 0, cmax_in, scr, r, 48, lane); continue; } r -= I_A;
                if (r < I_B) { p0_transpose_item_i8(w_in, IN_W, OFF_UG, D, ws + WS_WIN, (float*)(ws + WS_SBW), 1536, cmax_in, scr, r, 96, lane); continue; } r -= I_B;
                if (r < I_WA) { p0_transpose_item(args.in[8], D, 0, AW, (bf16*)(ws + WS_WA), 0, scr, r, 32, lane, 1.0f / 255.0f); continue; } r -= I_WA;
                if (r < I_WB) { p0_transpose_item(args.in[9], D, 0, SW, (bf16*)(ws + WS_WB), 0, scr, r, 32, lane, 1.0f / 255.0f); continue; } r -= I_WB;
                if (r < I_WO) { p0_transpose_item(args.in[10], D, 0, D, (bf16*)(ws + WS_WOUT), 0, scr, r, 32, lane); continue; } r -= I_WO;
                p0_transpose_item_i8(args.in[12], QPW, 0, D, ws + WS_WQ, (float*)(ws + WS_SBWQ), 0, cmax_in + CMAX_WQ, scr, r, 64, lane);
            }
        }
        {
            const size_t gtid = (size_t)gw * 64 + lane, nthr = (size_t)NGW * 64;
            cvt_chunks(args.in[13], (bf16*)(ws + WS_SK), (size_t)PH * 2 * PKEYS * PHALF / 8, gtid, nthr);
#pragma unroll 1
            for (int e0 = CONV_P0_FROM + 4 * gw; e0 < 2 * NEXP; e0 += 4 * NGW) convert_rows<4>(e0, args.in[14], args.in[15], ws, lane);
            const float* w_s = args.in[6]; bf16* wsm = (bf16*)(ws + WS_WSM);
            for (size_t c = gtid; c < (size_t)NG * CHUNK * CHUNK / 8; c += nthr) {
                const int pos = (int)((c * 8) & 127), t = (int)((c * 8) >> 7) & 127, ks = pos >> 4, hh = (pos >> 3) & 1, s0 = 16 * ks + 4 * hh, s1 = s0 + 8;
                const float* src = w_s + ((c * 8) & ~(size_t)127);
                const f32x4 a = *(const GAS f32x4*)(src + s0), b = *(const GAS f32x4*)(src + s1);
                v4u o; o.x = pg8::cvt_pk_bf16(s0 + 0 <= t ? a.x : 0.f, s0 + 1 <= t ? a.y : 0.f); o.y = pg8::cvt_pk_bf16(s0 + 2 <= t ? a.z : 0.f, s0 + 3 <= t ? a.w : 0.f);
                o.z = pg8::cvt_pk_bf16(s1 + 0 <= t ? b.x : 0.f, s1 + 1 <= t ? b.y : 0.f); o.w = pg8::cvt_pk_bf16(s1 + 2 <= t ? b.z : 0.f, s1 + 3 <= t ? b.w : 0.f);
                ((GAS v4u*)wsm)[c] = o; }
        }
        __syncthreads();
        {
            LAS float* wf = (LAS float*)(L + RING_OFF);
            for (int i = tid; i < 8 * D; i += NWAVES * 64) { const int k = i >> 3, c = i & 7; wf[c * D + k] = w_in[(size_t)k * IN_W + OFF_F + c]; }
            __syncthreads();
            const float* g1 = args.in[1]; const float* b_f = args.in[3];
            f32x4 gv[4];
#pragma unroll
            for (int j = 0; j < 4; ++j) gv[j] = ((const GAS f32x4*)g1)[lane + 64 * j];
#pragma unroll 1
            for (int m0 = 4 * gw; m0 < M; m0 += 4 * NGW) {
                f32x4 vv[4][4];
#pragma unroll
                for (int rr = 0; rr < 4; ++rr)
#pragma unroll
                    for (int j = 0; j < 4; ++j) vv[rr][j] = ((const GAS f32x4*)(x + (size_t)(m0 + rr) * D) + lane)[64 * j];
#pragma unroll
                for (int rr = 0; rr < 4; ++rr) {
                    const int m = m0 + rr; f32x4 v[4]; float s = 0.f;
#pragma unroll
                    for (int j = 0; j < 4; ++j) { v[j] = vv[rr][j]; s += (v[j].x * v[j].x + v[j].y * v[j].y) + (v[j].z * v[j].z + v[j].w * v[j].w); }
                    const float r = 1.0f / sqrtf(wave_sum(s) * (1.f / D) + EPS);
#pragma unroll
                    for (int j = 0; j < 4; ++j) v[j] = v[j] * r * gv[j];
                    {
                        float am = 0.f;
#pragma unroll
                        for (int j = 0; j < 4; ++j) am = fmaxf(fmaxf(am, fmaxf(fabsf(v[j].x), fabsf(v[j].y))), fmaxf(fabsf(v[j].z), fabsf(v[j].w)));
                        am = wave_allmax(am); const float qs = am > 0.f ? 127.0f / am : 0.f;
                        GAS unsigned* o4 = (GAS unsigned*)(ws + WS_XN + (size_t)m * D) + lane;
#pragma unroll
                        for (int j = 0; j < 4; ++j) o4[64 * j] = peer_body::pack_i8x4(v[j].x * qs, v[j].y * qs, v[j].z * qs, v[j].w * qs);
                        if (lane == 0) ((GAS float*)(ws + WS_SA))[m] = am * (1.0f / 127.0f); }
                    float fsum = 0.f;
#pragma unroll
                    for (int c = 0; c < 8; ++c) { float pp = 0.f;
#pragma unroll
                        for (int j = 0; j < 4; ++j) { const f32x4 w4 = *(const LAS f32x4*)(wf + c * D + 256 * j + 4 * lane); pp += (v[j].x * w4.x + v[j].y * w4.y) + (v[j].z * w4.z + v[j].w * w4.w); }
                        pp = wave_sum(pp); if (lane == c) fsum = pp; }
                    if (lane < 8) LOGF[(size_t)m * NH + lane] = log_sigmoid(fsum + b_f[lane]);
                }
            }
        }
        if (BOTH(0)) GRID_BAR(0);
    }

    for (int rp12_ = 0; rp12_ < RP12; ++rp12_) {
    for (int rp_ = 0; rp_ < RP1; ++rp_) if (IN(1)) {
        PHASE_VARS
        if (vcu < BATCH * NH) {
            const int b = vcu / NH, h = vcu % NH; LAS float* part = (LAS float*)(L + MISC_OFF + 64);
            float v[4];
#pragma unroll
            for (int i = 0; i < 4; ++i) v[i] = LOGF[(size_t)(b * SEQ + 4 * tid + i) * NH + h];
            v[1] += v[0]; v[2] += v[1]; v[3] += v[2];
            float tot = v[3];
#pragma unroll
            for (int o = 1; o < 64; o <<= 1) { const float u = __shfl_up(tot, o); if (lane >= o) tot += u; }
            if (lane == 63) part[wave] = tot;
            __syncthreads();
            float base = tot - v[3];
            for (int w = 0; w < wave; ++w) base += part[w];
#pragma unroll
            for (int i = 0; i < 4; ++i) CL2[(size_t)vcu * SEQ + 4 * tid + i] = (base + v[i]) * LOG2E;
            __syncthreads();
        }
        pg8::Gemm g{XN, (const bf16*)(ws + WS_WIN), M, NPROJ, D / 2}; pg8::StaticOrder S; S.init(M, NPROJ, G, bx);
        pg8::EpiProjI8 E{Qb, (size_t)M * 512, GATE, C2, (const float*)(ws + WS_SA), (const float*)(ws + WS_SBW)};
        pg8::gemm_phase<pg8::EpiProjI8, pg8::StaticOrder, true, true, true>(L + RING_OFF, g, S, E);
        {
            constexpr int NUN = (M / 256) * (NPROJ / 256);
            const int nmax = (NUN + G - 1) / G, nun = (NUN - bx + G - 1) / G;
            int ii_ = bx - (NUN - (nmax - 1) * G), nidle_ = G - (NUN - (nmax - 1) * G);
            if (nidle_ <= 0) { ii_ = bx; nidle_ = G; }
            if (nun < nmax || nidle_ == G) {
#pragma unroll 1
                for (int e0 = 4 * (ii_ * NWAVES + wave); e0 < CONV_SPLIT; e0 += 4 * nidle_ * NWAVES) convert_rows<4>(e0, args.in[14], args.in[15], ws, lane);
            }
        }
        if (BOTH(1)) GRID_BAR(1);
    }

    if (IN(2)) {
        PHASE_VARS
        static_assert(attn_body::ATTN_LDS_BYTES <= RING_BYTES && peer_body::PEER_FUSED_LDS <= RING_BYTES, "phase LDS");
#ifdef P2PROBE
        for (int pr_ = 0; pr_ < P2PROBE; ++pr_) {
            for (int u = vcu; u < 2 * (M / CHUNK); u += G)
                sgu_body::sgu_unit(u >> 1, u & 1, (const bf16*)(ws + WS_VG), UG, (bf16*)(ws + 232 * MiB), (const bf16*)(ws + WS_WSM), args.in[4], args.in[5], args.in[7], (char*)lds + RING_OFF);
#ifndef P2PROBE_SGU_ONLY
            const attn_body::AttnTensors ATp{(const attn_body::bf16*)Qb, (const attn_body::bf16*)(ws + WS_K), (const attn_body::bf16*)(ws + WS_V), (attn_body::bf16*)(ws + 216 * MiB), CL2};
            const attn_body::StaticOrder Sp(G, bx);
            attn_body::attn_phase<attn_body::StaticOrder>((char*)lds + RING_OFF, ATp, Sp);
#endif
            GRID_BAR(2);
        }
#endif
#ifndef CONVREP
#define CONVREP 1
#endif
        constexpr int NCONV1 = (CONV_P0_FROM - CONV_SPLIT) / 64, NCONVQ = CONVREP * NCONV1, NIL = NCONVQ < 512 ? NCONVQ : 512;
        for (;;) {
            __syncthreads();
            if (tid == 0) MISC[26] = __hip_atomic_fetch_add(ctl + CW_QUEUE, 1u, RLX_AGENT);
            __syncthreads();
            const int u = __builtin_amdgcn_readfirstlane((int)MISC[26]);
            if (u >= 768 + NCONVQ) break;
            int ua = -1, uc = -1, us = -1;
#if QORDER == 1
            if (u < NCONVQ) uc = u; else if (u < 512 + NCONVQ) ua = u - NCONVQ; else us = u - 512 - NCONVQ;
#elif QORDER == 3
            static_assert(NCONVQ == 384, "spread order: 2 attention : 3 conversion : 2 gating units per block of 7");
            if (u < 256) ua = u;
            else { const int v_ = u - 256, blk = v_ / 7, r_ = v_ - 7 * blk;
                if (r_ == 0 || r_ == 4) ua = 256 + 2 * blk + (r_ == 4); else if (r_ & 1) uc = 3 * blk + (r_ >> 1); else us = 2 * blk + (r_ == 6); }
#elif QORDER == 4
            static_assert(NCONVQ == 384, "spread order: 2 attention : 3 conversion per block of 5, gating units last");
            if (u < 256) ua = u;
            else if (u < 256 + 640) { const int v_ = u - 256, blk = v_ / 5, r_ = v_ - 5 * blk;
                if (r_ & 1) ua = 256 + 2 * blk + (r_ >> 1); else uc = 3 * blk + (r_ >> 1); }
            else us = u - 896;
#elif QORDER == 2
            if (u < 512) ua = u; else if (u < 768) us = u - 512; else uc = u - 768;
#else
            if (u < 2 * NIL) { if (u & 1) uc = u >> 1; else ua = u >> 1; }
            else if (u < 512 + NCONVQ) { if (NCONVQ > 512) uc = u - 512; else ua = u - NCONVQ; }
            else us = u - 512 - NCONVQ;
#endif
            if (ua >= 0) { const int qb = 7 - (ua >> 6), bh = ua & 63;
                const int t0 = attn_body::attn_first_tile(CL2, bh, qb);
                attn_body::attn_unit<8>(bh / NH, bh % NH, qb, (const attn_body::bf16*)Qb, (const attn_body::bf16*)(ws + WS_K), (const attn_body::bf16*)(ws + WS_V), (attn_body::bf16*)Qb, CL2, (char*)lds + RING_OFF, t0); }
            else if (uc >= 0) convert_rows<8>(CONV_SPLIT + 64 * (uc % NCONV1) + 8 * wave, args.in[14], args.in[15], ws, lane);
            else sgu_body::sgu_unit(us >> 1, us & 1, (const bf16*)(ws + WS_VG), UG, UG, (const bf16*)(ws + WS_WSM), args.in[4], args.in[5], args.in[7], (char*)lds + RING_OFF);
        }
        if (BOTH(2)) GRID_BAR(2);
    }
    }

    for (int rp_ = 0; rp_ < RP3; ++rp_) if (IN(3)) {
        PHASE_VARS
        static_assert(WS_UG - WS_Q == (size_t)pg8::MERGE_DPM * 256 * AW * 2 && WS_WB - WS_WA == (size_t)4 * 256 * AW * 2, "merge passes: buffer offsets");
        { pg8::Gemm g{Qb, (const bf16*)(ws + WS_WA), M, D, AW}; pg8::MergeOrder S; S.init(M, D, G, bx);
          pg8::EpiMergeAB E{GATE, MERGED};
          pg8::gemm_phase<pg8::EpiMergeAB, pg8::MergeOrder, true, true>(L + RING_OFF, g, S, E); }
        if (BOTH(3)) GRID_BAR(3);
    }

    for (int rp_ = 0; rp_ < RP4; ++rp_) if (IN(4)) {
        PHASE_VARS
        pg8::Gemm g{MERGED, (const bf16*)(ws + WS_WOUT), M, D, D}; pg8::StaticOrder S; S.init(M, D, G, bx);
        pg8::EpiResidB E{x, (bf16*)(ws + WS_X1B), D};
        pg8::gemm_phase<pg8::EpiResidB, pg8::StaticOrder, true, true>(L + RING_OFF, g, S, E);
        if (BOTH(4)) GRID_BAR(4);
    }

    for (int rp_ = 0; rp_ < RP5; ++rp_) if (IN(5)) {
        PHASE_VARS
        const float* g2 = args.in[11];
        f32x4 gv[4];
#pragma unroll
        for (int j = 0; j < 4; ++j) gv[j] = ((const GAS f32x4*)g2)[lane + 64 * j];
#pragma unroll 1
        for (int m0 = 4 * gw; m0 < M; m0 += 4 * NGW) {
            v2u vv[4][4];
#pragma unroll
            for (int rr = 0; rr < 4; ++rr)
#pragma unroll
                for (int j = 0; j < 4; ++j) vv[rr][j] = ((const GAS v2u*)(ws + WS_X1B + (size_t)(m0 + rr) * (D * 2)) + lane)[64 * j];
            asm volatile("" ::: "memory");
#pragma unroll
            for (int rr = 0; rr < 4; ++rr) {
                const int m = m0 + rr; f32x4 v[4]; float s = 0.f;
#pragma unroll
                for (int j = 0; j < 4; ++j) { const v2u w = vv[rr][j]; v[j] = (f32x4){__uint_as_float(w.x << 16), __uint_as_float(w.x & 0xffff0000u), __uint_as_float(w.y << 16), __uint_as_float(w.y & 0xffff0000u)};
                    s += (v[j].x * v[j].x + v[j].y * v[j].y) + (v[j].z * v[j].z + v[j].w * v[j].w); }
                const float r = 1.0f / sqrtf(wave_sum(s) * (1.f / D) + EPS);
                float am = 0.f;
#pragma unroll
                for (int j = 0; j < 4; ++j) { v[j] = v[j] * r * gv[j];
                    am = fmaxf(fmaxf(am, fmaxf(fabsf(v[j].x), fabsf(v[j].y))), fmaxf(fabsf(v[j].z), fabsf(v[j].w))); }
                am = wave_allmax(am);
                const float qs = am > 0.f ? 127.0f / am : 0.f;
#pragma unroll
                for (int j = 0; j < 4; ++j) { const unsigned q4 = peer_body::pack_i8x4(v[j].x * qs, v[j].y * qs, v[j].z * qs, v[j].w * qs);
                    *(GAS unsigned*)(ws + WS_H2Q + (size_t)(2 * j + (lane >> 5)) * ((size_t)M * 128) + (size_t)m * 128 + ((4 * lane) & 127)) = q4; ((GAS unsigned*)(ws + WS_XN + (size_t)m * D))[lane + 64 * j] = q4; }
                if (lane == 0) ((GAS float*)(ws + WS_ST))[m] = am * (1.0f / 127.0f);
            }
        }
        if (BOTH(5)) GRID_BAR(5);
    }

    for (int rp_ = 0; rp_ < RP6; ++rp_) if (IN(6)) {
        PHASE_VARS
        pg8::Gemm g{XN, (const bf16*)(ws + WS_WQ), M, QPW, D / 2}; pg8::StaticOrder S; S.init(M, QPW, G, bx);
        pg8::EpiBf16I8 E{QP, QPW, (const float*)(ws + WS_ST), (const float*)(ws + WS_SBWQ)};
        pg8::gemm_phase<pg8::EpiBf16I8, pg8::StaticOrder, true, true, true>(L + RING_OFF, g, S, E);
        if (BOTH(6)) GRID_BAR(6);
    }
    for (int rp_ = 0; rp_ < RP7; ++rp_) if (IN(7)) {
        PHASE_VARS
        for (int tk = vcu; tk < 8 * (M / 512); tk += G)
            peer_body::peer_retrieve(tk, QP, (const bf16*)(ws + WS_SK), (const float*)(ws + WS_SU), (const float*)(ws + WS_SV), (const float*)(ws + WS_ST),
                                     (bf16*)(ws + WS_PID), (float*)(ws + WS_G2), (float*)(ws + WS_PS2), (char*)lds + RING_OFF);
        if (BOTH(7)) GRID_BAR(7);
    }
    if (IN(8)) {
        PHASE_VARS
#ifdef TIMEPH
        const float oscale = 1.0f + sqrtf((float)(((__hip_atomic_load(ctl + 2048 + TIMEPH, RLX_AGENT) + TIMEOFF) / TIMEQ) * TIMEQ) * 1e-5f);
#else
        const float oscale = 1.0f;
#endif
        const int p = bx & 7, cntp = (G - p + 7) >> 3;
        peer_body::peer_fused(p, (bx >> 3) * NWAVES + wave, cntp * NWAVES, (const bf16*)(ws + WS_PID), (const float*)(ws + WS_G2), (const float*)(ws + WS_PS2), (const unsigned char*)(ws + WS_H2Q),
                              (const unsigned char*)(ws + WS_EU), (const unsigned char*)(ws + WS_EV), (const bf16*)(ws + WS_X1B), out, args.in[16], (char*)lds + RING_OFF, oscale);
    }
#undef IN
#undef BOTH
#undef GRID_BAR
}

extern "C" void kernel_launch(void* const* d_in, const int* in_sizes, int n_in, void* d_out, int out_size, void* d_ws, size_t ws_size, hipStream_t stream) {
    static int grid = 0;
    if (grid == 0) {
        int dev = 0, cus = 0;
        if (n_in != 17 || out_size != M * D || ws_size < WS_END) { fprintf(stderr, "kernel_launch: unexpected shapes (n_in %d out %d ws %zu)\n", n_in, out_size, ws_size); grid = -1; return; }
        if (hipGetDevice(&dev) != hipSuccess || hipDeviceGetAttribute(&cus, hipDeviceAttributeMultiprocessorCount, dev) != hipSuccess) { grid = -1; return; }
        if (hipFuncSetAttribute((const void*)skel_fwd, hipFuncAttributeMaxDynamicSharedMemorySize, LDS_BYTES) != hipSuccess) { fprintf(stderr, "kernel_launch: hipFuncSetAttribute failed\n"); grid = -1; return; }
        int per_cu = 0;
        if (hipOccupancyMaxActiveBlocksPerMultiprocessor(&per_cu, (const void*)skel_fwd, NWAVES * 64, LDS_BYTES) != hipSuccess || per_cu < 1) { fprintf(stderr, "kernel_launch: occupancy query says %d workgroups per CU\n", per_cu); grid = -1; return; }
        grid = cus;
    }
    if (grid < 0) return;
    unsigned char* ws = (unsigned char*)d_ws; float* out = (float*)d_out;
    (void)hipMemsetAsync(ws + WS_CTL, 0, CTL_ZERO_BYTES, stream);
    Args a{};
    for (int i = 0; i < 17; ++i) a.in[i] = (const float*)d_in[i];
    a.out = out; a.ws = ws;
#ifndef MULTI_LAUNCH
    {
        a.ph_lo = 0; a.ph_hi = N_PHASES; a.li = 0;
        void* kargs[] = {(void*)&a};
#ifdef PLAIN_LAUNCH
        hipLaunchKernelGGL(skel_fwd, dim3(grid), dim3(NWAVES * 64), LDS_BYTES, stream, a); const hipError_t e = hipPeekAtLastError(); (void)kargs;
#else
        const hipError_t e = hipLaunchCooperativeKernel((const void*)skel_fwd, dim3(grid), dim3(NWAVES * 64), kargs, LDS_BYTES, stream);
#endif
        if (e != hipSuccess) fprintf(stderr, "kernel_launch: cooperative launch failed: %s (grid %d)\n", hipGetErrorString(e), grid);
    }
#else
    for (int k = 0; k < N_PHASES; ++k) { a.ph_lo = k; a.ph_hi = k + 1; a.li = k; hipLaunchKernelGGL(skel_fwd, dim3(grid), dim3(NWAVES * 64), LDS_BYTES, stream, a); }
#endif
}
```
